# Optimizing an MI355X kernel written in HIP

```python
import jax, jax.numpy as jnp
from jax import lax
import numpy as np

D_MODEL = 2048
BATCH = 4
SEQ = 2048
DEPTH = 1
DEC_BATCH = 128
DEC_SEQ = 1
PAST_LEN = 16384
PAGE_SIZE = 128

BR_W = D_MODEL // 2
N_BRANCH = 3
GMLP_GROUPS = 4
CHUNK = 128
LRU_BLOCKS = 8
LRU_BLOCK = BR_W // LRU_BLOCKS
CONV_W = 4
LRU_C = 8.0
N_MEM = 256
XA_HEADS = 4
XA_HEAD_DIM = BR_W // XA_HEADS
D_FF = 5632
IN_COLS = 5 * BR_W + N_BRANCH * D_MODEL
LN_EPS = 1e-5
ALPHA = (2.0 * DEPTH) ** 0.25
BETA = (8.0 * DEPTH) ** -0.25

kernel_name = 'hybrid_gmlp_rglru_memxattn_decoder_step'


def layer_norm(x, g, b):
    xf = x.astype(jnp.float32)
    mu = jnp.mean(xf, axis=-1, keepdims=True)
    var = jnp.mean(jnp.square(xf - mu), axis=-1, keepdims=True)
    return ((xf - mu) * lax.rsqrt(var + LN_EPS) * g.astype(jnp.float32) + b.astype(jnp.float32)).astype(x.dtype)


def swiglu_ffn(x, w_gu, w_down):
    g, u = jnp.split(x @ w_gu, 2, axis=-1)
    return (jax.nn.silu(g) * u) @ w_down


def chunk_spatial_gate(u, v, w_s, b_s):
    bsz, t, c = v.shape
    cl = min(t, CHUNK)
    pad = (-t) % cl
    vp = jnp.pad(v, ((0, 0), (0, pad), (0, 0)))
    nc = (t + pad) // cl
    vc = vp.reshape(bsz, nc, cl, GMLP_GROUPS, c // GMLP_GROUPS)
    mask = jnp.tril(jnp.ones((cl, cl), dtype=bool))
    w = jnp.where(mask, w_s[:, :cl, :cl], jnp.zeros((), w_s.dtype))
    s = jnp.einsum('gts,bnsgc->bntgc', w, vc) + b_s[:, :cl].T[None, None, :, :, None]
    s = s.reshape(bsz, nc * cl, c)[:, :t]
    return u * s


def causal_conv(x, buf, w, b):
    t = x.shape[1]
    xp = jnp.concatenate([buf.astype(x.dtype), x], axis=1)
    out = b
    for k in range(CONV_W):
        out = out + xp[:, k:k + t] * w[k]
    return out, xp[:, -(CONV_W - 1):]


def rg_lru(x, h0, w_a, b_a, w_x, b_x, lam):
    bsz, t, c = x.shape
    xb = x.reshape(bsz, t, LRU_BLOCKS, LRU_BLOCK)
    r = jax.nn.sigmoid((jnp.einsum('btki,kij->btkj', xb, w_a).reshape(bsz, t, c) + b_a).astype(jnp.float32))
    i = jax.nn.sigmoid((jnp.einsum('btki,kij->btkj', xb, w_x).reshape(bsz, t, c) + b_x).astype(jnp.float32))
    log_a = -LRU_C * r * jax.nn.softplus(-lam.astype(jnp.float32))
    a = jnp.exp(log_a)
    bterm = jnp.sqrt(-jnp.expm1(2.0 * log_a)) * (i * x.astype(jnp.float32))
    bterm = bterm.at[:, 0].add(a[:, 0] * h0.astype(jnp.float32))

    def combine(p, q):
        a1, b1 = p
        a2, b2 = q
        return a1 * a2, a2 * b1 + b2

    _, h = lax.associative_scan(combine, (a, bterm), axis=1)
    return h.astype(x.dtype), h[:, -1].astype(x.dtype)


def cross_attention(q, k, v):
    s = jnp.einsum('bthd,bmhd->bhtm', q, k).astype(jnp.float32) * (XA_HEAD_DIM ** -0.5)
    p = jax.nn.softmax(s, axis=-1).astype(v.dtype)
    return jnp.einsum('bhtm,bmhd->bthd', p, v)


def memory_kv(mem, g, b, w_kv):
    bsz = mem.shape[0]
    k, v = jnp.split(layer_norm(mem, g, b) @ w_kv, 2, axis=-1)
    return (k.reshape(bsz, N_MEM, XA_HEADS, XA_HEAD_DIM), v.reshape(bsz, N_MEM, XA_HEADS, XA_HEAD_DIM))


def token_mixer(x, mem_k, mem_v, conv_buf, h0, p):
    bsz, t, _ = x.shape
    z = x @ p['w_in']
    u, v, rx, rg, q, gl = jnp.split(z, [BR_W, 2 * BR_W, 3 * BR_W, 4 * BR_W, 5 * BR_W], axis=-1)
    u = jax.nn.gelu(u)
    v = layer_norm(jax.nn.gelu(v), p['gmlp_ln_g'], p['gmlp_ln_b'])
    y_gmlp = chunk_spatial_gate(u, v, p['gmlp_w_s'], p['gmlp_b_s'])
    xc, new_buf = causal_conv(rx, conv_buf, p['conv_w'], p['conv_b'])
    h, h_last = rg_lru(xc, h0, p['lru_w_a'], p['lru_b_a'], p['lru_w_x'], p['lru_b_x'], p['lru_lambda'])
    y_lru = jax.nn.gelu(rg) * h
    y_xa = cross_attention(q.reshape(bsz, t, XA_HEADS, XA_HEAD_DIM), mem_k, mem_v).reshape(bsz, t, BR_W)
    ys = jnp.stack([y_gmlp, y_lru, y_xa], axis=2)
    proj = jnp.einsum('btkc,kcd->btkd', ys, p['w_branch'])
    gates = jax.nn.sigmoid(gl.reshape(bsz, t, N_BRANCH, D_MODEL) + p['gate_b'])
    merged = jnp.einsum('btkd,btkd->btd', gates, proj)
    return merged @ p['w_out'], v, new_buf, h_last


def decoder_layer(x, mem_k, mem_v, conv_buf, h0, p):
    x = layer_norm(ALPHA * x + 0.5 * swiglu_ffn(x, p['ffn1_w_gu'], p['ffn1_w_down']), p['ln1_g'], p['ln1_b'])
    m, v_rows, new_buf, h_last = token_mixer(x, mem_k, mem_v, conv_buf, h0, p)
    x = layer_norm(ALPHA * x + m, p['ln2_g'], p['ln2_b'])
    x = layer_norm(ALPHA * x + 0.5 * swiglu_ffn(x, p['ffn2_w_gu'], p['ffn2_w_down']), p['ln3_g'], p['ln3_b'])
    return x, v_rows, new_buf, h_last


def _nrm(key, shape, scale):
    return scale * jax.random.normal(key, shape, jnp.float32)


def _gain(key, shape):
    return 1.0 + _nrm(key, shape, 0.02)


def setup_inputs(seed: int = 0) -> dict:
    key = jax.random.key(seed)
    ks = list(jax.random.split(key, 48))
    L, D = DEPTH, D_MODEL
    x_prompt = _nrm(ks[0], (BATCH, SEQ, D), 1.0)
    x_sample = _nrm(ks[1], (DEC_BATCH, DEC_SEQ, D), 1.0)
    mem_prompt = _nrm(ks[2], (BATCH, N_MEM, D), 1.0)
    cache_mem_k = _nrm(ks[3], (L, DEC_BATCH, N_MEM, XA_HEADS, XA_HEAD_DIM), 1.0)
    cache_mem_v = _nrm(ks[4], (L, DEC_BATCH, N_MEM, XA_HEADS, XA_HEAD_DIM), BETA)
    state_conv = _nrm(ks[5], (L, DEC_BATCH, CONV_W - 1, BR_W), 1.0)
    state_lru_h = _nrm(ks[6], (L, DEC_BATCH, BR_W), 0.5)
    ffn1_w_gu = _nrm(ks[7], (L, D, 2 * D_FF), BETA * D ** -0.5)
    ffn1_w_down = _nrm(ks[8], (L, D_FF, D), BETA * D_FF ** -0.5)
    ln1_g = _gain(ks[9], (L, D))
    ln1_b = _nrm(ks[10], (L, D), 0.02)
    w_in = _nrm(ks[11], (L, D, IN_COLS), D ** -0.5)
    gate_b = _nrm(ks[12], (L, N_BRANCH, D), 0.1)
    gmlp_ln_g = _gain(ks[13], (L, BR_W))
    gmlp_ln_b = _nrm(ks[14], (L, BR_W), 0.02)
    gmlp_w_s = _nrm(ks[15], (L, GMLP_GROUPS, CHUNK, CHUNK), CHUNK ** -0.5)
    gmlp_b_s = 1.0 + _nrm(ks[16], (L, GMLP_GROUPS, CHUNK), 0.1)
    conv_w = _nrm(ks[17], (L, CONV_W, BR_W), CONV_W ** -0.5)
    conv_b = _nrm(ks[18], (L, BR_W), 0.02)
    lru_w_a = _nrm(ks[19], (L, LRU_BLOCKS, LRU_BLOCK, LRU_BLOCK), LRU_BLOCK ** -0.5)
    lru_b_a = _nrm(ks[20], (L, BR_W), 0.02)
    lru_w_x = _nrm(ks[21], (L, LRU_BLOCKS, LRU_BLOCK, LRU_BLOCK), LRU_BLOCK ** -0.5)
    lru_b_x = _nrm(ks[22], (L, BR_W), 0.02)
    a_c = jax.random.uniform(ks[23], (L, BR_W), jnp.float32, 0.9, 0.999)
    a_base = a_c ** (1.0 / LRU_C)
    lru_lambda = jnp.log(a_base) - jnp.log1p(-a_base)
    mem_ln_g = _gain(ks[24], (L, D))
    mem_ln_b = _nrm(ks[25], (L, D), 0.02)
    w_mem_kv = jnp.concatenate([_nrm(ks[26], (L, D, BR_W), D ** -0.5),
                                _nrm(ks[27], (L, D, BR_W), BETA * D ** -0.5)], axis=-1)
    w_branch = _nrm(ks[28], (L, N_BRANCH, BR_W, D), BETA * BR_W ** -0.5)
    w_out = _nrm(ks[29], (L, D, D), BETA * D ** -0.5)
    ln2_g = _gain(ks[30], (L, D))
    ln2_b = _nrm(ks[31], (L, D), 0.02)
    ffn2_w_gu = _nrm(ks[32], (L, D, 2 * D_FF), BETA * D ** -0.5)
    ffn2_w_down = _nrm(ks[33], (L, D_FF, D), BETA * D_FF ** -0.5)
    ln3_g = _gain(ks[34], (L, D))
    ln3_b = _nrm(ks[35], (L, D), 0.02)
    return {'x_prompt': x_prompt, 'x_sample': x_sample, 'mem_prompt': mem_prompt,
            'cache_mem_k': cache_mem_k, 'cache_mem_v': cache_mem_v,
            'state_conv': state_conv, 'state_lru_h': state_lru_h,
            'ffn1_w_gu': ffn1_w_gu, 'ffn1_w_down': ffn1_w_down, 'ln1_g': ln1_g, 'ln1_b': ln1_b,
            'w_in': w_in, 'gate_b': gate_b, 'gmlp_ln_g': gmlp_ln_g, 'gmlp_ln_b': gmlp_ln_b,
            'gmlp_w_s': gmlp_w_s, 'gmlp_b_s': gmlp_b_s, 'conv_w': conv_w, 'conv_b': conv_b,
            'lru_w_a': lru_w_a, 'lru_b_a': lru_b_a, 'lru_w_x': lru_w_x, 'lru_b_x': lru_b_x,
            'lru_lambda': lru_lambda, 'mem_ln_g': mem_ln_g, 'mem_ln_b': mem_ln_b, 'w_mem_kv': w_mem_kv,
            'w_branch': w_branch, 'w_out': w_out, 'ln2_g': ln2_g, 'ln2_b': ln2_b,
            'ffn2_w_gu': ffn2_w_gu, 'ffn2_w_down': ffn2_w_down, 'ln3_g': ln3_g, 'ln3_b': ln3_b}


def reference(x_prompt, x_sample, mem_prompt, cache_mem_k, cache_mem_v, state_conv, state_lru_h,
              ffn1_w_gu, ffn1_w_down, ln1_g, ln1_b, w_in, gate_b, gmlp_ln_g, gmlp_ln_b, gmlp_w_s, gmlp_b_s,
              conv_w, conv_b, lru_w_a, lru_b_a, lru_w_x, lru_b_x, lru_lambda, mem_ln_g, mem_ln_b, w_mem_kv,
              w_branch, w_out, ln2_g, ln2_b, ffn2_w_gu, ffn2_w_down, ln3_g, ln3_b):
    xp, xs = x_prompt, x_sample
    bsz_p = x_prompt.shape[0]
    mk_p, mv_p, cb_p, hh_p, cb_s, hh_s, vr_s = [], [], [], [], [], [], []
    for l in range(DEPTH):
        p = {'ffn1_w_gu': ffn1_w_gu[l], 'ffn1_w_down': ffn1_w_down[l], 'ln1_g': ln1_g[l], 'ln1_b': ln1_b[l],
             'w_in': w_in[l], 'gate_b': gate_b[l], 'gmlp_ln_g': gmlp_ln_g[l], 'gmlp_ln_b': gmlp_ln_b[l],
             'gmlp_w_s': gmlp_w_s[l], 'gmlp_b_s': gmlp_b_s[l], 'conv_w': conv_w[l], 'conv_b': conv_b[l],
             'lru_w_a': lru_w_a[l], 'lru_b_a': lru_b_a[l], 'lru_w_x': lru_w_x[l], 'lru_b_x': lru_b_x[l],
             'lru_lambda': lru_lambda[l], 'w_branch': w_branch[l], 'w_out': w_out[l],
             'ln2_g': ln2_g[l], 'ln2_b': ln2_b[l], 'ffn2_w_gu': ffn2_w_gu[l], 'ffn2_w_down': ffn2_w_down[l],
             'ln3_g': ln3_g[l], 'ln3_b': ln3_b[l]}
        k_p, v_p = memory_kv(mem_prompt, mem_ln_g[l], mem_ln_b[l], w_mem_kv[l])
        zbuf = jnp.zeros((bsz_p, CONV_W - 1, BR_W), xp.dtype)
        zh = jnp.zeros((bsz_p, BR_W), xp.dtype)
        xp, _, nb_p, nh_p = decoder_layer(xp, k_p, v_p, zbuf, zh, p)
        xs, vrows_s, nb_s, nh_s = decoder_layer(xs, cache_mem_k[l], cache_mem_v[l], state_conv[l], state_lru_h[l], p)
        mk_p.append(k_p)
        mv_p.append(v_p)
        cb_p.append(nb_p)
        hh_p.append(nh_p)
        cb_s.append(nb_s)
        hh_s.append(nh_s)
        vr_s.append(vrows_s)
    return (xp, xs, jnp.stack(mk_p), jnp.stack(mv_p), jnp.stack(cb_p), jnp.stack(hh_p),
            jnp.stack(cb_s), jnp.stack(hh_s), jnp.stack(vr_s))
```

```cpp
#include <hip/hip_runtime.h>
#include <hip/hip_cooperative_groups.h>
#include <cstdio>
#include <cstdint>
namespace cg = cooperative_groups;

#define LAS __attribute__((address_space(3)))
typedef unsigned short bf16_t;
typedef short bf16x8 __attribute__((ext_vector_type(8)));
typedef short bf16x4 __attribute__((ext_vector_type(4)));
typedef float f32x4 __attribute__((ext_vector_type(4)));
typedef float f32x2 __attribute__((ext_vector_type(2)));
typedef unsigned u32x4 __attribute__((ext_vector_type(4)));
typedef unsigned u32x2 __attribute__((ext_vector_type(2)));

constexpr int D = 2048, FF = 5632, BW = 1024, NZ = 11264;
constexpr int MP = 8192, MS = 128, MR = MP + MS, MPAD = 8448;
constexpr int SEQ = 2048, NB = 4, NMEM = 256, NH = 4, HD = 256;
constexpr float LN_EPS = 1e-5f;
constexpr float ALPHA = 1.189207115002721f;
constexpr int NTHREADS = 512, NWAVES = 8;

constexpr int XCD_BAR_WORDS_ = 3456;
constexpr size_t al256(size_t x) { return (x + 255) & ~(size_t)255; }
constexpr size_t WS_WGU1 = 0;
constexpr size_t WS_WD1 = WS_WGU1 + al256((size_t)NZ * D * 2);
constexpr size_t WS_WIN = WS_WD1 + al256((size_t)D * FF * 2);
constexpr size_t WS_WKV = WS_WIN + al256((size_t)NZ * D * 2);
constexpr size_t WS_WBR = WS_WKV + al256((size_t)D * D * 2);
constexpr size_t WS_WOUT = WS_WBR + al256((size_t)3 * D * BW * 2);
constexpr size_t WS_WGU2 = WS_WOUT + al256((size_t)D * D * 2);
constexpr size_t WS_WD2 = WS_WGU2 + al256((size_t)NZ * D * 2);
constexpr size_t WS_WLRU = WS_WD2 + al256((size_t)D * FF * 2);
constexpr size_t WS_WSP = WS_WLRU + al256((size_t)8 * 256 * 128 * 2);
constexpr size_t WS_XB = WS_WSP + al256((size_t)4 * 128 * 128 * 2);
constexpr size_t WS_ZH = WS_XB + al256((size_t)MPAD * D * 2);
constexpr size_t WS_Y = WS_ZH + al256((size_t)MPAD * NZ * 2);
constexpr size_t WS_X1 = WS_Y + al256((size_t)MPAD * D * 4);
constexpr size_t WS_VP = WS_X1 + al256((size_t)MPAD * D * 4);
constexpr size_t WS_HL = WS_VP + al256((size_t)MPAD * BW * 2);
constexpr size_t WS_AC = WS_HL + al256((size_t)MP * BW * 4);
constexpr size_t WS_SUM = WS_AC + al256((size_t)MP * BW * 4);
constexpr size_t WS_YS = WS_SUM + al256((size_t)64 * 2 * BW * 4);
constexpr size_t WS_MEMLN = WS_YS + al256((size_t)MPAD * 3 * BW * 2);
constexpr size_t WS_KB = WS_MEMLN + al256((size_t)1024 * D * 2);
constexpr size_t WS_VT = WS_KB + al256((size_t)1024 * 1024 * 2);
constexpr size_t WS_BAR = WS_VT + al256((size_t)1024 * 1024 * 2);
constexpr size_t WS_END = WS_BAR + al256((size_t)XCD_BAR_WORDS_ * 4);

constexpr size_t O_Y = 0;
constexpr size_t O_MK = (size_t)MR * D;
constexpr size_t O_MV = O_MK + (size_t)1024 * 1024;
constexpr size_t O_CP = O_MV + (size_t)1024 * 1024;
constexpr size_t O_HP = O_CP + (size_t)4 * 3 * 1024;
constexpr size_t O_CS = O_HP + (size_t)4 * 1024;
constexpr size_t O_HS = O_CS + (size_t)128 * 3 * 1024;
constexpr size_t O_VS = O_HS + (size_t)128 * 1024;
constexpr size_t O_END = O_VS + (size_t)128 * 1024;

constexpr int LDS_BYTES = 159744;

struct Params { const float* in[35]; float* out; unsigned char* ws; };
enum { I_XP = 0, I_XS, I_MEM, I_CK, I_CV, I_SCONV, I_SLRU, I_GU1, I_DN1, I_LN1G, I_LN1B, I_WIN, I_GATEB, I_GLNG, I_GLNB, I_WS, I_BS, I_CONVW, I_CONVB,
       I_LWA, I_LBA, I_LWX, I_LBX, I_LAM, I_MLNG, I_MLNB, I_WKV, I_WBR, I_WOUT, I_LN2G, I_LN2B, I_GU2, I_DN2, I_LN3G, I_LN3B };

__device__ __forceinline__ unsigned cvt_pk_bf16(float lo, float hi) { unsigned r; asm volatile("v_cvt_pk_bf16_f32 %0, %1, %2" : "=v"(r) : "v"(lo), "v"(hi)); return r; }
__device__ __forceinline__ float bf2f(unsigned short b) { return __uint_as_float(((unsigned)b) << 16); }
__device__ __forceinline__ float bflo(unsigned w) { return __uint_as_float(w << 16); }
__device__ __forceinline__ float bfhi(unsigned w) { return __uint_as_float(w & 0xffff0000u); }
__device__ __forceinline__ float sigmoidf_(float x) { return __builtin_amdgcn_rcpf(1.0f + __expf(-x)); }
__device__ __forceinline__ float siluf_(float x) { return x * sigmoidf_(x); }
__device__ __forceinline__ float gelu_tanh(float x) { return x * sigmoidf_(1.5957691216057308f * (x + 0.044715f * x * x * x)); }
__device__ __forceinline__ float wave_sum(float v) {
#pragma unroll
    for (int o = 1; o < 64; o <<= 1) v += __shfl_xor(v, o);
    return v;
}
__device__ __forceinline__ float wave_max(float v) {
#pragma unroll
    for (int o = 1; o < 64; o <<= 1) v = fmaxf(v, __shfl_xor(v, o));
    return v;
}

namespace pg8 {
constexpr int BM = 256, BK = 64, HALF = 128, HTB = HALF * BK * 2, STAGE_BYTES = 8 * HTB, NXCD = 8, WGM = 8;
__host__ __device__ __forceinline__ int lds_byte(int r, int c) { const int st = (r >> 4) * 2 + (c >> 5), rr = r & 15, cc = c & 31, ob = rr * 64 + cc * 2; return st * 1024 + (ob ^ (((ob >> 9) & 1) << 5)); }
__host__ __device__ __forceinline__ void stage_rc(int b, int& R, int& C) { const int st = b / 1024, sb = b % 1024, swz = sb ^ (((sb >> 9) & 1) << 5); R = (st >> 1) * 16 + swz / 64; C = (st & 1) * 32 + (swz % 64) / 2; }
__host__ __device__ __forceinline__ int perm32(int rho) { const int n = rho >> 4, i = rho & 15; return 8 * (i >> 2) + 4 * n + (i & 3); }

struct Unit { const char* A; const char* B; int pm, pn, kind; };

__device__ __forceinline__ void tile_of(int wgid, int nM, int nN, int& pm, int& pn) {
    const int nwg = nM * nN;
    { const int q = nwg / NXCD, r = nwg % NXCD, xcd = wgid % NXCD, off = wgid / NXCD; wgid = (xcd < r ? xcd * (q + 1) : r * (q + 1) + (xcd - r) * q) + off; }
    const int nig = WGM * nN, gid = wgid / nig, fm = gid * WGM, gsz = (nM - fm) < WGM ? (nM - fm) : WGM;
    pm = fm + ((wgid % nig) % gsz); pn = (wgid % nig) / gsz;
}
struct PlainSched {
    const bf16_t* A; const bf16_t* Bt; int nM, nN, lda, ldb, G, c;
    __device__ __forceinline__ bool next(int i, Unit& u) const {
        const int L = i * G + c; if (L >= nM * nN) return false;
        tile_of(L, nM, nN, u.pm, u.pn); u.kind = 0;
        u.A = (const char*)(A + (size_t)u.pm * BM * lda); u.B = (const char*)(Bt + (size_t)u.pn * BM * ldb); return true;
    }
};
struct WinSched {
    const bf16_t* XB_; const bf16_t* WIN_; const bf16_t* MEMLN_; const bf16_t* WKV_; int G, c;
    __device__ __forceinline__ bool next(int i, Unit& u) const {
        const int L = i * G + c; constexpr int NZU = 33 * 44;
        if (L < NZU) { tile_of(L, 33, 44, u.pm, u.pn); u.kind = 0; u.A = (const char*)(XB_ + (size_t)u.pm * BM * D); u.B = (const char*)(WIN_ + (size_t)u.pn * BM * D); return true; }
        if (L < NZU + 32) { const int j = L - NZU; u.pm = j >> 3; u.pn = j & 7; u.kind = 1; u.A = (const char*)(MEMLN_ + (size_t)u.pm * BM * D); u.B = (const char*)(WKV_ + (size_t)u.pn * BM * D); return true; }
        if (L < NZU + 48) { const int j = L - NZU - 32; u.pm = j >> 2; u.pn = j & 3; u.kind = 2; u.A = (const char*)(WKV_ + (size_t)(1024 + u.pm * BM) * D); u.B = (const char*)(MEMLN_ + (size_t)u.pn * BM * D); return true; }
        return false;
    }
};
struct BranchSched {
    const bf16_t* YS_; const bf16_t* WBR_; int G, c;
    __device__ __forceinline__ bool next(int i, Unit& u) const {
        const int t = (i / 3) * G + c, k = i % 3; if (t >= 256) return false;
        tile_of(t, 32, 8, u.pm, u.pn); u.kind = k;
        u.A = (const char*)(YS_ + (size_t)u.pm * BM * (3 * BW) + k * BW); u.B = (const char*)(WBR_ + (size_t)k * D * BW + (size_t)u.pn * BM * BW); return true;
    }
};

template <class Sched, class Epi, bool ALIGN_EPI, bool SP2>
__device__ __forceinline__ void gemm_phase(LAS unsigned char* lds, const int K, const int lda, const int ldb, const Sched& S, const Epi& E) {
    int tid = threadIdx.x; asm volatile("" : "+v"(tid));
    const int wid = __builtin_amdgcn_readfirstlane(tid >> 6), lane = tid & 63, wr = wid >> 2, wc = wid & 3, fr = lane & 15, fq = lane >> 4;
    const int nt = K / BK;
    unsigned voffA[2], voffB[2];
#pragma unroll
    for (int i = 0; i < 2; ++i) { int R, C; stage_rc(tid * 16 + i * 8192, R, C); const int Rb = Epi::PERM ? ((R & ~31) + perm32(R & 31)) : R;
        voffA[i] = (unsigned)(R * lda + C) * 2u; voffB[i] = (unsigned)(Rb * ldb + C) * 2u; }
    const size_t kstep = (size_t)(BK * 2);
    const size_t hstepA = (size_t)HALF * lda * 2, hstepB = (size_t)HALF * ldb * 2;
    const unsigned ldsw = (unsigned)wid * 1024u;
    const int aoff = lds_byte(wr * 64 + fr, fq * 8), boff = lds_byte(wc * 32 + fr, fq * 8);
#define PG8_SA(b, h) (((b) * 2 + (h)) * HTB)
#define PG8_SB(b, h) ((4 + (b) * 2 + (h)) * HTB)
#define PG8_STAGE(bufoff, gbase, voff) do { _Pragma("unroll") for (int _i = 0; _i < 2; ++_i) \
        __builtin_amdgcn_global_load_lds((const unsigned*)((const char*)(gbase) + (voff)[_i]), (LAS unsigned*)(lds + (bufoff) + ldsw + _i * 8192), 16, 0, 0); } while (0)
#define PG8_LDA(dst, b, h) do { _Pragma("unroll") for (int m = 0; m < 4; ++m) _Pragma("unroll") for (int k = 0; k < 2; ++k) dst[m][k] = *(const LAS bf16x8*)(lds + PG8_SA(b, h) + aoff + m * 2048 + k * 1024); } while (0)
#define PG8_LDB(dst, b, h) do { _Pragma("unroll") for (int n = 0; n < 2; ++n) _Pragma("unroll") for (int k = 0; k < 2; ++k) dst[n][k] = *(const LAS bf16x8*)(lds + PG8_SB(b, h) + boff + n * 2048 + k * 1024); } while (0)
#define PG8_MMA(ai, bj, At, Bt) do { __builtin_amdgcn_s_setprio(1); _Pragma("unroll") for (int m = 0; m < 4; ++m) _Pragma("unroll") for (int n = 0; n < 2; ++n) _Pragma("unroll") for (int k = 0; k < 2; ++k) \
        acc[ai][bj][m][n] = __builtin_amdgcn_mfma_f32_16x16x32_bf16(Bt[n][k], At[m][k], acc[ai][bj][m][n], 0, 0, 0); __builtin_amdgcn_s_setprio(0); } while (0)
#define PG8_WAIT_V(n) asm volatile("s_waitcnt vmcnt(" #n ")" ::: "memory")
#define PG8_WAIT_L(n) asm volatile("s_waitcnt lgkmcnt(" #n ")" ::: "memory")
#define PG8_BAR __builtin_amdgcn_s_barrier()
#define PG8_SCHED __builtin_amdgcn_sched_barrier(0)
    Unit cur, nxt; int ui = 0;
    if (!S.next(0, cur)) return;
    f32x4 acc[2][2][4][2];
#pragma unroll
    for (int a = 0; a < 2; ++a)
#pragma unroll
        for (int b = 0; b < 2; ++b)
#pragma unroll
            for (int m = 0; m < 4; ++m)
#pragma unroll
                for (int n = 0; n < 2; ++n) acc[a][b][m][n] = (f32x4){0.f, 0.f, 0.f, 0.f};
    bf16x8 At[4][2], B0[2][2], B1[2][2];
    const char* cA = cur.A; const char* cB = cur.B;
    if constexpr (SP2) {
        PG8_STAGE(PG8_SB(0, 0), cB, voffB); PG8_STAGE(PG8_SB(0, 1), cB + hstepB, voffB); PG8_STAGE(PG8_SA(0, 0), cA, voffA); PG8_STAGE(PG8_SA(0, 1), cA + hstepA, voffA);
        if (wr == 1) PG8_BAR;
        PG8_WAIT_V(2); PG8_BAR;
        PG8_STAGE(PG8_SB(1, 0), cB + kstep, voffB); PG8_STAGE(PG8_SA(1, 0), cA + kstep, voffA); PG8_STAGE(PG8_SB(1, 1), cB + hstepB + kstep, voffB);
        PG8_WAIT_V(6); PG8_BAR;
    } else {
        PG8_STAGE(PG8_SB(0, 0), cB, voffB); PG8_STAGE(PG8_SA(0, 0), cA, voffA); PG8_STAGE(PG8_SB(0, 1), cB + hstepB, voffB); PG8_STAGE(PG8_SA(0, 1), cA + hstepA, voffA);
        if (wr == 1) PG8_BAR;
        PG8_WAIT_V(4); PG8_BAR;
        PG8_STAGE(PG8_SB(1, 0), cB + kstep, voffB); PG8_STAGE(PG8_SA(1, 0), cA + kstep, voffA); PG8_STAGE(PG8_SB(1, 1), cB + hstepB + kstep, voffB);
        PG8_WAIT_V(6); PG8_BAR;
    }
    for (;;) {
        const bool has_next = S.next(ui + 1, nxt);
        const char* nA = has_next ? nxt.A : cA; const char* nB = has_next ? nxt.B : cB;
        for (int t = 0; t < nt; t += 2) {
            const bool last = (t == nt - 2);
            const char* a1 = cA + (size_t)(t + 1) * kstep;
            const char* a2 = last ? nA : cA + (size_t)(t + 2) * kstep; const char* b2 = last ? nB : cB + (size_t)(t + 2) * kstep;
            const char* a3 = a2 + kstep; const char* b3 = b2 + kstep;
            if constexpr (SP2) {
            PG8_LDB(B0, 0, 0); PG8_LDB(B1, 0, 1); PG8_SCHED; PG8_LDA(At, 0, 0); PG8_STAGE(PG8_SA(1, 1), a1 + hstepA, voffA);
            PG8_WAIT_V(8); PG8_WAIT_L(0); PG8_BAR; PG8_MMA(0, 0, At, B0); PG8_MMA(0, 1, At, B1); PG8_BAR; PG8_SCHED;
            PG8_LDA(At, 0, 1); PG8_STAGE(PG8_SB(0, 0), b2, voffB); PG8_STAGE(PG8_SB(0, 1), b2 + hstepB, voffB); PG8_STAGE(PG8_SA(0, 0), a2, voffA);
            PG8_WAIT_V(8); PG8_WAIT_L(0); PG8_BAR; PG8_MMA(1, 0, At, B0); PG8_MMA(1, 1, At, B1); PG8_BAR; PG8_SCHED;
            PG8_LDB(B0, 1, 0); PG8_LDB(B1, 1, 1); PG8_SCHED; PG8_LDA(At, 1, 0); PG8_STAGE(PG8_SA(0, 1), a2 + hstepA, voffA);
            PG8_WAIT_V(8); PG8_WAIT_L(0); PG8_BAR; PG8_MMA(0, 0, At, B0); PG8_MMA(0, 1, At, B1); PG8_BAR; PG8_SCHED;
            PG8_LDA(At, 1, 1); PG8_STAGE(PG8_SB(1, 0), b3, voffB); PG8_STAGE(PG8_SB(1, 1), b3 + hstepB, voffB); PG8_STAGE(PG8_SA(1, 0), a3, voffA);
            PG8_WAIT_V(8); PG8_WAIT_L(0); PG8_BAR; PG8_MMA(1, 0, At, B0); PG8_MMA(1, 1, At, B1); PG8_BAR; PG8_SCHED;
            } else {
            PG8_LDB(B0, 0, 0); PG8_SCHED; PG8_LDA(At, 0, 0); PG8_STAGE(PG8_SA(1, 1), a1 + hstepA, voffA);
            PG8_WAIT_L(8); PG8_BAR; PG8_WAIT_L(0); PG8_MMA(0, 0, At, B0); PG8_BAR; PG8_SCHED;
            PG8_LDB(B1, 0, 1); PG8_STAGE(PG8_SB(0, 0), b2, voffB);
            PG8_BAR; PG8_WAIT_L(0); PG8_MMA(0, 1, At, B1); PG8_BAR;
            PG8_LDA(At, 0, 1); PG8_STAGE(PG8_SA(0, 0), a2, voffA);
            PG8_BAR; PG8_WAIT_L(0); PG8_MMA(1, 0, At, B0); PG8_BAR; PG8_SCHED;
            PG8_STAGE(PG8_SB(0, 1), b2 + hstepB, voffB);
            PG8_WAIT_V(6); PG8_BAR; PG8_MMA(1, 1, At, B1); PG8_BAR;
            PG8_LDB(B0, 1, 0); PG8_SCHED; PG8_LDA(At, 1, 0); PG8_STAGE(PG8_SA(0, 1), a2 + hstepA, voffA);
            PG8_WAIT_L(8); PG8_BAR; PG8_WAIT_L(0); PG8_MMA(0, 0, At, B0); PG8_BAR; PG8_SCHED;
            PG8_LDB(B1, 1, 1); PG8_STAGE(PG8_SB(1, 0), b3, voffB);
            PG8_BAR; PG8_WAIT_L(0); PG8_MMA(0, 1, At, B1); PG8_BAR;
            PG8_LDA(At, 1, 1); PG8_STAGE(PG8_SA(1, 0), a3, voffA);
            PG8_BAR; PG8_WAIT_L(0); PG8_MMA(1, 0, At, B0); PG8_BAR; PG8_SCHED;
            PG8_STAGE(PG8_SB(1, 1), b3 + hstepB, voffB);
            PG8_WAIT_V(6); PG8_BAR; PG8_MMA(1, 1, At, B1); PG8_BAR;
            }
        }
        if constexpr (ALIGN_EPI) { if (wr == 0) PG8_BAR; }
        E(acc, cur, wr, wc, fr, fq);
        if (!has_next) break;
#pragma unroll
        for (int a = 0; a < 2; ++a)
#pragma unroll
            for (int b = 0; b < 2; ++b)
#pragma unroll
                for (int m = 0; m < 4; ++m)
#pragma unroll
                    for (int n = 0; n < 2; ++n) acc[a][b][m][n] = (f32x4){0.f, 0.f, 0.f, 0.f};
        cur = nxt; cA = nA; cB = nB; ++ui;
        if constexpr (ALIGN_EPI) { if (wr == 1) PG8_BAR; }
    }
    PG8_WAIT_V(0);
    if constexpr (!ALIGN_EPI) { if (wr == 0) PG8_BAR; }
    PG8_BAR;
#undef PG8_SA
#undef PG8_SB
#undef PG8_STAGE
#undef PG8_LDA
#undef PG8_LDB
#undef PG8_MMA
#undef PG8_WAIT_V
#undef PG8_WAIT_L
#undef PG8_BAR
#undef PG8_SCHED
}


struct EpiSwiglu {
    static constexpr bool PERM = true;
    bf16_t* H; int ldh;
    __device__ __forceinline__ void operator()(const f32x4 (&acc)[2][2][4][2], const Unit& u, int wr, int wc, int fr, int fq) const {
        const int row0 = u.pm * BM + wr * 64 + fr, col0 = u.pn * HALF + wc * 32 + 8 * fq;
#pragma unroll
        for (int ai = 0; ai < 2; ++ai)
#pragma unroll
            for (int m = 0; m < 4; ++m) {
                bf16_t* rowp = H + (size_t)(row0 + ai * HALF + m * 16) * ldh + col0;
                f32x4 v0, v1;
#pragma unroll
                for (int j = 0; j < 4; ++j) { v0[j] = siluf_(acc[ai][0][m][0][j]) * acc[ai][1][m][0][j]; v1[j] = siluf_(acc[ai][0][m][1][j]) * acc[ai][1][m][1][j]; }
                u32x4 w; w.x = cvt_pk_bf16(v0[0], v0[1]); w.y = cvt_pk_bf16(v0[2], v0[3]); w.z = cvt_pk_bf16(v1[0], v1[1]); w.w = cvt_pk_bf16(v1[2], v1[3]);
                *(u32x4*)rowp = w;
            }
    }
};
struct EpiResid {
    static constexpr bool PERM = false;
    float* Y; const float* res; float alpha, scale;
    __device__ __forceinline__ void operator()(const f32x4 (&acc)[2][2][4][2], const Unit& u, int wr, int wc, int fr, int fq) const {
        const int row0 = u.pm * BM + wr * 64 + fr, col0 = u.pn * BM + wc * 32 + 4 * fq;
#pragma unroll
        for (int ai = 0; ai < 2; ++ai)
#pragma unroll
            for (int m2 = 0; m2 < 2; ++m2) {
                f32x4 xv[2][2][2];
#pragma unroll
                for (int mm = 0; mm < 2; ++mm)
#pragma unroll
                    for (int bj = 0; bj < 2; ++bj)
#pragma unroll
                        for (int n = 0; n < 2; ++n) xv[mm][bj][n] = *(const f32x4*)(res + (size_t)(row0 + ai * HALF + (2 * m2 + mm) * 16) * D + col0 + bj * HALF + n * 16);
#pragma unroll
                for (int mm = 0; mm < 2; ++mm)
#pragma unroll
                    for (int bj = 0; bj < 2; ++bj)
#pragma unroll
                        for (int n = 0; n < 2; ++n) *(f32x4*)(Y + (size_t)(row0 + ai * HALF + (2 * m2 + mm) * 16) * D + col0 + bj * HALF + n * 16) = xv[mm][bj][n] * alpha + acc[ai][bj][2 * m2 + mm][n] * scale;
            }
    }
};
struct EpiWin {
    static constexpr bool PERM = true;
    bf16_t* Z; const LAS float* gate_b; float* outK; float* outV; bf16_t* KB; bf16_t* VT;
    __device__ __forceinline__ void operator()(const f32x4 (&acc)[2][2][4][2], const Unit& u, int wr, int wc, int fr, int fq) const {
        const int row0 = u.pm * BM + wr * 64 + fr, col0 = u.pn * BM + wc * 32 + 8 * fq;
        if (u.kind == 0) {
            const int mode = (u.pn < 8) ? 1 : (u.pn < 12) ? 0 : (u.pn < 16) ? 1 : (u.pn < 20) ? 0 : 2;
            f32x4 gb[2][2];
#pragma unroll
            for (int bj = 0; bj < 2; ++bj)
#pragma unroll
                for (int n = 0; n < 2; ++n) gb[bj][n] = (mode == 2) ? *(const LAS f32x4*)(gate_b + (col0 - 5120) + bj * HALF + 4 * n) : (f32x4){0.f, 0.f, 0.f, 0.f};
#pragma unroll
            for (int ai = 0; ai < 2; ++ai)
#pragma unroll
                for (int m = 0; m < 4; ++m) {
                    bf16_t* rowp = Z + (size_t)(row0 + ai * HALF + m * 16) * NZ + col0;
#pragma unroll
                    for (int bj = 0; bj < 2; ++bj) {
                        f32x4 v0 = acc[ai][bj][m][0], v1 = acc[ai][bj][m][1];
                        if (mode == 1) {
#pragma unroll
                            for (int j = 0; j < 4; ++j) { v0[j] = gelu_tanh(v0[j]); v1[j] = gelu_tanh(v1[j]); }
                        } else if (mode == 2) {
#pragma unroll
                            for (int j = 0; j < 4; ++j) { v0[j] = sigmoidf_(v0[j] + gb[bj][0][j]); v1[j] = sigmoidf_(v1[j] + gb[bj][1][j]); }
                        }
                        u32x4 w; w.x = cvt_pk_bf16(v0[0], v0[1]); w.y = cvt_pk_bf16(v0[2], v0[3]); w.z = cvt_pk_bf16(v1[0], v1[1]); w.w = cvt_pk_bf16(v1[2], v1[3]);
                        *(u32x4*)(rowp + bj * HALF) = w;
                    }
                }
        } else if (u.kind == 1) {
            const bool isk = u.pn < 4; const int c0 = col0 - (isk ? 0 : 1024);
            float* ob = isk ? outK : outV;
#pragma unroll
            for (int ai = 0; ai < 2; ++ai)
#pragma unroll
                for (int m = 0; m < 4; ++m) {
                    const size_t off = (size_t)(row0 + ai * HALF + m * 16) * 1024 + c0;
#pragma unroll
                    for (int bj = 0; bj < 2; ++bj) {
                        const f32x4 v0 = acc[ai][bj][m][0], v1 = acc[ai][bj][m][1];
                        *(f32x4*)(ob + off + bj * HALF) = v0; *(f32x4*)(ob + off + bj * HALF + 4) = v1;
                        if (isk) { u32x4 w; w.x = cvt_pk_bf16(v0[0], v0[1]); w.y = cvt_pk_bf16(v0[2], v0[3]); w.z = cvt_pk_bf16(v1[0], v1[1]); w.w = cvt_pk_bf16(v1[2], v1[3]); *(u32x4*)(KB + off + bj * HALF) = w; }
                    }
                }
        } else {
#pragma unroll
            for (int ai = 0; ai < 2; ++ai)
#pragma unroll
                for (int m = 0; m < 4; ++m) {
                    bf16_t* rowp = VT + (size_t)(row0 + ai * HALF + m * 16) * 1024 + col0;
#pragma unroll
                    for (int bj = 0; bj < 2; ++bj) {
                        const f32x4 v0 = acc[ai][bj][m][0], v1 = acc[ai][bj][m][1];
                        u32x4 w; w.x = cvt_pk_bf16(v0[0], v0[1]); w.y = cvt_pk_bf16(v0[2], v0[3]); w.z = cvt_pk_bf16(v1[0], v1[1]); w.w = cvt_pk_bf16(v1[2], v1[3]);
                        *(u32x4*)(rowp + bj * HALF) = w;
                    }
                }
        }
    }
};
struct EpiMerge {
    static constexpr bool PERM = false;
    const bf16_t* Z; float* MG; bf16_t* MB;
    template <int KI> __device__ __forceinline__ void body(const f32x4 (&acc)[2][2][4][2], const Unit& u, int wr, int wc, int fr, int fq) const {
        const int row0 = u.pm * BM + wr * 64 + fr, col0 = u.pn * BM + wc * 32 + 4 * fq;
#pragma unroll
        for (int ai = 0; ai < 2; ++ai)
#pragma unroll
            for (int m2 = 0; m2 < 2; ++m2) {
                u32x2 gw[2][2][2]; f32x4 mg[2][2][2];
#pragma unroll
                for (int mm = 0; mm < 2; ++mm)
#pragma unroll
                    for (int bj = 0; bj < 2; ++bj)
#pragma unroll
                        for (int n = 0; n < 2; ++n) {
                            const int r = row0 + ai * HALF + (2 * m2 + mm) * 16;
                            gw[mm][bj][n] = *(const u32x2*)(Z + (size_t)r * NZ + 5120 + KI * 2048 + col0 + bj * HALF + n * 16);
                            if (KI > 0) mg[mm][bj][n] = *(const f32x4*)(MG + (size_t)r * D + col0 + bj * HALF + n * 16);
                        }
#pragma unroll
                for (int mm = 0; mm < 2; ++mm)
#pragma unroll
                    for (int bj = 0; bj < 2; ++bj)
#pragma unroll
                        for (int n = 0; n < 2; ++n) {
                            const int r = row0 + ai * HALF + (2 * m2 + mm) * 16;
                            const size_t off = (size_t)r * D + col0 + bj * HALF + n * 16;
                            const u32x2 g2 = gw[mm][bj][n];
                            f32x4 v = (f32x4){bflo(g2.x), bfhi(g2.x), bflo(g2.y), bfhi(g2.y)} * acc[ai][bj][2 * m2 + mm][n];
                            if (KI > 0) v += mg[mm][bj][n];
                            if (KI < 2) *(f32x4*)(MG + off) = v;
                            else { u32x2 w; w.x = cvt_pk_bf16(v[0], v[1]); w.y = cvt_pk_bf16(v[2], v[3]); *(u32x2*)(MB + off) = w; }
                        }
            }
    }
    __device__ __forceinline__ void operator()(const f32x4 (&acc)[2][2][4][2], const Unit& u, int wr, int wc, int fr, int fq) const {
        if (u.kind == 0) body<0>(acc, u, wr, wc, fr, fq); else if (u.kind == 1) body<1>(acc, u, wr, wc, fr, fq); else body<2>(acc, u, wr, wc, fr, fq);
    }
};
}

#ifndef PHMASK
#define PHMASK 0xFFFFFFFFu
#endif
#ifndef GREP
#define GREP 1
#endif
#ifndef NREP
#define NREP 1
#endif
#define PHON(n) (((PHMASK) >> (n)) & 1u)
#define LDS_WAIT() asm volatile("s_waitcnt lgkmcnt(0)" ::: "memory")

__device__ __forceinline__ void transpose_item(const float* W, int N, bf16_t* WT, int ldk, int k0, int n0, int dst_row0, LAS float* scr, int lane) {
    f32x4 v[8];
    const int n4 = (lane & 7) * 4, kr = lane >> 3;
#pragma unroll
    for (int i = 0; i < 8; ++i) v[i] = *(const f32x4*)(W + (size_t)(k0 + kr + 8 * i) * N + n0 + n4);
#pragma unroll
    for (int i = 0; i < 8; ++i) { LAS float* d = scr + (kr + 8 * i) * 33 + n4; d[0] = v[i][0]; d[1] = v[i][1]; d[2] = v[i][2]; d[3] = v[i][3]; }
    LDS_WAIT(); asm volatile("" ::: "memory");
    const int c = lane & 7;
#pragma unroll
    for (int j = 0; j < 4; ++j) { const int n = (lane >> 3) + 8 * j; const LAS float* s = scr + (8 * c) * 33 + n;
        u32x4 o; o.x = cvt_pk_bf16(s[0 * 33], s[1 * 33]); o.y = cvt_pk_bf16(s[2 * 33], s[3 * 33]); o.z = cvt_pk_bf16(s[4 * 33], s[5 * 33]); o.w = cvt_pk_bf16(s[6 * 33], s[7 * 33]);
        *(u32x4*)(WT + (size_t)(dst_row0 + n) * ldk + k0 + 8 * c) = o; }
    LDS_WAIT(); asm volatile("" ::: "memory");
}
__device__ __forceinline__ void ln_row(const float* yrow, const float* g, const float* b, float* of, bf16_t* ob, int lane) {
    f32x4 v[8]; float s = 0.f;
#pragma unroll
    for (int j = 0; j < 8; ++j) { v[j] = *(const f32x4*)(yrow + 4 * lane + 256 * j); s += (v[j][0] + v[j][1]) + (v[j][2] + v[j][3]); }
    const float mean = wave_sum(s) * (1.f / D); float s2 = 0.f;
#pragma unroll
    for (int j = 0; j < 8; ++j) { v[j] = v[j] - mean; s2 += (v[j][0] * v[j][0] + v[j][1] * v[j][1]) + (v[j][2] * v[j][2] + v[j][3] * v[j][3]); }
    const float rstd = 1.0f / sqrtf(wave_sum(s2) * (1.f / D) + LN_EPS);
#pragma unroll
    for (int j = 0; j < 8; ++j) {
        const f32x4 gg = *(const f32x4*)(g + 4 * lane + 256 * j), bb = *(const f32x4*)(b + 4 * lane + 256 * j);
        const f32x4 o = v[j] * rstd * gg + bb;
        if (of) *(f32x4*)(of + 4 * lane + 256 * j) = o;
        if (ob) { u32x2 w; w.x = cvt_pk_bf16(o[0], o[1]); w.y = cvt_pk_bf16(o[2], o[3]); *(u32x2*)(ob + 4 * lane + 256 * j) = w; }
    }
}

#define XB_TMO      128
#define XB_XCNT(j)  (256  + 64 * (j))
#define XB_XSUB(j)  (1280 + 64 * (j))
#define XB_XGEN(j)  (2304 + 64 * (j))
#define XB_TOP      3328
#define XB_TOPGEN   3392
#define XCD_BAR_WORDS 3456
#define XB_SPIN_CAP (1u << 22)
__device__ __forceinline__ unsigned xb_ld(unsigned* p)              { return __hip_atomic_load(p, __ATOMIC_RELAXED, __HIP_MEMORY_SCOPE_AGENT); }
__device__ __forceinline__ unsigned xb_add(unsigned* p, unsigned v) { return __hip_atomic_fetch_add(p, v, __ATOMIC_RELAXED, __HIP_MEMORY_SCOPE_AGENT); }
__device__ __forceinline__ unsigned xb_xcc_id() { return (unsigned)__builtin_amdgcn_s_getreg((3 << 11) | 20) & 0xFu; }
#define XB_SPIN(cond, bar) do { unsigned _sp = 0; while (cond) { __builtin_amdgcn_s_sleep(1); \
    if ((++_sp & 255u) == 0u) { if (xb_ld(&(bar)[XB_TMO])) break; if (_sp > XB_SPIN_CAP) { atomicAdd(&(bar)[XB_TMO], 1u); break; } } } } while (0)
struct XcdBarrier { unsigned* bar; unsigned x; volatile LAS unsigned* st; };
__device__ __forceinline__ XcdBarrier xcd_barrier_post(unsigned* bar, volatile LAS unsigned* st) {
    XcdBarrier b; b.bar = bar; b.x = xb_xcc_id(); b.st = st;
    if (threadIdx.x == 0) st[2] = xb_add(&bar[XB_XCNT(b.x)], 1u);
    return b;
}
__device__ __forceinline__ void xcd_barrier_complete(unsigned* bar, unsigned x, unsigned& nloc, unsigned& nx, unsigned& uniform8) {
    const unsigned G = gridDim.x * gridDim.y * gridDim.z;
    unsigned sum, cnt, mine, sp = 0u;
    for (;;) {
        sum = 0u; cnt = 0u; mine = 0u; uniform8 = 1u;
#pragma unroll
        for (unsigned j = 0; j < 16; ++j) { const unsigned c = xb_ld(&bar[XB_XCNT(j)]); sum += c; cnt += (c > 0u) ? 1u : 0u; mine = (j == x) ? c : mine; if (c != ((j < 8u) ? (G >> 3) : 0u)) uniform8 = 0u; }
        if (sum == G) break;
        __builtin_amdgcn_s_sleep(1);
        if ((++sp & 255u) == 0u) { if (xb_ld(&bar[XB_TMO])) break; if (sp > XB_SPIN_CAP) { atomicAdd(&bar[XB_TMO], 1u); break; } }
    }
    nloc = mine > 0u ? mine : 1u; nx = cnt > 0u ? cnt : 1u;
}
__device__ __forceinline__ void xcd_barrier(const XcdBarrier& b) {
    asm volatile("s_waitcnt vmcnt(0)" ::: "memory");
    __syncthreads();
    if (threadIdx.x == 0) {
        unsigned* bar = b.bar;
        __builtin_amdgcn_s_waitcnt(0);
        const unsigned G_ = gridDim.x; unsigned nloc = b.st[0], nx = b.st[1];
        if (nloc == 0u) { unsigned u8; xcd_barrier_complete(bar, b.x, nloc, nx, u8); b.st[0] = nloc; b.st[1] = nx; b.st[3] = ((G_ & 7u) == 0u) ? u8 : 0u; }
        const unsigned old = xb_add(&bar[XB_XSUB(b.x)], 1u);
        const unsigned gen = old / nloc;
        if (old + 1u == (gen + 1u) * nloc) {
            __builtin_amdgcn_fence(__ATOMIC_RELEASE, "agent");
            asm volatile("s_waitcnt vmcnt(0)" ::: "memory");
            const unsigned og = xb_add(&bar[XB_TOP], 1u);
            const unsigned tg = og / nx;
            if (og + 1u == (tg + 1u) * nx) xb_add(&bar[XB_TOPGEN], 1u);
            else XB_SPIN(xb_ld(&bar[XB_TOPGEN]) == tg, bar);
            __builtin_amdgcn_fence(__ATOMIC_ACQUIRE, "agent");
            xb_add(&bar[XB_XGEN(b.x)], 1u);
            asm volatile("s_waitcnt vmcnt(0)" ::: "memory");
        } else {
            XB_SPIN(xb_ld(&bar[XB_XGEN(b.x)]) == gen, bar);
            __builtin_amdgcn_fence(__ATOMIC_ACQUIRE, "agent");
            asm volatile("s_waitcnt vmcnt(0)" ::: "memory");
        }
    }
    __syncthreads();
}

template <int MODE>
__device__ __forceinline__ void skinny(LAS unsigned char* lds, int bid, int G, int wave, int lane, const bf16_t* A, int lda, const bf16_t* Bt, int ldb, int K,
                                       float* Ys, const float* res, float alpha, float scale, const bf16_t* Zs, bf16_t* MBs) {
    const int fr = lane & 15, fq = lane >> 4, tw = wave & 3, kh = wave >> 2;
    LAS f32x4* red = (LAS f32x4*)lds;
    for (int T0 = bid * 4; T0 < 1024; T0 += G * 4) {
        const int T = T0 + tw, rt = T >> 7, ct = T & 127;
        f32x4 tot = (f32x4){0.f, 0.f, 0.f, 0.f};
        if (MODE == 0) {
            const int kb = kh * (K / 2);
            const bf16_t* ap = A + (size_t)(rt * 16 + fr) * lda + kb + fq * 8;
            const bf16_t* bp = Bt + (size_t)(ct * 16 + fr) * ldb + kb + fq * 8;
#pragma unroll 16
            for (int ks = 0; ks < K / 64; ++ks) {
                const bf16x8 af = *(const bf16x8*)(ap + ks * 32), bfv = *(const bf16x8*)(bp + ks * 32);
                tot = __builtin_amdgcn_mfma_f32_16x16x32_bf16(bfv, af, tot, 0, 0, 0);
            }
        } else {
#pragma unroll
            for (int k = 0; k < 3; ++k) {
                const int kb = kh * (BW / 2);
                const bf16_t* ap = A + (size_t)(rt * 16 + fr) * lda + k * BW + kb + fq * 8;
                const bf16_t* bp = Bt + (size_t)k * D * BW + (size_t)(ct * 16 + fr) * ldb + kb + fq * 8;
                f32x4 acc = (f32x4){0.f, 0.f, 0.f, 0.f};
#pragma unroll 8
                for (int ks = 0; ks < BW / 64; ++ks) {
                    const bf16x8 af = *(const bf16x8*)(ap + ks * 32), bfv = *(const bf16x8*)(bp + ks * 32);
                    acc = __builtin_amdgcn_mfma_f32_16x16x32_bf16(bfv, af, acc, 0, 0, 0);
                }
                const u32x2 gw = *(const u32x2*)(Zs + (size_t)(rt * 16 + fr) * NZ + 5120 + k * 2048 + ct * 16 + 4 * fq);
                tot += acc * (f32x4){bflo(gw.x), bfhi(gw.x), bflo(gw.y), bfhi(gw.y)};
            }
        }
        if (kh == 1) red[tw * 64 + lane] = tot;
        __syncthreads();
        if (kh == 0) {
            tot += red[tw * 64 + lane];
            const size_t off = (size_t)(rt * 16 + fr) * D + ct * 16 + 4 * fq;
            if (MODE == 0) { const f32x4 xv = *(const f32x4*)(res + off); *(f32x4*)(Ys + off) = xv * alpha + tot * scale; }
            else { u32x2 w; w.x = cvt_pk_bf16(tot[0], tot[1]); w.y = cvt_pk_bf16(tot[2], tot[3]); *(u32x2*)(MBs + off) = w; }
        }
        __syncthreads();
    }
}

#define WGU1 ((bf16_t*)(P.ws + WS_WGU1))
#define WD1 ((bf16_t*)(P.ws + WS_WD1))
#define WIN ((bf16_t*)(P.ws + WS_WIN))
#define WKV ((bf16_t*)(P.ws + WS_WKV))
#define WBR ((bf16_t*)(P.ws + WS_WBR))
#define WOUT ((bf16_t*)(P.ws + WS_WOUT))
#define WGU2 ((bf16_t*)(P.ws + WS_WGU2))
#define WD2 ((bf16_t*)(P.ws + WS_WD2))
#define WLRU ((bf16_t*)(P.ws + WS_WLRU))
#define WSP ((bf16_t*)(P.ws + WS_WSP))
#define XB ((bf16_t*)(P.ws + WS_XB))
#define Z ((bf16_t*)(P.ws + WS_ZH))
#define H ((bf16_t*)(P.ws + WS_ZH))
#define Y ((float*)(P.ws + WS_Y))
#define X1 ((float*)(P.ws + WS_X1))
#define VP ((bf16_t*)(P.ws + WS_VP))
#define HL ((float*)(P.ws + WS_HL))
#define AC ((float*)(P.ws + WS_AC))
#define SUM ((float*)(P.ws + WS_SUM))
#define YS ((bf16_t*)(P.ws + WS_YS))
#define MEMLN ((bf16_t*)(P.ws + WS_MEMLN))
#define KB ((bf16_t*)(P.ws + WS_KB))
#define VT ((bf16_t*)(P.ws + WS_VT))
__device__ __forceinline__ void p5d_sample_attn(const Params& P, LAS unsigned char* lds, int bid, int G, int tid_in) {
    int tid = tid_in; asm volatile("" : "+v"(tid));
    const int lane = tid & 63, wave = __builtin_amdgcn_readfirstlane(tid >> 6);

        LAS float* sS = (LAS float*)(lds + 131072);
        LAS float* sO = (LAS float*)(lds + 131072 + 1024);
        const int vb = (G % 8 == 0) ? (bid & 7) * (G >> 3) + (bid >> 3) : bid;
        for (int it = vb; it < 512; it += G) {
            const int b = it >> 2, h = it & 3;
            const u32x2 qw = *(const u32x2*)(Z + (size_t)(MP + b) * NZ + 4096 + h * HD + 4 * lane);
            const f32x4 q = (f32x4){bflo(qw.x), bfhi(qw.x), bflo(qw.y), bfhi(qw.y)};
            const float* kbase = P.in[I_CK] + ((size_t)(b * NMEM + 32 * wave) * NH + h) * HD + 4 * lane;
            const float* vbase = P.in[I_CV] + ((size_t)(b * NMEM + 32 * wave) * NH + h) * HD + 4 * lane;
            float d[32];
#pragma unroll
            for (int mi = 0; mi < 32; ++mi) {
                const f32x4 kv = __builtin_nontemporal_load((const f32x4*)(kbase + (size_t)mi * (NH * HD)));
                d[mi] = (kv[0] * q[0] + kv[1] * q[1]) + (kv[2] * q[2] + kv[3] * q[3]);
                if (mi == 15) asm volatile("" ::: "memory");
            }
#pragma unroll
            for (int i = 0; i < 16; ++i) { const bool hi = (lane & 32) != 0; const float snd = hi ? d[i] : d[i + 16], kp = hi ? d[i + 16] : d[i]; d[i] = kp + __shfl_xor(snd, 32); }
#pragma unroll
            for (int i = 0; i < 8; ++i) { const bool hi = (lane & 16) != 0; const float snd = hi ? d[i] : d[i + 8], kp = hi ? d[i + 8] : d[i]; d[i] = kp + __shfl_xor(snd, 16); }
#pragma unroll
            for (int i = 0; i < 4; ++i) { const bool hi = (lane & 8) != 0; const float snd = hi ? d[i] : d[i + 4], kp = hi ? d[i + 4] : d[i]; d[i] = kp + __shfl_xor(snd, 8); }
#pragma unroll
            for (int i = 0; i < 2; ++i) { const bool hi = (lane & 4) != 0; const float snd = hi ? d[i] : d[i + 2], kp = hi ? d[i + 2] : d[i]; d[i] = kp + __shfl_xor(snd, 4); }
            { const bool hi = (lane & 2) != 0; const float snd = hi ? d[0] : d[1], kp = hi ? d[1] : d[0]; d[0] = kp + __shfl_xor(snd, 2); }
            d[0] += __shfl_xor(d[0], 1);
            if ((lane & 1) == 0) sS[32 * wave + (lane >> 1)] = d[0] * 0.0625f;
            f32x4 vv[16];
#pragma unroll
            for (int mi = 0; mi < 16; ++mi) vv[mi] = __builtin_nontemporal_load((const f32x4*)(vbase + (size_t)mi * (NH * HD)));
            __syncthreads();
            float mx = fmaxf(fmaxf(sS[lane], sS[lane + 64]), fmaxf(sS[lane + 128], sS[lane + 192]));
            mx = wave_max(mx);
            float sm = __expf(sS[lane] - mx) + __expf(sS[lane + 64] - mx) + __expf(sS[lane + 128] - mx) + __expf(sS[lane + 192] - mx);
            sm = wave_sum(sm);
            const float inv = 1.0f / sm;
            f32x4 o = (f32x4){0.f, 0.f, 0.f, 0.f};
            f32x4 vw[16];
#pragma unroll
            for (int mi = 0; mi < 16; ++mi) vw[mi] = __builtin_nontemporal_load((const f32x4*)(vbase + (size_t)(16 + mi) * (NH * HD)));
#pragma unroll
            for (int mi = 0; mi < 16; ++mi) { const float p = __expf(sS[32 * wave + mi] - mx) * inv; o += vv[mi] * p; }
#pragma unroll
            for (int mi = 0; mi < 16; ++mi) { const float p = __expf(sS[32 * wave + 16 + mi] - mx) * inv; o += vw[mi] * p; }
            *(LAS f32x4*)(sO + wave * 256 + 4 * lane) = o;
            __syncthreads();
            if (tid < 256) {
                float a = 0.f;
#pragma unroll
                for (int w = 0; w < 8; ++w) a += sO[w * 256 + tid];
                YS[(size_t)(MP + b) * 3072 + 2048 + h * HD + tid] = (bf16_t)(cvt_pk_bf16(a, 0.f) & 0xffffu);
            }
            __syncthreads();
        }
}

__global__ void __launch_bounds__(NTHREADS, 2) fwd_kernel(Params P) {
    extern __shared__ __attribute__((aligned(16))) unsigned char lds_raw[];
    LAS unsigned char* lds = (LAS unsigned char*)lds_raw;
    cg::grid_group grid = cg::this_grid();
    const int tid = threadIdx.x, lane = tid & 63, wave = __builtin_amdgcn_readfirstlane(tid >> 6);
    const int G = gridDim.x, bid = blockIdx.x;
    const int gw = bid * NWAVES + wave, NGW = G * NWAVES;
    float* out = P.out;
    volatile LAS unsigned* bst = (volatile LAS unsigned*)(lds + LDS_BYTES - 64);
    if (tid == 0) { bst[0] = 0u; bst[1] = 0u; }
    __syncthreads();
    const XcdBarrier gbar = xcd_barrier_post((unsigned*)(P.ws + WS_BAR), bst);
#define GRID_BAR() xcd_barrier(gbar)

    if (PHON(0)) {
        LAS float* scr = (LAS float*)(lds + wave * 16384);
        constexpr int IT_GU = (D / 64) * (NZ / 32), IT_DN = (FF / 64) * (D / 32), IT_SQ = (D / 64) * (D / 32), IT_BR = (BW / 64) * (D / 32), IT_LR = 2 * 4;
        constexpr int IT_TOTAL = 3 * IT_GU + 2 * IT_DN + 2 * IT_SQ + 3 * IT_BR + 16 * IT_LR;
        for (int it = gw; it < IT_TOTAL; it += NGW) {
            int r = it; const float* W; bf16_t* WT; int N, ldk, mode = 0;
            if (r < IT_GU) { W = P.in[I_GU1]; WT = WGU1; N = NZ; ldk = D; mode = 1; }
            else if ((r -= IT_GU) < IT_DN) { W = P.in[I_DN1]; WT = WD1; N = D; ldk = FF; }
            else if ((r -= IT_DN) < IT_GU) { W = P.in[I_WIN]; WT = WIN; N = NZ; ldk = D; }
            else if ((r -= IT_GU) < IT_SQ) { W = P.in[I_WKV]; WT = WKV; N = D; ldk = D; }
            else if ((r -= IT_SQ) < 3 * IT_BR) { const int k = r / IT_BR; r -= k * IT_BR; W = P.in[I_WBR] + (size_t)k * BW * D; WT = WBR + (size_t)k * D * BW; N = D; ldk = BW; }
            else if ((r -= 3 * IT_BR) < IT_SQ) { W = P.in[I_WOUT]; WT = WOUT; N = D; ldk = D; }
            else if ((r -= IT_SQ) < IT_GU) { W = P.in[I_GU2]; WT = WGU2; N = NZ; ldk = D; mode = 1; }
            else if ((r -= IT_GU) < IT_DN) { W = P.in[I_DN2]; WT = WD2; N = D; ldk = FF; }
            else { r -= IT_DN; const int m = r / IT_LR; r -= m * IT_LR; const int k = m >> 1, x = m & 1;
                W = (x ? P.in[I_LWX] : P.in[I_LWA]) + (size_t)k * 128 * 128; WT = WLRU + (size_t)k * 256 * 128 + x * 128 * 128; N = 128; ldk = 128; }
            const int nblk = N / 32, kb = r / nblk, nb = r % nblk, n0 = 32 * nb;
            int dr = n0;
            if (mode == 1) dr = (n0 < FF) ? (n0 / 128) * 256 + (n0 % 128) : ((n0 - FF) / 128) * 256 + 128 + ((n0 - FF) % 128);
            transpose_item(W, N, WT, ldk, 64 * kb, n0, dr, scr, lane);
        }
        for (int i = gw * 64 + lane; i < 4 * 128 * 128; i += NGW * 64) { const int t = (i >> 7) & 127, s = i & 127; const float w = P.in[I_WS][i]; WSP[i] = (bf16_t)(cvt_pk_bf16(s <= t ? w : 0.f, 0.f) & 0xffffu); }
        for (size_t i = (size_t)gw * 64 + lane; i < (size_t)MPAD * D / 8; i += (size_t)NGW * 64) {
            const size_t e = i * 8; const int r = (int)(e / D);
            u32x4 w = (u32x4){0u, 0u, 0u, 0u};
            if (r < MR) { const float* src = (r < MP) ? P.in[I_XP] + e : P.in[I_XS] + (e - (size_t)MP * D);
                const f32x4 a = *(const f32x4*)src, b = *(const f32x4*)(src + 4);
                w.x = cvt_pk_bf16(a[0], a[1]); w.y = cvt_pk_bf16(a[2], a[3]); w.z = cvt_pk_bf16(b[0], b[1]); w.w = cvt_pk_bf16(b[2], b[3]); }
            *(u32x4*)(XB + e) = w;
        }
        for (int r = gw; r < 1024; r += NGW) ln_row(P.in[I_MEM] + (size_t)r * D, P.in[I_MLNG], P.in[I_MLNB], nullptr, MEMLN + (size_t)r * D, lane);
    }
    if (P.ws == nullptr) grid.sync();
    GRID_BAR();
    const int vc = bst[3] ? (int)(bst[2] * 8u + gbar.x) : bid;

    if (PHON(1)) {
        pg8::PlainSched S{XB, WGU1, 33, 44, D, D, G, vc};
        pg8::EpiSwiglu E{H, FF};
        pg8::gemm_phase<pg8::PlainSched, pg8::EpiSwiglu, true, true>(lds, D, D, D, S, E);
    }
    GRID_BAR();
    if (PHON(2)) {
        skinny<0>(lds, bid, G, wave, lane, H + (size_t)MP * FF, FF, WD1, FF, FF, Y + (size_t)MP * D, P.in[I_XS], ALPHA, 0.5f, nullptr, nullptr);
        pg8::PlainSched S{H, WD1, 32, 8, FF, FF, G, vc};
        pg8::EpiResid E{Y, P.in[I_XP], ALPHA, 0.5f};
        pg8::gemm_phase<pg8::PlainSched, pg8::EpiResid, true, true>(lds, FF, FF, FF, S, E);
    }
    GRID_BAR();
    if (PHON(3)) for (int r = gw; r < MR; r += NGW) ln_row(Y + (size_t)r * D, P.in[I_LN1G], P.in[I_LN1B], X1 + (size_t)r * D, XB + (size_t)r * D, lane);
    GRID_BAR();

    if (PHON(4)) {
        LAS float* gbl = (LAS float*)(lds + 131072);
        for (int i = tid; i < 3 * D / 4; i += NTHREADS) *(LAS f32x4*)(gbl + 4 * i) = *(const f32x4*)(P.in[I_GATEB] + 4 * i);
        __syncthreads();
        pg8::WinSched S{XB, WIN, MEMLN, WKV, G, vc};
        pg8::EpiWin E{Z, gbl, out + O_MK, out + O_MV, KB, VT};
        pg8::gemm_phase<pg8::WinSched, pg8::EpiWin, true, true>(lds, D, D, D, S, E);
    }
    GRID_BAR();

    const bool dfirst_ = ((bid >> 5) & 1) != 0;
    if (dfirst_ && PHON(8)) p5d_sample_attn(P, lds, bid, G, tid);
    if (PHON(5)) for (int r = gw; r < MR; r += NGW) {
        const bf16_t* zr = Z + (size_t)r * NZ + 1024;
        float v[16]; float s = 0.f;
#pragma unroll
        for (int h = 0; h < 2; ++h) { const u32x4 w = *(const u32x4*)(zr + 8 * lane + 512 * h);
            v[8 * h + 0] = bflo(w.x); v[8 * h + 1] = bfhi(w.x); v[8 * h + 2] = bflo(w.y); v[8 * h + 3] = bfhi(w.y); v[8 * h + 4] = bflo(w.z); v[8 * h + 5] = bfhi(w.z); v[8 * h + 6] = bflo(w.w); v[8 * h + 7] = bfhi(w.w); }
#pragma unroll
        for (int j = 0; j < 16; ++j) s += v[j];
        const float mean = wave_sum(s) * (1.f / BW); float s2 = 0.f;
#pragma unroll
        for (int j = 0; j < 16; ++j) { v[j] -= mean; s2 += v[j] * v[j]; }
        const float rstd = 1.0f / sqrtf(wave_sum(s2) * (1.f / BW) + LN_EPS);
#pragma unroll
        for (int h = 0; h < 2; ++h) {
            const int c0 = 8 * lane + 512 * h; float o[8];
#pragma unroll
            for (int j = 0; j < 8; ++j) o[j] = v[8 * h + j] * rstd * P.in[I_GLNG][c0 + j] + P.in[I_GLNB][c0 + j];
            u32x4 w; w.x = cvt_pk_bf16(o[0], o[1]); w.y = cvt_pk_bf16(o[2], o[3]); w.z = cvt_pk_bf16(o[4], o[5]); w.w = cvt_pk_bf16(o[6], o[7]);
            *(u32x4*)(VP + (size_t)r * BW + c0) = w;
            if (r >= MP) { float* ov = out + O_VS + (size_t)(r - MP) * BW + c0; *(f32x4*)ov = (f32x4){o[0], o[1], o[2], o[3]}; *(f32x4*)(ov + 4) = (f32x4){o[4], o[5], o[6], o[7]}; }
        }
    }
    if (PHON(6)) {
        LAS bf16_t* XCB = (LAS bf16_t*)lds;
        LAS float* AARR = (LAS float*)lds;
        LAS float* XCF = (LAS float*)(lds + 65536);
        for (int it = bid; it < 65 * 8; it += G) {
            const int c = it >> 3, k = it & 7; const bool smp = (c == 64);
            const int r0 = c * 128, ch0 = k * 128;
            int lane_o = lane; asm volatile("" : "+v"(lane_o));
            const int fr = lane_o & 15, fq = lane_o >> 4, rh = wave >> 2, cq = wave & 3;
            bf16x8 wfr[4][4];
            {
                const bf16_t* wb = WLRU + (size_t)k * 256 * 128;
#pragma unroll
                for (int ct = 0; ct < 4; ++ct)
#pragma unroll
                    for (int ks = 0; ks < 4; ++ks) wfr[ct][ks] = *(const bf16x8*)(wb + (size_t)((ct >> 1) * 128 + 32 * cq + 16 * (ct & 1) + fr) * 128 + ks * 32 + fq * 8);
            }
            LAS float* prm = (LAS float*)(lds + 131072 + 4096);
            if (tid < 128) { prm[tid] = P.in[I_LBA][ch0 + tid]; prm[128 + tid] = P.in[I_LBX][ch0 + tid]; prm[256 + tid] = __logf(1.0f + __expf(-P.in[I_LAM][ch0 + tid])); }
            {
                const int c4 = (tid & 31) * 4, rg = tid >> 5;
                const int ch = ch0 + c4;
                const f32x4 w0 = *(const f32x4*)(P.in[I_CONVW] + 0 * BW + ch), w1 = *(const f32x4*)(P.in[I_CONVW] + 1 * BW + ch), w2 = *(const f32x4*)(P.in[I_CONVW] + 2 * BW + ch), w3 = *(const f32x4*)(P.in[I_CONVW] + 3 * BW + ch);
                const f32x4 cb = *(const f32x4*)(P.in[I_CONVB] + ch);
                if (!smp) {
                    const bool first = ((c & 15) == 0);
                    const int rs = rg * 8;
                    const bool hist = !(first && rs == 0);
                    u32x2 zr[11];
#pragma unroll
                    for (int i = 0; i < 11; ++i) { zr[i] = (u32x2){0u, 0u}; if (i >= 3 || hist) zr[i] = *(const u32x2*)(Z + (size_t)(r0 + rs - 3 + i) * NZ + 2048 + ch); }
#define ZF(i) ((f32x4){bflo(zr[i].x), bfhi(zr[i].x), bflo(zr[i].y), bfhi(zr[i].y)})
#pragma unroll
                    for (int i = 0; i < 8; ++i) {
                        const int row = rs + i;
                        const f32x4 x0 = ZF(i + 3);
                        const f32x4 xc = cb + w3 * x0 + w2 * ZF(i + 2) + w1 * ZF(i + 1) + w0 * ZF(i);
                        *(LAS f32x4*)(XCF + row * 128 + c4) = xc;
                        u32x2 w; w.x = cvt_pk_bf16(xc[0], xc[1]); w.y = cvt_pk_bf16(xc[2], xc[3]);
                        *(LAS u32x2*)(XCB + row * 136 + c4) = w;
                        if ((c & 15) == 15 && row >= 125) *(f32x4*)(out + O_CP + (size_t)((c >> 4) * 3 + (row - 125)) * BW + ch) = x0;
                    }
#undef ZF
                } else {
#pragma unroll 4
                    for (int i = 0; i < 8; ++i) {
                        const int row = rg * 8 + i;
                        const float* sc = P.in[I_SCONV] + (size_t)row * 3 * BW + ch;
                        const f32x4 b0 = *(const f32x4*)sc, b1 = *(const f32x4*)(sc + BW), b2 = *(const f32x4*)(sc + 2 * BW);
                        const u32x2 a = *(const u32x2*)(Z + (size_t)(MP + row) * NZ + 2048 + ch);
                        const f32x4 x0 = (f32x4){bflo(a.x), bfhi(a.x), bflo(a.y), bfhi(a.y)};
                        const f32x4 xc = cb + w3 * x0 + w2 * b2 + w1 * b1 + w0 * b0;
                        *(LAS f32x4*)(XCF + row * 128 + c4) = xc;
                        u32x2 w; w.x = cvt_pk_bf16(xc[0], xc[1]); w.y = cvt_pk_bf16(xc[2], xc[3]);
                        *(LAS u32x2*)(XCB + row * 136 + c4) = w;
                        float* oc = out + O_CS + (size_t)row * 3 * BW + ch;
                        *(f32x4*)oc = b1; *(f32x4*)(oc + BW) = b2; *(f32x4*)(oc + 2 * BW) = x0;
                    }
                }
            }
            __syncthreads();
            f32x4 ga[4][4];
#pragma unroll
            for (int rt = 0; rt < 4; ++rt)
#pragma unroll
                for (int ct = 0; ct < 4; ++ct) ga[rt][ct] = (f32x4){0.f, 0.f, 0.f, 0.f};
#pragma unroll
            for (int rt = 0; rt < 4; ++rt) {
                bf16x8 af[4];
#pragma unroll
                for (int ks = 0; ks < 4; ++ks) af[ks] = *(const LAS bf16x8*)(XCB + (64 * rh + 16 * rt + fr) * 136 + ks * 32 + fq * 8);
#pragma unroll
                for (int ct = 0; ct < 4; ++ct)
#pragma unroll
                    for (int ks = 0; ks < 4; ++ks) ga[rt][ct] = __builtin_amdgcn_mfma_f32_16x16x32_bf16(af[ks], wfr[ct][ks], ga[rt][ct], 0, 0, 0);
            }
            __syncthreads();
#pragma unroll
            for (int cl = 0; cl < 2; ++cl) {
                const int chl = 32 * cq + 16 * cl + fr, chg = ch0 + chl;
                const float ba = prm[chl], bx = prm[128 + chl], sp = prm[256 + chl];
#pragma unroll
                for (int rt = 0; rt < 4; ++rt)
#pragma unroll
                    for (int j = 0; j < 4; ++j) {
                        const int row = 64 * rh + 16 * rt + 4 * fq + j;
                        const float rr = sigmoidf_(ga[rt][cl][j] + ba), ii = sigmoidf_(ga[rt][2 + cl][j] + bx);
                        const float la = -8.0f * rr * sp;
                        const float a = __expf(la);
                        const float xc = XCF[row * 128 + chl];
                        const float bt = __builtin_amdgcn_sqrtf(fmaxf(1.0f - a * a, 0.f)) * (ii * xc);
                        if (smp) {
                            const float h = a * P.in[I_SLRU][(size_t)row * BW + chg] + bt;
                            out[O_HS + (size_t)row * BW + chg] = h;
                            const float rgv = bf2f(Z[(size_t)(MP + row) * NZ + 3072 + chg]);
                            YS[(size_t)(MP + row) * 3072 + 1024 + chg] = (bf16_t)(cvt_pk_bf16(rgv * h, 0.f) & 0xffffu);
                        } else {
                            AARR[row * 128 + chl] = a; XCF[row * 128 + chl] = bt;
                        }
                        if (j == 3) asm volatile("" ::: "memory");
                    }
            }
            __syncthreads();
            if (!smp) {
                {
                    LAS float* segA = (LAS float*)(lds + 131072); LAS float* segH = segA + 512;
                    const int seg = tid >> 7, chn = tid & 127;
                    float h = 0.f, pa = 1.f;
#pragma unroll 8
                    for (int i = 0; i < 32; ++i) { const int o = (32 * seg + i) * 128 + chn; const float a = AARR[o], b = XCF[o]; h = a * h + b; pa *= a; XCF[o] = h; AARR[o] = pa; }
                    segA[tid] = pa; segH[tid] = h;
                    __syncthreads();
                    float cA = 1.f, cH = 0.f;
                    for (int sg = 0; sg < seg; ++sg) { const float sa = segA[sg * 128 + chn]; cH = sa * cH + segH[sg * 128 + chn]; cA *= sa; }
                    if (seg > 0) {
#pragma unroll 8
                        for (int i = 0; i < 32; ++i) { const int o = (32 * seg + i) * 128 + chn; const float hl = XCF[o], pc = AARR[o]; XCF[o] = hl + pc * cH; AARR[o] = pc * cA; }
                    }
                    if (seg == 3) { SUM[(size_t)(c * 2 + 0) * BW + ch0 + chn] = pa * cA; SUM[(size_t)(c * 2 + 1) * BW + ch0 + chn] = h + pa * cH; }
                }
                __syncthreads();
#pragma unroll
                for (int i = 0; i < 8; ++i) { const int e = (i * 512 + tid) * 4, row = e >> 7, cc = e & 127;
                    *(f32x4*)(HL + (size_t)(r0 + row) * BW + ch0 + cc) = *(const LAS f32x4*)(XCF + e);
                    *(f32x4*)(AC + (size_t)(r0 + row) * BW + ch0 + cc) = *(const LAS f32x4*)(AARR + e); }
            }
            __syncthreads();
        }
    }
    if (PHON(7)) for (int it = bid; it < 256; it += G) {
        const int b = it >> 6, h = (it >> 4) & 3, qt = it & 15;
        int lane_o = lane; asm volatile("" : "+v"(lane_o));
        const int fr = lane_o & 15, fq = lane_o >> 4;
        const int row0 = b * SEQ + qt * 128 + wave * 16;
        bf16x8 qf[8];
#pragma unroll
        for (int ks = 0; ks < 8; ++ks) qf[ks] = *(const bf16x8*)(Z + (size_t)(row0 + fr) * NZ + 4096 + h * HD + ks * 32 + fq * 8);
        f32x4 s[16];
        LAS bf16_t* KL = (LAS bf16_t*)lds;
        __syncthreads();
        {
            const bf16_t* kb = KB + (size_t)(b * NMEM) * 1024 + h * HD;
            u32x4 t[16];
#pragma unroll
            for (int i = 0; i < 16; ++i) { const int e = tid + i * NTHREADS, m = e >> 5, c8 = (e & 31) * 8; t[i] = *(const u32x4*)(kb + (size_t)m * 1024 + c8); }
#pragma unroll
            for (int i = 0; i < 16; ++i) { const int e = tid + i * NTHREADS, m = e >> 5, c8 = (e & 31) * 8; *(LAS u32x4*)(KL + m * 264 + c8) = t[i]; }
        }
        asm volatile("" ::: "memory");
        u32x4 tv[16];
        {
            const bf16_t* vt0 = VT + (size_t)(h * HD) * 1024 + b * NMEM;
#pragma unroll
            for (int i = 0; i < 16; ++i) { const int e = tid + i * NTHREADS, dd = e >> 5, c8 = (e & 31) * 8; tv[i] = *(const u32x4*)(vt0 + (size_t)dd * 1024 + c8); }
        }
        __syncthreads();
#pragma unroll
        for (int mt = 0; mt < 16; ++mt) {
            s[mt] = (f32x4){0.f, 0.f, 0.f, 0.f};
#pragma unroll
            for (int ks = 0; ks < 8; ++ks) {
                const bf16x8 kf = *(const LAS bf16x8*)(KL + (mt * 16 + fr) * 264 + ks * 32 + fq * 8);
                s[mt] = __builtin_amdgcn_mfma_f32_16x16x32_bf16(kf, qf[ks], s[mt], 0, 0, 0);
            }
        }
        __syncthreads();
#pragma unroll
        for (int i = 0; i < 16; ++i) { const int e = tid + i * NTHREADS, dd = e >> 5, c8 = (e & 31) * 8; *(LAS u32x4*)(KL + dd * 264 + c8) = tv[i]; }
        float mx = -3.0e38f;
#pragma unroll
        for (int mt = 0; mt < 16; ++mt) mx = fmaxf(mx, fmaxf(fmaxf(s[mt][0], s[mt][1]), fmaxf(s[mt][2], s[mt][3])));
        mx = fmaxf(mx, __shfl_xor(mx, 16)); mx = fmaxf(mx, __shfl_xor(mx, 32));
        float sm = 0.f;
#pragma unroll
        for (int mt = 0; mt < 16; ++mt)
#pragma unroll
            for (int j = 0; j < 4; ++j) { const float p = __expf((s[mt][j] - mx) * 0.0625f); s[mt][j] = p; sm += p; }
        sm += __shfl_xor(sm, 16); sm += __shfl_xor(sm, 32);
        const float inv = 1.0f / sm;
        bf16x8 pf[8];
#pragma unroll
        for (int ks = 0; ks < 8; ++ks) {
            u32x4 w; w.x = cvt_pk_bf16(s[2 * ks][0], s[2 * ks][1]); w.y = cvt_pk_bf16(s[2 * ks][2], s[2 * ks][3]); w.z = cvt_pk_bf16(s[2 * ks + 1][0], s[2 * ks + 1][1]); w.w = cvt_pk_bf16(s[2 * ks + 1][2], s[2 * ks + 1][3]);
            pf[ks] = __builtin_bit_cast(bf16x8, w);
        }
        __syncthreads();
#pragma unroll 4
        for (int dt = 0; dt < 16; ++dt) {
            f32x4 o = (f32x4){0.f, 0.f, 0.f, 0.f};
#pragma unroll
            for (int ks = 0; ks < 8; ++ks) {
                const LAS bf16_t* vp = KL + (dt * 16 + fr) * 264 + ks * 32 + 4 * fq;
                const u32x2 lo = *(const LAS u32x2*)vp, hi = *(const LAS u32x2*)(vp + 16);
                const u32x4 w = (u32x4){lo.x, lo.y, hi.x, hi.y};
                o = __builtin_amdgcn_mfma_f32_16x16x32_bf16(__builtin_bit_cast(bf16x8, w), pf[ks], o, 0, 0, 0);
            }
            u32x2 w; w.x = cvt_pk_bf16(o[0] * inv, o[1] * inv); w.y = cvt_pk_bf16(o[2] * inv, o[3] * inv);
            *(u32x2*)(YS + (size_t)(row0 + fr) * 3072 + 2048 + h * HD + dt * 16 + 4 * fq) = w;
        }
    }
    if (!dfirst_ && PHON(8)) p5d_sample_attn(P, lds, bid, G, tid);
    GRID_BAR();

    if (PHON(9)) for (int it = bid; it < 256; it += G) {
        const int c = it >> 2, rq = it & 3, n = c & 15, cb = c & ~15;
        const int ch = 2 * tid;
        f32x2 carry = (f32x2){0.f, 0.f};
        {
            f32x2 pa[15], hh[15];
#pragma unroll
            for (int j = 0; j < 15; ++j) { pa[j] = (f32x2){1.f, 1.f}; hh[j] = (f32x2){0.f, 0.f};
                if (j < n) { pa[j] = *(const f32x2*)(SUM + (size_t)((cb + j) * 2 + 0) * BW + ch); hh[j] = *(const f32x2*)(SUM + (size_t)((cb + j) * 2 + 1) * BW + ch); } }
#pragma unroll
            for (int j = 0; j < 15; ++j) carry = pa[j] * carry + hh[j];
        }
#pragma unroll 8
        for (int i = 0; i < 32; ++i) {
            const int r = c * 128 + rq * 32 + i;
            const f32x2 hl = *(const f32x2*)(HL + (size_t)r * BW + ch), ac = *(const f32x2*)(AC + (size_t)r * BW + ch);
            const f32x2 hv = hl + ac * carry;
            const unsigned rw = *(const unsigned*)(Z + (size_t)r * NZ + 3072 + ch);
            *(unsigned*)(YS + (size_t)r * 3072 + 1024 + ch) = cvt_pk_bf16(bflo(rw) * hv[0], bfhi(rw) * hv[1]);
            if (n == 15 && rq == 3 && i == 31) *(f32x2*)(out + O_HP + (size_t)(c >> 4) * BW + ch) = hv;
        }
    }
    if (PHON(10)) {
        LAS bf16_t* VL = (LAS bf16_t*)lds;
        for (int e = bid * NTHREADS + tid; e < MS * BW / 2; e += G * NTHREADS) {
            const int r = e / (BW / 2), c2 = (e % (BW / 2)) * 2, g = c2 >> 8;
            const float w00 = P.in[I_WS][(size_t)g * 128 * 128], b0 = P.in[I_BS][g * 128];
            const unsigned vw = *(const unsigned*)(VP + (size_t)(MP + r) * BW + c2), uw = *(const unsigned*)(Z + (size_t)(MP + r) * NZ + c2);
            *(unsigned*)(YS + (size_t)(MP + r) * 3072 + c2) = cvt_pk_bf16(bflo(uw) * (w00 * bflo(vw) + b0), bfhi(uw) * (w00 * bfhi(vw) + b0));
        }
        for (int it = bid; it < 256; it += G) {
            const int g = it & 3, cn = it >> 2;
            const int r0 = cn * 128;
            __syncthreads();
            {
                u32x4 vt8[8];
#pragma unroll
                for (int i = 0; i < 8; ++i) { const int e = tid + i * NTHREADS, s = e >> 5, c8 = (e & 31) * 8; vt8[i] = *(const u32x4*)(VP + (size_t)(r0 + s) * BW + g * 256 + c8); }
#pragma unroll
                for (int i = 0; i < 8; ++i) { const int e = tid + i * NTHREADS, s = e >> 5, c8 = (e & 31) * 8; *(LAS u32x4*)(VL + s * 264 + c8) = vt8[i]; }
            }
            __syncthreads();
            const int fr = lane & 15, fq = lane >> 4;
            bf16x8 vf[2][4];
#pragma unroll
            for (int ct = 0; ct < 2; ++ct)
#pragma unroll
                for (int ks = 0; ks < 4; ++ks) {
                    bf16x8 t;
#pragma unroll
                    for (int j = 0; j < 8; ++j) t[j] = (short)VL[(ks * 32 + fq * 8 + j) * 264 + (2 * wave + ct) * 16 + fr];
                    vf[ct][ks] = t;
                }
            const bf16_t* wsp = WSP + (size_t)g * 128 * 128;
            u32x2 uwp[8][2];
#pragma unroll
            for (int tt = 0; tt < 8; ++tt)
#pragma unroll
                for (int ct = 0; ct < 2; ++ct) uwp[tt][ct] = *(const u32x2*)(Z + (size_t)(r0 + tt * 16 + fr) * NZ + g * 256 + (2 * wave + ct) * 16 + 4 * fq);
#pragma unroll
            for (int tt = 0; tt < 8; ++tt) {
                f32x4 o0 = (f32x4){0.f, 0.f, 0.f, 0.f}, o1 = o0;
#pragma unroll
                for (int ks = 0; ks < 4; ++ks) {
                    const bf16x8 wf = *(const bf16x8*)(wsp + (size_t)(tt * 16 + fr) * 128 + ks * 32 + fq * 8);
                    o0 = __builtin_amdgcn_mfma_f32_16x16x32_bf16(vf[0][ks], wf, o0, 0, 0, 0);
                    o1 = __builtin_amdgcn_mfma_f32_16x16x32_bf16(vf[1][ks], wf, o1, 0, 0, 0);
                }
                if ((tt & 3) == 3) asm volatile("" ::: "memory");
                const int t = tt * 16 + fr; const float bs = P.in[I_BS][g * 128 + t];
                const size_t r = (size_t)(r0 + t);
#pragma unroll
                for (int ct = 0; ct < 2; ++ct) {
                    const f32x4 o = ct ? o1 : o0;
                    const int cc = g * 256 + (2 * wave + ct) * 16 + 4 * fq;
                    const u32x2 uw = uwp[tt][ct];
                    u32x2 w; w.x = cvt_pk_bf16(bflo(uw.x) * (o[0] + bs), bfhi(uw.x) * (o[1] + bs)); w.y = cvt_pk_bf16(bflo(uw.y) * (o[2] + bs), bfhi(uw.y) * (o[3] + bs));
                    *(u32x2*)(YS + r * 3072 + cc) = w;
                }
            }
        }
        __syncthreads();
    }
    GRID_BAR();

    if (PHON(11)) {
        skinny<1>(lds, bid, G, wave, lane, YS + (size_t)MP * 3 * BW, 3 * BW, WBR, BW, BW, nullptr, nullptr, 0.f, 0.f, Z + (size_t)MP * NZ, XB + (size_t)MP * D);
        pg8::BranchSched S{YS, WBR, G, vc};
        pg8::EpiMerge E{Z, Y, XB};
        pg8::gemm_phase<pg8::BranchSched, pg8::EpiMerge, true, true>(lds, BW, 3 * BW, BW, S, E);
    }
    GRID_BAR();
    if (PHON(12)) {
        skinny<0>(lds, bid, G, wave, lane, XB + (size_t)MP * D, D, WOUT, D, D, Y + (size_t)MP * D, X1 + (size_t)MP * D, ALPHA, 1.0f, nullptr, nullptr);
        pg8::PlainSched S{XB, WOUT, 32, 8, D, D, G, vc};
        pg8::EpiResid E{Y, X1, ALPHA, 1.0f};
        pg8::gemm_phase<pg8::PlainSched, pg8::EpiResid, true, true>(lds, D, D, D, S, E);
    }
    GRID_BAR();
    if (PHON(13)) for (int r = gw; r < MR; r += NGW) ln_row(Y + (size_t)r * D, P.in[I_LN2G], P.in[I_LN2B], X1 + (size_t)r * D, XB + (size_t)r * D, lane);
    GRID_BAR();
    if (PHON(14)) {
        pg8::PlainSched S{XB, WGU2, 33, 44, D, D, G, vc};
        pg8::EpiSwiglu E{H, FF};
        pg8::gemm_phase<pg8::PlainSched, pg8::EpiSwiglu, true, true>(lds, D, D, D, S, E);
    }
    GRID_BAR();
    if (PHON(15)) {
        skinny<0>(lds, bid, G, wave, lane, H + (size_t)MP * FF, FF, WD2, FF, FF, Y + (size_t)MP * D, X1 + (size_t)MP * D, ALPHA, 0.5f, nullptr, nullptr);
        pg8::PlainSched S{H, WD2, 32, 8, FF, FF, G, vc};
        pg8::EpiResid E{Y, X1, ALPHA, 0.5f};
        pg8::gemm_phase<pg8::PlainSched, pg8::EpiResid, true, true>(lds, FF, FF, FF, S, E);
    }
    GRID_BAR();
    if (PHON(16)) for (int r = gw; r < MR; r += NGW) ln_row(Y + (size_t)r * D, P.in[I_LN3G], P.in[I_LN3B], out + O_Y + (size_t)r * D, nullptr, lane);
}

extern "C" void kernel_launch(void* const* d_in, const int* in_sizes, int n_in, void* d_out, int out_size, void* d_ws, size_t ws_size, hipStream_t stream) {
    static int grid = 0;
    if (grid == 0) {
        if (n_in != 35 || (size_t)out_size != O_END || ws_size < WS_END) { fprintf(stderr, "kernel_launch: unexpected shapes: n_in %d out %d (want %zu) ws %zu (need %zu)\n", n_in, out_size, (size_t)O_END, ws_size, (size_t)WS_END); grid = -1; return; }
        int dev = 0, cus = 0, per_cu = 0;
        hipGetDevice(&dev);
        hipDeviceGetAttribute(&cus, hipDeviceAttributeMultiprocessorCount, dev);
        hipFuncSetAttribute((const void*)fwd_kernel, hipFuncAttributeMaxDynamicSharedMemorySize, LDS_BYTES);
        hipOccupancyMaxActiveBlocksPerMultiprocessor(&per_cu, (const void*)fwd_kernel, NTHREADS, LDS_BYTES);
        if (per_cu < 1) { fprintf(stderr, "kernel_launch: occupancy query says %d blocks/CU\n", per_cu); per_cu = 1; }
        (void)hipGetLastError();
        grid = cus;
    }
    if (grid < 0) return;
    Params p{};
    for (int i = 0; i < 35; ++i) p.in[i] = (const float*)d_in[i];
    p.out = (float*)d_out; p.ws = (unsigned char*)d_ws;
    (void)hipMemsetAsync((char*)d_ws + WS_BAR, 0, (size_t)XCD_BAR_WORDS_ * 4, stream);
    void* args[] = {&p};
    hipError_t e = hipLaunchCooperativeKernel((const void*)fwd_kernel, dim3(grid), dim3(NTHREADS), args, LDS_BYTES, stream);
    if (e != hipSuccess) fprintf(stderr, "cooperative launch failed: %s (grid %d)\n", hipGetErrorString(e), grid);
}
```

```cpp
#include <hip/hip_runtime.h>
#include <hip/hip_cooperative_groups.h>
#include <cstdio>
#include <cstdint>
namespace cg = cooperative_groups;

#define LAS __attribute__((address_space(3)))
typedef unsigned short bf16_t;
typedef short bf16x8 __attribute__((ext_vector_type(8)));
typedef short bf16x4 __attribute__((ext_vector_type(4)));
typedef float f32x4 __attribute__((ext_vector_type(4)));
typedef float f32x2 __attribute__((ext_vector_type(2)));
typedef unsigned u32x4 __attribute__((ext_vector_type(4)));
typedef unsigned u32x2 __attribute__((ext_vector_type(2)));

constexpr int D = 2048, FF = 5632, BW = 1024, NZ = 11264;
constexpr int MP = 8192, MS = 128, MR = MP + MS, MPAD = 8448;
constexpr int SEQ = 2048, NB = 4, NMEM = 256, NH = 4, HD = 256;
constexpr float LN_EPS = 1e-5f;
constexpr float ALPHA = 1.189207115002721f;
constexpr int NTHREADS = 512, NWAVES = 8;

constexpr int XCD_BAR_WORDS_ = 3456;
constexpr size_t al256(size_t x) { return (x + 255) & ~(size_t)255; }
constexpr size_t WS_WGU1 = 0;
constexpr size_t WS_WD1 = WS_WGU1 + al256((size_t)NZ * D * 2);
constexpr size_t WS_WIN = WS_WD1 + al256((size_t)D * FF * 2);
constexpr size_t WS_WKV = WS_WIN + al256((size_t)NZ * D * 2);
constexpr size_t WS_WBR = WS_WKV + al256((size_t)D * D * 2);
constexpr size_t WS_WOUT = WS_WBR + al256((size_t)3 * D * BW * 2);
constexpr size_t WS_WGU2 = WS_WOUT + al256((size_t)D * D * 2);
constexpr size_t WS_WD2 = WS_WGU2 + al256((size_t)NZ * D * 2);
constexpr size_t WS_WLRU = WS_WD2 + al256((size_t)D * FF * 2);
constexpr size_t WS_WSP = WS_WLRU + al256((size_t)8 * 256 * 128 * 2);
constexpr size_t WS_XB = WS_WSP + al256((size_t)4 * 128 * 128 * 2);
constexpr size_t WS_ZH = WS_XB + al256((size_t)MPAD * D * 2);
constexpr size_t WS_Y = WS_ZH + al256((size_t)MPAD * NZ * 2);
constexpr size_t WS_X1 = WS_Y + al256((size_t)MPAD * D * 4);
constexpr size_t WS_VP = WS_X1 + al256((size_t)MPAD * D * 4);
constexpr size_t WS_HL = WS_VP + al256((size_t)MPAD * BW * 2);
constexpr size_t WS_AC = WS_HL + al256((size_t)MP * BW * 4);
constexpr size_t WS_SUM = WS_AC + al256((size_t)MP * BW * 4);
constexpr size_t WS_YS = WS_SUM + al256((size_t)64 * 2 * BW * 4);
constexpr size_t WS_MEMLN = WS_YS + al256((size_t)MPAD * 3 * BW * 2);
constexpr size_t WS_KB = WS_MEMLN + al256((size_t)1024 * D * 2);
constexpr size_t WS_VT = WS_KB + al256((size_t)1024 * 1024 * 2);
constexpr size_t WS_BAR = WS_VT + al256((size_t)1024 * 1024 * 2);
constexpr size_t WS_END = WS_BAR + al256((size_t)XCD_BAR_WORDS_ * 4);

constexpr size_t O_Y = 0;
constexpr size_t O_MK = (size_t)MR * D;
constexpr size_t O_MV = O_MK + (size_t)1024 * 1024;
constexpr size_t O_CP = O_MV + (size_t)1024 * 1024;
constexpr size_t O_HP = O_CP + (size_t)4 * 3 * 1024;
constexpr size_t O_CS = O_HP + (size_t)4 * 1024;
constexpr size_t O_HS = O_CS + (size_t)128 * 3 * 1024;
constexpr size_t O_VS = O_HS + (size_t)128 * 1024;
constexpr size_t O_END = O_VS + (size_t)128 * 1024;

constexpr int LDS_BYTES = 159744;

struct Params { const float* in[35]; float* out; unsigned char* ws; };
enum { I_XP = 0, I_XS, I_MEM, I_CK, I_CV, I_SCONV, I_SLRU, I_GU1, I_DN1, I_LN1G, I_LN1B, I_WIN, I_GATEB, I_GLNG, I_GLNB, I_WS, I_BS, I_CONVW, I_CONVB,
       I_LWA, I_LBA, I_LWX, I_LBX, I_LAM, I_MLNG, I_MLNB, I_WKV, I_WBR, I_WOUT, I_LN2G, I_LN2B, I_GU2, I_DN2, I_LN3G, I_LN3B };

__device__ __forceinline__ unsigned cvt_pk_bf16(float lo, float hi) { unsigned r; asm volatile("v_cvt_pk_bf16_f32 %0, %1, %2" : "=v"(r) : "v"(lo), "v"(hi)); return r; }
__device__ __forceinline__ float bf2f(unsigned short b) { return __uint_as_float(((unsigned)b) << 16); }
__device__ __forceinline__ float bflo(unsigned w) { return __uint_as_float(w << 16); }
__device__ __forceinline__ float bfhi(unsigned w) { return __uint_as_float(w & 0xffff0000u); }
__device__ __forceinline__ float sigmoidf_(float x) { return __builtin_amdgcn_rcpf(1.0f + __expf(-x)); }
__device__ __forceinline__ float siluf_(float x) { return x * sigmoidf_(x); }
__device__ __forceinline__ float gelu_tanh(float x) { return x * sigmoidf_(1.5957691216057308f * (x + 0.044715f * x * x * x)); }
__device__ __forceinline__ float wave_sum(float v) {
#pragma unroll
    for (int o = 1; o < 64; o <<= 1) v += __shfl_xor(v, o);
    return v;
}
__device__ __forceinline__ float wave_max(float v) {
#pragma unroll
    for (int o = 1; o < 64; o <<= 1) v = fmaxf(v, __shfl_xor(v, o));
    return v;
}

namespace pg8 {
constexpr int BM = 256, BK = 64, HALF = 128, HTB = HALF * BK * 2, STAGE_BYTES = 8 * HTB, NXCD = 8, WGM = 8;
__host__ __device__ __forceinline__ int lds_byte(int r, int c) { const int st = (r >> 4) * 2 + (c >> 5), rr = r & 15, cc = c & 31, ob = rr * 64 + cc * 2; return st * 1024 + (ob ^ (((ob >> 9) & 1) << 5)); }
__host__ __device__ __forceinline__ void stage_rc(int b, int& R, int& C) { const int st = b / 1024, sb = b % 1024, swz = sb ^ (((sb >> 9) & 1) << 5); R = (st >> 1) * 16 + swz / 64; C = (st & 1) * 32 + (swz % 64) / 2; }
__host__ __device__ __forceinline__ int perm32(int rho) { const int n = rho >> 4, i = rho & 15; return 8 * (i >> 2) + 4 * n + (i & 3); }

struct Unit { const char* A; const char* B; int pm, pn, kind; };

__device__ __forceinline__ void tile_of(int wgid, int nM, int nN, int& pm, int& pn) {
    const int nwg = nM * nN;
    { const int q = nwg / NXCD, r = nwg % NXCD, xcd = wgid % NXCD, off = wgid / NXCD; wgid = (xcd < r ? xcd * (q + 1) : r * (q + 1) + (xcd - r) * q) + off; }
    const int nig = WGM * nN, gid = wgid / nig, fm = gid * WGM, gsz = (nM - fm) < WGM ? (nM - fm) : WGM;
    pm = fm + ((wgid % nig) % gsz); pn = (wgid % nig) / gsz;
}
struct PlainSched {
    const bf16_t* A; const bf16_t* Bt; int nM, nN, lda, ldb, G, c;
    __device__ __forceinline__ bool next(int i, Unit& u) const {
        const int L = i * G + c; if (L >= nM * nN) return false;
        tile_of(L, nM, nN, u.pm, u.pn); u.kind = 0;
        u.A = (const char*)(A + (size_t)u.pm * BM * lda); u.B = (const char*)(Bt + (size_t)u.pn * BM * ldb); return true;
    }
};
struct WinSched {
    const bf16_t* XB_; const bf16_t* WIN_; const bf16_t* MEMLN_; const bf16_t* WKV_; int G, c;
    __device__ __forceinline__ bool next(int i, Unit& u) const {
        const int L = i * G + c; constexpr int NZU = 33 * 44;
        if (L < NZU) { tile_of(L, 33, 44, u.pm, u.pn); u.kind = 0; u.A = (const char*)(XB_ + (size_t)u.pm * BM * D); u.B = (const char*)(WIN_ + (size_t)u.pn * BM * D); return true; }
        if (L < NZU + 32) { const int j = L - NZU; u.pm = j >> 3; u.pn = j & 7; u.kind = 1; u.A = (const char*)(MEMLN_ + (size_t)u.pm * BM * D); u.B = (const char*)(WKV_ + (size_t)u.pn * BM * D); return true; }
        if (L < NZU + 48) { const int j = L - NZU - 32; u.pm = j >> 2; u.pn = j & 3; u.kind = 2; u.A = (const char*)(WKV_ + (size_t)(1024 + u.pm * BM) * D); u.B = (const char*)(MEMLN_ + (size_t)u.pn * BM * D); return true; }
        return false;
    }
};
struct BranchSched {
    const bf16_t* YS_; const bf16_t* WBR_; int G, c;
    __device__ __forceinline__ bool next(int i, Unit& u) const {
        const int t = (i / 3) * G + c, k = i % 3; if (t >= 256) return false;
        tile_of(t, 32, 8, u.pm, u.pn); u.kind = k;
        u.A = (const char*)(YS_ + (size_t)u.pm * BM * (3 * BW) + k * BW); u.B = (const char*)(WBR_ + (size_t)k * D * BW + (size_t)u.pn * BM * BW); return true;
    }
};

template <class Sched, class Epi, bool ALIGN_EPI, bool SP2>
__device__ __forceinline__ void gemm_phase(LAS unsigned char* lds, const int K, const int lda, const int ldb, const Sched& S, const Epi& E) {
    int tid = threadIdx.x; asm volatile("" : "+v"(tid));
    const int wid = __builtin_amdgcn_readfirstlane(tid >> 6), lane = tid & 63, wr = wid >> 2, wc = wid & 3, fr = lane & 15, fq = lane >> 4;
    const int nt = K / BK;
    unsigned voffA[2], voffB[2];
#pragma unroll
    for (int i = 0; i < 2; ++i) { int R, C; stage_rc(tid * 16 + i * 8192, R, C); const int Rb = Epi::PERM ? ((R & ~31) + perm32(R & 31)) : R;
        voffA[i] = (unsigned)(R * lda + C) * 2u; voffB[i] = (unsigned)(Rb * ldb + C) * 2u; }
    const size_t kstep = (size_t)(BK * 2);
    const size_t hstepA = (size_t)HALF * lda * 2, hstepB = (size_t)HALF * ldb * 2;
    const unsigned ldsw = (unsigned)wid * 1024u;
    const int aoff = lds_byte(wr * 64 + fr, fq * 8), boff = lds_byte(wc * 32 + fr, fq * 8);
#define PG8_SA(b, h) (((b) * 2 + (h)) * HTB)
#define PG8_SB(b, h) ((4 + (b) * 2 + (h)) * HTB)
#define PG8_STAGE(bufoff, gbase, voff) do { _Pragma("unroll") for (int _i = 0; _i < 2; ++_i) \
        __builtin_amdgcn_global_load_lds((const unsigned*)((const char*)(gbase) + (voff)[_i]), (LAS unsigned*)(lds + (bufoff) + ldsw + _i * 8192), 16, 0, 0); } while (0)
#define PG8_LDA(dst, b, h) do { _Pragma("unroll") for (int m = 0; m < 4; ++m) _Pragma("unroll") for (int k = 0; k < 2; ++k) dst[m][k] = *(const LAS bf16x8*)(lds + PG8_SA(b, h) + aoff + m * 2048 + k * 1024); } while (0)
#define PG8_LDB(dst, b, h) do { _Pragma("unroll") for (int n = 0; n < 2; ++n) _Pragma("unroll") for (int k = 0; k < 2; ++k) dst[n][k] = *(const LAS bf16x8*)(lds + PG8_SB(b, h) + boff + n * 2048 + k * 1024); } while (0)
#define PG8_MMA(ai, bj, At, Bt) do { __builtin_amdgcn_s_setprio(1); _Pragma("unroll") for (int m = 0; m < 4; ++m) _Pragma("unroll") for (int n = 0; n < 2; ++n) _Pragma("unroll") for (int k = 0; k < 2; ++k) \
        acc[ai][bj][m][n] = __builtin_amdgcn_mfma_f32_16x16x32_bf16(Bt[n][k], At[m][k], acc[ai][bj][m][n], 0, 0, 0); __builtin_amdgcn_s_setprio(0); } while (0)
#define PG8_WAIT_V(n) asm volatile("s_waitcnt vmcnt(" #n ")" ::: "memory")
#define PG8_WAIT_L(n) asm volatile("s_waitcnt lgkmcnt(" #n ")" ::: "memory")
#define PG8_BAR __builtin_amdgcn_s_barrier()
#define PG8_SCHED __builtin_amdgcn_sched_barrier(0)
    Unit cur, nxt; int ui = 0;
    if (!S.next(0, cur)) return;
    f32x4 acc[2][2][4][2];
#pragma unroll
    for (int a = 0; a < 2; ++a)
#pragma unroll
        for (int b = 0; b < 2; ++b)
#pragma unroll
            for (int m = 0; m < 4; ++m)
#pragma unroll
                for (int n = 0; n < 2; ++n) acc[a][b][m][n] = (f32x4){0.f, 0.f, 0.f, 0.f};
    bf16x8 At[4][2], B0[2][2], B1[2][2];
    const char* cA = cur.A; const char* cB = cur.B;
    if constexpr (SP2) {
        PG8_STAGE(PG8_SB(0, 0), cB, voffB); PG8_STAGE(PG8_SB(0, 1), cB + hstepB, voffB); PG8_STAGE(PG8_SA(0, 0), cA, voffA); PG8_STAGE(PG8_SA(0, 1), cA + hstepA, voffA);
        if (wr == 1) PG8_BAR;
        PG8_WAIT_V(2); PG8_BAR;
        PG8_STAGE(PG8_SB(1, 0), cB + kstep, voffB); PG8_STAGE(PG8_SA(1, 0), cA + kstep, voffA); PG8_STAGE(PG8_SB(1, 1), cB + hstepB + kstep, voffB);
        PG8_WAIT_V(6); PG8_BAR;
    } else {
        PG8_STAGE(PG8_SB(0, 0), cB, voffB); PG8_STAGE(PG8_SA(0, 0), cA, voffA); PG8_STAGE(PG8_SB(0, 1), cB + hstepB, voffB); PG8_STAGE(PG8_SA(0, 1), cA + hstepA, voffA);
        if (wr == 1) PG8_BAR;
        PG8_WAIT_V(4); PG8_BAR;
        PG8_STAGE(PG8_SB(1, 0), cB + kstep, voffB); PG8_STAGE(PG8_SA(1, 0), cA + kstep, voffA); PG8_STAGE(PG8_SB(1, 1), cB + hstepB + kstep, voffB);
        PG8_WAIT_V(6); PG8_BAR;
    }
    for (;;) {
        const bool has_next = S.next(ui + 1, nxt);
        const char* nA = has_next ? nxt.A : cA; const char* nB = has_next ? nxt.B : cB;
        for (int t = 0; t < nt; t += 2) {
            const bool last = (t == nt - 2);
            const char* a1 = cA + (size_t)(t + 1) * kstep;
            const char* a2 = last ? nA : cA + (size_t)(t + 2) * kstep; const char* b2 = last ? nB : cB + (size_t)(t + 2) * kstep;
            const char* a3 = a2 + kstep; const char* b3 = b2 + kstep;
            if constexpr (SP2) {
            PG8_LDB(B0, 0, 0); PG8_LDB(B1, 0, 1); PG8_SCHED; PG8_LDA(At, 0, 0); PG8_STAGE(PG8_SA(1, 1), a1 + hstepA, voffA);
            PG8_WAIT_V(8); PG8_WAIT_L(0); PG8_BAR; PG8_MMA(0, 0, At, B0); PG8_MMA(0, 1, At, B1); PG8_BAR; PG8_SCHED;
            PG8_LDA(At, 0, 1); PG8_STAGE(PG8_SB(0, 0), b2, voffB); PG8_STAGE(PG8_SB(0, 1), b2 + hstepB, voffB); PG8_STAGE(PG8_SA(0, 0), a2, voffA);
            PG8_WAIT_V(8); PG8_WAIT_L(0); PG8_BAR; PG8_MMA(1, 0, At, B0); PG8_MMA(1, 1, At, B1); PG8_BAR; PG8_SCHED;
            PG8_LDB(B0, 1, 0); PG8_LDB(B1, 1, 1); PG8_SCHED; PG8_LDA(At, 1, 0); PG8_STAGE(PG8_SA(0, 1), a2 + hstepA, voffA);
            PG8_WAIT_V(8); PG8_WAIT_L(0); PG8_BAR; PG8_MMA(0, 0, At, B0); PG8_MMA(0, 1, At, B1); PG8_BAR; PG8_SCHED;
            PG8_LDA(At, 1, 1); PG8_STAGE(PG8_SB(1, 0), b3, voffB); PG8_STAGE(PG8_SB(1, 1), b3 + hstepB, voffB); PG8_STAGE(PG8_SA(1, 0), a3, voffA);
            PG8_WAIT_V(8); PG8_WAIT_L(0); PG8_BAR; PG8_MMA(1, 0, At, B0); PG8_MMA(1, 1, At, B1); PG8_BAR; PG8_SCHED;
            } else {
            PG8_LDB(B0, 0, 0); PG8_SCHED; PG8_LDA(At, 0, 0); PG8_STAGE(PG8_SA(1, 1), a1 + hstepA, voffA);
            PG8_WAIT_L(8); PG8_BAR; PG8_WAIT_L(0); PG8_MMA(0, 0, At, B0); PG8_BAR; PG8_SCHED;
            PG8_LDB(B1, 0, 1); PG8_STAGE(PG8_SB(0, 0), b2, voffB);
            PG8_BAR; PG8_WAIT_L(0); PG8_MMA(0, 1, At, B1); PG8_BAR;
            PG8_LDA(At, 0, 1); PG8_STAGE(PG8_SA(0, 0), a2, voffA);
            PG8_BAR; PG8_WAIT_L(0); PG8_MMA(1, 0, At, B0); PG8_BAR; PG8_SCHED;
            PG8_STAGE(PG8_SB(0, 1), b2 + hstepB, voffB);
            PG8_WAIT_V(6); PG8_BAR; PG8_MMA(1, 1, At, B1); PG8_BAR;
            PG8_LDB(B0, 1, 0); PG8_SCHED; PG8_LDA(At, 1, 0); PG8_STAGE(PG8_SA(0, 1), a2 + hstepA, voffA);
            PG8_WAIT_L(8); PG8_BAR; PG8_WAIT_L(0); PG8_MMA(0, 0, At, B0); PG8_BAR; PG8_SCHED;
            PG8_LDB(B1, 1, 1); PG8_STAGE(PG8_SB(1, 0), b3, voffB);
            PG8_BAR; PG8_WAIT_L(0); PG8_MMA(0, 1, At, B1); PG8_BAR;
            PG8_LDA(At, 1, 1); PG8_STAGE(PG8_SA(1, 0), a3, voffA);
            PG8_BAR; PG8_WAIT_L(0); PG8_MMA(1, 0, At, B0); PG8_BAR; PG8_SCHED;
            PG8_STAGE(PG8_SB(1, 1), b3 + hstepB, voffB);
            PG8_WAIT_V(6); PG8_BAR; PG8_MMA(1, 1, At, B1); PG8_BAR;
            }
        }
        if constexpr (ALIGN_EPI) { if (wr == 0) PG8_BAR; }
        E(acc, cur, wr, wc, fr, fq);
        if (!has_next) break;
#pragma unroll
        for (int a = 0; a < 2; ++a)
#pragma unroll
            for (int b = 0; b < 2; ++b)
#pragma unroll
                for (int m = 0; m < 4; ++m)
#pragma unroll
                    for (int n = 0; n < 2; ++n) acc[a][b][m][n] = (f32x4){0.f, 0.f, 0.f, 0.f};
        cur = nxt; cA = nA; cB = nB; ++ui;
        if constexpr (ALIGN_EPI) { if (wr == 1) PG8_BAR; }
    }
    PG8_WAIT_V(0);
    if constexpr (!ALIGN_EPI) { if (wr == 0) PG8_BAR; }
    PG8_BAR;
#undef PG8_SA
#undef PG8_SB
#undef PG8_STAGE
#undef PG8_LDA
#undef PG8_LDB
#undef PG8_MMA
#undef PG8_WAIT_V
#undef PG8_WAIT_L
#undef PG8_BAR
#undef PG8_SCHED
}


struct EpiSwiglu {
    static constexpr bool PERM = true;
    bf16_t* H; int ldh;
    __device__ __forceinline__ void operator()(const f32x4 (&acc)[2][2][4][2], const Unit& u, int wr, int wc, int fr, int fq) const {
        const int row0 = u.pm * BM + wr * 64 + fr, col0 = u.pn * HALF + wc * 32 + 8 * fq;
#pragma unroll
        for (int ai = 0; ai < 2; ++ai)
#pragma unroll
            for (int m = 0; m < 4; ++m) {
                bf16_t* rowp = H + (size_t)(row0 + ai * HALF + m * 16) * ldh + col0;
                f32x4 v0, v1;
#pragma unroll
                for (int j = 0; j < 4; ++j) { v0[j] = siluf_(acc[ai][0][m][0][j]) * acc[ai][1][m][0][j]; v1[j] = siluf_(acc[ai][0][m][1][j]) * acc[ai][1][m][1][j]; }
                u32x4 w; w.x = cvt_pk_bf16(v0[0], v0[1]); w.y = cvt_pk_bf16(v0[2], v0[3]); w.z = cvt_pk_bf16(v1[0], v1[1]); w.w = cvt_pk_bf16(v1[2], v1[3]);
                *(u32x4*)rowp = w;
            }
    }
};
struct EpiResid {
    static constexpr bool PERM = false;
    float* Y; const float* res; float alpha, scale;
    __device__ __forceinline__ void operator()(const f32x4 (&acc)[2][2][4][2], const Unit& u, int wr, int wc, int fr, int fq) const {
        const int row0 = u.pm * BM + wr * 64 + fr, col0 = u.pn * BM + wc * 32 + 4 * fq;
#pragma unroll
        for (int ai = 0; ai < 2; ++ai)
#pragma unroll
            for (int m2 = 0; m2 < 2; ++m2) {
                f32x4 xv[2][2][2];
#pragma unroll
                for (int mm = 0; mm < 2; ++mm)
#pragma unroll
                    for (int bj = 0; bj < 2; ++bj)
#pragma unroll
                        for (int n = 0; n < 2; ++n) xv[mm][bj][n] = *(const f32x4*)(res + (size_t)(row0 + ai * HALF + (2 * m2 + mm) * 16) * D + col0 + bj * HALF + n * 16);
#pragma unroll
                for (int mm = 0; mm < 2; ++mm)
#pragma unroll
                    for (int bj = 0; bj < 2; ++bj)
#pragma unroll
                        for (int n = 0; n < 2; ++n) *(f32x4*)(Y + (size_t)(row0 + ai * HALF + (2 * m2 + mm) * 16) * D + col0 + bj * HALF + n * 16) = xv[mm][bj][n] * alpha + acc[ai][bj][2 * m2 + mm][n] * scale;
            }
    }
};
struct EpiWin {
    static constexpr bool PERM = true;
    bf16_t* Z; const LAS float* gate_b; float* outK; float* outV; bf16_t* KB; bf16_t* VT;
    __device__ __forceinline__ void operator()(const f32x4 (&acc)[2][2][4][2], const Unit& u, int wr, int wc, int fr, int fq) const {
        const int row0 = u.pm * BM + wr * 64 + fr, col0 = u.pn * BM + wc * 32 + 8 * fq;
        if (u.kind == 0) {
            const int mode = (u.pn < 8) ? 1 : (u.pn < 12) ? 0 : (u.pn < 16) ? 1 : (u.pn < 20) ? 0 : 2;
            f32x4 gb[2][2];
#pragma unroll
            for (int bj = 0; bj < 2; ++bj)
#pragma unroll
                for (int n = 0; n < 2; ++n) gb[bj][n] = (mode == 2) ? *(const LAS f32x4*)(gate_b + (col0 - 5120) + bj * HALF + 4 * n) : (f32x4){0.f, 0.f, 0.f, 0.f};
#pragma unroll
            for (int ai = 0; ai < 2; ++ai)
#pragma unroll
                for (int m = 0; m < 4; ++m) {
                    bf16_t* rowp = Z + (size_t)(row0 + ai * HALF + m * 16) * NZ + col0;
#pragma unroll
                    for (int bj = 0; bj < 2; ++bj) {
                        f32x4 v0 = acc[ai][bj][m][0], v1 = acc[ai][bj][m][1];
                        if (mode == 1) {
#pragma unroll
                            for (int j = 0; j < 4; ++j) { v0[j] = gelu_tanh(v0[j]); v1[j] = gelu_tanh(v1[j]); }
                        } else if (mode == 2) {
#pragma unroll
                            for (int j = 0; j < 4; ++j) { v0[j] = sigmoidf_(v0[j] + gb[bj][0][j]); v1[j] = sigmoidf_(v1[j] + gb[bj][1][j]); }
                        }
                        u32x4 w; w.x = cvt_pk_bf16(v0[0], v0[1]); w.y = cvt_pk_bf16(v0[2], v0[3]); w.z = cvt_pk_bf16(v1[0], v1[1]); w.w = cvt_pk_bf16(v1[2], v1[3]);
                        *(u32x4*)(rowp + bj * HALF) = w;
                    }
                }
        } else if (u.kind == 1) {
            const bool isk = u.pn < 4; const int c0 = col0 - (isk ? 0 : 1024);
            float* ob = isk ? outK : outV;
#pragma unroll
            for (int ai = 0; ai < 2; ++ai)
#pragma unroll
                for (int m = 0; m < 4; ++m) {
                    const size_t off = (size_t)(row0 + ai * HALF + m * 16) * 1024 + c0;
#pragma unroll
                    for (int bj = 0; bj < 2; ++bj) {
                        const f32x4 v0 = acc[ai][bj][m][0], v1 = acc[ai][bj][m][1];
                        *(f32x4*)(ob + off + bj * HALF) = v0; *(f32x4*)(ob + off + bj * HALF + 4) = v1;
                        if (isk) { u32x4 w; w.x = cvt_pk_bf16(v0[0], v0[1]); w.y = cvt_pk_bf16(v0[2], v0[3]); w.z = cvt_pk_bf16(v1[0], v1[1]); w.w = cvt_pk_bf16(v1[2], v1[3]); *(u32x4*)(KB + off + bj * HALF) = w; }
                    }
                }
        } else {
#pragma unroll
            for (int ai = 0; ai < 2; ++ai)
#pragma unroll
                for (int m = 0; m < 4; ++m) {
                    bf16_t* rowp = VT + (size_t)(row0 + ai * HALF + m * 16) * 1024 + col0;
#pragma unroll
                    for (int bj = 0; bj < 2; ++bj) {
                        const f32x4 v0 = acc[ai][bj][m][0], v1 = acc[ai][bj][m][1];
                        u32x4 w; w.x = cvt_pk_bf16(v0[0], v0[1]); w.y = cvt_pk_bf16(v0[2], v0[3]); w.z = cvt_pk_bf16(v1[0], v1[1]); w.w = cvt_pk_bf16(v1[2], v1[3]);
                        *(u32x4*)(rowp + bj * HALF) = w;
                    }
                }
        }
    }
};
struct EpiMerge {
    static constexpr bool PERM = false;
    const bf16_t* Z; float* MG; bf16_t* MB;
    template <int KI> __device__ __forceinline__ void body(const f32x4 (&acc)[2][2][4][2], const Unit& u, int wr, int wc, int fr, int fq) const {
        const int row0 = u.pm * BM + wr * 64 + fr, col0 = u.pn * BM + wc * 32 + 4 * fq;
#pragma unroll
        for (int ai = 0; ai < 2; ++ai)
#pragma unroll
            for (int m2 = 0; m2 < 2; ++m2) {
                u32x2 gw[2][2][2]; f32x4 mg[2][2][2];
#pragma unroll
                for (int mm = 0; mm < 2; ++mm)
#pragma unroll
                    for (int bj = 0; bj < 2; ++bj)
#pragma unroll
                        for (int n = 0; n < 2; ++n) {
                            const int r = row0 + ai * HALF + (2 * m2 + mm) * 16;
                            gw[mm][bj][n] = *(const u32x2*)(Z + (size_t)r * NZ + 5120 + KI * 2048 + col0 + bj * HALF + n * 16);
                            if (KI > 0) mg[mm][bj][n] = *(const f32x4*)(MG + (size_t)r * D + col0 + bj * HALF + n * 16);
                        }
#pragma unroll
                for (int mm = 0; mm < 2; ++mm)
#pragma unroll
                    for (int bj = 0; bj < 2; ++bj)
#pragma unroll
                        for (int n = 0; n < 2; ++n) {
                            const int r = row0 + ai * HALF + (2 * m2 + mm) * 16;
                            const size_t off = (size_t)r * D + col0 + bj * HALF + n * 16;
                            const u32x2 g2 = gw[mm][bj][n];
                            f32x4 v = (f32x4){bflo(g2.x), bfhi(g2.x), bflo(g2.y), bfhi(g2.y)} * acc[ai][bj][2 * m2 + mm][n];
                            if (KI > 0) v += mg[mm][bj][n];
                            if (KI < 2) *(f32x4*)(MG + off) = v;
                            else { u32x2 w; w.x = cvt_pk_bf16(v[0], v[1]); w.y = cvt_pk_bf16(v[2], v[3]); *(u32x2*)(MB + off) = w; }
                        }
            }
    }
    __device__ __forceinline__ void operator()(const f32x4 (&acc)[2][2][4][2], const Unit& u, int wr, int wc, int fr, int fq) const {
        if (u.kind == 0) body<0>(acc, u, wr, wc, fr, fq); else if (u.kind == 1) body<1>(acc, u, wr, wc, fr, fq); else body<2>(acc, u, wr, wc, fr, fq);
    }
};
}

#ifndef PHMASK
#define PHMASK 0xFFFFFFFFu
#endif
#ifndef GREP
#define GREP 1
#endif
#ifndef NREP
#define NREP 1
#endif
#define PHON(n) (((PHMASK) >> (n)) & 1u)
#define LDS_WAIT() asm volatile("s_waitcnt lgkmcnt(0)" ::: "memory")

__device__ __forceinline__ void transpose_item(const float* W, int N, bf16_t* WT, int ldk, int k0, int n0, int dst_row0, LAS float* scr, int lane) {
    f32x4 v[8];
    const int n4 = (lane & 7) * 4, kr = lane >> 3;
#pragma unroll
    for (int i = 0; i < 8; ++i) v[i] = __builtin_nontemporal_load((const f32x4*)(W + (size_t)(k0 + kr + 8 * i) * N + n0 + n4));
#pragma unroll
    for (int i = 0; i < 8; ++i) { LAS float* d = scr + (kr + 8 * i) * 33 + n4; d[0] = v[i][0]; d[1] = v[i][1]; d[2] = v[i][2]; d[3] = v[i][3]; }
    LDS_WAIT(); asm volatile("" ::: "memory");
    const int c = lane & 7;
#pragma unroll
    for (int j = 0; j < 4; ++j) { const int n = (lane >> 3) + 8 * j; const LAS float* s = scr + (8 * c) * 33 + n;
        u32x4 o; o.x = cvt_pk_bf16(s[0 * 33], s[1 * 33]); o.y = cvt_pk_bf16(s[2 * 33], s[3 * 33]); o.z = cvt_pk_bf16(s[4 * 33], s[5 * 33]); o.w = cvt_pk_bf16(s[6 * 33], s[7 * 33]);
        *(u32x4*)(WT + (size_t)(dst_row0 + n) * ldk + k0 + 8 * c) = o; }
    LDS_WAIT(); asm volatile("" ::: "memory");
}
__device__ __forceinline__ void ln_row(const float* yrow, const float* g, const float* b, float* of, bf16_t* ob, int lane) {
    f32x4 v[8]; float s = 0.f;
#pragma unroll
    for (int j = 0; j < 8; ++j) { v[j] = *(const f32x4*)(yrow + 4 * lane + 256 * j); s += (v[j][0] + v[j][1]) + (v[j][2] + v[j][3]); }
    const float mean = wave_sum(s) * (1.f / D); float s2 = 0.f;
#pragma unroll
    for (int j = 0; j < 8; ++j) { v[j] = v[j] - mean; s2 += (v[j][0] * v[j][0] + v[j][1] * v[j][1]) + (v[j][2] * v[j][2] + v[j][3] * v[j][3]); }
    const float rstd = 1.0f / sqrtf(wave_sum(s2) * (1.f / D) + LN_EPS);
#pragma unroll
    for (int j = 0; j < 8; ++j) {
        const f32x4 gg = *(const f32x4*)(g + 4 * lane + 256 * j), bb = *(const f32x4*)(b + 4 * lane + 256 * j);
        const f32x4 o = v[j] * rstd * gg + bb;
        if (of) *(f32x4*)(of + 4 * lane + 256 * j) = o;
        if (ob) { u32x2 w; w.x = cvt_pk_bf16(o[0], o[1]); w.y = cvt_pk_bf16(o[2], o[3]); *(u32x2*)(ob + 4 * lane + 256 * j) = w; }
    }
}

#define XB_TMO      128
#define XB_XCNT(j)  (256  + 64 * (j))
#define XB_XSUB(j)  (1280 + 64 * (j))
#define XB_XGEN(j)  (2304 + 64 * (j))
#define XB_TOP      3328
#define XB_TOPGEN   3392
#define XCD_BAR_WORDS 3456
#define XB_SPIN_CAP (1u << 22)
__device__ __forceinline__ unsigned xb_ld(unsigned* p)              { return __hip_atomic_load(p, __ATOMIC_RELAXED, __HIP_MEMORY_SCOPE_AGENT); }
__device__ __forceinline__ unsigned xb_add(unsigned* p, unsigned v) { return __hip_atomic_fetch_add(p, v, __ATOMIC_RELAXED, __HIP_MEMORY_SCOPE_AGENT); }
__device__ __forceinline__ unsigned xb_xcc_id() { return (unsigned)__builtin_amdgcn_s_getreg((3 << 11) | 20) & 0xFu; }
#define XB_SPIN(cond, bar) do { unsigned _sp = 0; while (cond) { __builtin_amdgcn_s_sleep(1); \
    if ((++_sp & 255u) == 0u) { if (xb_ld(&(bar)[XB_TMO])) break; if (_sp > XB_SPIN_CAP) { atomicAdd(&(bar)[XB_TMO], 1u); break; } } } } while (0)
struct XcdBarrier { unsigned* bar; unsigned x; volatile LAS unsigned* st; };
__device__ __forceinline__ XcdBarrier xcd_barrier_post(unsigned* bar, volatile LAS unsigned* st) {
    XcdBarrier b; b.bar = bar; b.x = xb_xcc_id(); b.st = st;
    if (threadIdx.x == 0) (void)xb_add(&bar[XB_XCNT(b.x)], 1u);
    return b;
}
__device__ __forceinline__ void xcd_barrier_complete(unsigned* bar, unsigned x, unsigned& nloc, unsigned& nx) {
    const unsigned G = gridDim.x * gridDim.y * gridDim.z;
    unsigned sum, cnt, mine, sp = 0u;
    for (;;) {
        sum = 0u; cnt = 0u; mine = 0u;
#pragma unroll
        for (unsigned j = 0; j < 16; ++j) { const unsigned c = xb_ld(&bar[XB_XCNT(j)]); sum += c; cnt += (c > 0u) ? 1u : 0u; mine = (j == x) ? c : mine; }
        if (sum == G) break;
        __builtin_amdgcn_s_sleep(1);
        if ((++sp & 255u) == 0u) { if (xb_ld(&bar[XB_TMO])) break; if (sp > XB_SPIN_CAP) { atomicAdd(&bar[XB_TMO], 1u); break; } }
    }
    nloc = mine > 0u ? mine : 1u; nx = cnt > 0u ? cnt : 1u;
}
__device__ __forceinline__ void xcd_barrier(const XcdBarrier& b) {
    asm volatile("s_waitcnt vmcnt(0)" ::: "memory");
    __syncthreads();
    if (threadIdx.x == 0) {
        unsigned* bar = b.bar;
        __builtin_amdgcn_s_waitcnt(0);
        unsigned nloc = b.st[0], nx = b.st[1];
        if (nloc == 0u) { xcd_barrier_complete(bar, b.x, nloc, nx); b.st[0] = nloc; b.st[1] = nx; }
        const unsigned old = xb_add(&bar[XB_XSUB(b.x)], 1u);
        const unsigned gen = old / nloc;
        if (old + 1u == (gen + 1u) * nloc) {
            __builtin_amdgcn_fence(__ATOMIC_RELEASE, "agent");
            asm volatile("s_waitcnt vmcnt(0)" ::: "memory");
            const unsigned og = xb_add(&bar[XB_TOP], 1u);
            const unsigned tg = og / nx;
            if (og + 1u == (tg + 1u) * nx) xb_add(&bar[XB_TOPGEN], 1u);
            else XB_SPIN(xb_ld(&bar[XB_TOPGEN]) == tg, bar);
            __builtin_amdgcn_fence(__ATOMIC_ACQUIRE, "agent");
            xb_add(&bar[XB_XGEN(b.x)], 1u);
            asm volatile("s_waitcnt vmcnt(0)" ::: "memory");
        } else {
            XB_SPIN(xb_ld(&bar[XB_XGEN(b.x)]) == gen, bar);
            __builtin_amdgcn_fence(__ATOMIC_ACQUIRE, "agent");
            asm volatile("s_waitcnt vmcnt(0)" ::: "memory");
        }
    }
    __syncthreads();
}

template <int MODE>
__device__ __forceinline__ void skinny(LAS unsigned char* lds, int bid, int G, int wave, int lane, const bf16_t* A, int lda, const bf16_t* Bt, int ldb, int K,
                                       float* Ys, const float* res, float alpha, float scale, const bf16_t* Zs, bf16_t* MBs) {
    const int fr = lane & 15, fq = lane >> 4, tw = wave & 3, kh = wave >> 2;
    LAS f32x4* red = (LAS f32x4*)lds;
    for (int T0 = bid * 4; T0 < 1024; T0 += G * 4) {
        const int T = T0 + tw, rt = T >> 7, ct = T & 127;
        f32x4 tot = (f32x4){0.f, 0.f, 0.f, 0.f};
        if (MODE == 0) {
            const int kb = kh * (K / 2);
            const bf16_t* ap = A + (size_t)(rt * 16 + fr) * lda + kb + fq * 8;
            const bf16_t* bp = Bt + (size_t)(ct * 16 + fr) * ldb + kb + fq * 8;
#pragma unroll 16
            for (int ks = 0; ks < K / 64; ++ks) {
                const bf16x8 af = *(const bf16x8*)(ap + ks * 32), bfv = *(const bf16x8*)(bp + ks * 32);
                tot = __builtin_amdgcn_mfma_f32_16x16x32_bf16(bfv, af, tot, 0, 0, 0);
            }
        } else {
#pragma unroll
            for (int k = 0; k < 3; ++k) {
                const int kb = kh * (BW / 2);
                const bf16_t* ap = A + (size_t)(rt * 16 + fr) * lda + k * BW + kb + fq * 8;
                const bf16_t* bp = Bt + (size_t)k * D * BW + (size_t)(ct * 16 + fr) * ldb + kb + fq * 8;
                f32x4 acc = (f32x4){0.f, 0.f, 0.f, 0.f};
#pragma unroll 8
                for (int ks = 0; ks < BW / 64; ++ks) {
                    const bf16x8 af = *(const bf16x8*)(ap + ks * 32), bfv = *(const bf16x8*)(bp + ks * 32);
                    acc = __builtin_amdgcn_mfma_f32_16x16x32_bf16(bfv, af, acc, 0, 0, 0);
                }
                const u32x2 gw = *(const u32x2*)(Zs + (size_t)(rt * 16 + fr) * NZ + 5120 + k * 2048 + ct * 16 + 4 * fq);
                tot += acc * (f32x4){bflo(gw.x), bfhi(gw.x), bflo(gw.y), bfhi(gw.y)};
            }
        }
        if (kh == 1) red[tw * 64 + lane] = tot;
        __syncthreads();
        if (kh == 0) {
            tot += red[tw * 64 + lane];
            const size_t off = (size_t)(rt * 16 + fr) * D + ct * 16 + 4 * fq;
            if (MODE == 0) { const f32x4 xv = *(const f32x4*)(res + off); *(f32x4*)(Ys + off) = xv * alpha + tot * scale; }
            else { u32x2 w; w.x = cvt_pk_bf16(tot[0], tot[1]); w.y = cvt_pk_bf16(tot[2], tot[3]); *(u32x2*)(MBs + off) = w; }
        }
        __syncthreads();
    }
}

#define WGU1 ((bf16_t*)(P.ws + WS_WGU1))
#define WD1 ((bf16_t*)(P.ws + WS_WD1))
#define WIN ((bf16_t*)(P.ws + WS_WIN))
#define WKV ((bf16_t*)(P.ws + WS_WKV))
#define WBR ((bf16_t*)(P.ws + WS_WBR))
#define WOUT ((bf16_t*)(P.ws + WS_WOUT))
#define WGU2 ((bf16_t*)(P.ws + WS_WGU2))
#define WD2 ((bf16_t*)(P.ws + WS_WD2))
#define WLRU ((bf16_t*)(P.ws + WS_WLRU))
#define WSP ((bf16_t*)(P.ws + WS_WSP))
#define XB ((bf16_t*)(P.ws + WS_XB))
#define Z ((bf16_t*)(P.ws + WS_ZH))
#define H ((bf16_t*)(P.ws + WS_ZH))
#define Y ((float*)(P.ws + WS_Y))
#define X1 ((float*)(P.ws + WS_X1))
#define VP ((bf16_t*)(P.ws + WS_VP))
#define HL ((float*)(P.ws + WS_HL))
#define AC ((float*)(P.ws + WS_AC))
#define SUM ((float*)(P.ws + WS_SUM))
#define YS ((bf16_t*)(P.ws + WS_YS))
#define MEMLN ((bf16_t*)(P.ws + WS_MEMLN))
#define KB ((bf16_t*)(P.ws + WS_KB))
#define VT ((bf16_t*)(P.ws + WS_VT))
__device__ __forceinline__ void p5d_sample_attn(const Params& P, LAS unsigned char* lds, int bid, int G, int tid_in) {
    int tid = tid_in; asm volatile("" : "+v"(tid));
    const int lane = tid & 63, wave = __builtin_amdgcn_readfirstlane(tid >> 6);

        LAS float* sS = (LAS float*)(lds + 131072);
        LAS float* sO = (LAS float*)(lds + 131072 + 1024);
        const int vb = (G % 8 == 0) ? (bid & 7) * (G >> 3) + (bid >> 3) : bid;
        for (int it = vb; it < 512; it += G) {
            const int b = it >> 2, h = it & 3;
            const u32x2 qw = *(const u32x2*)(Z + (size_t)(MP + b) * NZ + 4096 + h * HD + 4 * lane);
            const f32x4 q = (f32x4){bflo(qw.x), bfhi(qw.x), bflo(qw.y), bfhi(qw.y)};
            const float* kbase = P.in[I_CK] + ((size_t)(b * NMEM + 32 * wave) * NH + h) * HD + 4 * lane;
            const float* vbase = P.in[I_CV] + ((size_t)(b * NMEM + 32 * wave) * NH + h) * HD + 4 * lane;
            float d[32];
#pragma unroll
            for (int mi = 0; mi < 32; ++mi) {
                const f32x4 kv = __builtin_nontemporal_load((const f32x4*)(kbase + (size_t)mi * (NH * HD)));
                d[mi] = (kv[0] * q[0] + kv[1] * q[1]) + (kv[2] * q[2] + kv[3] * q[3]);
                if (mi == 15) asm volatile("" ::: "memory");
            }
#pragma unroll
            for (int i = 0; i < 16; ++i) { const bool hi = (lane & 32) != 0; const float snd = hi ? d[i] : d[i + 16], kp = hi ? d[i + 16] : d[i]; d[i] = kp + __shfl_xor(snd, 32); }
#pragma unroll
            for (int i = 0; i < 8; ++i) { const bool hi = (lane & 16) != 0; const float snd = hi ? d[i] : d[i + 8], kp = hi ? d[i + 8] : d[i]; d[i] = kp + __shfl_xor(snd, 16); }
#pragma unroll
            for (int i = 0; i < 4; ++i) { const bool hi = (lane & 8) != 0; const float snd = hi ? d[i] : d[i + 4], kp = hi ? d[i + 4] : d[i]; d[i] = kp + __shfl_xor(snd, 8); }
#pragma unroll
            for (int i = 0; i < 2; ++i) { const bool hi = (lane & 4) != 0; const float snd = hi ? d[i] : d[i + 2], kp = hi ? d[i + 2] : d[i]; d[i] = kp + __shfl_xor(snd, 4); }
            { const bool hi = (lane & 2) != 0; const float snd = hi ? d[0] : d[1], kp = hi ? d[1] : d[0]; d[0] = kp + __shfl_xor(snd, 2); }
            d[0] += __shfl_xor(d[0], 1);
            if ((lane & 1) == 0) sS[32 * wave + (lane >> 1)] = d[0] * 0.0625f;
            f32x4 vv[16];
#pragma unroll
            for (int mi = 0; mi < 16; ++mi) vv[mi] = __builtin_nontemporal_load((const f32x4*)(vbase + (size_t)mi * (NH * HD)));
            __syncthreads();
            float mx = fmaxf(fmaxf(sS[lane], sS[lane + 64]), fmaxf(sS[lane + 128], sS[lane + 192]));
            mx = wave_max(mx);
            float sm = __expf(sS[lane] - mx) + __expf(sS[lane + 64] - mx) + __expf(sS[lane + 128] - mx) + __expf(sS[lane + 192] - mx);
            sm = wave_sum(sm);
            const float inv = 1.0f / sm;
            f32x4 o = (f32x4){0.f, 0.f, 0.f, 0.f};
            f32x4 vw[16];
#pragma unroll
            for (int mi = 0; mi < 16; ++mi) vw[mi] = __builtin_nontemporal_load((const f32x4*)(vbase + (size_t)(16 + mi) * (NH * HD)));
#pragma unroll
            for (int mi = 0; mi < 16; ++mi) { const float p = __expf(sS[32 * wave + mi] - mx) * inv; o += vv[mi] * p; }
#pragma unroll
            for (int mi = 0; mi < 16; ++mi) { const float p = __expf(sS[32 * wave + 16 + mi] - mx) * inv; o += vw[mi] * p; }
            *(LAS f32x4*)(sO + wave * 256 + 4 * lane) = o;
            __syncthreads();
            if (tid < 256) {
                float a = 0.f;
#pragma unroll
                for (int w = 0; w < 8; ++w) a += sO[w * 256 + tid];
                YS[(size_t)(MP + b) * 3072 + 2048 + h * HD + tid] = (bf16_t)(cvt_pk_bf16(a, 0.f) & 0xffffu);
            }
            __syncthreads();
        }
}

__global__ void __launch_bounds__(NTHREADS, 2) fwd_kernel(Params P) {
    extern __shared__ __attribute__((aligned(16))) unsigned char lds_raw[];
    LAS unsigned char* lds = (LAS unsigned char*)lds_raw;
    cg::grid_group grid = cg::this_grid();
    const int tid = threadIdx.x, lane = tid & 63, wave = __builtin_amdgcn_readfirstlane(tid >> 6);
    const int G = gridDim.x, bid = blockIdx.x;
    const int gw = bid * NWAVES + wave, NGW = G * NWAVES;
    float* out = P.out;
    volatile LAS unsigned* bst = (volatile LAS unsigned*)(lds + LDS_BYTES - 64);
    if (tid == 0) { bst[0] = 0u; bst[1] = 0u; }
    __syncthreads();
    const XcdBarrier gbar = xcd_barrier_post((unsigned*)(P.ws + WS_BAR), bst);
#define GRID_BAR() xcd_barrier(gbar)

    if (PHON(0)) {
        LAS float* scr = (LAS float*)(lds + wave * 16384);
        constexpr int IT_GU = (D / 64) * (NZ / 32), IT_DN = (FF / 64) * (D / 32), IT_SQ = (D / 64) * (D / 32), IT_BR = (BW / 64) * (D / 32), IT_LR = 2 * 4;
        constexpr int IT_TOTAL = 3 * IT_GU + 2 * IT_DN + 2 * IT_SQ + 3 * IT_BR + 16 * IT_LR;
        for (int it = gw; it < IT_TOTAL; it += NGW) {
            int r = it; const float* W; bf16_t* WT; int N, ldk, mode = 0;
            if (r < IT_DN) { W = P.in[I_DN1]; WT = WD1; N = D; ldk = FF; }
            else if ((r -= IT_DN) < IT_GU) { W = P.in[I_WIN]; WT = WIN; N = NZ; ldk = D; }
            else if ((r -= IT_GU) < IT_SQ) { W = P.in[I_WKV]; WT = WKV; N = D; ldk = D; }
            else if ((r -= IT_SQ) < 3 * IT_BR) { const int k = r / IT_BR; r -= k * IT_BR; W = P.in[I_WBR] + (size_t)k * BW * D; WT = WBR + (size_t)k * D * BW; N = D; ldk = BW; }
            else if ((r -= 3 * IT_BR) < IT_SQ) { W = P.in[I_WOUT]; WT = WOUT; N = D; ldk = D; }
            else if ((r -= IT_SQ) < IT_GU) { W = P.in[I_GU2]; WT = WGU2; N = NZ; ldk = D; mode = 1; }
            else if ((r -= IT_GU) < IT_DN) { W = P.in[I_DN2]; WT = WD2; N = D; ldk = FF; }
            else if ((r -= IT_DN) < 16 * IT_LR) { const int m = r / IT_LR; r -= m * IT_LR; const int k = m >> 1, x = m & 1;
                W = (x ? P.in[I_LWX] : P.in[I_LWA]) + (size_t)k * 128 * 128; WT = WLRU + (size_t)k * 256 * 128 + x * 128 * 128; N = 128; ldk = 128; }
            else { r -= 16 * IT_LR; W = P.in[I_GU1]; WT = WGU1; N = NZ; ldk = D; mode = 1; }
            const int nblk = N / 32, kb = r / nblk, nb = r % nblk, n0 = 32 * nb;
            int dr = n0;
            if (mode == 1) dr = (n0 < FF) ? (n0 / 128) * 256 + (n0 % 128) : ((n0 - FF) / 128) * 256 + 128 + ((n0 - FF) % 128);
            transpose_item(W, N, WT, ldk, 64 * kb, n0, dr, scr, lane);
        }
        for (int i = gw * 64 + lane; i < 4 * 128 * 128; i += NGW * 64) { const int t = (i >> 7) & 127, s = i & 127; const float w = P.in[I_WS][i]; WSP[i] = (bf16_t)(cvt_pk_bf16(s <= t ? w : 0.f, 0.f) & 0xffffu); }
        for (size_t i = (size_t)gw * 64 + lane; i < (size_t)MPAD * D / 8; i += (size_t)NGW * 64) {
            const size_t e = i * 8; const int r = (int)(e / D);
            u32x4 w = (u32x4){0u, 0u, 0u, 0u};
            if (r < MR) { const float* src = (r < MP) ? P.in[I_XP] + e : P.in[I_XS] + (e - (size_t)MP * D);
                const f32x4 a = __builtin_nontemporal_load((const f32x4*)src), b = __builtin_nontemporal_load((const f32x4*)(src + 4));
                w.x = cvt_pk_bf16(a[0], a[1]); w.y = cvt_pk_bf16(a[2], a[3]); w.z = cvt_pk_bf16(b[0], b[1]); w.w = cvt_pk_bf16(b[2], b[3]); }
            *(u32x4*)(XB + e) = w;
        }
        for (int r = gw; r < 1024; r += NGW) ln_row(P.in[I_MEM] + (size_t)r * D, P.in[I_MLNG], P.in[I_MLNB], nullptr, MEMLN + (size_t)r * D, lane);
    }
    if (P.ws == nullptr) grid.sync();
    GRID_BAR();

    if (PHON(1)) {
        pg8::PlainSched S{XB, WGU1, 33, 44, D, D, G, bid};
        pg8::EpiSwiglu E{H, FF};
        pg8::gemm_phase<pg8::PlainSched, pg8::EpiSwiglu, true, true>(lds, D, D, D, S, E);
    }
    GRID_BAR();
    if (PHON(2)) {
        skinny<0>(lds, bid, G, wave, lane, H + (size_t)MP * FF, FF, WD1, FF, FF, Y + (size_t)MP * D, P.in[I_XS], ALPHA, 0.5f, nullptr, nullptr);
        pg8::PlainSched S{H, WD1, 32, 8, FF, FF, G, bid};
        pg8::EpiResid E{Y, P.in[I_XP], ALPHA, 0.5f};
        pg8::gemm_phase<pg8::PlainSched, pg8::EpiResid, true, true>(lds, FF, FF, FF, S, E);
    }
    GRID_BAR();
    if (PHON(3)) for (int r = gw; r < MR; r += NGW) ln_row(Y + (size_t)r * D, P.in[I_LN1G], P.in[I_LN1B], X1 + (size_t)r * D, XB + (size_t)r * D, lane);
    GRID_BAR();

    if (PHON(4)) {
        LAS float* gbl = (LAS float*)(lds + 131072);
        for (int i = tid; i < 3 * D / 4; i += NTHREADS) *(LAS f32x4*)(gbl + 4 * i) = *(const f32x4*)(P.in[I_GATEB] + 4 * i);
        __syncthreads();
        pg8::WinSched S{XB, WIN, MEMLN, WKV, G, bid};
        pg8::EpiWin E{Z, gbl, out + O_MK, out + O_MV, KB, VT};
        pg8::gemm_phase<pg8::WinSched, pg8::EpiWin, true, true>(lds, D, D, D, S, E);
    }
    GRID_BAR();

    const bool dfirst_ = ((bid >> 5) & 1) != 0;
    if (dfirst_ && PHON(8)) p5d_sample_attn(P, lds, bid, G, tid);
    if (PHON(5)) for (int r = gw; r < MR; r += NGW) {
        const bf16_t* zr = Z + (size_t)r * NZ + 1024;
        float v[16]; float s = 0.f;
#pragma unroll
        for (int h = 0; h < 2; ++h) { const u32x4 w = *(const u32x4*)(zr + 8 * lane + 512 * h);
            v[8 * h + 0] = bflo(w.x); v[8 * h + 1] = bfhi(w.x); v[8 * h + 2] = bflo(w.y); v[8 * h + 3] = bfhi(w.y); v[8 * h + 4] = bflo(w.z); v[8 * h + 5] = bfhi(w.z); v[8 * h + 6] = bflo(w.w); v[8 * h + 7] = bfhi(w.w); }
#pragma unroll
        for (int j = 0; j < 16; ++j) s += v[j];
        const float mean = wave_sum(s) * (1.f / BW); float s2 = 0.f;
#pragma unroll
        for (int j = 0; j < 16; ++j) { v[j] -= mean; s2 += v[j] * v[j]; }
        const float rstd = 1.0f / sqrtf(wave_sum(s2) * (1.f / BW) + LN_EPS);
#pragma unroll
        for (int h = 0; h < 2; ++h) {
            const int c0 = 8 * lane + 512 * h; float o[8];
#pragma unroll
            for (int j = 0; j < 8; ++j) o[j] = v[8 * h + j] * rstd * P.in[I_GLNG][c0 + j] + P.in[I_GLNB][c0 + j];
            u32x4 w; w.x = cvt_pk_bf16(o[0], o[1]); w.y = cvt_pk_bf16(o[2], o[3]); w.z = cvt_pk_bf16(o[4], o[5]); w.w = cvt_pk_bf16(o[6], o[7]);
            *(u32x4*)(VP + (size_t)r * BW + c0) = w;
            if (r >= MP) { float* ov = out + O_VS + (size_t)(r - MP) * BW + c0; *(f32x4*)ov = (f32x4){o[0], o[1], o[2], o[3]}; *(f32x4*)(ov + 4) = (f32x4){o[4], o[5], o[6], o[7]}; }
        }
    }
    if (PHON(6)) {
        LAS bf16_t* XCB = (LAS bf16_t*)lds;
        LAS float* AARR = (LAS float*)lds;
        LAS float* XCF = (LAS float*)(lds + 65536);
        for (int it = bid; it < 65 * 8; it += G) {
            const int c = it >> 3, k = it & 7; const bool smp = (c == 64);
            const int r0 = c * 128, ch0 = k * 128;
            int lane_o = lane; asm volatile("" : "+v"(lane_o));
            const int fr = lane_o & 15, fq = lane_o >> 4, rh = wave >> 2, cq = wave & 3;
            bf16x8 wfr[4][4];
            {
                const bf16_t* wb = WLRU + (size_t)k * 256 * 128;
#pragma unroll
                for (int ct = 0; ct < 4; ++ct)
#pragma unroll
                    for (int ks = 0; ks < 4; ++ks) wfr[ct][ks] = *(const bf16x8*)(wb + (size_t)((ct >> 1) * 128 + 32 * cq + 16 * (ct & 1) + fr) * 128 + ks * 32 + fq * 8);
            }
            LAS float* prm = (LAS float*)(lds + 131072 + 4096);
            if (tid < 128) { prm[tid] = P.in[I_LBA][ch0 + tid]; prm[128 + tid] = P.in[I_LBX][ch0 + tid]; prm[256 + tid] = __logf(1.0f + __expf(-P.in[I_LAM][ch0 + tid])); }
            {
                const int c4 = (tid & 31) * 4, rg = tid >> 5;
                const int ch = ch0 + c4;
                const f32x4 w0 = *(const f32x4*)(P.in[I_CONVW] + 0 * BW + ch), w1 = *(const f32x4*)(P.in[I_CONVW] + 1 * BW + ch), w2 = *(const f32x4*)(P.in[I_CONVW] + 2 * BW + ch), w3 = *(const f32x4*)(P.in[I_CONVW] + 3 * BW + ch);
                const f32x4 cb = *(const f32x4*)(P.in[I_CONVB] + ch);
                if (!smp) {
                    const bool first = ((c & 15) == 0);
                    const int rs = rg * 8;
                    const bool hist = !(first && rs == 0);
                    u32x2 zr[11];
#pragma unroll
                    for (int i = 0; i < 11; ++i) { zr[i] = (u32x2){0u, 0u}; if (i >= 3 || hist) zr[i] = *(const u32x2*)(Z + (size_t)(r0 + rs - 3 + i) * NZ + 2048 + ch); }
#define ZF(i) ((f32x4){bflo(zr[i].x), bfhi(zr[i].x), bflo(zr[i].y), bfhi(zr[i].y)})
#pragma unroll
                    for (int i = 0; i < 8; ++i) {
                        const int row = rs + i;
                        const f32x4 x0 = ZF(i + 3);
                        const f32x4 xc = cb + w3 * x0 + w2 * ZF(i + 2) + w1 * ZF(i + 1) + w0 * ZF(i);
                        *(LAS f32x4*)(XCF + row * 128 + c4) = xc;
                        u32x2 w; w.x = cvt_pk_bf16(xc[0], xc[1]); w.y = cvt_pk_bf16(xc[2], xc[3]);
                        *(LAS u32x2*)(XCB + row * 136 + c4) = w;
                        if ((c & 15) == 15 && row >= 125) *(f32x4*)(out + O_CP + (size_t)((c >> 4) * 3 + (row - 125)) * BW + ch) = x0;
                    }
#undef ZF
                } else {
#pragma unroll 4
                    for (int i = 0; i < 8; ++i) {
                        const int row = rg * 8 + i;
                        const float* sc = P.in[I_SCONV] + (size_t)row * 3 * BW + ch;
                        const f32x4 b0 = *(const f32x4*)sc, b1 = *(const f32x4*)(sc + BW), b2 = *(const f32x4*)(sc + 2 * BW);
                        const u32x2 a = *(const u32x2*)(Z + (size_t)(MP + row) * NZ + 2048 + ch);
                        const f32x4 x0 = (f32x4){bflo(a.x), bfhi(a.x), bflo(a.y), bfhi(a.y)};
                        const f32x4 xc = cb + w3 * x0 + w2 * b2 + w1 * b1 + w0 * b0;
                        *(LAS f32x4*)(XCF + row * 128 + c4) = xc;
                        u32x2 w; w.x = cvt_pk_bf16(xc[0], xc[1]); w.y = cvt_pk_bf16(xc[2], xc[3]);
                        *(LAS u32x2*)(XCB + row * 136 + c4) = w;
                        float* oc = out + O_CS + (size_t)row * 3 * BW + ch;
                        *(f32x4*)oc = b1; *(f32x4*)(oc + BW) = b2; *(f32x4*)(oc + 2 * BW) = x0;
                    }
                }
            }
            __syncthreads();
            f32x4 ga[4][4];
#pragma unroll
            for (int rt = 0; rt < 4; ++rt)
#pragma unroll
                for (int ct = 0; ct < 4; ++ct) ga[rt][ct] = (f32x4){0.f, 0.f, 0.f, 0.f};
#pragma unroll
            for (int rt = 0; rt < 4; ++rt) {
                bf16x8 af[4];
#pragma unroll
                for (int ks = 0; ks < 4; ++ks) af[ks] = *(const LAS bf16x8*)(XCB + (64 * rh + 16 * rt + fr) * 136 + ks * 32 + fq * 8);
#pragma unroll
                for (int ct = 0; ct < 4; ++ct)
#pragma unroll
                    for (int ks = 0; ks < 4; ++ks) ga[rt][ct] = __builtin_amdgcn_mfma_f32_16x16x32_bf16(af[ks], wfr[ct][ks], ga[rt][ct], 0, 0, 0);
            }
            __syncthreads();
#pragma unroll
            for (int cl = 0; cl < 2; ++cl) {
                const int chl = 32 * cq + 16 * cl + fr, chg = ch0 + chl;
                const float ba = prm[chl], bx = prm[128 + chl], sp = prm[256 + chl];
#pragma unroll
                for (int rt = 0; rt < 4; ++rt)
#pragma unroll
                    for (int j = 0; j < 4; ++j) {
                        const int row = 64 * rh + 16 * rt + 4 * fq + j;
                        const float rr = sigmoidf_(ga[rt][cl][j] + ba), ii = sigmoidf_(ga[rt][2 + cl][j] + bx);
                        const float la = -8.0f * rr * sp;
                        const float a = __expf(la);
                        const float xc = XCF[row * 128 + chl];
                        const float bt = __builtin_amdgcn_sqrtf(fmaxf(1.0f - a * a, 0.f)) * (ii * xc);
                        if (smp) {
                            const float h = a * P.in[I_SLRU][(size_t)row * BW + chg] + bt;
                            out[O_HS + (size_t)row * BW + chg] = h;
                            const float rgv = bf2f(Z[(size_t)(MP + row) * NZ + 3072 + chg]);
                            YS[(size_t)(MP + row) * 3072 + 1024 + chg] = (bf16_t)(cvt_pk_bf16(rgv * h, 0.f) & 0xffffu);
                        } else {
                            AARR[row * 128 + chl] = a; XCF[row * 128 + chl] = bt;
                        }
                        if (j == 3) asm volatile("" ::: "memory");
                    }
            }
            __syncthreads();
            if (!smp) {
                {
                    LAS float* segA = (LAS float*)(lds + 131072); LAS float* segH = segA + 512;
                    const int seg = tid >> 7, chn = tid & 127;
                    float h = 0.f, pa = 1.f;
#pragma unroll 8
                    for (int i = 0; i < 32; ++i) { const int o = (32 * seg + i) * 128 + chn; const float a = AARR[o], b = XCF[o]; h = a * h + b; pa *= a; XCF[o] = h; AARR[o] = pa; }
                    segA[tid] = pa; segH[tid] = h;
                    __syncthreads();
                    float cA = 1.f, cH = 0.f;
                    for (int sg = 0; sg < seg; ++sg) { const float sa = segA[sg * 128 + chn]; cH = sa * cH + segH[sg * 128 + chn]; cA *= sa; }
                    if (seg > 0) {
#pragma unroll 8
                        for (int i = 0; i < 32; ++i) { const int o = (32 * seg + i) * 128 + chn; const float hl = XCF[o], pc = AARR[o]; XCF[o] = hl + pc * cH; AARR[o] = pc * cA; }
                    }
                    if (seg == 3) { SUM[(size_t)(c * 2 + 0) * BW + ch0 + chn] = pa * cA; SUM[(size_t)(c * 2 + 1) * BW + ch0 + chn] = h + pa * cH; }
                }
                __syncthreads();
#pragma unroll
                for (int i = 0; i < 8; ++i) { const int e = (i * 512 + tid) * 4, row = e >> 7, cc = e & 127;
                    *(f32x4*)(HL + (size_t)(r0 + row) * BW + ch0 + cc) = *(const LAS f32x4*)(XCF + e);
                    *(f32x4*)(AC + (size_t)(r0 + row) * BW + ch0 + cc) = *(const LAS f32x4*)(AARR + e); }
            }
            __syncthreads();
        }
    }
    if (PHON(7)) for (int it = bid; it < 256; it += G) {
        const int b = it >> 6, h = (it >> 4) & 3, qt = it & 15;
        int lane_o = lane; asm volatile("" : "+v"(lane_o));
        const int fr = lane_o & 15, fq = lane_o >> 4;
        const int row0 = b * SEQ + qt * 128 + wave * 16;
        bf16x8 qf[8];
#pragma unroll
        for (int ks = 0; ks < 8; ++ks) qf[ks] = *(const bf16x8*)(Z + (size_t)(row0 + fr) * NZ + 4096 + h * HD + ks * 32 + fq * 8);
        f32x4 s[16];
        LAS bf16_t* KL = (LAS bf16_t*)lds;
        __syncthreads();
        {
            const bf16_t* kb = KB + (size_t)(b * NMEM) * 1024 + h * HD;
            u32x4 t[16];
#pragma unroll
            for (int i = 0; i < 16; ++i) { const int e = tid + i * NTHREADS, m = e >> 5, c8 = (e & 31) * 8; t[i] = *(const u32x4*)(kb + (size_t)m * 1024 + c8); }
#pragma unroll
            for (int i = 0; i < 16; ++i) { const int e = tid + i * NTHREADS, m = e >> 5, c8 = (e & 31) * 8; *(LAS u32x4*)(KL + m * 264 + c8) = t[i]; }
        }
        asm volatile("" ::: "memory");
        u32x4 tv[16];
        {
            const bf16_t* vt0 = VT + (size_t)(h * HD) * 1024 + b * NMEM;
#pragma unroll
            for (int i = 0; i < 16; ++i) { const int e = tid + i * NTHREADS, dd = e >> 5, c8 = (e & 31) * 8; tv[i] = *(const u32x4*)(vt0 + (size_t)dd * 1024 + c8); }
        }
        __syncthreads();
#pragma unroll
        for (int mt = 0; mt < 16; ++mt) {
            s[mt] = (f32x4){0.f, 0.f, 0.f, 0.f};
#pragma unroll
            for (int ks = 0; ks < 8; ++ks) {
                const bf16x8 kf = *(const LAS bf16x8*)(KL + (mt * 16 + fr) * 264 + ks * 32 + fq * 8);
                s[mt] = __builtin_amdgcn_mfma_f32_16x16x32_bf16(kf, qf[ks], s[mt], 0, 0, 0);
            }
        }
        __syncthreads();
#pragma unroll
        for (int i = 0; i < 16; ++i) { const int e = tid + i * NTHREADS, dd = e >> 5, c8 = (e & 31) * 8; *(LAS u32x4*)(KL + dd * 264 + c8) = tv[i]; }
        float mx = -3.0e38f;
#pragma unroll
        for (int mt = 0; mt < 16; ++mt) mx = fmaxf(mx, fmaxf(fmaxf(s[mt][0], s[mt][1]), fmaxf(s[mt][2], s[mt][3])));
        mx = fmaxf(mx, __shfl_xor(mx, 16)); mx = fmaxf(mx, __shfl_xor(mx, 32));
        float sm = 0.f;
#pragma unroll
        for (int mt = 0; mt < 16; ++mt)
#pragma unroll
            for (int j = 0; j < 4; ++j) { const float p = __expf((s[mt][j] - mx) * 0.0625f); s[mt][j] = p; sm += p; }
        sm += __shfl_xor(sm, 16); sm += __shfl_xor(sm, 32);
        const float inv = 1.0f / sm;
        bf16x8 pf[8];
#pragma unroll
        for (int ks = 0; ks < 8; ++ks) {
            u32x4 w; w.x = cvt_pk_bf16(s[2 * ks][0], s[2 * ks][1]); w.y = cvt_pk_bf16(s[2 * ks][2], s[2 * ks][3]); w.z = cvt_pk_bf16(s[2 * ks + 1][0], s[2 * ks + 1][1]); w.w = cvt_pk_bf16(s[2 * ks + 1][2], s[2 * ks + 1][3]);
            pf[ks] = __builtin_bit_cast(bf16x8, w);
        }
        __syncthreads();
#pragma unroll 4
        for (int dt = 0; dt < 16; ++dt) {
            f32x4 o = (f32x4){0.f, 0.f, 0.f, 0.f};
#pragma unroll
            for (int ks = 0; ks < 8; ++ks) {
                const LAS bf16_t* vp = KL + (dt * 16 + fr) * 264 + ks * 32 + 4 * fq;
                const u32x2 lo = *(const LAS u32x2*)vp, hi = *(const LAS u32x2*)(vp + 16);
                const u32x4 w = (u32x4){lo.x, lo.y, hi.x, hi.y};
                o = __builtin_amdgcn_mfma_f32_16x16x32_bf16(__builtin_bit_cast(bf16x8, w), pf[ks], o, 0, 0, 0);
            }
            u32x2 w; w.x = cvt_pk_bf16(o[0] * inv, o[1] * inv); w.y = cvt_pk_bf16(o[2] * inv, o[3] * inv);
            *(u32x2*)(YS + (size_t)(row0 + fr) * 3072 + 2048 + h * HD + dt * 16 + 4 * fq) = w;
        }
    }
    if (!dfirst_ && PHON(8)) p5d_sample_attn(P, lds, bid, G, tid);
    GRID_BAR();

    if (PHON(9)) for (int it = bid; it < 256; it += G) {
        const int c = it >> 2, rq = it & 3, n = c & 15, cb = c & ~15;
        const int ch = 2 * tid;
        f32x2 carry = (f32x2){0.f, 0.f};
        {
            f32x2 pa[15], hh[15];
#pragma unroll
            for (int j = 0; j < 15; ++j) { pa[j] = (f32x2){1.f, 1.f}; hh[j] = (f32x2){0.f, 0.f};
                if (j < n) { pa[j] = *(const f32x2*)(SUM + (size_t)((cb + j) * 2 + 0) * BW + ch); hh[j] = *(const f32x2*)(SUM + (size_t)((cb + j) * 2 + 1) * BW + ch); } }
#pragma unroll
            for (int j = 0; j < 15; ++j) carry = pa[j] * carry + hh[j];
        }
#pragma unroll 8
        for (int i = 0; i < 32; ++i) {
            const int r = c * 128 + rq * 32 + i;
            const f32x2 hl = *(const f32x2*)(HL + (size_t)r * BW + ch), ac = *(const f32x2*)(AC + (size_t)r * BW + ch);
            const f32x2 hv = hl + ac * carry;
            const unsigned rw = *(const unsigned*)(Z + (size_t)r * NZ + 3072 + ch);
            *(unsigned*)(YS + (size_t)r * 3072 + 1024 + ch) = cvt_pk_bf16(bflo(rw) * hv[0], bfhi(rw) * hv[1]);
            if (n == 15 && rq == 3 && i == 31) *(f32x2*)(out + O_HP + (size_t)(c >> 4) * BW + ch) = hv;
        }
    }
    if (PHON(10)) {
        LAS bf16_t* VL = (LAS bf16_t*)lds;
        for (int e = bid * NTHREADS + tid; e < MS * BW / 2; e += G * NTHREADS) {
            const int r = e / (BW / 2), c2 = (e % (BW / 2)) * 2, g = c2 >> 8;
            const float w00 = P.in[I_WS][(size_t)g * 128 * 128], b0 = P.in[I_BS][g * 128];
            const unsigned vw = *(const unsigned*)(VP + (size_t)(MP + r) * BW + c2), uw = *(const unsigned*)(Z + (size_t)(MP + r) * NZ + c2);
            *(unsigned*)(YS + (size_t)(MP + r) * 3072 + c2) = cvt_pk_bf16(bflo(uw) * (w00 * bflo(vw) + b0), bfhi(uw) * (w00 * bfhi(vw) + b0));
        }
        for (int it = bid; it < 256; it += G) {
            const int g = it & 3, cn = it >> 2;
            const int r0 = cn * 128;
            __syncthreads();
            {
                u32x4 vt8[8];
#pragma unroll
                for (int i = 0; i < 8; ++i) { const int e = tid + i * NTHREADS, s = e >> 5, c8 = (e & 31) * 8; vt8[i] = *(const u32x4*)(VP + (size_t)(r0 + s) * BW + g * 256 + c8); }
#pragma unroll
                for (int i = 0; i < 8; ++i) { const int e = tid + i * NTHREADS, s = e >> 5, c8 = (e & 31) * 8; *(LAS u32x4*)(VL + s * 264 + c8) = vt8[i]; }
            }
            __syncthreads();
            const int fr = lane & 15, fq = lane >> 4;
            bf16x8 vf[2][4];
#pragma unroll
            for (int ct = 0; ct < 2; ++ct)
#pragma unroll
                for (int ks = 0; ks < 4; ++ks) {
                    bf16x8 t;
#pragma unroll
                    for (int j = 0; j < 8; ++j) t[j] = (short)VL[(ks * 32 + fq * 8 + j) * 264 + (2 * wave + ct) * 16 + fr];
                    vf[ct][ks] = t;
                }
            const bf16_t* wsp = WSP + (size_t)g * 128 * 128;
            u32x2 uwp[8][2];
#pragma unroll
            for (int tt = 0; tt < 8; ++tt)
#pragma unroll
                for (int ct = 0; ct < 2; ++ct) uwp[tt][ct] = *(const u32x2*)(Z + (size_t)(r0 + tt * 16 + fr) * NZ + g * 256 + (2 * wave + ct) * 16 + 4 * fq);
#pragma unroll
            for (int tt = 0; tt < 8; ++tt) {
                f32x4 o0 = (f32x4){0.f, 0.f, 0.f, 0.f}, o1 = o0;
#pragma unroll
                for (int ks = 0; ks < 4; ++ks) {
                    const bf16x8 wf = *(const bf16x8*)(wsp + (size_t)(tt * 16 + fr) * 128 + ks * 32 + fq * 8);
                    o0 = __builtin_amdgcn_mfma_f32_16x16x32_bf16(vf[0][ks], wf, o0, 0, 0, 0);
                    o1 = __builtin_amdgcn_mfma_f32_16x16x32_bf16(vf[1][ks], wf, o1, 0, 0, 0);
                }
                if ((tt & 3) == 3) asm volatile("" ::: "memory");
                const int t = tt * 16 + fr; const float bs = P.in[I_BS][g * 128 + t];
                const size_t r = (size_t)(r0 + t);
#pragma unroll
                for (int ct = 0; ct < 2; ++ct) {
                    const f32x4 o = ct ? o1 : o0;
                    const int cc = g * 256 + (2 * wave + ct) * 16 + 4 * fq;
                    const u32x2 uw = uwp[tt][ct];
                    u32x2 w; w.x = cvt_pk_bf16(bflo(uw.x) * (o[0] + bs), bfhi(uw.x) * (o[1] + bs)); w.y = cvt_pk_bf16(bflo(uw.y) * (o[2] + bs), bfhi(uw.y) * (o[3] + bs));
                    *(u32x2*)(YS + r * 3072 + cc) = w;
                }
            }
        }
        __syncthreads();
    }
    GRID_BAR();

    if (PHON(11)) {
        skinny<1>(lds, bid, G, wave, lane, YS + (size_t)MP * 3 * BW, 3 * BW, WBR, BW, BW, nullptr, nullptr, 0.f, 0.f, Z + (size_t)MP * NZ, XB + (size_t)MP * D);
        pg8::BranchSched S{YS, WBR, G, bid};
        pg8::EpiMerge E{Z, Y, XB};
        pg8::gemm_phase<pg8::BranchSched, pg8::EpiMerge, true, true>(lds, BW, 3 * BW, BW, S, E);
    }
    GRID_BAR();
    if (PHON(12)) {
        skinny<0>(lds, bid, G, wave, lane, XB + (size_t)MP * D, D, WOUT, D, D, Y + (size_t)MP * D, X1 + (size_t)MP * D, ALPHA, 1.0f, nullptr, nullptr);
        pg8::PlainSched S{XB, WOUT, 32, 8, D, D, G, bid};
        pg8::EpiResid E{Y, X1, ALPHA, 1.0f};
        pg8::gemm_phase<pg8::PlainSched, pg8::EpiResid, true, true>(lds, D, D, D, S, E);
    }
    GRID_BAR();
    if (PHON(13)) for (int r = gw; r < MR; r += NGW) ln_row(Y + (size_t)r * D, P.in[I_LN2G], P.in[I_LN2B], X1 + (size_t)r * D, XB + (size_t)r * D, lane);
    GRID_BAR();
    if (PHON(14)) {
        pg8::PlainSched S{XB, WGU2, 33, 44, D, D, G, bid};
        pg8::EpiSwiglu E{H, FF};
        pg8::gemm_phase<pg8::PlainSched, pg8::EpiSwiglu, true, true>(lds, D, D, D, S, E);
    }
    GRID_BAR();
    if (PHON(15)) {
        skinny<0>(lds, bid, G, wave, lane, H + (size_t)MP * FF, FF, WD2, FF, FF, Y + (size_t)MP * D, X1 + (size_t)MP * D, ALPHA, 0.5f, nullptr, nullptr);
        pg8::PlainSched S{H, WD2, 32, 8, FF, FF, G, bid};
        pg8::EpiResid E{Y, X1, ALPHA, 0.5f};
        pg8::gemm_phase<pg8::PlainSched, pg8::EpiResid, true, true>(lds, FF, FF, FF, S, E);
    }
    GRID_BAR();
    if (PHON(16)) for (int r = gw; r < MR; r += NGW) ln_row(Y + (size_t)r * D, P.in[I_LN3G], P.in[I_LN3B], out + O_Y + (size_t)r * D, nullptr, lane);
}

extern "C" void kernel_launch(void* const* d_in, const int* in_sizes, int n_in, void* d_out, int out_size, void* d_ws, size_t ws_size, hipStream_t stream) {
    static int grid = 0;
    if (grid == 0) {
        if (n_in != 35 || (size_t)out_size != O_END || ws_size < WS_END) { fprintf(stderr, "kernel_launch: unexpected shapes: n_in %d out %d (want %zu) ws %zu (need %zu)\n", n_in, out_size, (size_t)O_END, ws_size, (size_t)WS_END); grid = -1; return; }
        int dev = 0, cus = 0, per_cu = 0;
        hipGetDevice(&dev);
        hipDeviceGetAttribute(&cus, hipDeviceAttributeMultiprocessorCount, dev);
        hipFuncSetAttribute((const void*)fwd_kernel, hipFuncAttributeMaxDynamicSharedMemorySize, LDS_BYTES);
        hipOccupancyMaxActiveBlocksPerMultiprocessor(&per_cu, (const void*)fwd_kernel, NTHREADS, LDS_BYTES);
        if (per_cu < 1) { fprintf(stderr, "kernel_launch: occupancy query says %d blocks/CU\n", per_cu); per_cu = 1; }
        (void)hipGetLastError();
        grid = cus;
    }
    if (grid < 0) return;
    Params p{};
    for (int i = 0; i < 35; ++i) p.in[i] = (const float*)d_in[i];
    p.out = (float*)d_out; p.ws = (unsigned char*)d_ws;
    (void)hipMemsetAsync((char*)d_ws + WS_BAR, 0, (size_t)XCD_BAR_WORDS_ * 4, stream);
    void* args[] = {&p};
    hipError_t e = hipLaunchCooperativeKernel((const void*)fwd_kernel, dim3(grid), dim3(NTHREADS), args, LDS_BYTES, stream);
    if (e != hipSuccess) fprintf(stderr, "cooperative launch failed: %s (grid %d)\n", hipGetErrorString(e), grid);
}
```

```cpp
#include <hip/hip_runtime.h>
#include <hip/hip_cooperative_groups.h>
#include <cstdio>
#include <cstdint>
namespace cg = cooperative_groups;

#define LAS __attribute__((address_space(3)))
typedef unsigned short bf16_t;
typedef short bf16x8 __attribute__((ext_vector_type(8)));
typedef short bf16x4 __attribute__((ext_vector_type(4)));
typedef float f32x4 __attribute__((ext_vector_type(4)));
typedef float f32x2 __attribute__((ext_vector_type(2)));
typedef unsigned u32x4 __attribute__((ext_vector_type(4)));
typedef unsigned u32x2 __attribute__((ext_vector_type(2)));

constexpr int D = 2048, FF = 5632, BW = 1024, NZ = 11264;
constexpr int MP = 8192, MS = 128, MR = MP + MS, MPAD = 8448;
constexpr int SEQ = 2048, NB = 4, NMEM = 256, NH = 4, HD = 256;
constexpr float LN_EPS = 1e-5f;
constexpr float ALPHA = 1.189207115002721f;
constexpr int NTHREADS = 512, NWAVES = 8;

constexpr int XCD_BAR_WORDS_ = 3456;
constexpr size_t al256(size_t x) { return (x + 255) & ~(size_t)255; }
constexpr size_t WS_WGU1 = 0;
constexpr size_t WS_WD1 = WS_WGU1 + al256((size_t)NZ * D * 2);
constexpr size_t WS_WIN = WS_WD1 + al256((size_t)D * FF * 2);
constexpr size_t WS_WKV = WS_WIN + al256((size_t)NZ * D * 2);
constexpr size_t WS_WBR = WS_WKV + al256((size_t)D * D * 2);
constexpr size_t WS_WOUT = WS_WBR + al256((size_t)3 * D * BW * 2);
constexpr size_t WS_WGU2 = WS_WOUT + al256((size_t)D * D * 2);
constexpr size_t WS_WD2 = WS_WGU2 + al256((size_t)NZ * D * 2);
constexpr size_t WS_WLRU = WS_WD2 + al256((size_t)D * FF * 2);
constexpr size_t WS_WSP = WS_WLRU + al256((size_t)8 * 256 * 128 * 2);
constexpr size_t WS_XB = WS_WSP + al256((size_t)4 * 128 * 128 * 2);
constexpr size_t WS_ZH = WS_XB + al256((size_t)MPAD * D * 2);
constexpr size_t WS_Y = WS_ZH + al256((size_t)MPAD * NZ * 2);
constexpr size_t WS_X1 = WS_Y + al256((size_t)MPAD * D * 4);
constexpr size_t WS_VP = WS_X1 + al256((size_t)MPAD * D * 4);
constexpr size_t WS_HL = WS_VP + al256((size_t)MPAD * BW * 2);
constexpr size_t WS_AC = WS_HL + al256((size_t)MP * BW * 4);
constexpr size_t WS_SUM = WS_AC + al256((size_t)MP * BW * 4);
constexpr size_t WS_YS = WS_SUM + al256((size_t)64 * 2 * BW * 4);
constexpr size_t WS_MEMLN = WS_YS + al256((size_t)MPAD * 3 * BW * 2);
constexpr size_t WS_KB = WS_MEMLN + al256((size_t)1024 * D * 2);
constexpr size_t WS_VT = WS_KB + al256((size_t)1024 * 1024 * 2);
constexpr size_t WS_BAR = WS_VT + al256((size_t)1024 * 1024 * 2);
constexpr size_t WS_END = WS_BAR + al256((size_t)XCD_BAR_WORDS_ * 4);

constexpr size_t O_Y = 0;
constexpr size_t O_MK = (size_t)MR * D;
constexpr size_t O_MV = O_MK + (size_t)1024 * 1024;
constexpr size_t O_CP = O_MV + (size_t)1024 * 1024;
constexpr size_t O_HP = O_CP + (size_t)4 * 3 * 1024;
constexpr size_t O_CS = O_HP + (size_t)4 * 1024;
constexpr size_t O_HS = O_CS + (size_t)128 * 3 * 1024;
constexpr size_t O_VS = O_HS + (size_t)128 * 1024;
constexpr size_t O_END = O_VS + (size_t)128 * 1024;

constexpr int LDS_BYTES = 159744;

struct Params { const float* in[35]; float* out; unsigned char* ws; };
enum { I_XP = 0, I_XS, I_MEM, I_CK, I_CV, I_SCONV, I_SLRU, I_GU1, I_DN1, I_LN1G, I_LN1B, I_WIN, I_GATEB, I_GLNG, I_GLNB, I_WS, I_BS, I_CONVW, I_CONVB,
       I_LWA, I_LBA, I_LWX, I_LBX, I_LAM, I_MLNG, I_MLNB, I_WKV, I_WBR, I_WOUT, I_LN2G, I_LN2B, I_GU2, I_DN2, I_LN3G, I_LN3B };

__device__ __forceinline__ unsigned cvt_pk_bf16(float lo, float hi) { unsigned r; asm volatile("v_cvt_pk_bf16_f32 %0, %1, %2" : "=v"(r) : "v"(lo), "v"(hi)); return r; }
__device__ __forceinline__ float bf2f(unsigned short b) { return __uint_as_float(((unsigned)b) << 16); }
__device__ __forceinline__ float bflo(unsigned w) { return __uint_as_float(w << 16); }
__device__ __forceinline__ float bfhi(unsigned w) { return __uint_as_float(w & 0xffff0000u); }
__device__ __forceinline__ float sigmoidf_(float x) { return __builtin_amdgcn_rcpf(1.0f + __expf(-x)); }
__device__ __forceinline__ float siluf_(float x) { return x * sigmoidf_(x); }
__device__ __forceinline__ float gelu_tanh(float x) { return x * sigmoidf_(1.5957691216057308f * (x + 0.044715f * x * x * x)); }
__device__ __forceinline__ float wave_sum(float v) {
#pragma unroll
    for (int o = 1; o < 64; o <<= 1) v += __shfl_xor(v, o);
    return v;
}
__device__ __forceinline__ float wave_max(float v) {
#pragma unroll
    for (int o = 1; o < 64; o <<= 1) v = fmaxf(v, __shfl_xor(v, o));
    return v;
}

namespace pg8 {
constexpr int BM = 256, BK = 64, HALF = 128, HTB = HALF * BK * 2, STAGE_BYTES = 8 * HTB, NXCD = 8, WGM = 8;
__host__ __device__ __forceinline__ int lds_byte(int r, int c) { const int st = (r >> 4) * 2 + (c >> 5), rr = r & 15, cc = c & 31, ob = rr * 64 + cc * 2; return st * 1024 + (ob ^ (((ob >> 9) & 1) << 5)); }
__host__ __device__ __forceinline__ void stage_rc(int b, int& R, int& C) { const int st = b / 1024, sb = b % 1024, swz = sb ^ (((sb >> 9) & 1) << 5); R = (st >> 1) * 16 + swz / 64; C = (st & 1) * 32 + (swz % 64) / 2; }
__host__ __device__ __forceinline__ int perm32(int rho) { const int n = rho >> 4, i = rho & 15; return 8 * (i >> 2) + 4 * n + (i & 3); }

struct Unit { const char* A; const char* B; int pm, pn, kind; };

__device__ __forceinline__ void tile_of(int wgid, int nM, int nN, int& pm, int& pn) {
    const int nwg = nM * nN;
    { const int q = nwg / NXCD, r = nwg % NXCD, xcd = wgid % NXCD, off = wgid / NXCD; wgid = (xcd < r ? xcd * (q + 1) : r * (q + 1) + (xcd - r) * q) + off; }
    const int nig = WGM * nN, gid = wgid / nig, fm = gid * WGM, gsz = (nM - fm) < WGM ? (nM - fm) : WGM;
    pm = fm + ((wgid % nig) % gsz); pn = (wgid % nig) / gsz;
}
struct PlainSched {
    const bf16_t* A; const bf16_t* Bt; int nM, nN, lda, ldb, G, c;
    __device__ __forceinline__ bool next(int i, Unit& u) const {
        const int L = i * G + c; if (L >= nM * nN) return false;
        tile_of(L, nM, nN, u.pm, u.pn); u.kind = 0;
        u.A = (const char*)(A + (size_t)u.pm * BM * lda); u.B = (const char*)(Bt + (size_t)u.pn * BM * ldb); return true;
    }
};
struct WinSched {
    const bf16_t* XB_; const bf16_t* WIN_; const bf16_t* MEMLN_; const bf16_t* WKV_; int G, c;
    __device__ __forceinline__ bool next(int i, Unit& u) const {
        const int L = i * G + c; constexpr int NZU = 33 * 44;
        if (L < NZU) { tile_of(L, 33, 44, u.pm, u.pn); u.kind = 0; u.A = (const char*)(XB_ + (size_t)u.pm * BM * D); u.B = (const char*)(WIN_ + (size_t)u.pn * BM * D); return true; }
        if (L < NZU + 32) { const int j = L - NZU; u.pm = j >> 3; u.pn = j & 7; u.kind = 1; u.A = (const char*)(MEMLN_ + (size_t)u.pm * BM * D); u.B = (const char*)(WKV_ + (size_t)u.pn * BM * D); return true; }
        if (L < NZU + 48) { const int j = L - NZU - 32; u.pm = j >> 2; u.pn = j & 3; u.kind = 2; u.A = (const char*)(WKV_ + (size_t)(1024 + u.pm * BM) * D); u.B = (const char*)(MEMLN_ + (size_t)u.pn * BM * D); return true; }
        return false;
    }
};
struct BranchSched {
    const bf16_t* YS_; const bf16_t* WBR_; int G, c;
    __device__ __forceinline__ bool next(int i, Unit& u) const {
        const int t = (i / 3) * G + c, k = i % 3; if (t >= 256) return false;
        tile_of(t, 32, 8, u.pm, u.pn); u.kind = k;
        u.A = (const char*)(YS_ + (size_t)u.pm * BM * (3 * BW) + k * BW); u.B = (const char*)(WBR_ + (size_t)k * D * BW + (size_t)u.pn * BM * BW); return true;
    }
};

template <class Sched, class Epi, bool ALIGN_EPI, bool SP2>
__device__ __forceinline__ void gemm_phase(LAS unsigned char* lds, const int K, const int lda, const int ldb, const Sched& S, const Epi& E) {
    int tid = threadIdx.x; asm volatile("" : "+v"(tid));
    const int wid = __builtin_amdgcn_readfirstlane(tid >> 6), lane = tid & 63, wr = wid >> 2, wc = wid & 3, fr = lane & 15, fq = lane >> 4;
    const int nt = K / BK;
    unsigned voffA[2], voffB[2];
#pragma unroll
    for (int i = 0; i < 2; ++i) { int R, C; stage_rc(tid * 16 + i * 8192, R, C); const int Rb = Epi::PERM ? ((R & ~31) + perm32(R & 31)) : R;
        voffA[i] = (unsigned)(R * lda + C) * 2u; voffB[i] = (unsigned)(Rb * ldb + C) * 2u; }
    const size_t kstep = (size_t)(BK * 2);
    const size_t hstepA = (size_t)HALF * lda * 2, hstepB = (size_t)HALF * ldb * 2;
    const unsigned ldsw = (unsigned)wid * 1024u;
    const int aoff = lds_byte(wr * 64 + fr, fq * 8), boff = lds_byte(wc * 32 + fr, fq * 8);
#define PG8_SA(b, h) (((b) * 2 + (h)) * HTB)
#define PG8_SB(b, h) ((4 + (b) * 2 + (h)) * HTB)
#define PG8_STAGE(bufoff, gbase, voff) do { _Pragma("unroll") for (int _i = 0; _i < 2; ++_i) \
        __builtin_amdgcn_global_load_lds((const unsigned*)((const char*)(gbase) + (voff)[_i]), (LAS unsigned*)(lds + (bufoff) + ldsw + _i * 8192), 16, 0, 0); } while (0)
#define PG8_LDA(dst, b, h) do { _Pragma("unroll") for (int m = 0; m < 4; ++m) _Pragma("unroll") for (int k = 0; k < 2; ++k) dst[m][k] = *(const LAS bf16x8*)(lds + PG8_SA(b, h) + aoff + m * 2048 + k * 1024); } while (0)
#define PG8_LDB(dst, b, h) do { _Pragma("unroll") for (int n = 0; n < 2; ++n) _Pragma("unroll") for (int k = 0; k < 2; ++k) dst[n][k] = *(const LAS bf16x8*)(lds + PG8_SB(b, h) + boff + n * 2048 + k * 1024); } while (0)
#define PG8_MMA(ai, bj, At, Bt) do { __builtin_amdgcn_s_setprio(1); _Pragma("unroll") for (int m = 0; m < 4; ++m) _Pragma("unroll") for (int n = 0; n < 2; ++n) _Pragma("unroll") for (int k = 0; k < 2; ++k) \
        acc[ai][bj][m][n] = __builtin_amdgcn_mfma_f32_16x16x32_bf16(Bt[n][k], At[m][k], acc[ai][bj][m][n], 0, 0, 0); __builtin_amdgcn_s_setprio(0); } while (0)
#define PG8_WAIT_V(n) asm volatile("s_waitcnt vmcnt(" #n ")" ::: "memory")
#define PG8_WAIT_L(n) asm volatile("s_waitcnt lgkmcnt(" #n ")" ::: "memory")
#define PG8_BAR __builtin_amdgcn_s_barrier()
#define PG8_SCHED __builtin_amdgcn_sched_barrier(0)
    Unit cur, nxt; int ui = 0;
    if (!S.next(0, cur)) return;
    f32x4 acc[2][2][4][2];
#pragma unroll
    for (int a = 0; a < 2; ++a)
#pragma unroll
        for (int b = 0; b < 2; ++b)
#pragma unroll
            for (int m = 0; m < 4; ++m)
#pragma unroll
                for (int n = 0; n < 2; ++n) acc[a][b][m][n] = (f32x4){0.f, 0.f, 0.f, 0.f};
    bf16x8 At[4][2], B0[2][2], B1[2][2];
    const char* cA = cur.A; const char* cB = cur.B;
    if constexpr (SP2) {
        PG8_STAGE(PG8_SB(0, 0), cB, voffB); PG8_STAGE(PG8_SB(0, 1), cB + hstepB, voffB); PG8_STAGE(PG8_SA(0, 0), cA, voffA); PG8_STAGE(PG8_SA(0, 1), cA + hstepA, voffA);
        if (wr == 1) PG8_BAR;
        PG8_WAIT_V(2); PG8_BAR;
        PG8_STAGE(PG8_SB(1, 0), cB + kstep, voffB); PG8_STAGE(PG8_SA(1, 0), cA + kstep, voffA); PG8_STAGE(PG8_SB(1, 1), cB + hstepB + kstep, voffB);
        PG8_WAIT_V(6); PG8_BAR;
    } else {
        PG8_STAGE(PG8_SB(0, 0), cB, voffB); PG8_STAGE(PG8_SA(0, 0), cA, voffA); PG8_STAGE(PG8_SB(0, 1), cB + hstepB, voffB); PG8_STAGE(PG8_SA(0, 1), cA + hstepA, voffA);
        if (wr == 1) PG8_BAR;
        PG8_WAIT_V(4); PG8_BAR;
        PG8_STAGE(PG8_SB(1, 0), cB + kstep, voffB); PG8_STAGE(PG8_SA(1, 0), cA + kstep, voffA); PG8_STAGE(PG8_SB(1, 1), cB + hstepB + kstep, voffB);
        PG8_WAIT_V(6); PG8_BAR;
    }
    for (;;) {
        const bool has_next = S.next(ui + 1, nxt);
        const char* nA = has_next ? nxt.A : cA; const char* nB = has_next ? nxt.B : cB;
        for (int t = 0; t < nt; t += 2) {
            const bool last = (t == nt - 2);
            const char* a1 = cA + (size_t)(t + 1) * kstep;
            const char* a2 = last ? nA : cA + (size_t)(t + 2) * kstep; const char* b2 = last ? nB : cB + (size_t)(t + 2) * kstep;
            const char* a3 = a2 + kstep; const char* b3 = b2 + kstep;
            if constexpr (SP2) {
            PG8_LDB(B0, 0, 0); PG8_LDB(B1, 0, 1); PG8_SCHED; PG8_LDA(At, 0, 0); PG8_STAGE(PG8_SA(1, 1), a1 + hstepA, voffA);
            PG8_WAIT_V(8); PG8_WAIT_L(0); PG8_BAR; PG8_MMA(0, 0, At, B0); PG8_MMA(0, 1, At, B1); PG8_BAR; PG8_SCHED;
            PG8_LDA(At, 0, 1); PG8_STAGE(PG8_SB(0, 0), b2, voffB); PG8_STAGE(PG8_SB(0, 1), b2 + hstepB, voffB); PG8_STAGE(PG8_SA(0, 0), a2, voffA);
            PG8_WAIT_V(8); PG8_WAIT_L(0); PG8_BAR; PG8_MMA(1, 0, At, B0); PG8_MMA(1, 1, At, B1); PG8_BAR; PG8_SCHED;
            PG8_LDB(B0, 1, 0); PG8_LDB(B1, 1, 1); PG8_SCHED; PG8_LDA(At, 1, 0); PG8_STAGE(PG8_SA(0, 1), a2 + hstepA, voffA);
            PG8_WAIT_V(8); PG8_WAIT_L(0); PG8_BAR; PG8_MMA(0, 0, At, B0); PG8_MMA(0, 1, At, B1); PG8_BAR; PG8_SCHED;
            PG8_LDA(At, 1, 1); PG8_STAGE(PG8_SB(1, 0), b3, voffB); PG8_STAGE(PG8_SB(1, 1), b3 + hstepB, voffB); PG8_STAGE(PG8_SA(1, 0), a3, voffA);
            PG8_WAIT_V(8); PG8_WAIT_L(0); PG8_BAR; PG8_MMA(1, 0, At, B0); PG8_MMA(1, 1, At, B1); PG8_BAR; PG8_SCHED;
            } else {
            PG8_LDB(B0, 0, 0); PG8_SCHED; PG8_LDA(At, 0, 0); PG8_STAGE(PG8_SA(1, 1), a1 + hstepA, voffA);
            PG8_WAIT_L(8); PG8_BAR; PG8_WAIT_L(0); PG8_MMA(0, 0, At, B0); PG8_BAR; PG8_SCHED;
            PG8_LDB(B1, 0, 1); PG8_STAGE(PG8_SB(0, 0), b2, voffB);
            PG8_BAR; PG8_WAIT_L(0); PG8_MMA(0, 1, At, B1); PG8_BAR;
            PG8_LDA(At, 0, 1); PG8_STAGE(PG8_SA(0, 0), a2, voffA);
            PG8_BAR; PG8_WAIT_L(0); PG8_MMA(1, 0, At, B0); PG8_BAR; PG8_SCHED;
            PG8_STAGE(PG8_SB(0, 1), b2 + hstepB, voffB);
            PG8_WAIT_V(6); PG8_BAR; PG8_MMA(1, 1, At, B1); PG8_BAR;
            PG8_LDB(B0, 1, 0); PG8_SCHED; PG8_LDA(At, 1, 0); PG8_STAGE(PG8_SA(0, 1), a2 + hstepA, voffA);
            PG8_WAIT_L(8); PG8_BAR; PG8_WAIT_L(0); PG8_MMA(0, 0, At, B0); PG8_BAR; PG8_SCHED;
            PG8_LDB(B1, 1, 1); PG8_STAGE(PG8_SB(1, 0), b3, voffB);
            PG8_BAR; PG8_WAIT_L(0); PG8_MMA(0, 1, At, B1); PG8_BAR;
            PG8_LDA(At, 1, 1); PG8_STAGE(PG8_SA(1, 0), a3, voffA);
            PG8_BAR; PG8_WAIT_L(0); PG8_MMA(1, 0, At, B0); PG8_BAR; PG8_SCHED;
            PG8_STAGE(PG8_SB(1, 1), b3 + hstepB, voffB);
            PG8_WAIT_V(6); PG8_BAR; PG8_MMA(1, 1, At, B1); PG8_BAR;
            }
        }
        if constexpr (ALIGN_EPI) { if (wr == 0) PG8_BAR; }
        E(acc, cur, wr, wc, fr, fq);
        if (!has_next) break;
#pragma unroll
        for (int a = 0; a < 2; ++a)
#pragma unroll
            for (int b = 0; b < 2; ++b)
#pragma unroll
                for (int m = 0; m < 4; ++m)
#pragma unroll
                    for (int n = 0; n < 2; ++n) acc[a][b][m][n] = (f32x4){0.f, 0.f, 0.f, 0.f};
        cur = nxt; cA = nA; cB = nB; ++ui;
        if constexpr (ALIGN_EPI) { if (wr == 1) PG8_BAR; }
    }
    PG8_WAIT_V(0);
    if constexpr (!ALIGN_EPI) { if (wr == 0) PG8_BAR; }
    PG8_BAR;
#undef PG8_SA
#undef PG8_SB
#undef PG8_STAGE
#undef PG8_LDA
#undef PG8_LDB
#undef PG8_MMA
#undef PG8_WAIT_V
#undef PG8_WAIT_L
#undef PG8_BAR
#undef PG8_SCHED
}


struct EpiSwiglu {
    static constexpr bool PERM = true;
    bf16_t* H; int ldh;
    __device__ __forceinline__ void operator()(const f32x4 (&acc)[2][2][4][2], const Unit& u, int wr, int wc, int fr, int fq) const {
        const int row0 = u.pm * BM + wr * 64 + fr, col0 = u.pn * HALF + wc * 32 + 8 * fq;
#pragma unroll
        for (int ai = 0; ai < 2; ++ai)
#pragma unroll
            for (int m = 0; m < 4; ++m) {
                bf16_t* rowp = H + (size_t)(row0 + ai * HALF + m * 16) * ldh + col0;
                f32x4 v0, v1;
#pragma unroll
                for (int j = 0; j < 4; ++j) { v0[j] = siluf_(acc[ai][0][m][0][j]) * acc[ai][1][m][0][j]; v1[j] = siluf_(acc[ai][0][m][1][j]) * acc[ai][1][m][1][j]; }
                u32x4 w; w.x = cvt_pk_bf16(v0[0], v0[1]); w.y = cvt_pk_bf16(v0[2], v0[3]); w.z = cvt_pk_bf16(v1[0], v1[1]); w.w = cvt_pk_bf16(v1[2], v1[3]);
                *(u32x4*)rowp = w;
            }
    }
};
struct EpiResid {
    static constexpr bool PERM = false;
    float* Y; const float* res; float alpha, scale; bool stream;
    __device__ __forceinline__ void operator()(const f32x4 (&acc)[2][2][4][2], const Unit& u, int wr, int wc, int fr, int fq) const {
        const int row0 = u.pm * BM + wr * 64 + fr, col0 = u.pn * BM + wc * 32 + 4 * fq;
#pragma unroll
        for (int ai = 0; ai < 2; ++ai)
#pragma unroll
            for (int m2 = 0; m2 < 2; ++m2) {
                f32x4 xv[2][2][2];
#pragma unroll
                for (int mm = 0; mm < 2; ++mm)
#pragma unroll
                    for (int bj = 0; bj < 2; ++bj)
#pragma unroll
                        for (int n = 0; n < 2; ++n) { const f32x4* rp = (const f32x4*)(res + (size_t)(row0 + ai * HALF + (2 * m2 + mm) * 16) * D + col0 + bj * HALF + n * 16); xv[mm][bj][n] = stream ? __builtin_nontemporal_load(rp) : *rp; }
#pragma unroll
                for (int mm = 0; mm < 2; ++mm)
#pragma unroll
                    for (int bj = 0; bj < 2; ++bj)
#pragma unroll
                        for (int n = 0; n < 2; ++n) *(f32x4*)(Y + (size_t)(row0 + ai * HALF + (2 * m2 + mm) * 16) * D + col0 + bj * HALF + n * 16) = xv[mm][bj][n] * alpha + acc[ai][bj][2 * m2 + mm][n] * scale;
            }
    }
};
struct EpiWin {
    static constexpr bool PERM = true;
    bf16_t* Z; const LAS float* gate_b; float* outK; float* outV; bf16_t* KB; bf16_t* VT;
    __device__ __forceinline__ void operator()(const f32x4 (&acc)[2][2][4][2], const Unit& u, int wr, int wc, int fr, int fq) const {
        const int row0 = u.pm * BM + wr * 64 + fr, col0 = u.pn * BM + wc * 32 + 8 * fq;
        if (u.kind == 0) {
            const int mode = (u.pn < 8) ? 1 : (u.pn < 12) ? 0 : (u.pn < 16) ? 1 : (u.pn < 20) ? 0 : 2;
            f32x4 gb[2][2];
#pragma unroll
            for (int bj = 0; bj < 2; ++bj)
#pragma unroll
                for (int n = 0; n < 2; ++n) gb[bj][n] = (mode == 2) ? *(const LAS f32x4*)(gate_b + (col0 - 5120) + bj * HALF + 4 * n) : (f32x4){0.f, 0.f, 0.f, 0.f};
#pragma unroll
            for (int ai = 0; ai < 2; ++ai)
#pragma unroll
                for (int m = 0; m < 4; ++m) {
                    bf16_t* rowp = Z + (size_t)(row0 + ai * HALF + m * 16) * NZ + col0;
#pragma unroll
                    for (int bj = 0; bj < 2; ++bj) {
                        f32x4 v0 = acc[ai][bj][m][0], v1 = acc[ai][bj][m][1];
                        if (mode == 1) {
#pragma unroll
                            for (int j = 0; j < 4; ++j) { v0[j] = gelu_tanh(v0[j]); v1[j] = gelu_tanh(v1[j]); }
                        } else if (mode == 2) {
#pragma unroll
                            for (int j = 0; j < 4; ++j) { v0[j] = sigmoidf_(v0[j] + gb[bj][0][j]); v1[j] = sigmoidf_(v1[j] + gb[bj][1][j]); }
                        }
                        u32x4 w; w.x = cvt_pk_bf16(v0[0], v0[1]); w.y = cvt_pk_bf16(v0[2], v0[3]); w.z = cvt_pk_bf16(v1[0], v1[1]); w.w = cvt_pk_bf16(v1[2], v1[3]);
                        *(u32x4*)(rowp + bj * HALF) = w;
                    }
                }
        } else if (u.kind == 1) {
            const bool isk = u.pn < 4; const int c0 = col0 - (isk ? 0 : 1024);
            float* ob = isk ? outK : outV;
#pragma unroll
            for (int ai = 0; ai < 2; ++ai)
#pragma unroll
                for (int m = 0; m < 4; ++m) {
                    const size_t off = (size_t)(row0 + ai * HALF + m * 16) * 1024 + c0;
#pragma unroll
                    for (int bj = 0; bj < 2; ++bj) {
                        const f32x4 v0 = acc[ai][bj][m][0], v1 = acc[ai][bj][m][1];
                        *(f32x4*)(ob + off + bj * HALF) = v0; *(f32x4*)(ob + off + bj * HALF + 4) = v1;
                        if (isk) { u32x4 w; w.x = cvt_pk_bf16(v0[0], v0[1]); w.y = cvt_pk_bf16(v0[2], v0[3]); w.z = cvt_pk_bf16(v1[0], v1[1]); w.w = cvt_pk_bf16(v1[2], v1[3]); *(u32x4*)(KB + off + bj * HALF) = w; }
                    }
                }
        } else {
#pragma unroll
            for (int ai = 0; ai < 2; ++ai)
#pragma unroll
                for (int m = 0; m < 4; ++m) {
                    bf16_t* rowp = VT + (size_t)(row0 + ai * HALF + m * 16) * 1024 + col0;
#pragma unroll
                    for (int bj = 0; bj < 2; ++bj) {
                        const f32x4 v0 = acc[ai][bj][m][0], v1 = acc[ai][bj][m][1];
                        u32x4 w; w.x = cvt_pk_bf16(v0[0], v0[1]); w.y = cvt_pk_bf16(v0[2], v0[3]); w.z = cvt_pk_bf16(v1[0], v1[1]); w.w = cvt_pk_bf16(v1[2], v1[3]);
                        *(u32x4*)(rowp + bj * HALF) = w;
                    }
                }
        }
    }
};
struct EpiMerge {
    static constexpr bool PERM = false;
    const bf16_t* Z; float* MG; bf16_t* MB;
    template <int KI> __device__ __forceinline__ void body(const f32x4 (&acc)[2][2][4][2], const Unit& u, int wr, int wc, int fr, int fq) const {
        const int row0 = u.pm * BM + wr * 64 + fr, col0 = u.pn * BM + wc * 32 + 4 * fq;
#pragma unroll
        for (int ai = 0; ai < 2; ++ai)
#pragma unroll
            for (int m2 = 0; m2 < 2; ++m2) {
                u32x2 gw[2][2][2]; f32x4 mg[2][2][2];
#pragma unroll
                for (int mm = 0; mm < 2; ++mm)
#pragma unroll
                    for (int bj = 0; bj < 2; ++bj)
#pragma unroll
                        for (int n = 0; n < 2; ++n) {
                            const int r = row0 + ai * HALF + (2 * m2 + mm) * 16;
                            gw[mm][bj][n] = *(const u32x2*)(Z + (size_t)r * NZ + 5120 + KI * 2048 + col0 + bj * HALF + n * 16);
                            if (KI > 0) mg[mm][bj][n] = *(const f32x4*)(MG + (size_t)r * D + col0 + bj * HALF + n * 16);
                        }
#pragma unroll
                for (int mm = 0; mm < 2; ++mm)
#pragma unroll
                    for (int bj = 0; bj < 2; ++bj)
#pragma unroll
                        for (int n = 0; n < 2; ++n) {
                            const int r = row0 + ai * HALF + (2 * m2 + mm) * 16;
                            const size_t off = (size_t)r * D + col0 + bj * HALF + n * 16;
                            const u32x2 g2 = gw[mm][bj][n];
                            f32x4 v = (f32x4){bflo(g2.x), bfhi(g2.x), bflo(g2.y), bfhi(g2.y)} * acc[ai][bj][2 * m2 + mm][n];
                            if (KI > 0) v += mg[mm][bj][n];
                            if (KI < 2) *(f32x4*)(MG + off) = v;
                            else { u32x2 w; w.x = cvt_pk_bf16(v[0], v[1]); w.y = cvt_pk_bf16(v[2], v[3]); *(u32x2*)(MB + off) = w; }
                        }
            }
    }
    __device__ __forceinline__ void operator()(const f32x4 (&acc)[2][2][4][2], const Unit& u, int wr, int wc, int fr, int fq) const {
        if (u.kind == 0) body<0>(acc, u, wr, wc, fr, fq); else if (u.kind == 1) body<1>(acc, u, wr, wc, fr, fq); else body<2>(acc, u, wr, wc, fr, fq);
    }
};
}

#ifndef PHMASK
#define PHMASK 0xFFFFFFFFu
#endif
#ifndef GREP
#define GREP 1
#endif
#ifndef NREP
#define NREP 1
#endif
#define PHON(n) (((PHMASK) >> (n)) & 1u)
#define LDS_WAIT() asm volatile("s_waitcnt lgkmcnt(0)" ::: "memory")

__device__ __forceinline__ void transpose_item(const float* W, int N, bf16_t* WT, int ldk, int k0, int n0, int dst_row0, LAS float* scr, int lane) {
    f32x4 v[8];
    const int n4 = (lane & 7) * 4, kr = lane >> 3;
#pragma unroll
    for (int i = 0; i < 8; ++i) v[i] = __builtin_nontemporal_load((const f32x4*)(W + (size_t)(k0 + kr + 8 * i) * N + n0 + n4));
#pragma unroll
    for (int i = 0; i < 8; ++i) { LAS float* d = scr + (kr + 8 * i) * 33 + n4; d[0] = v[i][0]; d[1] = v[i][1]; d[2] = v[i][2]; d[3] = v[i][3]; }
    LDS_WAIT(); asm volatile("" ::: "memory");
    const int c = lane & 7;
#pragma unroll
    for (int j = 0; j < 4; ++j) { const int n = (lane >> 3) + 8 * j; const LAS float* s = scr + (8 * c) * 33 + n;
        u32x4 o; o.x = cvt_pk_bf16(s[0 * 33], s[1 * 33]); o.y = cvt_pk_bf16(s[2 * 33], s[3 * 33]); o.z = cvt_pk_bf16(s[4 * 33], s[5 * 33]); o.w = cvt_pk_bf16(s[6 * 33], s[7 * 33]);
        *(u32x4*)(WT + (size_t)(dst_row0 + n) * ldk + k0 + 8 * c) = o; }
    LDS_WAIT(); asm volatile("" ::: "memory");
}
__device__ __forceinline__ void ln_row(const float* yrow, const float* g, const float* b, float* of, bf16_t* ob, int lane) {
    f32x4 v[8]; float s = 0.f;
#pragma unroll
    for (int j = 0; j < 8; ++j) { v[j] = *(const f32x4*)(yrow + 4 * lane + 256 * j); s += (v[j][0] + v[j][1]) + (v[j][2] + v[j][3]); }
    const float mean = wave_sum(s) * (1.f / D); float s2 = 0.f;
#pragma unroll
    for (int j = 0; j < 8; ++j) { v[j] = v[j] - mean; s2 += (v[j][0] * v[j][0] + v[j][1] * v[j][1]) + (v[j][2] * v[j][2] + v[j][3] * v[j][3]); }
    const float rstd = 1.0f / sqrtf(wave_sum(s2) * (1.f / D) + LN_EPS);
#pragma unroll
    for (int j = 0; j < 8; ++j) {
        const f32x4 gg = *(const f32x4*)(g + 4 * lane + 256 * j), bb = *(const f32x4*)(b + 4 * lane + 256 * j);
        const f32x4 o = v[j] * rstd * gg + bb;
        if (of) __builtin_nontemporal_store(o, (f32x4*)(of + 4 * lane + 256 * j));
        if (ob) { u32x2 w; w.x = cvt_pk_bf16(o[0], o[1]); w.y = cvt_pk_bf16(o[2], o[3]); *(u32x2*)(ob + 4 * lane + 256 * j) = w; }
    }
}

#define XB_TMO      128
#define XB_XCNT(j)  (256  + 64 * (j))
#define XB_XSUB(j)  (1280 + 64 * (j))
#define XB_XGEN(j)  (2304 + 64 * (j))
#define XB_TOP      3328
#define XB_TOPGEN   3392
#define XCD_BAR_WORDS 3456
#define XB_SPIN_CAP (1u << 22)
__device__ __forceinline__ unsigned xb_ld(unsigned* p)              { return __hip_atomic_load(p, __ATOMIC_RELAXED, __HIP_MEMORY_SCOPE_AGENT); }
__device__ __forceinline__ unsigned xb_add(unsigned* p, unsigned v) { return __hip_atomic_fetch_add(p, v, __ATOMIC_RELAXED, __HIP_MEMORY_SCOPE_AGENT); }
__device__ __forceinline__ unsigned xb_xcc_id() { return (unsigned)__builtin_amdgcn_s_getreg((3 << 11) | 20) & 0xFu; }
#define XB_SPIN(cond, bar) do { unsigned _sp = 0; while (cond) { __builtin_amdgcn_s_sleep(1); \
    if ((++_sp & 255u) == 0u) { if (xb_ld(&(bar)[XB_TMO])) break; if (_sp > XB_SPIN_CAP) { atomicAdd(&(bar)[XB_TMO], 1u); break; } } } } while (0)
struct XcdBarrier { unsigned* bar; unsigned x; volatile LAS unsigned* st; };
__device__ __forceinline__ XcdBarrier xcd_barrier_post(unsigned* bar, volatile LAS unsigned* st) {
    XcdBarrier b; b.bar = bar; b.x = xb_xcc_id(); b.st = st;
    if (threadIdx.x == 0) (void)xb_add(&bar[XB_XCNT(b.x)], 1u);
    return b;
}
__device__ __forceinline__ void xcd_barrier_complete(unsigned* bar, unsigned x, unsigned& nloc, unsigned& nx) {
    const unsigned G = gridDim.x * gridDim.y * gridDim.z;
    unsigned sum, cnt, mine, sp = 0u;
    for (;;) {
        sum = 0u; cnt = 0u; mine = 0u;
#pragma unroll
        for (unsigned j = 0; j < 16; ++j) { const unsigned c = xb_ld(&bar[XB_XCNT(j)]); sum += c; cnt += (c > 0u) ? 1u : 0u; mine = (j == x) ? c : mine; }
        if (sum == G) break;
        __builtin_amdgcn_s_sleep(1);
        if ((++sp & 255u) == 0u) { if (xb_ld(&bar[XB_TMO])) break; if (sp > XB_SPIN_CAP) { atomicAdd(&bar[XB_TMO], 1u); break; } }
    }
    nloc = mine > 0u ? mine : 1u; nx = cnt > 0u ? cnt : 1u;
}
__device__ __forceinline__ void xcd_barrier(const XcdBarrier& b) {
    asm volatile("s_waitcnt vmcnt(0)" ::: "memory");
    __syncthreads();
    if (threadIdx.x == 0) {
        unsigned* bar = b.bar;
        __builtin_amdgcn_s_waitcnt(0);
        unsigned nloc = b.st[0], nx = b.st[1];
        if (nloc == 0u) { xcd_barrier_complete(bar, b.x, nloc, nx); b.st[0] = nloc; b.st[1] = nx; }
        const unsigned old = xb_add(&bar[XB_XSUB(b.x)], 1u);
        const unsigned gen = old / nloc;
        if (old + 1u == (gen + 1u) * nloc) {
            __builtin_amdgcn_fence(__ATOMIC_RELEASE, "agent");
            asm volatile("s_waitcnt vmcnt(0)" ::: "memory");
            const unsigned og = xb_add(&bar[XB_TOP], 1u);
            const unsigned tg = og / nx;
            if (og + 1u == (tg + 1u) * nx) xb_add(&bar[XB_TOPGEN], 1u);
            else XB_SPIN(xb_ld(&bar[XB_TOPGEN]) == tg, bar);
            __builtin_amdgcn_fence(__ATOMIC_ACQUIRE, "agent");
            xb_add(&bar[XB_XGEN(b.x)], 1u);
            asm volatile("s_waitcnt vmcnt(0)" ::: "memory");
        } else {
            XB_SPIN(xb_ld(&bar[XB_XGEN(b.x)]) == gen, bar);
            __builtin_amdgcn_fence(__ATOMIC_ACQUIRE, "agent");
            asm volatile("s_waitcnt vmcnt(0)" ::: "memory");
        }
    }
    __syncthreads();
}

template <int MODE>
__device__ __forceinline__ void skinny(LAS unsigned char* lds, int bid, int G, int wave, int lane, const bf16_t* A, int lda, const bf16_t* Bt, int ldb, int K,
                                       float* Ys, const float* res, float alpha, float scale, const bf16_t* Zs, bf16_t* MBs) {
    const int fr = lane & 15, fq = lane >> 4, tw = wave & 3, kh = wave >> 2;
    LAS f32x4* red = (LAS f32x4*)lds;
    for (int T0 = bid * 4; T0 < 1024; T0 += G * 4) {
        const int T = T0 + tw, rt = T >> 7, ct = T & 127;
        f32x4 tot = (f32x4){0.f, 0.f, 0.f, 0.f};
        if (MODE == 0) {
            const int kb = kh * (K / 2);
            const bf16_t* ap = A + (size_t)(rt * 16 + fr) * lda + kb + fq * 8;
            const bf16_t* bp = Bt + (size_t)(ct * 16 + fr) * ldb + kb + fq * 8;
#pragma unroll 16
            for (int ks = 0; ks < K / 64; ++ks) {
                const bf16x8 af = *(const bf16x8*)(ap + ks * 32), bfv = *(const bf16x8*)(bp + ks * 32);
                tot = __builtin_amdgcn_mfma_f32_16x16x32_bf16(bfv, af, tot, 0, 0, 0);
            }
        } else {
#pragma unroll
            for (int k = 0; k < 3; ++k) {
                const int kb = kh * (BW / 2);
                const bf16_t* ap = A + (size_t)(rt * 16 + fr) * lda + k * BW + kb + fq * 8;
                const bf16_t* bp = Bt + (size_t)k * D * BW + (size_t)(ct * 16 + fr) * ldb + kb + fq * 8;
                f32x4 acc = (f32x4){0.f, 0.f, 0.f, 0.f};
#pragma unroll 8
                for (int ks = 0; ks < BW / 64; ++ks) {
                    const bf16x8 af = *(const bf16x8*)(ap + ks * 32), bfv = *(const bf16x8*)(bp + ks * 32);
                    acc = __builtin_amdgcn_mfma_f32_16x16x32_bf16(bfv, af, acc, 0, 0, 0);
                }
                const u32x2 gw = *(const u32x2*)(Zs + (size_t)(rt * 16 + fr) * NZ + 5120 + k * 2048 + ct * 16 + 4 * fq);
                tot += acc * (f32x4){bflo(gw.x), bfhi(gw.x), bflo(gw.y), bfhi(gw.y)};
            }
        }
        if (kh == 1) red[tw * 64 + lane] = tot;
        __syncthreads();
        if (kh == 0) {
            tot += red[tw * 64 + lane];
            const size_t off = (size_t)(rt * 16 + fr) * D + ct * 16 + 4 * fq;
            if (MODE == 0) { const f32x4 xv = *(const f32x4*)(res + off); *(f32x4*)(Ys + off) = xv * alpha + tot * scale; }
            else { u32x2 w; w.x = cvt_pk_bf16(tot[0], tot[1]); w.y = cvt_pk_bf16(tot[2], tot[3]); *(u32x2*)(MBs + off) = w; }
        }
        __syncthreads();
    }
}

#define WGU1 ((bf16_t*)(P.ws + WS_WGU1))
#define WD1 ((bf16_t*)(P.ws + WS_WD1))
#define WIN ((bf16_t*)(P.ws + WS_WIN))
#define WKV ((bf16_t*)(P.ws + WS_WKV))
#define WBR ((bf16_t*)(P.ws + WS_WBR))
#define WOUT ((bf16_t*)(P.ws + WS_WOUT))
#define WGU2 ((bf16_t*)(P.ws + WS_WGU2))
#define WD2 ((bf16_t*)(P.ws + WS_WD2))
#define WLRU ((bf16_t*)(P.ws + WS_WLRU))
#define WSP ((bf16_t*)(P.ws + WS_WSP))
#define XB ((bf16_t*)(P.ws + WS_XB))
#define Z ((bf16_t*)(P.ws + WS_ZH))
#define H ((bf16_t*)(P.ws + WS_ZH))
#define Y ((float*)(P.ws + WS_Y))
#define X1 ((float*)(P.ws + WS_X1))
#define VP ((bf16_t*)(P.ws + WS_VP))
#define HL ((float*)(P.ws + WS_HL))
#define AC ((float*)(P.ws + WS_AC))
#define SUM ((float*)(P.ws + WS_SUM))
#define YS ((bf16_t*)(P.ws + WS_YS))
#define MEMLN ((bf16_t*)(P.ws + WS_MEMLN))
#define KB ((bf16_t*)(P.ws + WS_KB))
#define VT ((bf16_t*)(P.ws + WS_VT))
__device__ __forceinline__ void p5d_sample_attn(const Params& P, LAS unsigned char* lds, int bid, int G, int tid_in) {
    int tid = tid_in; asm volatile("" : "+v"(tid));
    const int lane = tid & 63, wave = __builtin_amdgcn_readfirstlane(tid >> 6);

        LAS float* sS = (LAS float*)(lds + 131072);
        LAS float* sO = (LAS float*)(lds + 131072 + 1024);
        const int vb = (G % 8 == 0) ? (bid & 7) * (G >> 3) + (bid >> 3) : bid;
        for (int it = vb; it < 512; it += G) {
            const int b = it >> 2, h = it & 3;
            const u32x2 qw = *(const u32x2*)(Z + (size_t)(MP + b) * NZ + 4096 + h * HD + 4 * lane);
            const f32x4 q = (f32x4){bflo(qw.x), bfhi(qw.x), bflo(qw.y), bfhi(qw.y)};
            const float* kbase = P.in[I_CK] + ((size_t)(b * NMEM + 32 * wave) * NH + h) * HD + 4 * lane;
            const float* vbase = P.in[I_CV] + ((size_t)(b * NMEM + 32 * wave) * NH + h) * HD + 4 * lane;
            float d[32];
#pragma unroll
            for (int mi = 0; mi < 32; ++mi) {
                const f32x4 kv = __builtin_nontemporal_load((const f32x4*)(kbase + (size_t)mi * (NH * HD)));
                d[mi] = (kv[0] * q[0] + kv[1] * q[1]) + (kv[2] * q[2] + kv[3] * q[3]);
                if (mi == 15) asm volatile("" ::: "memory");
            }
#pragma unroll
            for (int i = 0; i < 16; ++i) { const bool hi = (lane & 32) != 0; const float snd = hi ? d[i] : d[i + 16], kp = hi ? d[i + 16] : d[i]; d[i] = kp + __shfl_xor(snd, 32); }
#pragma unroll
            for (int i = 0; i < 8; ++i) { const bool hi = (lane & 16) != 0; const float snd = hi ? d[i] : d[i + 8], kp = hi ? d[i + 8] : d[i]; d[i] = kp + __shfl_xor(snd, 16); }
#pragma unroll
            for (int i = 0; i < 4; ++i) { const bool hi = (lane & 8) != 0; const float snd = hi ? d[i] : d[i + 4], kp = hi ? d[i + 4] : d[i]; d[i] = kp + __shfl_xor(snd, 8); }
#pragma unroll
            for (int i = 0; i < 2; ++i) { const bool hi = (lane & 4) != 0; const float snd = hi ? d[i] : d[i + 2], kp = hi ? d[i + 2] : d[i]; d[i] = kp + __shfl_xor(snd, 4); }
            { const bool hi = (lane & 2) != 0; const float snd = hi ? d[0] : d[1], kp = hi ? d[1] : d[0]; d[0] = kp + __shfl_xor(snd, 2); }
            d[0] += __shfl_xor(d[0], 1);
            if ((lane & 1) == 0) sS[32 * wave + (lane >> 1)] = d[0] * 0.0625f;
            f32x4 vv[16];
#pragma unroll
            for (int mi = 0; mi < 16; ++mi) vv[mi] = __builtin_nontemporal_load((const f32x4*)(vbase + (size_t)mi * (NH * HD)));
            __syncthreads();
            float mx = fmaxf(fmaxf(sS[lane], sS[lane + 64]), fmaxf(sS[lane + 128], sS[lane + 192]));
            mx = wave_max(mx);
            float sm = __expf(sS[lane] - mx) + __expf(sS[lane + 64] - mx) + __expf(sS[lane + 128] - mx) + __expf(sS[lane + 192] - mx);
            sm = wave_sum(sm);
            const float inv = 1.0f / sm;
            f32x4 o = (f32x4){0.f, 0.f, 0.f, 0.f};
            f32x4 vw[16];
#pragma unroll
            for (int mi = 0; mi < 16; ++mi) vw[mi] = __builtin_nontemporal_load((const f32x4*)(vbase + (size_t)(16 + mi) * (NH * HD)));
#pragma unroll
            for (int mi = 0; mi < 16; ++mi) { const float p = __expf(sS[32 * wave + mi] - mx) * inv; o += vv[mi] * p; }
#pragma unroll
            for (int mi = 0; mi < 16; ++mi) { const float p = __expf(sS[32 * wave + 16 + mi] - mx) * inv; o += vw[mi] * p; }
            *(LAS f32x4*)(sO + wave * 256 + 4 * lane) = o;
            __syncthreads();
            if (tid < 256) {
                float a = 0.f;
#pragma unroll
                for (int w = 0; w < 8; ++w) a += sO[w * 256 + tid];
                YS[(size_t)(MP + b) * 3072 + 2048 + h * HD + tid] = (bf16_t)(cvt_pk_bf16(a, 0.f) & 0xffffu);
            }
            __syncthreads();
        }
}

__global__ void __launch_bounds__(NTHREADS, 2) fwd_kernel(Params P) {
    extern __shared__ __attribute__((aligned(16))) unsigned char lds_raw[];
    LAS unsigned char* lds = (LAS unsigned char*)lds_raw;
    cg::grid_group grid = cg::this_grid();
    const int tid = threadIdx.x, lane = tid & 63, wave = __builtin_amdgcn_readfirstlane(tid >> 6);
    const int G = gridDim.x, bid = blockIdx.x;
    const int gw = bid * NWAVES + wave, NGW = G * NWAVES;
    float* out = P.out;
    volatile LAS unsigned* bst = (volatile LAS unsigned*)(lds + LDS_BYTES - 64);
    if (tid == 0) { bst[0] = 0u; bst[1] = 0u; }
    __syncthreads();
    const XcdBarrier gbar = xcd_barrier_post((unsigned*)(P.ws + WS_BAR), bst);
#define GRID_BAR() xcd_barrier(gbar)

    if (PHON(0)) {
        LAS float* scr = (LAS float*)(lds + wave * 16384);
        constexpr int IT_GU = (D / 64) * (NZ / 32), IT_DN = (FF / 64) * (D / 32), IT_SQ = (D / 64) * (D / 32), IT_BR = (BW / 64) * (D / 32), IT_LR = 2 * 4;
        constexpr int IT_TOTAL = 3 * IT_GU + 2 * IT_DN + 2 * IT_SQ + 3 * IT_BR + 16 * IT_LR;
        for (int it = gw; it < IT_TOTAL; it += NGW) {
            int r = it; const float* W; bf16_t* WT; int N, ldk, mode = 0;
            if (r < IT_GU) { W = P.in[I_WIN]; WT = WIN; N = NZ; ldk = D; }
            else if ((r -= IT_GU) < IT_SQ) { W = P.in[I_WKV]; WT = WKV; N = D; ldk = D; }
            else if ((r -= IT_SQ) < 3 * IT_BR) { const int k = r / IT_BR; r -= k * IT_BR; W = P.in[I_WBR] + (size_t)k * BW * D; WT = WBR + (size_t)k * D * BW; N = D; ldk = BW; }
            else if ((r -= 3 * IT_BR) < IT_SQ) { W = P.in[I_WOUT]; WT = WOUT; N = D; ldk = D; }
            else if ((r -= IT_SQ) < IT_GU) { W = P.in[I_GU2]; WT = WGU2; N = NZ; ldk = D; mode = 1; }
            else if ((r -= IT_GU) < IT_DN) { W = P.in[I_DN2]; WT = WD2; N = D; ldk = FF; }
            else if ((r -= IT_DN) < 16 * IT_LR) { const int m = r / IT_LR; r -= m * IT_LR; const int k = m >> 1, x = m & 1;
                W = (x ? P.in[I_LWX] : P.in[I_LWA]) + (size_t)k * 128 * 128; WT = WLRU + (size_t)k * 256 * 128 + x * 128 * 128; N = 128; ldk = 128; }
            else if ((r -= 16 * IT_LR) < IT_DN) { W = P.in[I_DN1]; WT = WD1; N = D; ldk = FF; }
            else { r -= IT_DN; W = P.in[I_GU1]; WT = WGU1; N = NZ; ldk = D; mode = 1; }
            const int nblk = N / 32, kb = r / nblk, nb = r % nblk, n0 = 32 * nb;
            int dr = n0;
            if (mode == 1) dr = (n0 < FF) ? (n0 / 128) * 256 + (n0 % 128) : ((n0 - FF) / 128) * 256 + 128 + ((n0 - FF) % 128);
            transpose_item(W, N, WT, ldk, 64 * kb, n0, dr, scr, lane);
        }
        for (int i = gw * 64 + lane; i < 4 * 128 * 128; i += NGW * 64) { const int t = (i >> 7) & 127, s = i & 127; const float w = P.in[I_WS][i]; WSP[i] = (bf16_t)(cvt_pk_bf16(s <= t ? w : 0.f, 0.f) & 0xffffu); }
        for (size_t i = (size_t)gw * 64 + lane; i < (size_t)MPAD * D / 8; i += (size_t)NGW * 64) {
            const size_t e = i * 8; const int r = (int)(e / D);
            u32x4 w = (u32x4){0u, 0u, 0u, 0u};
            if (r < MR) { const float* src = (r < MP) ? P.in[I_XP] + e : P.in[I_XS] + (e - (size_t)MP * D);
                const f32x4 a = __builtin_nontemporal_load((const f32x4*)src), b = __builtin_nontemporal_load((const f32x4*)(src + 4));
                w.x = cvt_pk_bf16(a[0], a[1]); w.y = cvt_pk_bf16(a[2], a[3]); w.z = cvt_pk_bf16(b[0], b[1]); w.w = cvt_pk_bf16(b[2], b[3]); }
            *(u32x4*)(XB + e) = w;
        }
        for (int r = gw; r < 1024; r += NGW) ln_row(P.in[I_MEM] + (size_t)r * D, P.in[I_MLNG], P.in[I_MLNB], nullptr, MEMLN + (size_t)r * D, lane);
    }
    if (P.ws == nullptr) grid.sync();
    GRID_BAR();

    if (PHON(1)) {
        pg8::PlainSched S{XB, WGU1, 33, 44, D, D, G, bid};
        pg8::EpiSwiglu E{H, FF};
        pg8::gemm_phase<pg8::PlainSched, pg8::EpiSwiglu, true, true>(lds, D, D, D, S, E);
    }
    GRID_BAR();
    if (PHON(2)) {
        skinny<0>(lds, bid, G, wave, lane, H + (size_t)MP * FF, FF, WD1, FF, FF, Y + (size_t)MP * D, P.in[I_XS], ALPHA, 0.5f, nullptr, nullptr);
        pg8::PlainSched S{H, WD1, 32, 8, FF, FF, G, bid};
        pg8::EpiResid E{Y, P.in[I_XP], ALPHA, 0.5f, true};
        pg8::gemm_phase<pg8::PlainSched, pg8::EpiResid, true, true>(lds, FF, FF, FF, S, E);
    }
    GRID_BAR();
    if (PHON(3)) for (int r = gw; r < MR; r += NGW) ln_row(Y + (size_t)r * D, P.in[I_LN1G], P.in[I_LN1B], X1 + (size_t)r * D, XB + (size_t)r * D, lane);
    GRID_BAR();

    if (PHON(4)) {
        LAS float* gbl = (LAS float*)(lds + 131072);
        for (int i = tid; i < 3 * D / 4; i += NTHREADS) *(LAS f32x4*)(gbl + 4 * i) = *(const f32x4*)(P.in[I_GATEB] + 4 * i);
        __syncthreads();
        pg8::WinSched S{XB, WIN, MEMLN, WKV, G, bid};
        pg8::EpiWin E{Z, gbl, out + O_MK, out + O_MV, KB, VT};
        pg8::gemm_phase<pg8::WinSched, pg8::EpiWin, true, true>(lds, D, D, D, S, E);
    }
    GRID_BAR();

    const bool dfirst_ = ((bid >> 5) & 1) != 0;
    if (dfirst_ && PHON(8)) p5d_sample_attn(P, lds, bid, G, tid);
    if (PHON(5)) for (int r = gw; r < MR; r += NGW) {
        const bf16_t* zr = Z + (size_t)r * NZ + 1024;
        float v[16]; float s = 0.f;
#pragma unroll
        for (int h = 0; h < 2; ++h) { const u32x4 w = *(const u32x4*)(zr + 8 * lane + 512 * h);
            v[8 * h + 0] = bflo(w.x); v[8 * h + 1] = bfhi(w.x); v[8 * h + 2] = bflo(w.y); v[8 * h + 3] = bfhi(w.y); v[8 * h + 4] = bflo(w.z); v[8 * h + 5] = bfhi(w.z); v[8 * h + 6] = bflo(w.w); v[8 * h + 7] = bfhi(w.w); }
#pragma unroll
        for (int j = 0; j < 16; ++j) s += v[j];
        const float mean = wave_sum(s) * (1.f / BW); float s2 = 0.f;
#pragma unroll
        for (int j = 0; j < 16; ++j) { v[j] -= mean; s2 += v[j] * v[j]; }
        const float rstd = 1.0f / sqrtf(wave_sum(s2) * (1.f / BW) + LN_EPS);
#pragma unroll
        for (int h = 0; h < 2; ++h) {
            const int c0 = 8 * lane + 512 * h; float o[8];
#pragma unroll
            for (int j = 0; j < 8; ++j) o[j] = v[8 * h + j] * rstd * P.in[I_GLNG][c0 + j] + P.in[I_GLNB][c0 + j];
            u32x4 w; w.x = cvt_pk_bf16(o[0], o[1]); w.y = cvt_pk_bf16(o[2], o[3]); w.z = cvt_pk_bf16(o[4], o[5]); w.w = cvt_pk_bf16(o[6], o[7]);
            *(u32x4*)(VP + (size_t)r * BW + c0) = w;
            if (r >= MP) { float* ov = out + O_VS + (size_t)(r - MP) * BW + c0; *(f32x4*)ov = (f32x4){o[0], o[1], o[2], o[3]}; *(f32x4*)(ov + 4) = (f32x4){o[4], o[5], o[6], o[7]}; }
        }
    }
    if (PHON(6)) {
        LAS bf16_t* XCB = (LAS bf16_t*)lds;
        LAS float* AARR = (LAS float*)lds;
        LAS float* XCF = (LAS float*)(lds + 65536);
        for (int it = bid; it < 65 * 8; it += G) {
            const int c = it >> 3, k = it & 7; const bool smp = (c == 64);
            const int r0 = c * 128, ch0 = k * 128;
            int lane_o = lane; asm volatile("" : "+v"(lane_o));
            const int fr = lane_o & 15, fq = lane_o >> 4, rh = wave >> 2, cq = wave & 3;
            bf16x8 wfr[4][4];
            {
                const bf16_t* wb = WLRU + (size_t)k * 256 * 128;
#pragma unroll
                for (int ct = 0; ct < 4; ++ct)
#pragma unroll
                    for (int ks = 0; ks < 4; ++ks) wfr[ct][ks] = *(const bf16x8*)(wb + (size_t)((ct >> 1) * 128 + 32 * cq + 16 * (ct & 1) + fr) * 128 + ks * 32 + fq * 8);
            }
            LAS float* prm = (LAS float*)(lds + 131072 + 4096);
            if (tid < 128) { prm[tid] = P.in[I_LBA][ch0 + tid]; prm[128 + tid] = P.in[I_LBX][ch0 + tid]; prm[256 + tid] = __logf(1.0f + __expf(-P.in[I_LAM][ch0 + tid])); }
            {
                const int c4 = (tid & 31) * 4, rg = tid >> 5;
                const int ch = ch0 + c4;
                const f32x4 w0 = *(const f32x4*)(P.in[I_CONVW] + 0 * BW + ch), w1 = *(const f32x4*)(P.in[I_CONVW] + 1 * BW + ch), w2 = *(const f32x4*)(P.in[I_CONVW] + 2 * BW + ch), w3 = *(const f32x4*)(P.in[I_CONVW] + 3 * BW + ch);
                const f32x4 cb = *(const f32x4*)(P.in[I_CONVB] + ch);
                if (!smp) {
                    const bool first = ((c & 15) == 0);
                    const int rs = rg * 8;
                    const bool hist = !(first && rs == 0);
                    u32x2 zr[11];
#pragma unroll
                    for (int i = 0; i < 11; ++i) { zr[i] = (u32x2){0u, 0u}; if (i >= 3 || hist) zr[i] = *(const u32x2*)(Z + (size_t)(r0 + rs - 3 + i) * NZ + 2048 + ch); }
#define ZF(i) ((f32x4){bflo(zr[i].x), bfhi(zr[i].x), bflo(zr[i].y), bfhi(zr[i].y)})
#pragma unroll
                    for (int i = 0; i < 8; ++i) {
                        const int row = rs + i;
                        const f32x4 x0 = ZF(i + 3);
                        const f32x4 xc = cb + w3 * x0 + w2 * ZF(i + 2) + w1 * ZF(i + 1) + w0 * ZF(i);
                        *(LAS f32x4*)(XCF + row * 128 + c4) = xc;
                        u32x2 w; w.x = cvt_pk_bf16(xc[0], xc[1]); w.y = cvt_pk_bf16(xc[2], xc[3]);
                        *(LAS u32x2*)(XCB + row * 136 + c4) = w;
                        if ((c & 15) == 15 && row >= 125) *(f32x4*)(out + O_CP + (size_t)((c >> 4) * 3 + (row - 125)) * BW + ch) = x0;
                    }
#undef ZF
                } else {
#pragma unroll 4
                    for (int i = 0; i < 8; ++i) {
                        const int row = rg * 8 + i;
                        const float* sc = P.in[I_SCONV] + (size_t)row * 3 * BW + ch;
                        const f32x4 b0 = *(const f32x4*)sc, b1 = *(const f32x4*)(sc + BW), b2 = *(const f32x4*)(sc + 2 * BW);
                        const u32x2 a = *(const u32x2*)(Z + (size_t)(MP + row) * NZ + 2048 + ch);
                        const f32x4 x0 = (f32x4){bflo(a.x), bfhi(a.x), bflo(a.y), bfhi(a.y)};
                        const f32x4 xc = cb + w3 * x0 + w2 * b2 + w1 * b1 + w0 * b0;
                        *(LAS f32x4*)(XCF + row * 128 + c4) = xc;
                        u32x2 w; w.x = cvt_pk_bf16(xc[0], xc[1]); w.y = cvt_pk_bf16(xc[2], xc[3]);
                        *(LAS u32x2*)(XCB + row * 136 + c4) = w;
                        float* oc = out + O_CS + (size_t)row * 3 * BW + ch;
                        *(f32x4*)oc = b1; *(f32x4*)(oc + BW) = b2; *(f32x4*)(oc + 2 * BW) = x0;
                    }
                }
            }
            __syncthreads();
            f32x4 ga[4][4];
#pragma unroll
            for (int rt = 0; rt < 4; ++rt)
#pragma unroll
                for (int ct = 0; ct < 4; ++ct) ga[rt][ct] = (f32x4){0.f, 0.f, 0.f, 0.f};
#pragma unroll
            for (int rt = 0; rt < 4; ++rt) {
                bf16x8 af[4];
#pragma unroll
                for (int ks = 0; ks < 4; ++ks) af[ks] = *(const LAS bf16x8*)(XCB + (64 * rh + 16 * rt + fr) * 136 + ks * 32 + fq * 8);
#pragma unroll
                for (int ct = 0; ct < 4; ++ct)
#pragma unroll
                    for (int ks = 0; ks < 4; ++ks) ga[rt][ct] = __builtin_amdgcn_mfma_f32_16x16x32_bf16(af[ks], wfr[ct][ks], ga[rt][ct], 0, 0, 0);
            }
            __syncthreads();
#pragma unroll
            for (int cl = 0; cl < 2; ++cl) {
                const int chl = 32 * cq + 16 * cl + fr, chg = ch0 + chl;
                const float ba = prm[chl], bx = prm[128 + chl], sp = prm[256 + chl];
#pragma unroll
                for (int rt = 0; rt < 4; ++rt)
#pragma unroll
                    for (int j = 0; j < 4; ++j) {
                        const int row = 64 * rh + 16 * rt + 4 * fq + j;
                        const float rr = sigmoidf_(ga[rt][cl][j] + ba), ii = sigmoidf_(ga[rt][2 + cl][j] + bx);
                        const float la = -8.0f * rr * sp;
                        const float a = __expf(la);
                        const float xc = XCF[row * 128 + chl];
                        const float bt = __builtin_amdgcn_sqrtf(fmaxf(1.0f - a * a, 0.f)) * (ii * xc);
                        if (smp) {
                            const float h = a * P.in[I_SLRU][(size_t)row * BW + chg] + bt;
                            out[O_HS + (size_t)row * BW + chg] = h;
                            const float rgv = bf2f(Z[(size_t)(MP + row) * NZ + 3072 + chg]);
                            YS[(size_t)(MP + row) * 3072 + 1024 + chg] = (bf16_t)(cvt_pk_bf16(rgv * h, 0.f) & 0xffffu);
                        } else {
                            AARR[row * 128 + chl] = a; XCF[row * 128 + chl] = bt;
                        }
                        if (j == 3) asm volatile("" ::: "memory");
                    }
            }
            __syncthreads();
            if (!smp) {
                {
                    LAS float* segA = (LAS float*)(lds + 131072); LAS float* segH = segA + 512;
                    const int seg = tid >> 7, chn = tid & 127;
                    float h = 0.f, pa = 1.f;
#pragma unroll 8
                    for (int i = 0; i < 32; ++i) { const int o = (32 * seg + i) * 128 + chn; const float a = AARR[o], b = XCF[o]; h = a * h + b; pa *= a; XCF[o] = h; AARR[o] = pa; }
                    segA[tid] = pa; segH[tid] = h;
                    __syncthreads();
                    float cA = 1.f, cH = 0.f;
                    for (int sg = 0; sg < seg; ++sg) { const float sa = segA[sg * 128 + chn]; cH = sa * cH + segH[sg * 128 + chn]; cA *= sa; }
                    if (seg > 0) {
#pragma unroll 8
                        for (int i = 0; i < 32; ++i) { const int o = (32 * seg + i) * 128 + chn; const float hl = XCF[o], pc = AARR[o]; XCF[o] = hl + pc * cH; AARR[o] = pc * cA; }
                    }
                    if (seg == 3) { SUM[(size_t)(c * 2 + 0) * BW + ch0 + chn] = pa * cA; SUM[(size_t)(c * 2 + 1) * BW + ch0 + chn] = h + pa * cH; }
                }
                __syncthreads();
#pragma unroll
                for (int i = 0; i < 8; ++i) { const int e = (i * 512 + tid) * 4, row = e >> 7, cc = e & 127;
                    *(f32x4*)(HL + (size_t)(r0 + row) * BW + ch0 + cc) = *(const LAS f32x4*)(XCF + e);
                    *(f32x4*)(AC + (size_t)(r0 + row) * BW + ch0 + cc) = *(const LAS f32x4*)(AARR + e); }
            }
            __syncthreads();
        }
    }
    if (PHON(7)) for (int it = bid; it < 256; it += G) {
        const int b = it >> 6, h = (it >> 4) & 3, qt = it & 15;
        int lane_o = lane; asm volatile("" : "+v"(lane_o));
        const int fr = lane_o & 15, fq = lane_o >> 4;
        const int row0 = b * SEQ + qt * 128 + wave * 16;
        bf16x8 qf[8];
#pragma unroll
        for (int ks = 0; ks < 8; ++ks) qf[ks] = *(const bf16x8*)(Z + (size_t)(row0 + fr) * NZ + 4096 + h * HD + ks * 32 + fq * 8);
        f32x4 s[16];
        LAS bf16_t* KL = (LAS bf16_t*)lds;
        __syncthreads();
        {
            const bf16_t* kb = KB + (size_t)(b * NMEM) * 1024 + h * HD;
            u32x4 t[16];
#pragma unroll
            for (int i = 0; i < 16; ++i) { const int e = tid + i * NTHREADS, m = e >> 5, c8 = (e & 31) * 8; t[i] = *(const u32x4*)(kb + (size_t)m * 1024 + c8); }
#pragma unroll
            for (int i = 0; i < 16; ++i) { const int e = tid + i * NTHREADS, m = e >> 5, c8 = (e & 31) * 8; *(LAS u32x4*)(KL + m * 264 + c8) = t[i]; }
        }
        asm volatile("" ::: "memory");
        u32x4 tv[16];
        {
            const bf16_t* vt0 = VT + (size_t)(h * HD) * 1024 + b * NMEM;
#pragma unroll
            for (int i = 0; i < 16; ++i) { const int e = tid + i * NTHREADS, dd = e >> 5, c8 = (e & 31) * 8; tv[i] = *(const u32x4*)(vt0 + (size_t)dd * 1024 + c8); }
        }
        __syncthreads();
#pragma unroll
        for (int mt = 0; mt < 16; ++mt) {
            s[mt] = (f32x4){0.f, 0.f, 0.f, 0.f};
#pragma unroll
            for (int ks = 0; ks < 8; ++ks) {
                const bf16x8 kf = *(const LAS bf16x8*)(KL + (mt * 16 + fr) * 264 + ks * 32 + fq * 8);
                s[mt] = __builtin_amdgcn_mfma_f32_16x16x32_bf16(kf, qf[ks], s[mt], 0, 0, 0);
            }
        }
        __syncthreads();
#pragma unroll
        for (int i = 0; i < 16; ++i) { const int e = tid + i * NTHREADS, dd = e >> 5, c8 = (e & 31) * 8; *(LAS u32x4*)(KL + dd * 264 + c8) = tv[i]; }
        float mx = -3.0e38f;
#pragma unroll
        for (int mt = 0; mt < 16; ++mt) mx = fmaxf(mx, fmaxf(fmaxf(s[mt][0], s[mt][1]), fmaxf(s[mt][2], s[mt][3])));
        mx = fmaxf(mx, __shfl_xor(mx, 16)); mx = fmaxf(mx, __shfl_xor(mx, 32));
        float sm = 0.f;
#pragma unroll
        for (int mt = 0; mt < 16; ++mt)
#pragma unroll
            for (int j = 0; j < 4; ++j) { const float p = __expf((s[mt][j] - mx) * 0.0625f); s[mt][j] = p; sm += p; }
        sm += __shfl_xor(sm, 16); sm += __shfl_xor(sm, 32);
        const float inv = 1.0f / sm;
        bf16x8 pf[8];
#pragma unroll
        for (int ks = 0; ks < 8; ++ks) {
            u32x4 w; w.x = cvt_pk_bf16(s[2 * ks][0], s[2 * ks][1]); w.y = cvt_pk_bf16(s[2 * ks][2], s[2 * ks][3]); w.z = cvt_pk_bf16(s[2 * ks + 1][0], s[2 * ks + 1][1]); w.w = cvt_pk_bf16(s[2 * ks + 1][2], s[2 * ks + 1][3]);
            pf[ks] = __builtin_bit_cast(bf16x8, w);
        }
        __syncthreads();
#pragma unroll 4
        for (int dt = 0; dt < 16; ++dt) {
            f32x4 o = (f32x4){0.f, 0.f, 0.f, 0.f};
#pragma unroll
            for (int ks = 0; ks < 8; ++ks) {
                const LAS bf16_t* vp = KL + (dt * 16 + fr) * 264 + ks * 32 + 4 * fq;
                const u32x2 lo = *(const LAS u32x2*)vp, hi = *(const LAS u32x2*)(vp + 16);
                const u32x4 w = (u32x4){lo.x, lo.y, hi.x, hi.y};
                o = __builtin_amdgcn_mfma_f32_16x16x32_bf16(__builtin_bit_cast(bf16x8, w), pf[ks], o, 0, 0, 0);
            }
            u32x2 w; w.x = cvt_pk_bf16(o[0] * inv, o[1] * inv); w.y = cvt_pk_bf16(o[2] * inv, o[3] * inv);
            *(u32x2*)(YS + (size_t)(row0 + fr) * 3072 + 2048 + h * HD + dt * 16 + 4 * fq) = w;
        }
    }
    if (!dfirst_ && PHON(8)) p5d_sample_attn(P, lds, bid, G, tid);
    GRID_BAR();

    if (PHON(9)) for (int it = bid; it < 256; it += G) {
        const int c = it >> 2, rq = it & 3, n = c & 15, cb = c & ~15;
        const int ch = 2 * tid;
        f32x2 carry = (f32x2){0.f, 0.f};
        {
            f32x2 pa[15], hh[15];
#pragma unroll
            for (int j = 0; j < 15; ++j) { pa[j] = (f32x2){1.f, 1.f}; hh[j] = (f32x2){0.f, 0.f};
                if (j < n) { pa[j] = *(const f32x2*)(SUM + (size_t)((cb + j) * 2 + 0) * BW + ch); hh[j] = *(const f32x2*)(SUM + (size_t)((cb + j) * 2 + 1) * BW + ch); } }
#pragma unroll
            for (int j = 0; j < 15; ++j) carry = pa[j] * carry + hh[j];
        }
#pragma unroll 8
        for (int i = 0; i < 32; ++i) {
            const int r = c * 128 + rq * 32 + i;
            const f32x2 hl = *(const f32x2*)(HL + (size_t)r * BW + ch), ac = *(const f32x2*)(AC + (size_t)r * BW + ch);
            const f32x2 hv = hl + ac * carry;
            const unsigned rw = *(const unsigned*)(Z + (size_t)r * NZ + 3072 + ch);
            *(unsigned*)(YS + (size_t)r * 3072 + 1024 + ch) = cvt_pk_bf16(bflo(rw) * hv[0], bfhi(rw) * hv[1]);
            if (n == 15 && rq == 3 && i == 31) *(f32x2*)(out + O_HP + (size_t)(c >> 4) * BW + ch) = hv;
        }
    }
    if (PHON(10)) {
        LAS bf16_t* VL = (LAS bf16_t*)lds;
        for (int e = bid * NTHREADS + tid; e < MS * BW / 2; e += G * NTHREADS) {
            const int r = e / (BW / 2), c2 = (e % (BW / 2)) * 2, g = c2 >> 8;
            const float w00 = P.in[I_WS][(size_t)g * 128 * 128], b0 = P.in[I_BS][g * 128];
            const unsigned vw = *(const unsigned*)(VP + (size_t)(MP + r) * BW + c2), uw = *(const unsigned*)(Z + (size_t)(MP + r) * NZ + c2);
            *(unsigned*)(YS + (size_t)(MP + r) * 3072 + c2) = cvt_pk_bf16(bflo(uw) * (w00 * bflo(vw) + b0), bfhi(uw) * (w00 * bfhi(vw) + b0));
        }
        for (int it = bid; it < 256; it += G) {
            const int g = it & 3, cn = it >> 2;
            const int r0 = cn * 128;
            __syncthreads();
            {
                u32x4 vt8[8];
#pragma unroll
                for (int i = 0; i < 8; ++i) { const int e = tid + i * NTHREADS, s = e >> 5, c8 = (e & 31) * 8; vt8[i] = *(const u32x4*)(VP + (size_t)(r0 + s) * BW + g * 256 + c8); }
#pragma unroll
                for (int i = 0; i < 8; ++i) { const int e = tid + i * NTHREADS, s = e >> 5, c8 = (e & 31) * 8; *(LAS u32x4*)(VL + s * 264 + c8) = vt8[i]; }
            }
            __syncthreads();
            const int fr = lane & 15, fq = lane >> 4;
            bf16x8 vf[2][4];
#pragma unroll
            for (int ct = 0; ct < 2; ++ct)
#pragma unroll
                for (int ks = 0; ks < 4; ++ks) {
                    bf16x8 t;
#pragma unroll
                    for (int j = 0; j < 8; ++j) t[j] = (short)VL[(ks * 32 + fq * 8 + j) * 264 + (2 * wave + ct) * 16 + fr];
                    vf[ct][ks] = t;
                }
            const bf16_t* wsp = WSP + (size_t)g * 128 * 128;
            u32x2 uwp[8][2];
#pragma unroll
            for (int tt = 0; tt < 8; ++tt)
#pragma unroll
                for (int ct = 0; ct < 2; ++ct) uwp[tt][ct] = *(const u32x2*)(Z + (size_t)(r0 + tt * 16 + fr) * NZ + g * 256 + (2 * wave + ct) * 16 + 4 * fq);
#pragma unroll
            for (int tt = 0; tt < 8; ++tt) {
                f32x4 o0 = (f32x4){0.f, 0.f, 0.f, 0.f}, o1 = o0;
#pragma unroll
                for (int ks = 0; ks < 4; ++ks) {
                    const bf16x8 wf = *(const bf16x8*)(wsp + (size_t)(tt * 16 + fr) * 128 + ks * 32 + fq * 8);
                    o0 = __builtin_amdgcn_mfma_f32_16x16x32_bf16(vf[0][ks], wf, o0, 0, 0, 0);
                    o1 = __builtin_amdgcn_mfma_f32_16x16x32_bf16(vf[1][ks], wf, o1, 0, 0, 0);
                }
                if ((tt & 3) == 3) asm volatile("" ::: "memory");
                const int t = tt * 16 + fr; const float bs = P.in[I_BS][g * 128 + t];
                const size_t r = (size_t)(r0 + t);
#pragma unroll
                for (int ct = 0; ct < 2; ++ct) {
                    const f32x4 o = ct ? o1 : o0;
                    const int cc = g * 256 + (2 * wave + ct) * 16 + 4 * fq;
                    const u32x2 uw = uwp[tt][ct];
                    u32x2 w; w.x = cvt_pk_bf16(bflo(uw.x) * (o[0] + bs), bfhi(uw.x) * (o[1] + bs)); w.y = cvt_pk_bf16(bflo(uw.y) * (o[2] + bs), bfhi(uw.y) * (o[3] + bs));
                    *(u32x2*)(YS + r * 3072 + cc) = w;
                }
            }
        }
        __syncthreads();
    }
    GRID_BAR();

    if (PHON(11)) {
        skinny<1>(lds, bid, G, wave, lane, YS + (size_t)MP * 3 * BW, 3 * BW, WBR, BW, BW, nullptr, nullptr, 0.f, 0.f, Z + (size_t)MP * NZ, XB + (size_t)MP * D);
        pg8::BranchSched S{YS, WBR, G, bid};
        pg8::EpiMerge E{Z, Y, XB};
        pg8::gemm_phase<pg8::BranchSched, pg8::EpiMerge, true, true>(lds, BW, 3 * BW, BW, S, E);
    }
    GRID_BAR();
    if (PHON(12)) {
        skinny<0>(lds, bid, G, wave, lane, XB + (size_t)MP * D, D, WOUT, D, D, Y + (size_t)MP * D, X1 + (size_t)MP * D, ALPHA, 1.0f, nullptr, nullptr);
        pg8::PlainSched S{XB, WOUT, 32, 8, D, D, G, bid};
        pg8::EpiResid E{Y, X1, ALPHA, 1.0f, false};
        pg8::gemm_phase<pg8::PlainSched, pg8::EpiResid, true, true>(lds, D, D, D, S, E);
    }
    GRID_BAR();
    if (PHON(13)) for (int r = gw; r < MR; r += NGW) ln_row(Y + (size_t)r * D, P.in[I_LN2G], P.in[I_LN2B], X1 + (size_t)r * D, XB + (size_t)r * D, lane);
    GRID_BAR();
    if (PHON(14)) {
        pg8::PlainSched S{XB, WGU2, 33, 44, D, D, G, bid};
        pg8::EpiSwiglu E{H, FF};
        pg8::gemm_phase<pg8::PlainSched, pg8::EpiSwiglu, true, true>(lds, D, D, D, S, E);
    }
    GRID_BAR();
    if (PHON(15)) {
        skinny<0>(lds, bid, G, wave, lane, H + (size_t)MP * FF, FF, WD2, FF, FF, Y + (size_t)MP * D, X1 + (size_t)MP * D, ALPHA, 0.5f, nullptr, nullptr);
        pg8::PlainSched S{H, WD2, 32, 8, FF, FF, G, bid};
        pg8::EpiResid E{Y, X1, ALPHA, 0.5f, false};
        pg8::gemm_phase<pg8::PlainSched, pg8::EpiResid, true, true>(lds, FF, FF, FF, S, E);
    }
    GRID_BAR();
    if (PHON(16)) for (int r = gw; r < MR; r += NGW) ln_row(Y + (size_t)r * D, P.in[I_LN3G], P.in[I_LN3B], out + O_Y + (size_t)r * D, nullptr, lane);
}

extern "C" void kernel_launch(void* const* d_in, const int* in_sizes, int n_in, void* d_out, int out_size, void* d_ws, size_t ws_size, hipStream_t stream) {
    static int grid = 0;
    if (grid == 0) {
        if (n_in != 35 || (size_t)out_size != O_END || ws_size < WS_END) { fprintf(stderr, "kernel_launch: unexpected shapes: n_in %d out %d (want %zu) ws %zu (need %zu)\n", n_in, out_size, (size_t)O_END, ws_size, (size_t)WS_END); grid = -1; return; }
        int dev = 0, cus = 0, per_cu = 0;
        hipGetDevice(&dev);
        hipDeviceGetAttribute(&cus, hipDeviceAttributeMultiprocessorCount, dev);
        hipFuncSetAttribute((const void*)fwd_kernel, hipFuncAttributeMaxDynamicSharedMemorySize, LDS_BYTES);
        hipOccupancyMaxActiveBlocksPerMultiprocessor(&per_cu, (const void*)fwd_kernel, NTHREADS, LDS_BYTES);
        if (per_cu < 1) { fprintf(stderr, "kernel_launch: occupancy query says %d blocks/CU\n", per_cu); per_cu = 1; }
        (void)hipGetLastError();
        grid = cus;
    }
    if (grid < 0) return;
    Params p{};
    for (int i = 0; i < 35; ++i) p.in[i] = (const float*)d_in[i];
    p.out = (float*)d_out; p.ws = (unsigned char*)d_ws;
    (void)hipMemsetAsync((char*)d_ws + WS_BAR, 0, (size_t)XCD_BAR_WORDS_ * 4, stream);
    void* args[] = {&p};
    hipError_t e = hipLaunchCooperativeKernel((const void*)fwd_kernel, dim3(grid), dim3(NTHREADS), args, LDS_BYTES, stream);
    if (e != hipSuccess) fprintf(stderr, "cooperative launch failed: %s (grid %d)\n", hipGetErrorString(e), grid);
}
```

```cpp
#include <hip/hip_runtime.h>
#include <hip/hip_cooperative_groups.h>
#include <cstdio>
#include <cstdint>
namespace cg = cooperative_groups;

#define LAS __attribute__((address_space(3)))
typedef unsigned short bf16_t;
typedef short bf16x8 __attribute__((ext_vector_type(8)));
typedef short bf16x4 __attribute__((ext_vector_type(4)));
typedef float f32x4 __attribute__((ext_vector_type(4)));
typedef float f32x2 __attribute__((ext_vector_type(2)));
typedef unsigned u32x4 __attribute__((ext_vector_type(4)));
typedef unsigned u32x2 __attribute__((ext_vector_type(2)));

constexpr int D = 2048, FF = 5632, BW = 1024, NZ = 11264;
constexpr int MP = 8192, MS = 128, MR = MP + MS, MPAD = 8448;
constexpr int SEQ = 2048, NB = 4, NMEM = 256, NH = 4, HD = 256;
constexpr float LN_EPS = 1e-5f;
constexpr float ALPHA = 1.189207115002721f;
constexpr int NTHREADS = 512, NWAVES = 8;

constexpr int XCD_BAR_WORDS_ = 3456;
constexpr size_t al256(size_t x) { return (x + 255) & ~(size_t)255; }
constexpr size_t WS_WGU1 = 0;
constexpr size_t WS_WD1 = WS_WGU1 + al256((size_t)NZ * D * 2);
constexpr size_t WS_WIN = WS_WD1 + al256((size_t)D * FF * 2);
constexpr size_t WS_WKV = WS_WIN + al256((size_t)NZ * D * 2);
constexpr size_t WS_WBR = WS_WKV + al256((size_t)D * D * 2);
constexpr size_t WS_WOUT = WS_WBR + al256((size_t)3 * D * BW * 2);
constexpr size_t WS_WGU2 = WS_WOUT + al256((size_t)D * D * 2);
constexpr size_t WS_WD2 = WS_WGU2 + al256((size_t)NZ * D * 2);
constexpr size_t WS_WLRU = WS_WD2 + al256((size_t)D * FF * 2);
constexpr size_t WS_WSP = WS_WLRU + al256((size_t)8 * 256 * 128 * 2);
constexpr size_t WS_XB = WS_WSP + al256((size_t)4 * 128 * 128 * 2);
constexpr size_t WS_ZH = WS_XB + al256((size_t)MPAD * D * 2);
constexpr size_t WS_Y = WS_ZH + al256((size_t)MPAD * NZ * 2);
constexpr size_t WS_X1 = WS_Y + al256((size_t)MPAD * D * 4);
constexpr size_t WS_VP = WS_X1 + al256((size_t)MPAD * D * 4);
constexpr size_t WS_HL = WS_VP + al256((size_t)MPAD * BW * 2);
constexpr size_t WS_AC = WS_HL + al256((size_t)MP * BW * 4);
constexpr size_t WS_SUM = WS_AC + al256((size_t)MP * BW * 4);
constexpr size_t WS_YS = WS_SUM + al256((size_t)64 * 2 * BW * 4);
constexpr size_t WS_MEMLN = WS_YS + al256((size_t)MPAD * 3 * BW * 2);
constexpr size_t WS_KB = WS_MEMLN + al256((size_t)1024 * D * 2);
constexpr size_t WS_VT = WS_KB + al256((size_t)1024 * 1024 * 2);
constexpr size_t WS_BAR = WS_VT + al256((size_t)1024 * 1024 * 2);
constexpr size_t WS_END = WS_BAR + al256((size_t)XCD_BAR_WORDS_ * 4);

constexpr size_t O_Y = 0;
constexpr size_t O_MK = (size_t)MR * D;
constexpr size_t O_MV = O_MK + (size_t)1024 * 1024;
constexpr size_t O_CP = O_MV + (size_t)1024 * 1024;
constexpr size_t O_HP = O_CP + (size_t)4 * 3 * 1024;
constexpr size_t O_CS = O_HP + (size_t)4 * 1024;
constexpr size_t O_HS = O_CS + (size_t)128 * 3 * 1024;
constexpr size_t O_VS = O_HS + (size_t)128 * 1024;
constexpr size_t O_END = O_VS + (size_t)128 * 1024;

constexpr int LDS_BYTES = 159744;

struct Params { const float* in[35]; float* out; unsigned char* ws; };
enum { I_XP = 0, I_XS, I_MEM, I_CK, I_CV, I_SCONV, I_SLRU, I_GU1, I_DN1, I_LN1G, I_LN1B, I_WIN, I_GATEB, I_GLNG, I_GLNB, I_WS, I_BS, I_CONVW, I_CONVB,
       I_LWA, I_LBA, I_LWX, I_LBX, I_LAM, I_MLNG, I_MLNB, I_WKV, I_WBR, I_WOUT, I_LN2G, I_LN2B, I_GU2, I_DN2, I_LN3G, I_LN3B };

__device__ __forceinline__ unsigned cvt_pk_bf16(float lo, float hi) { unsigned r; asm volatile("v_cvt_pk_bf16_f32 %0, %1, %2" : "=v"(r) : "v"(lo), "v"(hi)); return r; }
__device__ __forceinline__ float bf2f(unsigned short b) { return __uint_as_float(((unsigned)b) << 16); }
__device__ __forceinline__ float bflo(unsigned w) { return __uint_as_float(w << 16); }
__device__ __forceinline__ float bfhi(unsigned w) { return __uint_as_float(w & 0xffff0000u); }
__device__ __forceinline__ float sigmoidf_(float x) { return __builtin_amdgcn_rcpf(1.0f + __expf(-x)); }
__device__ __forceinline__ float siluf_(float x) { return x * sigmoidf_(x); }
__device__ __forceinline__ float gelu_tanh(float x) { return x * sigmoidf_(1.5957691216057308f * (x + 0.044715f * x * x * x)); }
__device__ __forceinline__ float wave_sum(float v) {
#pragma unroll
    for (int o = 1; o < 64; o <<= 1) v += __shfl_xor(v, o);
    return v;
}
__device__ __forceinline__ float wave_max(float v) {
#pragma unroll
    for (int o = 1; o < 64; o <<= 1) v = fmaxf(v, __shfl_xor(v, o));
    return v;
}

namespace pg8 {
constexpr int BM = 256, BK = 64, HALF = 128, HTB = HALF * BK * 2, STAGE_BYTES = 8 * HTB, NXCD = 8, WGM = 8;
__host__ __device__ __forceinline__ int lds_byte(int r, int c) { const int st = (r >> 4) * 2 + (c >> 5), rr = r & 15, cc = c & 31, ob = rr * 64 + cc * 2; return st * 1024 + (ob ^ (((ob >> 9) & 1) << 5)); }
__host__ __device__ __forceinline__ void stage_rc(int b, int& R, int& C) { const int st = b / 1024, sb = b % 1024, swz = sb ^ (((sb >> 9) & 1) << 5); R = (st >> 1) * 16 + swz / 64; C = (st & 1) * 32 + (swz % 64) / 2; }
__host__ __device__ __forceinline__ int perm32(int rho) { const int n = rho >> 4, i = rho & 15; return 8 * (i >> 2) + 4 * n + (i & 3); }

struct Unit { const char* A; const char* B; int pm, pn, kind; };

__device__ __forceinline__ void tile_of(int wgid, int nM, int nN, int& pm, int& pn) {
    const int nwg = nM * nN;
    { const int q = nwg / NXCD, r = nwg % NXCD, xcd = wgid % NXCD, off = wgid / NXCD; wgid = (xcd < r ? xcd * (q + 1) : r * (q + 1) + (xcd - r) * q) + off; }
    const int nig = WGM * nN, gid = wgid / nig, fm = gid * WGM, gsz = (nM - fm) < WGM ? (nM - fm) : WGM;
    pm = fm + ((wgid % nig) % gsz); pn = (wgid % nig) / gsz;
}
struct PlainSched {
    const bf16_t* A; const bf16_t* Bt; int nM, nN, lda, ldb, G, c;
    __device__ __forceinline__ bool next(int i, Unit& u) const {
        const int L = i * G + c; if (L >= nM * nN) return false;
        tile_of(L, nM, nN, u.pm, u.pn); u.kind = 0;
        u.A = (const char*)(A + (size_t)u.pm * BM * lda); u.B = (const char*)(Bt + (size_t)u.pn * BM * ldb); return true;
    }
};
struct WinSched {
    const bf16_t* XB_; const bf16_t* WIN_; const bf16_t* MEMLN_; const bf16_t* WKV_; int G, c;
    __device__ __forceinline__ bool next(int i, Unit& u) const {
        const int L = i * G + c; constexpr int NZU = 33 * 44;
        if (L < NZU) { tile_of(L, 33, 44, u.pm, u.pn); u.kind = 0; u.A = (const char*)(XB_ + (size_t)u.pm * BM * D); u.B = (const char*)(WIN_ + (size_t)u.pn * BM * D); return true; }
        if (L < NZU + 32) { const int j = L - NZU; u.pm = j >> 3; u.pn = j & 7; u.kind = 1; u.A = (const char*)(MEMLN_ + (size_t)u.pm * BM * D); u.B = (const char*)(WKV_ + (size_t)u.pn * BM * D); return true; }
        if (L < NZU + 48) { const int j = L - NZU - 32; u.pm = j >> 2; u.pn = j & 3; u.kind = 2; u.A = (const char*)(WKV_ + (size_t)(1024 + u.pm * BM) * D); u.B = (const char*)(MEMLN_ + (size_t)u.pn * BM * D); return true; }
        return false;
    }
};
struct BranchSched {
    const bf16_t* YS_; const bf16_t* WBR_; int G, c;
    __device__ __forceinline__ bool next(int i, Unit& u) const {
        const int t = (i / 3) * G + c, k = i % 3; if (t >= 256) return false;
        tile_of(t, 32, 8, u.pm, u.pn); u.kind = k;
        u.A = (const char*)(YS_ + (size_t)u.pm * BM * (3 * BW) + k * BW); u.B = (const char*)(WBR_ + (size_t)k * D * BW + (size_t)u.pn * BM * BW); return true;
    }
};

template <class Sched, class Epi, bool ALIGN_EPI, bool SP2>
__device__ __forceinline__ void gemm_phase(LAS unsigned char* lds, const int K, const int lda, const int ldb, const Sched& S, const Epi& E) {
    int tid = threadIdx.x; asm volatile("" : "+v"(tid));
    const int wid = __builtin_amdgcn_readfirstlane(tid >> 6), lane = tid & 63, wr = wid >> 2, wc = wid & 3, fr = lane & 15, fq = lane >> 4;
    const int nt = K / BK;
    unsigned voffA[2], voffB[2];
#pragma unroll
    for (int i = 0; i < 2; ++i) { int R, C; stage_rc(tid * 16 + i * 8192, R, C); const int Rb = Epi::PERM ? ((R & ~31) + perm32(R & 31)) : R;
        voffA[i] = (unsigned)(R * lda + C) * 2u; voffB[i] = (unsigned)(Rb * ldb + C) * 2u; }
    const size_t kstep = (size_t)(BK * 2);
    const size_t hstepA = (size_t)HALF * lda * 2, hstepB = (size_t)HALF * ldb * 2;
    const unsigned ldsw = (unsigned)wid * 1024u;
    const int aoff = lds_byte(wr * 64 + fr, fq * 8), boff = lds_byte(wc * 32 + fr, fq * 8);
#define PG8_SA(b, h) (((b) * 2 + (h)) * HTB)
#define PG8_SB(b, h) ((4 + (b) * 2 + (h)) * HTB)
#define PG8_STAGE(bufoff, gbase, voff) do { _Pragma("unroll") for (int _i = 0; _i < 2; ++_i) \
        __builtin_amdgcn_global_load_lds((const unsigned*)((const char*)(gbase) + (voff)[_i]), (LAS unsigned*)(lds + (bufoff) + ldsw + _i * 8192), 16, 0, 0); } while (0)
#define PG8_LDA(dst, b, h) do { _Pragma("unroll") for (int m = 0; m < 4; ++m) _Pragma("unroll") for (int k = 0; k < 2; ++k) dst[m][k] = *(const LAS bf16x8*)(lds + PG8_SA(b, h) + aoff + m * 2048 + k * 1024); } while (0)
#define PG8_LDB(dst, b, h) do { _Pragma("unroll") for (int n = 0; n < 2; ++n) _Pragma("unroll") for (int k = 0; k < 2; ++k) dst[n][k] = *(const LAS bf16x8*)(lds + PG8_SB(b, h) + boff + n * 2048 + k * 1024); } while (0)
#define PG8_MMA(ai, bj, At, Bt) do { __builtin_amdgcn_s_setprio(1); _Pragma("unroll") for (int m = 0; m < 4; ++m) _Pragma("unroll") for (int n = 0; n < 2; ++n) _Pragma("unroll") for (int k = 0; k < 2; ++k) \
        acc[ai][bj][m][n] = __builtin_amdgcn_mfma_f32_16x16x32_bf16(Bt[n][k], At[m][k], acc[ai][bj][m][n], 0, 0, 0); __builtin_amdgcn_s_setprio(0); } while (0)
#define PG8_WAIT_V(n) asm volatile("s_waitcnt vmcnt(" #n ")" ::: "memory")
#define PG8_WAIT_L(n) asm volatile("s_waitcnt lgkmcnt(" #n ")" ::: "memory")
#define PG8_BAR __builtin_amdgcn_s_barrier()
#define PG8_SCHED __builtin_amdgcn_sched_barrier(0)
    Unit cur, nxt; int ui = 0;
    if (!S.next(0, cur)) return;
    f32x4 acc[2][2][4][2];
#pragma unroll
    for (int a = 0; a < 2; ++a)
#pragma unroll
        for (int b = 0; b < 2; ++b)
#pragma unroll
            for (int m = 0; m < 4; ++m)
#pragma unroll
                for (int n = 0; n < 2; ++n) acc[a][b][m][n] = (f32x4){0.f, 0.f, 0.f, 0.f};
    bf16x8 At[4][2], B0[2][2], B1[2][2];
    const char* cA = cur.A; const char* cB = cur.B;
    if constexpr (SP2) {
        PG8_STAGE(PG8_SB(0, 0), cB, voffB); PG8_STAGE(PG8_SB(0, 1), cB + hstepB, voffB); PG8_STAGE(PG8_SA(0, 0), cA, voffA); PG8_STAGE(PG8_SA(0, 1), cA + hstepA, voffA);
        if (wr == 1) PG8_BAR;
        PG8_WAIT_V(2); PG8_BAR;
        PG8_STAGE(PG8_SB(1, 0), cB + kstep, voffB); PG8_STAGE(PG8_SA(1, 0), cA + kstep, voffA); PG8_STAGE(PG8_SB(1, 1), cB + hstepB + kstep, voffB);
        PG8_WAIT_V(6); PG8_BAR;
    } else {
        PG8_STAGE(PG8_SB(0, 0), cB, voffB); PG8_STAGE(PG8_SA(0, 0), cA, voffA); PG8_STAGE(PG8_SB(0, 1), cB + hstepB, voffB); PG8_STAGE(PG8_SA(0, 1), cA + hstepA, voffA);
        if (wr == 1) PG8_BAR;
        PG8_WAIT_V(4); PG8_BAR;
        PG8_STAGE(PG8_SB(1, 0), cB + kstep, voffB); PG8_STAGE(PG8_SA(1, 0), cA + kstep, voffA); PG8_STAGE(PG8_SB(1, 1), cB + hstepB + kstep, voffB);
        PG8_WAIT_V(6); PG8_BAR;
    }
    for (;;) {
        const bool has_next = S.next(ui + 1, nxt);
        const char* nA = has_next ? nxt.A : cA; const char* nB = has_next ? nxt.B : cB;
        for (int t = 0; t < nt; t += 2) {
            const bool last = (t == nt - 2);
            const char* a1 = cA + (size_t)(t + 1) * kstep;
            const char* a2 = last ? nA : cA + (size_t)(t + 2) * kstep; const char* b2 = last ? nB : cB + (size_t)(t + 2) * kstep;
            const char* a3 = a2 + kstep; const char* b3 = b2 + kstep;
            if constexpr (SP2) {
            PG8_LDB(B0, 0, 0); PG8_LDB(B1, 0, 1); PG8_SCHED; PG8_LDA(At, 0, 0); PG8_STAGE(PG8_SA(1, 1), a1 + hstepA, voffA);
            PG8_WAIT_V(8); PG8_WAIT_L(0); PG8_BAR; PG8_MMA(0, 0, At, B0); PG8_MMA(0, 1, At, B1); PG8_BAR; PG8_SCHED;
            PG8_LDA(At, 0, 1); PG8_STAGE(PG8_SB(0, 0), b2, voffB); PG8_STAGE(PG8_SB(0, 1), b2 + hstepB, voffB); PG8_STAGE(PG8_SA(0, 0), a2, voffA);
            PG8_WAIT_V(8); PG8_WAIT_L(0); PG8_BAR; PG8_MMA(1, 0, At, B0); PG8_MMA(1, 1, At, B1); PG8_BAR; PG8_SCHED;
            PG8_LDB(B0, 1, 0); PG8_LDB(B1, 1, 1); PG8_SCHED; PG8_LDA(At, 1, 0); PG8_STAGE(PG8_SA(0, 1), a2 + hstepA, voffA);
            PG8_WAIT_V(8); PG8_WAIT_L(0); PG8_BAR; PG8_MMA(0, 0, At, B0); PG8_MMA(0, 1, At, B1); PG8_BAR; PG8_SCHED;
            PG8_LDA(At, 1, 1); PG8_STAGE(PG8_SB(1, 0), b3, voffB); PG8_STAGE(PG8_SB(1, 1), b3 + hstepB, voffB); PG8_STAGE(PG8_SA(1, 0), a3, voffA);
            PG8_WAIT_V(8); PG8_WAIT_L(0); PG8_BAR; PG8_MMA(1, 0, At, B0); PG8_MMA(1, 1, At, B1); PG8_BAR; PG8_SCHED;
            } else {
            PG8_LDB(B0, 0, 0); PG8_SCHED; PG8_LDA(At, 0, 0); PG8_STAGE(PG8_SA(1, 1), a1 + hstepA, voffA);
            PG8_WAIT_L(8); PG8_BAR; PG8_WAIT_L(0); PG8_MMA(0, 0, At, B0); PG8_BAR; PG8_SCHED;
            PG8_LDB(B1, 0, 1); PG8_STAGE(PG8_SB(0, 0), b2, voffB);
            PG8_BAR; PG8_WAIT_L(0); PG8_MMA(0, 1, At, B1); PG8_BAR;
            PG8_LDA(At, 0, 1); PG8_STAGE(PG8_SA(0, 0), a2, voffA);
            PG8_BAR; PG8_WAIT_L(0); PG8_MMA(1, 0, At, B0); PG8_BAR; PG8_SCHED;
            PG8_STAGE(PG8_SB(0, 1), b2 + hstepB, voffB);
            PG8_WAIT_V(6); PG8_BAR; PG8_MMA(1, 1, At, B1); PG8_BAR;
            PG8_LDB(B0, 1, 0); PG8_SCHED; PG8_LDA(At, 1, 0); PG8_STAGE(PG8_SA(0, 1), a2 + hstepA, voffA);
            PG8_WAIT_L(8); PG8_BAR; PG8_WAIT_L(0); PG8_MMA(0, 0, At, B0); PG8_BAR; PG8_SCHED;
            PG8_LDB(B1, 1, 1); PG8_STAGE(PG8_SB(1, 0), b3, voffB);
            PG8_BAR; PG8_WAIT_L(0); PG8_MMA(0, 1, At, B1); PG8_BAR;
            PG8_LDA(At, 1, 1); PG8_STAGE(PG8_SA(1, 0), a3, voffA);
            PG8_BAR; PG8_WAIT_L(0); PG8_MMA(1, 0, At, B0); PG8_BAR; PG8_SCHED;
            PG8_STAGE(PG8_SB(1, 1), b3 + hstepB, voffB);
            PG8_WAIT_V(6); PG8_BAR; PG8_MMA(1, 1, At, B1); PG8_BAR;
            }
        }
        if constexpr (ALIGN_EPI) { if (wr == 0) PG8_BAR; }
        E(acc, cur, wr, wc, fr, fq);
        if (!has_next) break;
#pragma unroll
        for (int a = 0; a < 2; ++a)
#pragma unroll
            for (int b = 0; b < 2; ++b)
#pragma unroll
                for (int m = 0; m < 4; ++m)
#pragma unroll
                    for (int n = 0; n < 2; ++n) acc[a][b][m][n] = (f32x4){0.f, 0.f, 0.f, 0.f};
        cur = nxt; cA = nA; cB = nB; ++ui;
        if constexpr (ALIGN_EPI) { if (wr == 1) PG8_BAR; }
    }
    PG8_WAIT_V(0);
    if constexpr (!ALIGN_EPI) { if (wr == 0) PG8_BAR; }
    PG8_BAR;
#undef PG8_SA
#undef PG8_SB
#undef PG8_STAGE
#undef PG8_LDA
#undef PG8_LDB
#undef PG8_MMA
#undef PG8_WAIT_V
#undef PG8_WAIT_L
#undef PG8_BAR
#undef PG8_SCHED
}


struct EpiSwiglu {
    static constexpr bool PERM = true;
    bf16_t* H; int ldh;
    __device__ __forceinline__ void operator()(const f32x4 (&acc)[2][2][4][2], const Unit& u, int wr, int wc, int fr, int fq) const {
        const int row0 = u.pm * BM + wr * 64 + fr, col0 = u.pn * HALF + wc * 32 + 8 * fq;
#pragma unroll
        for (int ai = 0; ai < 2; ++ai)
#pragma unroll
            for (int m = 0; m < 4; ++m) {
                bf16_t* rowp = H + (size_t)(row0 + ai * HALF + m * 16) * ldh + col0;
                f32x4 v0, v1;
#pragma unroll
                for (int j = 0; j < 4; ++j) { v0[j] = siluf_(acc[ai][0][m][0][j]) * acc[ai][1][m][0][j]; v1[j] = siluf_(acc[ai][0][m][1][j]) * acc[ai][1][m][1][j]; }
                u32x4 w; w.x = cvt_pk_bf16(v0[0], v0[1]); w.y = cvt_pk_bf16(v0[2], v0[3]); w.z = cvt_pk_bf16(v1[0], v1[1]); w.w = cvt_pk_bf16(v1[2], v1[3]);
                *(u32x4*)rowp = w;
            }
    }
};
struct EpiResid {
    static constexpr bool PERM = false;
    float* Y; const float* res; float alpha, scale; bool stream;
    __device__ __forceinline__ void operator()(const f32x4 (&acc)[2][2][4][2], const Unit& u, int wr, int wc, int fr, int fq) const {
        const int row0 = u.pm * BM + wr * 64 + fr, col0 = u.pn * BM + wc * 32 + 4 * fq;
#pragma unroll
        for (int ai = 0; ai < 2; ++ai)
#pragma unroll
            for (int m2 = 0; m2 < 2; ++m2) {
                f32x4 xv[2][2][2];
#pragma unroll
                for (int mm = 0; mm < 2; ++mm)
#pragma unroll
                    for (int bj = 0; bj < 2; ++bj)
#pragma unroll
                        for (int n = 0; n < 2; ++n) { const f32x4* rp = (const f32x4*)(res + (size_t)(row0 + ai * HALF + (2 * m2 + mm) * 16) * D + col0 + bj * HALF + n * 16); xv[mm][bj][n] = stream ? __builtin_nontemporal_load(rp) : *rp; }
#pragma unroll
                for (int mm = 0; mm < 2; ++mm)
#pragma unroll
                    for (int bj = 0; bj < 2; ++bj)
#pragma unroll
                        for (int n = 0; n < 2; ++n) *(f32x4*)(Y + (size_t)(row0 + ai * HALF + (2 * m2 + mm) * 16) * D + col0 + bj * HALF + n * 16) = xv[mm][bj][n] * alpha + acc[ai][bj][2 * m2 + mm][n] * scale;
            }
    }
};
struct EpiWin {
    static constexpr bool PERM = true;
    bf16_t* Z; const LAS float* gate_b; float* outK; float* outV; bf16_t* KB; bf16_t* VT;
    __device__ __forceinline__ void operator()(const f32x4 (&acc)[2][2][4][2], const Unit& u, int wr, int wc, int fr, int fq) const {
        const int row0 = u.pm * BM + wr * 64 + fr, col0 = u.pn * BM + wc * 32 + 8 * fq;
        if (u.kind == 0) {
            const int mode = (u.pn < 8) ? 1 : (u.pn < 12) ? 0 : (u.pn < 16) ? 1 : (u.pn < 20) ? 0 : 2;
            f32x4 gb[2][2];
#pragma unroll
            for (int bj = 0; bj < 2; ++bj)
#pragma unroll
                for (int n = 0; n < 2; ++n) gb[bj][n] = (mode == 2) ? *(const LAS f32x4*)(gate_b + (col0 - 5120) + bj * HALF + 4 * n) : (f32x4){0.f, 0.f, 0.f, 0.f};
#pragma unroll
            for (int ai = 0; ai < 2; ++ai)
#pragma unroll
                for (int m = 0; m < 4; ++m) {
                    bf16_t* rowp = Z + (size_t)(row0 + ai * HALF + m * 16) * NZ + col0;
#pragma unroll
                    for (int bj = 0; bj < 2; ++bj) {
                        f32x4 v0 = acc[ai][bj][m][0], v1 = acc[ai][bj][m][1];
                        if (mode == 1) {
#pragma unroll
                            for (int j = 0; j < 4; ++j) { v0[j] = gelu_tanh(v0[j]); v1[j] = gelu_tanh(v1[j]); }
                        } else if (mode == 2) {
#pragma unroll
                            for (int j = 0; j < 4; ++j) { v0[j] = sigmoidf_(v0[j] + gb[bj][0][j]); v1[j] = sigmoidf_(v1[j] + gb[bj][1][j]); }
                        }
                        u32x4 w; w.x = cvt_pk_bf16(v0[0], v0[1]); w.y = cvt_pk_bf16(v0[2], v0[3]); w.z = cvt_pk_bf16(v1[0], v1[1]); w.w = cvt_pk_bf16(v1[2], v1[3]);
                        *(u32x4*)(rowp + bj * HALF) = w;
                    }
                }
        } else if (u.kind == 1) {
            const bool isk = u.pn < 4; const int c0 = col0 - (isk ? 0 : 1024);
            float* ob = isk ? outK : outV;
#pragma unroll
            for (int ai = 0; ai < 2; ++ai)
#pragma unroll
                for (int m = 0; m < 4; ++m) {
                    const size_t off = (size_t)(row0 + ai * HALF + m * 16) * 1024 + c0;
#pragma unroll
                    for (int bj = 0; bj < 2; ++bj) {
                        const f32x4 v0 = acc[ai][bj][m][0], v1 = acc[ai][bj][m][1];
                        __builtin_nontemporal_store(v0, (f32x4*)(ob + off + bj * HALF)); __builtin_nontemporal_store(v1, (f32x4*)(ob + off + bj * HALF + 4));
                        if (isk) { u32x4 w; w.x = cvt_pk_bf16(v0[0], v0[1]); w.y = cvt_pk_bf16(v0[2], v0[3]); w.z = cvt_pk_bf16(v1[0], v1[1]); w.w = cvt_pk_bf16(v1[2], v1[3]); *(u32x4*)(KB + off + bj * HALF) = w; }
                    }
                }
        } else {
#pragma unroll
            for (int ai = 0; ai < 2; ++ai)
#pragma unroll
                for (int m = 0; m < 4; ++m) {
                    bf16_t* rowp = VT + (size_t)(row0 + ai * HALF + m * 16) * 1024 + col0;
#pragma unroll
                    for (int bj = 0; bj < 2; ++bj) {
                        const f32x4 v0 = acc[ai][bj][m][0], v1 = acc[ai][bj][m][1];
                        u32x4 w; w.x = cvt_pk_bf16(v0[0], v0[1]); w.y = cvt_pk_bf16(v0[2], v0[3]); w.z = cvt_pk_bf16(v1[0], v1[1]); w.w = cvt_pk_bf16(v1[2], v1[3]);
                        *(u32x4*)(rowp + bj * HALF) = w;
                    }
                }
        }
    }
};
struct EpiMerge {
    static constexpr bool PERM = false;
    const bf16_t* Z; float* MG; bf16_t* MB;
    template <int KI> __device__ __forceinline__ void body(const f32x4 (&acc)[2][2][4][2], const Unit& u, int wr, int wc, int fr, int fq) const {
        const int row0 = u.pm * BM + wr * 64 + fr, col0 = u.pn * BM + wc * 32 + 4 * fq;
#pragma unroll
        for (int ai = 0; ai < 2; ++ai)
#pragma unroll
            for (int m2 = 0; m2 < 2; ++m2) {
                u32x2 gw[2][2][2]; f32x4 mg[2][2][2];
#pragma unroll
                for (int mm = 0; mm < 2; ++mm)
#pragma unroll
                    for (int bj = 0; bj < 2; ++bj)
#pragma unroll
                        for (int n = 0; n < 2; ++n) {
                            const int r = row0 + ai * HALF + (2 * m2 + mm) * 16;
                            gw[mm][bj][n] = *(const u32x2*)(Z + (size_t)r * NZ + 5120 + KI * 2048 + col0 + bj * HALF + n * 16);
                            if (KI > 0) mg[mm][bj][n] = *(const f32x4*)(MG + (size_t)r * D + col0 + bj * HALF + n * 16);
                        }
#pragma unroll
                for (int mm = 0; mm < 2; ++mm)
#pragma unroll
                    for (int bj = 0; bj < 2; ++bj)
#pragma unroll
                        for (int n = 0; n < 2; ++n) {
                            const int r = row0 + ai * HALF + (2 * m2 + mm) * 16;
                            const size_t off = (size_t)r * D + col0 + bj * HALF + n * 16;
                            const u32x2 g2 = gw[mm][bj][n];
                            f32x4 v = (f32x4){bflo(g2.x), bfhi(g2.x), bflo(g2.y), bfhi(g2.y)} * acc[ai][bj][2 * m2 + mm][n];
                            if (KI > 0) v += mg[mm][bj][n];
                            if (KI < 2) *(f32x4*)(MG + off) = v;
                            else { u32x2 w; w.x = cvt_pk_bf16(v[0], v[1]); w.y = cvt_pk_bf16(v[2], v[3]); *(u32x2*)(MB + off) = w; }
                        }
            }
    }
    __device__ __forceinline__ void operator()(const f32x4 (&acc)[2][2][4][2], const Unit& u, int wr, int wc, int fr, int fq) const {
        if (u.kind == 0) body<0>(acc, u, wr, wc, fr, fq); else if (u.kind == 1) body<1>(acc, u, wr, wc, fr, fq); else body<2>(acc, u, wr, wc, fr, fq);
    }
};
}

#ifndef PHMASK
#define PHMASK 0xFFFFFFFFu
#endif
#ifndef GREP
#define GREP 1
#endif
#ifndef NREP
#define NREP 1
#endif
#define PHON(n) (((PHMASK) >> (n)) & 1u)
#define LDS_WAIT() asm volatile("s_waitcnt lgkmcnt(0)" ::: "memory")

__device__ __forceinline__ void transpose_item(const float* W, int N, bf16_t* WT, int ldk, int k0, int n0, int dst_row0, LAS float* scr, int lane) {
    f32x4 v[8];
    const int n4 = (lane & 7) * 4, kr = lane >> 3;
#pragma unroll
    for (int i = 0; i < 8; ++i) v[i] = __builtin_nontemporal_load((const f32x4*)(W + (size_t)(k0 + kr + 8 * i) * N + n0 + n4));
#pragma unroll
    for (int i = 0; i < 8; ++i) { LAS float* d = scr + (kr + 8 * i) * 33 + n4; d[0] = v[i][0]; d[1] = v[i][1]; d[2] = v[i][2]; d[3] = v[i][3]; }
    LDS_WAIT(); asm volatile("" ::: "memory");
    const int c = lane & 7;
#pragma unroll
    for (int j = 0; j < 4; ++j) { const int n = (lane >> 3) + 8 * j; const LAS float* s = scr + (8 * c) * 33 + n;
        u32x4 o; o.x = cvt_pk_bf16(s[0 * 33], s[1 * 33]); o.y = cvt_pk_bf16(s[2 * 33], s[3 * 33]); o.z = cvt_pk_bf16(s[4 * 33], s[5 * 33]); o.w = cvt_pk_bf16(s[6 * 33], s[7 * 33]);
        *(u32x4*)(WT + (size_t)(dst_row0 + n) * ldk + k0 + 8 * c) = o; }
    LDS_WAIT(); asm volatile("" ::: "memory");
}
__device__ __forceinline__ void ln_row(const float* yrow, const float* g, const float* b, float* of, bf16_t* ob, int lane) {
    f32x4 v[8]; float s = 0.f;
#pragma unroll
    for (int j = 0; j < 8; ++j) { v[j] = *(const f32x4*)(yrow + 4 * lane + 256 * j); s += (v[j][0] + v[j][1]) + (v[j][2] + v[j][3]); }
    const float mean = wave_sum(s) * (1.f / D); float s2 = 0.f;
#pragma unroll
    for (int j = 0; j < 8; ++j) { v[j] = v[j] - mean; s2 += (v[j][0] * v[j][0] + v[j][1] * v[j][1]) + (v[j][2] * v[j][2] + v[j][3] * v[j][3]); }
    const float rstd = 1.0f / sqrtf(wave_sum(s2) * (1.f / D) + LN_EPS);
#pragma unroll
    for (int j = 0; j < 8; ++j) {
        const f32x4 gg = *(const f32x4*)(g + 4 * lane + 256 * j), bb = *(const f32x4*)(b + 4 * lane + 256 * j);
        const f32x4 o = v[j] * rstd * gg + bb;
        if (of) __builtin_nontemporal_store(o, (f32x4*)(of + 4 * lane + 256 * j));
        if (ob) { u32x2 w; w.x = cvt_pk_bf16(o[0], o[1]); w.y = cvt_pk_bf16(o[2], o[3]); *(u32x2*)(ob + 4 * lane + 256 * j) = w; }
    }
}

#define XB_TMO      128
#define XB_XCNT(j)  (256  + 64 * (j))
#define XB_XSUB(j)  (1280 + 64 * (j))
#define XB_XGEN(j)  (2304 + 64 * (j))
#define XB_TOP      3328
#define XB_TOPGEN   3392
#define XCD_BAR_WORDS 3456
#define XB_SPIN_CAP (1u << 22)
__device__ __forceinline__ unsigned xb_ld(unsigned* p)              { return __hip_atomic_load(p, __ATOMIC_RELAXED, __HIP_MEMORY_SCOPE_AGENT); }
__device__ __forceinline__ unsigned xb_add(unsigned* p, unsigned v) { return __hip_atomic_fetch_add(p, v, __ATOMIC_RELAXED, __HIP_MEMORY_SCOPE_AGENT); }
__device__ __forceinline__ unsigned xb_xcc_id() { return (unsigned)__builtin_amdgcn_s_getreg((3 << 11) | 20) & 0xFu; }
#define XB_SPIN(cond, bar) do { unsigned _sp = 0; while (cond) { __builtin_amdgcn_s_sleep(1); \
    if ((++_sp & 255u) == 0u) { if (xb_ld(&(bar)[XB_TMO])) break; if (_sp > XB_SPIN_CAP) { atomicAdd(&(bar)[XB_TMO], 1u); break; } } } } while (0)
struct XcdBarrier { unsigned* bar; unsigned x; volatile LAS unsigned* st; };
__device__ __forceinline__ XcdBarrier xcd_barrier_post(unsigned* bar, volatile LAS unsigned* st) {
    XcdBarrier b; b.bar = bar; b.x = xb_xcc_id(); b.st = st;
    if (threadIdx.x == 0) (void)xb_add(&bar[XB_XCNT(b.x)], 1u);
    return b;
}
__device__ __forceinline__ void xcd_barrier_complete(unsigned* bar, unsigned x, unsigned& nloc, unsigned& nx) {
    const unsigned G = gridDim.x * gridDim.y * gridDim.z;
    unsigned sum, cnt, mine, sp = 0u;
    for (;;) {
        sum = 0u; cnt = 0u; mine = 0u;
#pragma unroll
        for (unsigned j = 0; j < 16; ++j) { const unsigned c = xb_ld(&bar[XB_XCNT(j)]); sum += c; cnt += (c > 0u) ? 1u : 0u; mine = (j == x) ? c : mine; }
        if (sum == G) break;
        __builtin_amdgcn_s_sleep(1);
        if ((++sp & 255u) == 0u) { if (xb_ld(&bar[XB_TMO])) break; if (sp > XB_SPIN_CAP) { atomicAdd(&bar[XB_TMO], 1u); break; } }
    }
    nloc = mine > 0u ? mine : 1u; nx = cnt > 0u ? cnt : 1u;
}
__device__ __forceinline__ void xcd_barrier(const XcdBarrier& b) {
    asm volatile("s_waitcnt vmcnt(0)" ::: "memory");
    __syncthreads();
    if (threadIdx.x == 0) {
        unsigned* bar = b.bar;
        __builtin_amdgcn_s_waitcnt(0);
        unsigned nloc = b.st[0], nx = b.st[1];
        if (nloc == 0u) { xcd_barrier_complete(bar, b.x, nloc, nx); b.st[0] = nloc; b.st[1] = nx; }
        const unsigned old = xb_add(&bar[XB_XSUB(b.x)], 1u);
        const unsigned gen = old / nloc;
        if (old + 1u == (gen + 1u) * nloc) {
            __builtin_amdgcn_fence(__ATOMIC_RELEASE, "agent");
            asm volatile("s_waitcnt vmcnt(0)" ::: "memory");
            const unsigned og = xb_add(&bar[XB_TOP], 1u);
            const unsigned tg = og / nx;
            if (og + 1u == (tg + 1u) * nx) xb_add(&bar[XB_TOPGEN], 1u);
            else XB_SPIN(xb_ld(&bar[XB_TOPGEN]) == tg, bar);
            __builtin_amdgcn_fence(__ATOMIC_ACQUIRE, "agent");
            xb_add(&bar[XB_XGEN(b.x)], 1u);
            asm volatile("s_waitcnt vmcnt(0)" ::: "memory");
        } else {
            XB_SPIN(xb_ld(&bar[XB_XGEN(b.x)]) == gen, bar);
            __builtin_amdgcn_fence(__ATOMIC_ACQUIRE, "agent");
            asm volatile("s_waitcnt vmcnt(0)" ::: "memory");
        }
    }
    __syncthreads();
}

template <int MODE>
__device__ __forceinline__ void skinny(LAS unsigned char* lds, int bid, int G, int wave, int lane, const bf16_t* A, int lda, const bf16_t* Bt, int ldb, int K,
                                       float* Ys, const float* res, float alpha, float scale, const bf16_t* Zs, bf16_t* MBs) {
    const int fr = lane & 15, fq = lane >> 4, tw = wave & 3, kh = wave >> 2;
    LAS f32x4* red = (LAS f32x4*)lds;
    for (int T0 = bid * 4; T0 < 1024; T0 += G * 4) {
        const int T = T0 + tw, rt = T >> 7, ct = T & 127;
        f32x4 tot = (f32x4){0.f, 0.f, 0.f, 0.f};
        if (MODE == 0) {
            const int kb = kh * (K / 2);
            const bf16_t* ap = A + (size_t)(rt * 16 + fr) * lda + kb + fq * 8;
            const bf16_t* bp = Bt + (size_t)(ct * 16 + fr) * ldb + kb + fq * 8;
#pragma unroll 16
            for (int ks = 0; ks < K / 64; ++ks) {
                const bf16x8 af = *(const bf16x8*)(ap + ks * 32), bfv = *(const bf16x8*)(bp + ks * 32);
                tot = __builtin_amdgcn_mfma_f32_16x16x32_bf16(bfv, af, tot, 0, 0, 0);
            }
        } else {
#pragma unroll
            for (int k = 0; k < 3; ++k) {
                const int kb = kh * (BW / 2);
                const bf16_t* ap = A + (size_t)(rt * 16 + fr) * lda + k * BW + kb + fq * 8;
                const bf16_t* bp = Bt + (size_t)k * D * BW + (size_t)(ct * 16 + fr) * ldb + kb + fq * 8;
                f32x4 acc = (f32x4){0.f, 0.f, 0.f, 0.f};
#pragma unroll 8
                for (int ks = 0; ks < BW / 64; ++ks) {
                    const bf16x8 af = *(const bf16x8*)(ap + ks * 32), bfv = *(const bf16x8*)(bp + ks * 32);
                    acc = __builtin_amdgcn_mfma_f32_16x16x32_bf16(bfv, af, acc, 0, 0, 0);
                }
                const u32x2 gw = *(const u32x2*)(Zs + (size_t)(rt * 16 + fr) * NZ + 5120 + k * 2048 + ct * 16 + 4 * fq);
                tot += acc * (f32x4){bflo(gw.x), bfhi(gw.x), bflo(gw.y), bfhi(gw.y)};
            }
        }
        if (kh == 1) red[tw * 64 + lane] = tot;
        __syncthreads();
        if (kh == 0) {
            tot += red[tw * 64 + lane];
            const size_t off = (size_t)(rt * 16 + fr) * D + ct * 16 + 4 * fq;
            if (MODE == 0) { const f32x4 xv = *(const f32x4*)(res + off); *(f32x4*)(Ys + off) = xv * alpha + tot * scale; }
            else { u32x2 w; w.x = cvt_pk_bf16(tot[0], tot[1]); w.y = cvt_pk_bf16(tot[2], tot[3]); *(u32x2*)(MBs + off) = w; }
        }
        __syncthreads();
    }
}

#define WGU1 ((bf16_t*)(P.ws + WS_WGU1))
#define WD1 ((bf16_t*)(P.ws + WS_WD1))
#define WIN ((bf16_t*)(P.ws + WS_WIN))
#define WKV ((bf16_t*)(P.ws + WS_WKV))
#define WBR ((bf16_t*)(P.ws + WS_WBR))
#define WOUT ((bf16_t*)(P.ws + WS_WOUT))
#define WGU2 ((bf16_t*)(P.ws + WS_WGU2))
#define WD2 ((bf16_t*)(P.ws + WS_WD2))
#define WLRU ((bf16_t*)(P.ws + WS_WLRU))
#define WSP ((bf16_t*)(P.ws + WS_WSP))
#define XB ((bf16_t*)(P.ws + WS_XB))
#define Z ((bf16_t*)(P.ws + WS_ZH))
#define H ((bf16_t*)(P.ws + WS_ZH))
#define Y ((float*)(P.ws + WS_Y))
#define X1 ((float*)(P.ws + WS_X1))
#define VP ((bf16_t*)(P.ws + WS_VP))
#define HL ((float*)(P.ws + WS_HL))
#define AC ((float*)(P.ws + WS_AC))
#define SUM ((float*)(P.ws + WS_SUM))
#define YS ((bf16_t*)(P.ws + WS_YS))
#define MEMLN ((bf16_t*)(P.ws + WS_MEMLN))
#define KB ((bf16_t*)(P.ws + WS_KB))
#define VT ((bf16_t*)(P.ws + WS_VT))
__device__ __forceinline__ void p5d_sample_attn(const Params& P, LAS unsigned char* lds, int bid, int G, int tid_in) {
    int tid = tid_in; asm volatile("" : "+v"(tid));
    const int lane = tid & 63, wave = __builtin_amdgcn_readfirstlane(tid >> 6);

        LAS float* sS = (LAS float*)(lds + 131072);
        LAS float* sO = (LAS float*)(lds + 131072 + 1024);
        const int vb = (G % 8 == 0) ? (bid & 7) * (G >> 3) + (bid >> 3) : bid;
        for (int it = vb; it < 512; it += G) {
            const int b = it >> 2, h = it & 3;
            const u32x2 qw = *(const u32x2*)(Z + (size_t)(MP + b) * NZ + 4096 + h * HD + 4 * lane);
            const f32x4 q = (f32x4){bflo(qw.x), bfhi(qw.x), bflo(qw.y), bfhi(qw.y)};
            const float* kbase = P.in[I_CK] + ((size_t)(b * NMEM + 32 * wave) * NH + h) * HD + 4 * lane;
            const float* vbase = P.in[I_CV] + ((size_t)(b * NMEM + 32 * wave) * NH + h) * HD + 4 * lane;
            float d[32];
#pragma unroll
            for (int mi = 0; mi < 32; ++mi) {
                const f32x4 kv = __builtin_nontemporal_load((const f32x4*)(kbase + (size_t)mi * (NH * HD)));
                d[mi] = (kv[0] * q[0] + kv[1] * q[1]) + (kv[2] * q[2] + kv[3] * q[3]);
                if (mi == 15) asm volatile("" ::: "memory");
            }
#pragma unroll
            for (int i = 0; i < 16; ++i) { const bool hi = (lane & 32) != 0; const float snd = hi ? d[i] : d[i + 16], kp = hi ? d[i + 16] : d[i]; d[i] = kp + __shfl_xor(snd, 32); }
#pragma unroll
            for (int i = 0; i < 8; ++i) { const bool hi = (lane & 16) != 0; const float snd = hi ? d[i] : d[i + 8], kp = hi ? d[i + 8] : d[i]; d[i] = kp + __shfl_xor(snd, 16); }
#pragma unroll
            for (int i = 0; i < 4; ++i) { const bool hi = (lane & 8) != 0; const float snd = hi ? d[i] : d[i + 4], kp = hi ? d[i + 4] : d[i]; d[i] = kp + __shfl_xor(snd, 8); }
#pragma unroll
            for (int i = 0; i < 2; ++i) { const bool hi = (lane & 4) != 0; const float snd = hi ? d[i] : d[i + 2], kp = hi ? d[i + 2] : d[i]; d[i] = kp + __shfl_xor(snd, 4); }
            { const bool hi = (lane & 2) != 0; const float snd = hi ? d[0] : d[1], kp = hi ? d[1] : d[0]; d[0] = kp + __shfl_xor(snd, 2); }
            d[0] += __shfl_xor(d[0], 1);
            if ((lane & 1) == 0) sS[32 * wave + (lane >> 1)] = d[0] * 0.0625f;
            f32x4 vv[16];
#pragma unroll
            for (int mi = 0; mi < 16; ++mi) vv[mi] = __builtin_nontemporal_load((const f32x4*)(vbase + (size_t)mi * (NH * HD)));
            __syncthreads();
            float mx = fmaxf(fmaxf(sS[lane], sS[lane + 64]), fmaxf(sS[lane + 128], sS[lane + 192]));
            mx = wave_max(mx);
            float sm = __expf(sS[lane] - mx) + __expf(sS[lane + 64] - mx) + __expf(sS[lane + 128] - mx) + __expf(sS[lane + 192] - mx);
            sm = wave_sum(sm);
            const float inv = 1.0f / sm;
            f32x4 o = (f32x4){0.f, 0.f, 0.f, 0.f};
            f32x4 vw[16];
#pragma unroll
            for (int mi = 0; mi < 16; ++mi) vw[mi] = __builtin_nontemporal_load((const f32x4*)(vbase + (size_t)(16 + mi) * (NH * HD)));
#pragma unroll
            for (int mi = 0; mi < 16; ++mi) { const float p = __expf(sS[32 * wave + mi] - mx) * inv; o += vv[mi] * p; }
#pragma unroll
            for (int mi = 0; mi < 16; ++mi) { const float p = __expf(sS[32 * wave + 16 + mi] - mx) * inv; o += vw[mi] * p; }
            *(LAS f32x4*)(sO + wave * 256 + 4 * lane) = o;
            __syncthreads();
            if (tid < 256) {
                float a = 0.f;
#pragma unroll
                for (int w = 0; w < 8; ++w) a += sO[w * 256 + tid];
                YS[(size_t)(MP + b) * 3072 + 2048 + h * HD + tid] = (bf16_t)(cvt_pk_bf16(a, 0.f) & 0xffffu);
            }
            __syncthreads();
        }
}

__global__ void __launch_bounds__(NTHREADS, 2) fwd_kernel(Params P) {
    extern __shared__ __attribute__((aligned(16))) unsigned char lds_raw[];
    LAS unsigned char* lds = (LAS unsigned char*)lds_raw;
    cg::grid_group grid = cg::this_grid();
    const int tid = threadIdx.x, lane = tid & 63, wave = __builtin_amdgcn_readfirstlane(tid >> 6);
    const int G = gridDim.x, bid = blockIdx.x;
    const int gw = bid * NWAVES + wave, NGW = G * NWAVES;
    float* out = P.out;
    volatile LAS unsigned* bst = (volatile LAS unsigned*)(lds + LDS_BYTES - 64);
    if (tid == 0) { bst[0] = 0u; bst[1] = 0u; }
    __syncthreads();
    const XcdBarrier gbar = xcd_barrier_post((unsigned*)(P.ws + WS_BAR), bst);
#define GRID_BAR() xcd_barrier(gbar)

    if (PHON(0)) {
        LAS float* scr = (LAS float*)(lds + wave * 16384);
        constexpr int IT_GU = (D / 64) * (NZ / 32), IT_DN = (FF / 64) * (D / 32), IT_SQ = (D / 64) * (D / 32), IT_BR = (BW / 64) * (D / 32), IT_LR = 2 * 4;
        constexpr int IT_TOTAL = 3 * IT_GU + 2 * IT_DN + 2 * IT_SQ + 3 * IT_BR + 16 * IT_LR;
        for (int it = gw; it < IT_TOTAL; it += NGW) {
            int r = it; const float* W; bf16_t* WT; int N, ldk, mode = 0;
            if (r < IT_GU) { W = P.in[I_WIN]; WT = WIN; N = NZ; ldk = D; }
            else if ((r -= IT_GU) < IT_SQ) { W = P.in[I_WKV]; WT = WKV; N = D; ldk = D; }
            else if ((r -= IT_SQ) < 3 * IT_BR) { const int k = r / IT_BR; r -= k * IT_BR; W = P.in[I_WBR] + (size_t)k * BW * D; WT = WBR + (size_t)k * D * BW; N = D; ldk = BW; }
            else if ((r -= 3 * IT_BR) < IT_SQ) { W = P.in[I_WOUT]; WT = WOUT; N = D; ldk = D; }
            else if ((r -= IT_SQ) < IT_GU) { W = P.in[I_GU2]; WT = WGU2; N = NZ; ldk = D; mode = 1; }
            else if ((r -= IT_GU) < IT_DN) { W = P.in[I_DN2]; WT = WD2; N = D; ldk = FF; }
            else if ((r -= IT_DN) < 16 * IT_LR) { const int m = r / IT_LR; r -= m * IT_LR; const int k = m >> 1, x = m & 1;
                W = (x ? P.in[I_LWX] : P.in[I_LWA]) + (size_t)k * 128 * 128; WT = WLRU + (size_t)k * 256 * 128 + x * 128 * 128; N = 128; ldk = 128; }
            else if ((r -= 16 * IT_LR) < IT_DN) { W = P.in[I_DN1]; WT = WD1; N = D; ldk = FF; }
            else { r -= IT_DN; W = P.in[I_GU1]; WT = WGU1; N = NZ; ldk = D; mode = 1; }
            const int nblk = N / 32, kb = r / nblk, nb = r % nblk, n0 = 32 * nb;
            int dr = n0;
            if (mode == 1) dr = (n0 < FF) ? (n0 / 128) * 256 + (n0 % 128) : ((n0 - FF) / 128) * 256 + 128 + ((n0 - FF) % 128);
            transpose_item(W, N, WT, ldk, 64 * kb, n0, dr, scr, lane);
        }
        for (int i = gw * 64 + lane; i < 4 * 128 * 128; i += NGW * 64) { const int t = (i >> 7) & 127, s = i & 127; const float w = P.in[I_WS][i]; WSP[i] = (bf16_t)(cvt_pk_bf16(s <= t ? w : 0.f, 0.f) & 0xffffu); }
        for (size_t i = (size_t)gw * 64 + lane; i < (size_t)MPAD * D / 8; i += (size_t)NGW * 64) {
            const size_t e = i * 8; const int r = (int)(e / D);
            u32x4 w = (u32x4){0u, 0u, 0u, 0u};
            if (r < MR) { const float* src = (r < MP) ? P.in[I_XP] + e : P.in[I_XS] + (e - (size_t)MP * D);
                const f32x4 a = __builtin_nontemporal_load((const f32x4*)src), b = __builtin_nontemporal_load((const f32x4*)(src + 4));
                w.x = cvt_pk_bf16(a[0], a[1]); w.y = cvt_pk_bf16(a[2], a[3]); w.z = cvt_pk_bf16(b[0], b[1]); w.w = cvt_pk_bf16(b[2], b[3]); }
            *(u32x4*)(XB + e) = w;
        }
        for (int r = gw; r < 1024; r += NGW) ln_row(P.in[I_MEM] + (size_t)r * D, P.in[I_MLNG], P.in[I_MLNB], nullptr, MEMLN + (size_t)r * D, lane);
    }
    if (P.ws == nullptr) grid.sync();
    GRID_BAR();

    if (PHON(1)) {
        pg8::PlainSched S{XB, WGU1, 33, 44, D, D, G, bid};
        pg8::EpiSwiglu E{H, FF};
        pg8::gemm_phase<pg8::PlainSched, pg8::EpiSwiglu, true, true>(lds, D, D, D, S, E);
    }
    GRID_BAR();
    if (PHON(2)) {
        skinny<0>(lds, bid, G, wave, lane, H + (size_t)MP * FF, FF, WD1, FF, FF, Y + (size_t)MP * D, P.in[I_XS], ALPHA, 0.5f, nullptr, nullptr);
        pg8::PlainSched S{H, WD1, 32, 8, FF, FF, G, bid};
        pg8::EpiResid E{Y, P.in[I_XP], ALPHA, 0.5f, true};
        pg8::gemm_phase<pg8::PlainSched, pg8::EpiResid, true, true>(lds, FF, FF, FF, S, E);
    }
    GRID_BAR();
    if (PHON(3)) for (int r = gw; r < MR; r += NGW) ln_row(Y + (size_t)r * D, P.in[I_LN1G], P.in[I_LN1B], X1 + (size_t)r * D, XB + (size_t)r * D, lane);
    GRID_BAR();

    if (PHON(4)) {
        LAS float* gbl = (LAS float*)(lds + 131072);
        for (int i = tid; i < 3 * D / 4; i += NTHREADS) *(LAS f32x4*)(gbl + 4 * i) = *(const f32x4*)(P.in[I_GATEB] + 4 * i);
        __syncthreads();
        pg8::WinSched S{XB, WIN, MEMLN, WKV, G, bid};
        pg8::EpiWin E{Z, gbl, out + O_MK, out + O_MV, KB, VT};
        pg8::gemm_phase<pg8::WinSched, pg8::EpiWin, true, true>(lds, D, D, D, S, E);
    }
    GRID_BAR();

    const bool dfirst_ = ((bid >> 5) & 1) != 0;
    if (dfirst_ && PHON(8)) p5d_sample_attn(P, lds, bid, G, tid);
    if (PHON(5)) for (int r = gw; r < MR; r += NGW) {
        const bf16_t* zr = Z + (size_t)r * NZ + 1024;
        float v[16]; float s = 0.f;
#pragma unroll
        for (int h = 0; h < 2; ++h) { const u32x4 w = *(const u32x4*)(zr + 8 * lane + 512 * h);
            v[8 * h + 0] = bflo(w.x); v[8 * h + 1] = bfhi(w.x); v[8 * h + 2] = bflo(w.y); v[8 * h + 3] = bfhi(w.y); v[8 * h + 4] = bflo(w.z); v[8 * h + 5] = bfhi(w.z); v[8 * h + 6] = bflo(w.w); v[8 * h + 7] = bfhi(w.w); }
#pragma unroll
        for (int j = 0; j < 16; ++j) s += v[j];
        const float mean = wave_sum(s) * (1.f / BW); float s2 = 0.f;
#pragma unroll
        for (int j = 0; j < 16; ++j) { v[j] -= mean; s2 += v[j] * v[j]; }
        const float rstd = 1.0f / sqrtf(wave_sum(s2) * (1.f / BW) + LN_EPS);
#pragma unroll
        for (int h = 0; h < 2; ++h) {
            const int c0 = 8 * lane + 512 * h; float o[8];
#pragma unroll
            for (int j = 0; j < 8; ++j) o[j] = v[8 * h + j] * rstd * P.in[I_GLNG][c0 + j] + P.in[I_GLNB][c0 + j];
            u32x4 w; w.x = cvt_pk_bf16(o[0], o[1]); w.y = cvt_pk_bf16(o[2], o[3]); w.z = cvt_pk_bf16(o[4], o[5]); w.w = cvt_pk_bf16(o[6], o[7]);
            *(u32x4*)(VP + (size_t)r * BW + c0) = w;
            if (r >= MP) { float* ov = out + O_VS + (size_t)(r - MP) * BW + c0; *(f32x4*)ov = (f32x4){o[0], o[1], o[2], o[3]}; *(f32x4*)(ov + 4) = (f32x4){o[4], o[5], o[6], o[7]}; }
        }
    }
    if (PHON(6)) {
        LAS bf16_t* XCB = (LAS bf16_t*)lds;
        LAS float* AARR = (LAS float*)lds;
        LAS float* XCF = (LAS float*)(lds + 65536);
        for (int it = bid; it < 65 * 8; it += G) {
            const int c = it >> 3, k = it & 7; const bool smp = (c == 64);
            const int r0 = c * 128, ch0 = k * 128;
            int lane_o = lane; asm volatile("" : "+v"(lane_o));
            const int fr = lane_o & 15, fq = lane_o >> 4, rh = wave >> 2, cq = wave & 3;
            bf16x8 wfr[4][4];
            {
                const bf16_t* wb = WLRU + (size_t)k * 256 * 128;
#pragma unroll
                for (int ct = 0; ct < 4; ++ct)
#pragma unroll
                    for (int ks = 0; ks < 4; ++ks) wfr[ct][ks] = *(const bf16x8*)(wb + (size_t)((ct >> 1) * 128 + 32 * cq + 16 * (ct & 1) + fr) * 128 + ks * 32 + fq * 8);
            }
            LAS float* prm = (LAS float*)(lds + 131072 + 4096);
            if (tid < 128) { prm[tid] = P.in[I_LBA][ch0 + tid]; prm[128 + tid] = P.in[I_LBX][ch0 + tid]; prm[256 + tid] = __logf(1.0f + __expf(-P.in[I_LAM][ch0 + tid])); }
            {
                const int c4 = (tid & 31) * 4, rg = tid >> 5;
                const int ch = ch0 + c4;
                const f32x4 w0 = *(const f32x4*)(P.in[I_CONVW] + 0 * BW + ch), w1 = *(const f32x4*)(P.in[I_CONVW] + 1 * BW + ch), w2 = *(const f32x4*)(P.in[I_CONVW] + 2 * BW + ch), w3 = *(const f32x4*)(P.in[I_CONVW] + 3 * BW + ch);
                const f32x4 cb = *(const f32x4*)(P.in[I_CONVB] + ch);
                if (!smp) {
                    const bool first = ((c & 15) == 0);
                    const int rs = rg * 8;
                    const bool hist = !(first && rs == 0);
                    u32x2 zr[11];
#pragma unroll
                    for (int i = 0; i < 11; ++i) { zr[i] = (u32x2){0u, 0u}; if (i >= 3 || hist) zr[i] = *(const u32x2*)(Z + (size_t)(r0 + rs - 3 + i) * NZ + 2048 + ch); }
#define ZF(i) ((f32x4){bflo(zr[i].x), bfhi(zr[i].x), bflo(zr[i].y), bfhi(zr[i].y)})
#pragma unroll
                    for (int i = 0; i < 8; ++i) {
                        const int row = rs + i;
                        const f32x4 x0 = ZF(i + 3);
                        const f32x4 xc = cb + w3 * x0 + w2 * ZF(i + 2) + w1 * ZF(i + 1) + w0 * ZF(i);
                        *(LAS f32x4*)(XCF + row * 128 + c4) = xc;
                        u32x2 w; w.x = cvt_pk_bf16(xc[0], xc[1]); w.y = cvt_pk_bf16(xc[2], xc[3]);
                        *(LAS u32x2*)(XCB + row * 136 + c4) = w;
                        if ((c & 15) == 15 && row >= 125) *(f32x4*)(out + O_CP + (size_t)((c >> 4) * 3 + (row - 125)) * BW + ch) = x0;
                    }
#undef ZF
                } else {
#pragma unroll 4
                    for (int i = 0; i < 8; ++i) {
                        const int row = rg * 8 + i;
                        const float* sc = P.in[I_SCONV] + (size_t)row * 3 * BW + ch;
                        const f32x4 b0 = *(const f32x4*)sc, b1 = *(const f32x4*)(sc + BW), b2 = *(const f32x4*)(sc + 2 * BW);
                        const u32x2 a = *(const u32x2*)(Z + (size_t)(MP + row) * NZ + 2048 + ch);
                        const f32x4 x0 = (f32x4){bflo(a.x), bfhi(a.x), bflo(a.y), bfhi(a.y)};
                        const f32x4 xc = cb + w3 * x0 + w2 * b2 + w1 * b1 + w0 * b0;
                        *(LAS f32x4*)(XCF + row * 128 + c4) = xc;
                        u32x2 w; w.x = cvt_pk_bf16(xc[0], xc[1]); w.y = cvt_pk_bf16(xc[2], xc[3]);
                        *(LAS u32x2*)(XCB + row * 136 + c4) = w;
                        float* oc = out + O_CS + (size_t)row * 3 * BW + ch;
                        *(f32x4*)oc = b1; *(f32x4*)(oc + BW) = b2; *(f32x4*)(oc + 2 * BW) = x0;
                    }
                }
            }
            __syncthreads();
            f32x4 ga[4][4];
#pragma unroll
            for (int rt = 0; rt < 4; ++rt)
#pragma unroll
                for (int ct = 0; ct < 4; ++ct) ga[rt][ct] = (f32x4){0.f, 0.f, 0.f, 0.f};
#pragma unroll
            for (int rt = 0; rt < 4; ++rt) {
                bf16x8 af[4];
#pragma unroll
                for (int ks = 0; ks < 4; ++ks) af[ks] = *(const LAS bf16x8*)(XCB + (64 * rh + 16 * rt + fr) * 136 + ks * 32 + fq * 8);
#pragma unroll
                for (int ct = 0; ct < 4; ++ct)
#pragma unroll
                    for (int ks = 0; ks < 4; ++ks) ga[rt][ct] = __builtin_amdgcn_mfma_f32_16x16x32_bf16(af[ks], wfr[ct][ks], ga[rt][ct], 0, 0, 0);
            }
            __syncthreads();
#pragma unroll
            for (int cl = 0; cl < 2; ++cl) {
                const int chl = 32 * cq + 16 * cl + fr, chg = ch0 + chl;
                const float ba = prm[chl], bx = prm[128 + chl], sp = prm[256 + chl];
#pragma unroll
                for (int rt = 0; rt < 4; ++rt)
#pragma unroll
                    for (int j = 0; j < 4; ++j) {
                        const int row = 64 * rh + 16 * rt + 4 * fq + j;
                        const float rr = sigmoidf_(ga[rt][cl][j] + ba), ii = sigmoidf_(ga[rt][2 + cl][j] + bx);
                        const float la = -8.0f * rr * sp;
                        const float a = __expf(la);
                        const float xc = XCF[row * 128 + chl];
                        const float bt = __builtin_amdgcn_sqrtf(fmaxf(1.0f - a * a, 0.f)) * (ii * xc);
                        if (smp) {
                            const float h = a * P.in[I_SLRU][(size_t)row * BW + chg] + bt;
                            out[O_HS + (size_t)row * BW + chg] = h;
                            const float rgv = bf2f(Z[(size_t)(MP + row) * NZ + 3072 + chg]);
                            YS[(size_t)(MP + row) * 3072 + 1024 + chg] = (bf16_t)(cvt_pk_bf16(rgv * h, 0.f) & 0xffffu);
                        } else {
                            AARR[row * 128 + chl] = a; XCF[row * 128 + chl] = bt;
                        }
                        if (j == 3) asm volatile("" ::: "memory");
                    }
            }
            __syncthreads();
            if (!smp) {
                {
                    LAS float* segA = (LAS float*)(lds + 131072); LAS float* segH = segA + 512;
                    const int seg = tid >> 7, chn = tid & 127;
                    float h = 0.f, pa = 1.f;
#pragma unroll 8
                    for (int i = 0; i < 32; ++i) { const int o = (32 * seg + i) * 128 + chn; const float a = AARR[o], b = XCF[o]; h = a * h + b; pa *= a; XCF[o] = h; AARR[o] = pa; }
                    segA[tid] = pa; segH[tid] = h;
                    __syncthreads();
                    float cA = 1.f, cH = 0.f;
                    for (int sg = 0; sg < seg; ++sg) { const float sa = segA[sg * 128 + chn]; cH = sa * cH + segH[sg * 128 + chn]; cA *= sa; }
                    if (seg > 0) {
#pragma unroll 8
                        for (int i = 0; i < 32; ++i) { const int o = (32 * seg + i) * 128 + chn; const float hl = XCF[o], pc = AARR[o]; XCF[o] = hl + pc * cH; AARR[o] = pc * cA; }
                    }
                    if (seg == 3) { SUM[(size_t)(c * 2 + 0) * BW + ch0 + chn] = pa * cA; SUM[(size_t)(c * 2 + 1) * BW + ch0 + chn] = h + pa * cH; }
                }
                __syncthreads();
#pragma unroll
                for (int i = 0; i < 8; ++i) { const int e = (i * 512 + tid) * 4, row = e >> 7, cc = e & 127;
                    *(f32x4*)(HL + (size_t)(r0 + row) * BW + ch0 + cc) = *(const LAS f32x4*)(XCF + e);
                    *(f32x4*)(AC + (size_t)(r0 + row) * BW + ch0 + cc) = *(const LAS f32x4*)(AARR + e); }
            }
            __syncthreads();
        }
    }
    if (PHON(7)) for (int it = bid; it < 256; it += G) {
        const int b = it >> 6, h = (it >> 4) & 3, qt = it & 15;
        int lane_o = lane; asm volatile("" : "+v"(lane_o));
        const int fr = lane_o & 15, fq = lane_o >> 4;
        const int row0 = b * SEQ + qt * 128 + wave * 16;
        bf16x8 qf[8];
#pragma unroll
        for (int ks = 0; ks < 8; ++ks) qf[ks] = *(const bf16x8*)(Z + (size_t)(row0 + fr) * NZ + 4096 + h * HD + ks * 32 + fq * 8);
        f32x4 s[16];
        LAS bf16_t* KL = (LAS bf16_t*)lds;
        __syncthreads();
        {
            const bf16_t* kb = KB + (size_t)(b * NMEM) * 1024 + h * HD;
            u32x4 t[16];
#pragma unroll
            for (int i = 0; i < 16; ++i) { const int e = tid + i * NTHREADS, m = e >> 5, c8 = (e & 31) * 8; t[i] = *(const u32x4*)(kb + (size_t)m * 1024 + c8); }
#pragma unroll
            for (int i = 0; i < 16; ++i) { const int e = tid + i * NTHREADS, m = e >> 5, c8 = (e & 31) * 8; *(LAS u32x4*)(KL + m * 264 + c8) = t[i]; }
        }
        asm volatile("" ::: "memory");
        u32x4 tv[16];
        {
            const bf16_t* vt0 = VT + (size_t)(h * HD) * 1024 + b * NMEM;
#pragma unroll
            for (int i = 0; i < 16; ++i) { const int e = tid + i * NTHREADS, dd = e >> 5, c8 = (e & 31) * 8; tv[i] = *(const u32x4*)(vt0 + (size_t)dd * 1024 + c8); }
        }
        __syncthreads();
#pragma unroll
        for (int mt = 0; mt < 16; ++mt) {
            s[mt] = (f32x4){0.f, 0.f, 0.f, 0.f};
#pragma unroll
            for (int ks = 0; ks < 8; ++ks) {
                const bf16x8 kf = *(const LAS bf16x8*)(KL + (mt * 16 + fr) * 264 + ks * 32 + fq * 8);
                s[mt] = __builtin_amdgcn_mfma_f32_16x16x32_bf16(kf, qf[ks], s[mt], 0, 0, 0);
            }
        }
        __syncthreads();
#pragma unroll
        for (int i = 0; i < 16; ++i) { const int e = tid + i * NTHREADS, dd = e >> 5, c8 = (e & 31) * 8; *(LAS u32x4*)(KL + dd * 264 + c8) = tv[i]; }
        float mx = -3.0e38f;
#pragma unroll
        for (int mt = 0; mt < 16; ++mt) mx = fmaxf(mx, fmaxf(fmaxf(s[mt][0], s[mt][1]), fmaxf(s[mt][2], s[mt][3])));
        mx = fmaxf(mx, __shfl_xor(mx, 16)); mx = fmaxf(mx, __shfl_xor(mx, 32));
        float sm = 0.f;
#pragma unroll
        for (int mt = 0; mt < 16; ++mt)
#pragma unroll
            for (int j = 0; j < 4; ++j) { const float p = __expf((s[mt][j] - mx) * 0.0625f); s[mt][j] = p; sm += p; }
        sm += __shfl_xor(sm, 16); sm += __shfl_xor(sm, 32);
        const float inv = 1.0f / sm;
        bf16x8 pf[8];
#pragma unroll
        for (int ks = 0; ks < 8; ++ks) {
            u32x4 w; w.x = cvt_pk_bf16(s[2 * ks][0], s[2 * ks][1]); w.y = cvt_pk_bf16(s[2 * ks][2], s[2 * ks][3]); w.z = cvt_pk_bf16(s[2 * ks + 1][0], s[2 * ks + 1][1]); w.w = cvt_pk_bf16(s[2 * ks + 1][2], s[2 * ks + 1][3]);
            pf[ks] = __builtin_bit_cast(bf16x8, w);
        }
        __syncthreads();
#pragma unroll 4
        for (int dt = 0; dt < 16; ++dt) {
            f32x4 o = (f32x4){0.f, 0.f, 0.f, 0.f};
#pragma unroll
            for (int ks = 0; ks < 8; ++ks) {
                const LAS bf16_t* vp = KL + (dt * 16 + fr) * 264 + ks * 32 + 4 * fq;
                const u32x2 lo = *(const LAS u32x2*)vp, hi = *(const LAS u32x2*)(vp + 16);
                const u32x4 w = (u32x4){lo.x, lo.y, hi.x, hi.y};
                o = __builtin_amdgcn_mfma_f32_16x16x32_bf16(__builtin_bit_cast(bf16x8, w), pf[ks], o, 0, 0, 0);
            }
            u32x2 w; w.x = cvt_pk_bf16(o[0] * inv, o[1] * inv); w.y = cvt_pk_bf16(o[2] * inv, o[3] * inv);
            *(u32x2*)(YS + (size_t)(row0 + fr) * 3072 + 2048 + h * HD + dt * 16 + 4 * fq) = w;
        }
    }
    if (!dfirst_ && PHON(8)) p5d_sample_attn(P, lds, bid, G, tid);
    GRID_BAR();

    if (PHON(9)) for (int it = bid; it < 256; it += G) {
        const int c = it >> 2, rq = it & 3, n = c & 15, cb = c & ~15;
        const int ch = 2 * tid;
        f32x2 carry = (f32x2){0.f, 0.f};
        {
            f32x2 pa[15], hh[15];
#pragma unroll
            for (int j = 0; j < 15; ++j) { pa[j] = (f32x2){1.f, 1.f}; hh[j] = (f32x2){0.f, 0.f};
                if (j < n) { pa[j] = *(const f32x2*)(SUM + (size_t)((cb + j) * 2 + 0) * BW + ch); hh[j] = *(const f32x2*)(SUM + (size_t)((cb + j) * 2 + 1) * BW + ch); } }
#pragma unroll
            for (int j = 0; j < 15; ++j) carry = pa[j] * carry + hh[j];
        }
#pragma unroll 8
        for (int i = 0; i < 32; ++i) {
            const int r = c * 128 + rq * 32 + i;
            const f32x2 hl = __builtin_nontemporal_load((const f32x2*)(HL + (size_t)r * BW + ch)), ac = __builtin_nontemporal_load((const f32x2*)(AC + (size_t)r * BW + ch));
            const f32x2 hv = hl + ac * carry;
            const unsigned rw = *(const unsigned*)(Z + (size_t)r * NZ + 3072 + ch);
            *(unsigned*)(YS + (size_t)r * 3072 + 1024 + ch) = cvt_pk_bf16(bflo(rw) * hv[0], bfhi(rw) * hv[1]);
            if (n == 15 && rq == 3 && i == 31) *(f32x2*)(out + O_HP + (size_t)(c >> 4) * BW + ch) = hv;
        }
    }
    if (PHON(10)) {
        LAS bf16_t* VL = (LAS bf16_t*)lds;
        for (int e = bid * NTHREADS + tid; e < MS * BW / 2; e += G * NTHREADS) {
            const int r = e / (BW / 2), c2 = (e % (BW / 2)) * 2, g = c2 >> 8;
            const float w00 = P.in[I_WS][(size_t)g * 128 * 128], b0 = P.in[I_BS][g * 128];
            const unsigned vw = *(const unsigned*)(VP + (size_t)(MP + r) * BW + c2), uw = *(const unsigned*)(Z + (size_t)(MP + r) * NZ + c2);
            *(unsigned*)(YS + (size_t)(MP + r) * 3072 + c2) = cvt_pk_bf16(bflo(uw) * (w00 * bflo(vw) + b0), bfhi(uw) * (w00 * bfhi(vw) + b0));
        }
        for (int it = bid; it < 256; it += G) {
            const int g = it & 3, cn = it >> 2;
            const int r0 = cn * 128;
            __syncthreads();
            {
                u32x4 vt8[8];
#pragma unroll
                for (int i = 0; i < 8; ++i) { const int e = tid + i * NTHREADS, s = e >> 5, c8 = (e & 31) * 8; vt8[i] = *(const u32x4*)(VP + (size_t)(r0 + s) * BW + g * 256 + c8); }
#pragma unroll
                for (int i = 0; i < 8; ++i) { const int e = tid + i * NTHREADS, s = e >> 5, c8 = (e & 31) * 8; *(LAS u32x4*)(VL + s * 264 + c8) = vt8[i]; }
            }
            __syncthreads();
            const int fr = lane & 15, fq = lane >> 4;
            bf16x8 vf[2][4];
#pragma unroll
            for (int ct = 0; ct < 2; ++ct)
#pragma unroll
                for (int ks = 0; ks < 4; ++ks) {
                    bf16x8 t;
#pragma unroll
                    for (int j = 0; j < 8; ++j) t[j] = (short)VL[(ks * 32 + fq * 8 + j) * 264 + (2 * wave + ct) * 16 + fr];
                    vf[ct][ks] = t;
                }
            const bf16_t* wsp = WSP + (size_t)g * 128 * 128;
            u32x2 uwp[8][2];
#pragma unroll
            for (int tt = 0; tt < 8; ++tt)
#pragma unroll
                for (int ct = 0; ct < 2; ++ct) uwp[tt][ct] = *(const u32x2*)(Z + (size_t)(r0 + tt * 16 + fr) * NZ + g * 256 + (2 * wave + ct) * 16 + 4 * fq);
#pragma unroll
            for (int tt = 0; tt < 8; ++tt) {
                f32x4 o0 = (f32x4){0.f, 0.f, 0.f, 0.f}, o1 = o0;
#pragma unroll
                for (int ks = 0; ks < 4; ++ks) {
                    const bf16x8 wf = *(const bf16x8*)(wsp + (size_t)(tt * 16 + fr) * 128 + ks * 32 + fq * 8);
                    o0 = __builtin_amdgcn_mfma_f32_16x16x32_bf16(vf[0][ks], wf, o0, 0, 0, 0);
                    o1 = __builtin_amdgcn_mfma_f32_16x16x32_bf16(vf[1][ks], wf, o1, 0, 0, 0);
                }
                if ((tt & 3) == 3) asm volatile("" ::: "memory");
                const int t = tt * 16 + fr; const float bs = P.in[I_BS][g * 128 + t];
                const size_t r = (size_t)(r0 + t);
#pragma unroll
                for (int ct = 0; ct < 2; ++ct) {
                    const f32x4 o = ct ? o1 : o0;
                    const int cc = g * 256 + (2 * wave + ct) * 16 + 4 * fq;
                    const u32x2 uw = uwp[tt][ct];
                    u32x2 w; w.x = cvt_pk_bf16(bflo(uw.x) * (o[0] + bs), bfhi(uw.x) * (o[1] + bs)); w.y = cvt_pk_bf16(bflo(uw.y) * (o[2] + bs), bfhi(uw.y) * (o[3] + bs));
                    *(u32x2*)(YS + r * 3072 + cc) = w;
                }
            }
        }
        __syncthreads();
    }
    GRID_BAR();

    if (PHON(11)) {
        skinny<1>(lds, bid, G, wave, lane, YS + (size_t)MP * 3 * BW, 3 * BW, WBR, BW, BW, nullptr, nullptr, 0.f, 0.f, Z + (size_t)MP * NZ, XB + (size_t)MP * D);
        pg8::BranchSched S{YS, WBR, G, bid};
        pg8::EpiMerge E{Z, Y, XB};
        pg8::gemm_phase<pg8::BranchSched, pg8::EpiMerge, true, true>(lds, BW, 3 * BW, BW, S, E);
    }
    GRID_BAR();
    if (PHON(12)) {
        skinny<0>(lds, bid, G, wave, lane, XB + (size_t)MP * D, D, WOUT, D, D, Y + (size_t)MP * D, X1 + (size_t)MP * D, ALPHA, 1.0f, nullptr, nullptr);
        pg8::PlainSched S{XB, WOUT, 32, 8, D, D, G, bid};
        pg8::EpiResid E{Y, X1, ALPHA, 1.0f, false};
        pg8::gemm_phase<pg8::PlainSched, pg8::EpiResid, true, true>(lds, D, D, D, S, E);
    }
    GRID_BAR();
    if (PHON(13)) for (int r = gw; r < MR; r += NGW) ln_row(Y + (size_t)r * D, P.in[I_LN2G], P.in[I_LN2B], X1 + (size_t)r * D, XB + (size_t)r * D, lane);
    GRID_BAR();
    if (PHON(14)) {
        pg8::PlainSched S{XB, WGU2, 33, 44, D, D, G, bid};
        pg8::EpiSwiglu E{H, FF};
        pg8::gemm_phase<pg8::PlainSched, pg8::EpiSwiglu, true, true>(lds, D, D, D, S, E);
    }
    GRID_BAR();
    if (PHON(15)) {
        skinny<0>(lds, bid, G, wave, lane, H + (size_t)MP * FF, FF, WD2, FF, FF, Y + (size_t)MP * D, X1 + (size_t)MP * D, ALPHA, 0.5f, nullptr, nullptr);
        pg8::PlainSched S{H, WD2, 32, 8, FF, FF, G, bid};
        pg8::EpiResid E{Y, X1, ALPHA, 0.5f, false};
        pg8::gemm_phase<pg8::PlainSched, pg8::EpiResid, true, true>(lds, FF, FF, FF, S, E);
    }
    GRID_BAR();
    if (PHON(16)) for (int r = gw; r < MR; r += NGW) ln_row(Y + (size_t)r * D, P.in[I_LN3G], P.in[I_LN3B], out + O_Y + (size_t)r * D, nullptr, lane);
}

extern "C" void kernel_launch(void* const* d_in, const int* in_sizes, int n_in, void* d_out, int out_size, void* d_ws, size_t ws_size, hipStream_t stream) {
    static int grid = 0;
    if (grid == 0) {
        if (n_in != 35 || (size_t)out_size != O_END || ws_size < WS_END) { fprintf(stderr, "kernel_launch: unexpected shapes: n_in %d out %d (want %zu) ws %zu (need %zu)\n", n_in, out_size, (size_t)O_END, ws_size, (size_t)WS_END); grid = -1; return; }
        int dev = 0, cus = 0, per_cu = 0;
        hipGetDevice(&dev);
        hipDeviceGetAttribute(&cus, hipDeviceAttributeMultiprocessorCount, dev);
        hipFuncSetAttribute((const void*)fwd_kernel, hipFuncAttributeMaxDynamicSharedMemorySize, LDS_BYTES);
        hipOccupancyMaxActiveBlocksPerMultiprocessor(&per_cu, (const void*)fwd_kernel, NTHREADS, LDS_BYTES);
        if (per_cu < 1) { fprintf(stderr, "kernel_launch: occupancy query says %d blocks/CU\n", per_cu); per_cu = 1; }
        (void)hipGetLastError();
        grid = cus;
    }
    if (grid < 0) return;
    Params p{};
    for (int i = 0; i < 35; ++i) p.in[i] = (const float*)d_in[i];
    p.out = (float*)d_out; p.ws = (unsigned char*)d_ws;
    (void)hipMemsetAsync((char*)d_ws + WS_BAR, 0, (size_t)XCD_BAR_WORDS_ * 4, stream);
    void* args[] = {&p};
    hipError_t e = hipLaunchCooperativeKernel((const void*)fwd_kernel, dim3(grid), dim3(NTHREADS), args, LDS_BYTES, stream);
    if (e != hipSuccess) fprintf(stderr, "cooperative launch failed: %s (grid %d)\n", hipGetErrorString(e), grid);
}
```

```cpp
#include <hip/hip_runtime.h>
#include <hip/hip_cooperative_groups.h>
#include <cstdio>
#include <cstdint>
namespace cg = cooperative_groups;

#define LAS __attribute__((address_space(3)))
typedef unsigned short bf16_t;
typedef short bf16x8 __attribute__((ext_vector_type(8)));
typedef short bf16x4 __attribute__((ext_vector_type(4)));
typedef float f32x4 __attribute__((ext_vector_type(4)));
typedef float f32x2 __attribute__((ext_vector_type(2)));
typedef unsigned u32x4 __attribute__((ext_vector_type(4)));
typedef unsigned u32x2 __attribute__((ext_vector_type(2)));

constexpr int D = 2048, FF = 5632, BW = 1024, NZ = 11264;
constexpr int MP = 8192, MS = 128, MR = MP + MS, MPAD = 8448;
constexpr int SEQ = 2048, NB = 4, NMEM = 256, NH = 4, HD = 256;
constexpr float LN_EPS = 1e-5f;
constexpr float ALPHA = 1.189207115002721f;
constexpr int NTHREADS = 512, NWAVES = 8;

constexpr int XCD_BAR_WORDS_ = 3456;
constexpr size_t al256(size_t x) { return (x + 255) & ~(size_t)255; }
constexpr size_t WS_WGU1 = 0;
constexpr size_t WS_WD1 = WS_WGU1 + al256((size_t)NZ * D * 2);
constexpr size_t WS_WIN = WS_WD1 + al256((size_t)D * FF * 2);
constexpr size_t WS_WKV = WS_WIN + al256((size_t)NZ * D * 2);
constexpr size_t WS_WBR = WS_WKV + al256((size_t)D * D * 2);
constexpr size_t WS_WOUT = WS_WBR + al256((size_t)3 * D * BW * 2);
constexpr size_t WS_WGU2 = WS_WOUT + al256((size_t)D * D * 2);
constexpr size_t WS_WD2 = WS_WGU2 + al256((size_t)NZ * D * 2);
constexpr size_t WS_WLRU = WS_WD2 + al256((size_t)D * FF * 2);
constexpr size_t WS_WSP = WS_WLRU + al256((size_t)8 * 256 * 128 * 2);
constexpr size_t WS_XB = WS_WSP + al256((size_t)4 * 128 * 128 * 2);
constexpr size_t WS_ZH = WS_XB + al256((size_t)MPAD * D * 2);
constexpr size_t WS_Y = WS_ZH + al256((size_t)MPAD * NZ * 2);
constexpr size_t WS_X1 = WS_Y + al256((size_t)MPAD * D * 4);
constexpr size_t WS_VP = WS_X1 + al256((size_t)MPAD * D * 4);
constexpr size_t WS_HL = WS_VP + al256((size_t)MPAD * BW * 2);
constexpr size_t WS_AC = WS_HL + al256((size_t)MP * BW * 4);
constexpr size_t WS_SUM = WS_AC + al256((size_t)MP * BW * 4);
constexpr size_t WS_YS = WS_SUM + al256((size_t)64 * 2 * BW * 4);
constexpr size_t WS_MEMLN = WS_YS + al256((size_t)MPAD * 3 * BW * 2);
constexpr size_t WS_KB = WS_MEMLN + al256((size_t)1024 * D * 2);
constexpr size_t WS_VT = WS_KB + al256((size_t)1024 * 1024 * 2);
constexpr size_t WS_BAR = WS_VT + al256((size_t)1024 * 1024 * 2);
constexpr size_t WS_END = WS_BAR + al256((size_t)XCD_BAR_WORDS_ * 4);

constexpr size_t O_Y = 0;
constexpr size_t O_MK = (size_t)MR * D;
constexpr size_t O_MV = O_MK + (size_t)1024 * 1024;
constexpr size_t O_CP = O_MV + (size_t)1024 * 1024;
constexpr size_t O_HP = O_CP + (size_t)4 * 3 * 1024;
constexpr size_t O_CS = O_HP + (size_t)4 * 1024;
constexpr size_t O_HS = O_CS + (size_t)128 * 3 * 1024;
constexpr size_t O_VS = O_HS + (size_t)128 * 1024;
constexpr size_t O_END = O_VS + (size_t)128 * 1024;

constexpr int LDS_BYTES = 159744;

struct Params { const float* in[35]; float* out; unsigned char* ws; };
enum { I_XP = 0, I_XS, I_MEM, I_CK, I_CV, I_SCONV, I_SLRU, I_GU1, I_DN1, I_LN1G, I_LN1B, I_WIN, I_GATEB, I_GLNG, I_GLNB, I_WS, I_BS, I_CONVW, I_CONVB,
       I_LWA, I_LBA, I_LWX, I_LBX, I_LAM, I_MLNG, I_MLNB, I_WKV, I_WBR, I_WOUT, I_LN2G, I_LN2B, I_GU2, I_DN2, I_LN3G, I_LN3B };

__device__ __forceinline__ unsigned cvt_pk_bf16(float lo, float hi) { unsigned r; asm volatile("v_cvt_pk_bf16_f32 %0, %1, %2" : "=v"(r) : "v"(lo), "v"(hi)); return r; }
__device__ __forceinline__ float bf2f(unsigned short b) { return __uint_as_float(((unsigned)b) << 16); }
__device__ __forceinline__ float bflo(unsigned w) { return __uint_as_float(w << 16); }
__device__ __forceinline__ float bfhi(unsigned w) { return __uint_as_float(w & 0xffff0000u); }
__device__ __forceinline__ float sigmoidf_(float x) { return __builtin_amdgcn_rcpf(1.0f + __expf(-x)); }
__device__ __forceinline__ float siluf_(float x) { return x * sigmoidf_(x); }
__device__ __forceinline__ float gelu_tanh(float x) { return x * sigmoidf_(1.5957691216057308f * (x + 0.044715f * x * x * x)); }
__device__ __forceinline__ float wave_sum(float v) {
#pragma unroll
    for (int o = 1; o < 64; o <<= 1) v += __shfl_xor(v, o);
    return v;
}
__device__ __forceinline__ float wave_max(float v) {
#pragma unroll
    for (int o = 1; o < 64; o <<= 1) v = fmaxf(v, __shfl_xor(v, o));
    return v;
}

namespace pg8 {
constexpr int BM = 256, BK = 64, HALF = 128, HTB = HALF * BK * 2, STAGE_BYTES = 8 * HTB, NXCD = 8, WGM = 8;
__host__ __device__ __forceinline__ int lds_byte(int r, int c) { const int st = (r >> 4) * 2 + (c >> 5), rr = r & 15, cc = c & 31, ob = rr * 64 + cc * 2; return st * 1024 + (ob ^ (((ob >> 9) & 1) << 5)); }
__host__ __device__ __forceinline__ void stage_rc(int b, int& R, int& C) { const int st = b / 1024, sb = b % 1024, swz = sb ^ (((sb >> 9) & 1) << 5); R = (st >> 1) * 16 + swz / 64; C = (st & 1) * 32 + (swz % 64) / 2; }
__host__ __device__ __forceinline__ int perm32(int rho) { const int n = rho >> 4, i = rho & 15; return 8 * (i >> 2) + 4 * n + (i & 3); }

struct Unit { const char* A; const char* B; int pm, pn, kind; };

__device__ __forceinline__ void tile_of(int wgid, int nM, int nN, int& pm, int& pn) {
    const int nwg = nM * nN;
    { const int q = nwg / NXCD, r = nwg % NXCD, xcd = wgid % NXCD, off = wgid / NXCD; wgid = (xcd < r ? xcd * (q + 1) : r * (q + 1) + (xcd - r) * q) + off; }
    const int nig = WGM * nN, gid = wgid / nig, fm = gid * WGM, gsz = (nM - fm) < WGM ? (nM - fm) : WGM;
    pm = fm + ((wgid % nig) % gsz); pn = (wgid % nig) / gsz;
}
struct PlainSched {
    const bf16_t* A; const bf16_t* Bt; int nM, nN, lda, ldb, G, c;
    __device__ __forceinline__ bool next(int i, Unit& u) const {
        const int L = i * G + c; if (L >= nM * nN) return false;
        tile_of(L, nM, nN, u.pm, u.pn); u.kind = 0;
        u.A = (const char*)(A + (size_t)u.pm * BM * lda); u.B = (const char*)(Bt + (size_t)u.pn * BM * ldb); return true;
    }
};
struct WinSched {
    const bf16_t* XB_; const bf16_t* WIN_; const bf16_t* MEMLN_; const bf16_t* WKV_; int G, c;
    __device__ __forceinline__ bool next(int i, Unit& u) const {
        const int L = i * G + c; constexpr int NZU = 33 * 44;
        if (L < NZU) { tile_of(L, 33, 44, u.pm, u.pn); u.kind = 0; u.A = (const char*)(XB_ + (size_t)u.pm * BM * D); u.B = (const char*)(WIN_ + (size_t)u.pn * BM * D); return true; }
        if (L < NZU + 32) { const int j = L - NZU; u.pm = j >> 3; u.pn = j & 7; u.kind = 1; u.A = (const char*)(MEMLN_ + (size_t)u.pm * BM * D); u.B = (const char*)(WKV_ + (size_t)u.pn * BM * D); return true; }
        if (L < NZU + 48) { const int j = L - NZU - 32; u.pm = j >> 2; u.pn = j & 3; u.kind = 2; u.A = (const char*)(WKV_ + (size_t)(1024 + u.pm * BM) * D); u.B = (const char*)(MEMLN_ + (size_t)u.pn * BM * D); return true; }
        return false;
    }
};
struct BranchSched {
    const bf16_t* YS_; const bf16_t* WBR_; int G, c;
    __device__ __forceinline__ bool next(int i, Unit& u) const {
        const int t = (i / 3) * G + c, k = i % 3; if (t >= 256) return false;
        tile_of(t, 32, 8, u.pm, u.pn); u.kind = k;
        u.A = (const char*)(YS_ + (size_t)u.pm * BM * (3 * BW) + k * BW); u.B = (const char*)(WBR_ + (size_t)k * D * BW + (size_t)u.pn * BM * BW); return true;
    }
};

template <class Sched, class Epi, bool ALIGN_EPI, bool SP2>
__device__ __forceinline__ void gemm_phase(LAS unsigned char* lds, const int K, const int lda, const int ldb, const Sched& S, const Epi& E) {
    int tid = threadIdx.x; asm volatile("" : "+v"(tid));
    const int wid = __builtin_amdgcn_readfirstlane(tid >> 6), lane = tid & 63, wr = wid >> 2, wc = wid & 3, fr = lane & 15, fq = lane >> 4;
    const int nt = K / BK;
    unsigned voffA[2], voffB[2];
#pragma unroll
    for (int i = 0; i < 2; ++i) { int R, C; stage_rc(tid * 16 + i * 8192, R, C); const int Rb = Epi::PERM ? ((R & ~31) + perm32(R & 31)) : R;
        voffA[i] = (unsigned)(R * lda + C) * 2u; voffB[i] = (unsigned)(Rb * ldb + C) * 2u; }
    const size_t kstep = (size_t)(BK * 2);
    const size_t hstepA = (size_t)HALF * lda * 2, hstepB = (size_t)HALF * ldb * 2;
    const unsigned ldsw = (unsigned)wid * 1024u;
    const int aoff = lds_byte(wr * 64 + fr, fq * 8), boff = lds_byte(wc * 32 + fr, fq * 8);
#define PG8_SA(b, h) (((b) * 2 + (h)) * HTB)
#define PG8_SB(b, h) ((4 + (b) * 2 + (h)) * HTB)
#define PG8_STAGE(bufoff, gbase, voff) do { _Pragma("unroll") for (int _i = 0; _i < 2; ++_i) \
        __builtin_amdgcn_global_load_lds((const unsigned*)((const char*)(gbase) + (voff)[_i]), (LAS unsigned*)(lds + (bufoff) + ldsw + _i * 8192), 16, 0, 0); } while (0)
#define PG8_LDA(dst, b, h) do { _Pragma("unroll") for (int m = 0; m < 4; ++m) _Pragma("unroll") for (int k = 0; k < 2; ++k) dst[m][k] = *(const LAS bf16x8*)(lds + PG8_SA(b, h) + aoff + m * 2048 + k * 1024); } while (0)
#define PG8_LDB(dst, b, h) do { _Pragma("unroll") for (int n = 0; n < 2; ++n) _Pragma("unroll") for (int k = 0; k < 2; ++k) dst[n][k] = *(const LAS bf16x8*)(lds + PG8_SB(b, h) + boff + n * 2048 + k * 1024); } while (0)
#define PG8_MMA(ai, bj, At, Bt) do { __builtin_amdgcn_s_setprio(1); _Pragma("unroll") for (int m = 0; m < 4; ++m) _Pragma("unroll") for (int n = 0; n < 2; ++n) _Pragma("unroll") for (int k = 0; k < 2; ++k) \
        acc[ai][bj][m][n] = __builtin_amdgcn_mfma_f32_16x16x32_bf16(Bt[n][k], At[m][k], acc[ai][bj][m][n], 0, 0, 0); __builtin_amdgcn_s_setprio(0); } while (0)
#define PG8_WAIT_V(n) asm volatile("s_waitcnt vmcnt(" #n ")" ::: "memory")
#define PG8_WAIT_L(n) asm volatile("s_waitcnt lgkmcnt(" #n ")" ::: "memory")
#define PG8_BAR __builtin_amdgcn_s_barrier()
#define PG8_SCHED __builtin_amdgcn_sched_barrier(0)
    Unit cur, nxt; int ui = 0;
    if (!S.next(0, cur)) return;
    f32x4 acc[2][2][4][2];
#pragma unroll
    for (int a = 0; a < 2; ++a)
#pragma unroll
        for (int b = 0; b < 2; ++b)
#pragma unroll
            for (int m = 0; m < 4; ++m)
#pragma unroll
                for (int n = 0; n < 2; ++n) acc[a][b][m][n] = (f32x4){0.f, 0.f, 0.f, 0.f};
    bf16x8 At[4][2], B0[2][2], B1[2][2];
    const char* cA = cur.A; const char* cB = cur.B;
    if constexpr (SP2) {
        PG8_STAGE(PG8_SB(0, 0), cB, voffB); PG8_STAGE(PG8_SB(0, 1), cB + hstepB, voffB); PG8_STAGE(PG8_SA(0, 0), cA, voffA); PG8_STAGE(PG8_SA(0, 1), cA + hstepA, voffA);
        if (wr == 1) PG8_BAR;
        PG8_WAIT_V(2); PG8_BAR;
        PG8_STAGE(PG8_SB(1, 0), cB + kstep, voffB); PG8_STAGE(PG8_SA(1, 0), cA + kstep, voffA); PG8_STAGE(PG8_SB(1, 1), cB + hstepB + kstep, voffB);
        PG8_WAIT_V(6); PG8_BAR;
    } else {
        PG8_STAGE(PG8_SB(0, 0), cB, voffB); PG8_STAGE(PG8_SA(0, 0), cA, voffA); PG8_STAGE(PG8_SB(0, 1), cB + hstepB, voffB); PG8_STAGE(PG8_SA(0, 1), cA + hstepA, voffA);
        if (wr == 1) PG8_BAR;
        PG8_WAIT_V(4); PG8_BAR;
        PG8_STAGE(PG8_SB(1, 0), cB + kstep, voffB); PG8_STAGE(PG8_SA(1, 0), cA + kstep, voffA); PG8_STAGE(PG8_SB(1, 1), cB + hstepB + kstep, voffB);
        PG8_WAIT_V(6); PG8_BAR;
    }
    for (;;) {
        const bool has_next = S.next(ui + 1, nxt);
        const char* nA = has_next ? nxt.A : cA; const char* nB = has_next ? nxt.B : cB;
        for (int t = 0; t < nt; t += 2) {
            const bool last = (t == nt - 2);
            const char* a1 = cA + (size_t)(t + 1) * kstep;
            const char* a2 = last ? nA : cA + (size_t)(t + 2) * kstep; const char* b2 = last ? nB : cB + (size_t)(t + 2) * kstep;
            const char* a3 = a2 + kstep; const char* b3 = b2 + kstep;
            if constexpr (SP2) {
            PG8_LDB(B0, 0, 0); PG8_LDB(B1, 0, 1); PG8_SCHED; PG8_LDA(At, 0, 0); PG8_STAGE(PG8_SA(1, 1), a1 + hstepA, voffA);
            PG8_WAIT_V(8); PG8_WAIT_L(0); PG8_BAR; PG8_MMA(0, 0, At, B0); PG8_MMA(0, 1, At, B1); PG8_BAR; PG8_SCHED;
            PG8_LDA(At, 0, 1); PG8_STAGE(PG8_SB(0, 0), b2, voffB); PG8_STAGE(PG8_SB(0, 1), b2 + hstepB, voffB); PG8_STAGE(PG8_SA(0, 0), a2, voffA);
            PG8_WAIT_V(8); PG8_WAIT_L(0); PG8_BAR; PG8_MMA(1, 0, At, B0); PG8_MMA(1, 1, At, B1); PG8_BAR; PG8_SCHED;
            PG8_LDB(B0, 1, 0); PG8_LDB(B1, 1, 1); PG8_SCHED; PG8_LDA(At, 1, 0); PG8_STAGE(PG8_SA(0, 1), a2 + hstepA, voffA);
            PG8_WAIT_V(8); PG8_WAIT_L(0); PG8_BAR; PG8_MMA(0, 0, At, B0); PG8_MMA(0, 1, At, B1); PG8_BAR; PG8_SCHED;
            PG8_LDA(At, 1, 1); PG8_STAGE(PG8_SB(1, 0), b3, voffB); PG8_STAGE(PG8_SB(1, 1), b3 + hstepB, voffB); PG8_STAGE(PG8_SA(1, 0), a3, voffA);
            PG8_WAIT_V(8); PG8_WAIT_L(0); PG8_BAR; PG8_MMA(1, 0, At, B0); PG8_MMA(1, 1, At, B1); PG8_BAR; PG8_SCHED;
            } else {
            PG8_LDB(B0, 0, 0); PG8_SCHED; PG8_LDA(At, 0, 0); PG8_STAGE(PG8_SA(1, 1), a1 + hstepA, voffA);
            PG8_WAIT_L(8); PG8_BAR; PG8_WAIT_L(0); PG8_MMA(0, 0, At, B0); PG8_BAR; PG8_SCHED;
            PG8_LDB(B1, 0, 1); PG8_STAGE(PG8_SB(0, 0), b2, voffB);
            PG8_BAR; PG8_WAIT_L(0); PG8_MMA(0, 1, At, B1); PG8_BAR;
            PG8_LDA(At, 0, 1); PG8_STAGE(PG8_SA(0, 0), a2, voffA);
            PG8_BAR; PG8_WAIT_L(0); PG8_MMA(1, 0, At, B0); PG8_BAR; PG8_SCHED;
            PG8_STAGE(PG8_SB(0, 1), b2 + hstepB, voffB);
            PG8_WAIT_V(6); PG8_BAR; PG8_MMA(1, 1, At, B1); PG8_BAR;
            PG8_LDB(B0, 1, 0); PG8_SCHED; PG8_LDA(At, 1, 0); PG8_STAGE(PG8_SA(0, 1), a2 + hstepA, voffA);
            PG8_WAIT_L(8); PG8_BAR; PG8_WAIT_L(0); PG8_MMA(0, 0, At, B0); PG8_BAR; PG8_SCHED;
            PG8_LDB(B1, 1, 1); PG8_STAGE(PG8_SB(1, 0), b3, voffB);
            PG8_BAR; PG8_WAIT_L(0); PG8_MMA(0, 1, At, B1); PG8_BAR;
            PG8_LDA(At, 1, 1); PG8_STAGE(PG8_SA(1, 0), a3, voffA);
            PG8_BAR; PG8_WAIT_L(0); PG8_MMA(1, 0, At, B0); PG8_BAR; PG8_SCHED;
            PG8_STAGE(PG8_SB(1, 1), b3 + hstepB, voffB);
            PG8_WAIT_V(6); PG8_BAR; PG8_MMA(1, 1, At, B1); PG8_BAR;
            }
        }
        if constexpr (ALIGN_EPI) { if (wr == 0) PG8_BAR; }
        E(acc, cur, wr, wc, fr, fq);
        if (!has_next) break;
        bool keep = false;
        if constexpr (Epi::CAN_KEEP) keep = (cur.kind < 2);
        if (!keep) {
#pragma unroll
        for (int a = 0; a < 2; ++a)
#pragma unroll
            for (int b = 0; b < 2; ++b)
#pragma unroll
                for (int m = 0; m < 4; ++m)
#pragma unroll
                    for (int n = 0; n < 2; ++n) acc[a][b][m][n] = (f32x4){0.f, 0.f, 0.f, 0.f};
        }
        cur = nxt; cA = nA; cB = nB; ++ui;
        if constexpr (ALIGN_EPI) { if (wr == 1) PG8_BAR; }
    }
    PG8_WAIT_V(0);
    if constexpr (!ALIGN_EPI) { if (wr == 0) PG8_BAR; }
    PG8_BAR;
#undef PG8_SA
#undef PG8_SB
#undef PG8_STAGE
#undef PG8_LDA
#undef PG8_LDB
#undef PG8_MMA
#undef PG8_WAIT_V
#undef PG8_WAIT_L
#undef PG8_BAR
#undef PG8_SCHED
}


struct EpiSwiglu {
    static constexpr bool PERM = true, CAN_KEEP = false;
    bf16_t* H; int ldh;
    __device__ __forceinline__ void operator()(const f32x4 (&acc)[2][2][4][2], const Unit& u, int wr, int wc, int fr, int fq) const {
        const int row0 = u.pm * BM + wr * 64 + fr, col0 = u.pn * HALF + wc * 32 + 8 * fq;
#pragma unroll
        for (int ai = 0; ai < 2; ++ai)
#pragma unroll
            for (int m = 0; m < 4; ++m) {
                bf16_t* rowp = H + (size_t)(row0 + ai * HALF + m * 16) * ldh + col0;
                f32x4 v0, v1;
#pragma unroll
                for (int j = 0; j < 4; ++j) { v0[j] = siluf_(acc[ai][0][m][0][j]) * acc[ai][1][m][0][j]; v1[j] = siluf_(acc[ai][0][m][1][j]) * acc[ai][1][m][1][j]; }
                u32x4 w; w.x = cvt_pk_bf16(v0[0], v0[1]); w.y = cvt_pk_bf16(v0[2], v0[3]); w.z = cvt_pk_bf16(v1[0], v1[1]); w.w = cvt_pk_bf16(v1[2], v1[3]);
                *(u32x4*)rowp = w;
            }
    }
};
struct EpiResid {
    static constexpr bool PERM = false, CAN_KEEP = false;
    float* Y; const float* res; float alpha, scale; bool stream;
    __device__ __forceinline__ void operator()(const f32x4 (&acc)[2][2][4][2], const Unit& u, int wr, int wc, int fr, int fq) const {
        const int row0 = u.pm * BM + wr * 64 + fr, col0 = u.pn * BM + wc * 32 + 4 * fq;
#pragma unroll
        for (int ai = 0; ai < 2; ++ai)
#pragma unroll
            for (int m2 = 0; m2 < 2; ++m2) {
                f32x4 xv[2][2][2];
#pragma unroll
                for (int mm = 0; mm < 2; ++mm)
#pragma unroll
                    for (int bj = 0; bj < 2; ++bj)
#pragma unroll
                        for (int n = 0; n < 2; ++n) { const f32x4* rp = (const f32x4*)(res + (size_t)(row0 + ai * HALF + (2 * m2 + mm) * 16) * D + col0 + bj * HALF + n * 16); xv[mm][bj][n] = stream ? __builtin_nontemporal_load(rp) : *rp; }
#pragma unroll
                for (int mm = 0; mm < 2; ++mm)
#pragma unroll
                    for (int bj = 0; bj < 2; ++bj)
#pragma unroll
                        for (int n = 0; n < 2; ++n) *(f32x4*)(Y + (size_t)(row0 + ai * HALF + (2 * m2 + mm) * 16) * D + col0 + bj * HALF + n * 16) = xv[mm][bj][n] * alpha + acc[ai][bj][2 * m2 + mm][n] * scale;
            }
    }
};
struct EpiWin {
    static constexpr bool PERM = true, CAN_KEEP = false;
    bf16_t* Z; const LAS float* gate_b; float* outK; float* outV; bf16_t* KB; bf16_t* VT;
    __device__ __forceinline__ void operator()(const f32x4 (&acc)[2][2][4][2], const Unit& u, int wr, int wc, int fr, int fq) const {
        const int row0 = u.pm * BM + wr * 64 + fr, col0 = u.pn * BM + wc * 32 + 8 * fq;
        if (u.kind == 0) {
            const int mode = (u.pn < 8) ? 1 : (u.pn < 12) ? 0 : (u.pn < 16) ? 1 : (u.pn < 20) ? 0 : 2;
            f32x4 gb[2][2];
#pragma unroll
            for (int bj = 0; bj < 2; ++bj)
#pragma unroll
                for (int n = 0; n < 2; ++n) gb[bj][n] = (mode == 2) ? *(const LAS f32x4*)(gate_b + (col0 - 5120) + bj * HALF + 4 * n) : (f32x4){0.f, 0.f, 0.f, 0.f};
#pragma unroll
            for (int ai = 0; ai < 2; ++ai)
#pragma unroll
                for (int m = 0; m < 4; ++m) {
                    bf16_t* rowp = Z + (size_t)(row0 + ai * HALF + m * 16) * NZ + col0;
#pragma unroll
                    for (int bj = 0; bj < 2; ++bj) {
                        f32x4 v0 = acc[ai][bj][m][0], v1 = acc[ai][bj][m][1];
                        if (mode == 1) {
#pragma unroll
                            for (int j = 0; j < 4; ++j) { v0[j] = gelu_tanh(v0[j]); v1[j] = gelu_tanh(v1[j]); }
                        } else if (mode == 2) {
#pragma unroll
                            for (int j = 0; j < 4; ++j) { v0[j] = sigmoidf_(v0[j] + gb[bj][0][j]); v1[j] = sigmoidf_(v1[j] + gb[bj][1][j]); }
                        }
                        u32x4 w; w.x = cvt_pk_bf16(v0[0], v0[1]); w.y = cvt_pk_bf16(v0[2], v0[3]); w.z = cvt_pk_bf16(v1[0], v1[1]); w.w = cvt_pk_bf16(v1[2], v1[3]);
                        *(u32x4*)(rowp + bj * HALF) = w;
                    }
                }
        } else if (u.kind == 1) {
            const bool isk = u.pn < 4; const int c0 = col0 - (isk ? 0 : 1024);
            float* ob = isk ? outK : outV;
#pragma unroll
            for (int ai = 0; ai < 2; ++ai)
#pragma unroll
                for (int m = 0; m < 4; ++m) {
                    const size_t off = (size_t)(row0 + ai * HALF + m * 16) * 1024 + c0;
#pragma unroll
                    for (int bj = 0; bj < 2; ++bj) {
                        const f32x4 v0 = acc[ai][bj][m][0], v1 = acc[ai][bj][m][1];
                        __builtin_nontemporal_store(v0, (f32x4*)(ob + off + bj * HALF)); __builtin_nontemporal_store(v1, (f32x4*)(ob + off + bj * HALF + 4));
                        if (isk) { u32x4 w; w.x = cvt_pk_bf16(v0[0], v0[1]); w.y = cvt_pk_bf16(v0[2], v0[3]); w.z = cvt_pk_bf16(v1[0], v1[1]); w.w = cvt_pk_bf16(v1[2], v1[3]); *(u32x4*)(KB + off + bj * HALF) = w; }
                    }
                }
        } else {
#pragma unroll
            for (int ai = 0; ai < 2; ++ai)
#pragma unroll
                for (int m = 0; m < 4; ++m) {
                    bf16_t* rowp = VT + (size_t)(row0 + ai * HALF + m * 16) * 1024 + col0;
#pragma unroll
                    for (int bj = 0; bj < 2; ++bj) {
                        const f32x4 v0 = acc[ai][bj][m][0], v1 = acc[ai][bj][m][1];
                        u32x4 w; w.x = cvt_pk_bf16(v0[0], v0[1]); w.y = cvt_pk_bf16(v0[2], v0[3]); w.z = cvt_pk_bf16(v1[0], v1[1]); w.w = cvt_pk_bf16(v1[2], v1[3]);
                        *(u32x4*)(rowp + bj * HALF) = w;
                    }
                }
        }
    }
};
struct EpiMerge {
    static constexpr bool PERM = true, CAN_KEEP = true;
    const bf16_t* Z; bf16_t* MB;
    __device__ __forceinline__ void operator()(f32x4 (&acc)[2][2][4][2], const Unit& u, int wr, int wc, int fr, int fq) const {
        const int row0 = u.pm * BM + wr * 64 + fr, col0 = u.pn * BM + wc * 32 + 8 * fq;
        const bool last = (u.kind == 2);
        const int koff = 5120 + u.kind * 2048, noff = last ? 0 : 2048;
#pragma unroll
        for (int ai = 0; ai < 2; ++ai)
#pragma unroll
            for (int m2 = 0; m2 < 2; ++m2) {
                u32x4 ga[2][2], gb[2][2];
#pragma unroll
                for (int mm = 0; mm < 2; ++mm)
#pragma unroll
                    for (int bj = 0; bj < 2; ++bj) {
                        const bf16_t* zp = Z + (size_t)(row0 + ai * HALF + (2 * m2 + mm) * 16) * NZ + koff + col0 + bj * HALF;
                        ga[mm][bj] = *(const u32x4*)zp;
                        gb[mm][bj] = *(const u32x4*)(zp + noff);
                    }
#pragma unroll
                for (int mm = 0; mm < 2; ++mm)
#pragma unroll
                    for (int bj = 0; bj < 2; ++bj) {
                        const int m = 2 * m2 + mm;
                        const u32x4 a4 = ga[mm][bj], b4 = gb[mm][bj];
                        f32x4 g0 = (f32x4){bflo(a4.x), bfhi(a4.x), bflo(a4.y), bfhi(a4.y)}, g1 = (f32x4){bflo(a4.z), bfhi(a4.z), bflo(a4.w), bfhi(a4.w)};
                        const f32x4 h0 = (f32x4){bflo(b4.x), bfhi(b4.x), bflo(b4.y), bfhi(b4.y)}, h1 = (f32x4){bflo(b4.z), bfhi(b4.z), bflo(b4.w), bfhi(b4.w)};
#pragma unroll
                        for (int j = 0; j < 4; ++j) {
                            g0[j] = fmaxf(g0[j], 1e-6f) * (last ? 1.0f : __builtin_amdgcn_rcpf(fmaxf(h0[j], 1e-6f)));
                            g1[j] = fmaxf(g1[j], 1e-6f) * (last ? 1.0f : __builtin_amdgcn_rcpf(fmaxf(h1[j], 1e-6f)));
                        }
                        acc[ai][bj][m][0] *= g0; acc[ai][bj][m][1] *= g1;
                        if (last) {
                            const f32x4 v0 = acc[ai][bj][m][0], v1 = acc[ai][bj][m][1];
                            u32x4 w; w.x = cvt_pk_bf16(v0[0], v0[1]); w.y = cvt_pk_bf16(v0[2], v0[3]); w.z = cvt_pk_bf16(v1[0], v1[1]); w.w = cvt_pk_bf16(v1[2], v1[3]);
                            *(u32x4*)(MB + (size_t)(row0 + ai * HALF + m * 16) * D + col0 + bj * HALF) = w;
                        }
                    }
            }
    }
};
}

#ifndef PHMASK
#define PHMASK 0xFFFFFFFFu
#endif
#ifndef GREP
#define GREP 1
#endif
#ifndef NREP
#define NREP 1
#endif
#define PHON(n) (((PHMASK) >> (n)) & 1u)
#define LDS_WAIT() asm volatile("s_waitcnt lgkmcnt(0)" ::: "memory")

__device__ __forceinline__ void transpose_item(const float* W, int N, bf16_t* WT, int ldk, int k0, int n0, int dst_row0, LAS float* scr, int lane) {
    f32x4 v[8];
    const int n4 = (lane & 7) * 4, kr = lane >> 3;
#pragma unroll
    for (int i = 0; i < 8; ++i) v[i] = __builtin_nontemporal_load((const f32x4*)(W + (size_t)(k0 + kr + 8 * i) * N + n0 + n4));
#pragma unroll
    for (int i = 0; i < 8; ++i) { LAS float* d = scr + (kr + 8 * i) * 33 + n4; d[0] = v[i][0]; d[1] = v[i][1]; d[2] = v[i][2]; d[3] = v[i][3]; }
    LDS_WAIT(); asm volatile("" ::: "memory");
    const int c = lane & 7;
#pragma unroll
    for (int j = 0; j < 4; ++j) { const int n = (lane >> 3) + 8 * j; const LAS float* s = scr + (8 * c) * 33 + n;
        u32x4 o; o.x = cvt_pk_bf16(s[0 * 33], s[1 * 33]); o.y = cvt_pk_bf16(s[2 * 33], s[3 * 33]); o.z = cvt_pk_bf16(s[4 * 33], s[5 * 33]); o.w = cvt_pk_bf16(s[6 * 33], s[7 * 33]);
        *(u32x4*)(WT + (size_t)(dst_row0 + n) * ldk + k0 + 8 * c) = o; }
    LDS_WAIT(); asm volatile("" ::: "memory");
}
__device__ __forceinline__ void ln_row(const float* yrow, const float* g, const float* b, float* of, bf16_t* ob, int lane) {
    f32x4 v[8]; float s = 0.f;
#pragma unroll
    for (int j = 0; j < 8; ++j) { v[j] = *(const f32x4*)(yrow + 4 * lane + 256 * j); s += (v[j][0] + v[j][1]) + (v[j][2] + v[j][3]); }
    const float mean = wave_sum(s) * (1.f / D); float s2 = 0.f;
#pragma unroll
    for (int j = 0; j < 8; ++j) { v[j] = v[j] - mean; s2 += (v[j][0] * v[j][0] + v[j][1] * v[j][1]) + (v[j][2] * v[j][2] + v[j][3] * v[j][3]); }
    const float rstd = 1.0f / sqrtf(wave_sum(s2) * (1.f / D) + LN_EPS);
#pragma unroll
    for (int j = 0; j < 8; ++j) {
        const f32x4 gg = *(const f32x4*)(g + 4 * lane + 256 * j), bb = *(const f32x4*)(b + 4 * lane + 256 * j);
        const f32x4 o = v[j] * rstd * gg + bb;
        if (of) __builtin_nontemporal_store(o, (f32x4*)(of + 4 * lane + 256 * j));
        if (ob) { u32x2 w; w.x = cvt_pk_bf16(o[0], o[1]); w.y = cvt_pk_bf16(o[2], o[3]); *(u32x2*)(ob + 4 * lane + 256 * j) = w; }
    }
}

#define XB_TMO      128
#define XB_XCNT(j)  (256  + 64 * (j))
#define XB_XSUB(j)  (1280 + 64 * (j))
#define XB_XGEN(j)  (2304 + 64 * (j))
#define XB_TOP      3328
#define XB_TOPGEN   3392
#define XCD_BAR_WORDS 3456
#define XB_SPIN_CAP (1u << 22)
__device__ __forceinline__ unsigned xb_ld(unsigned* p)              { return __hip_atomic_load(p, __ATOMIC_RELAXED, __HIP_MEMORY_SCOPE_AGENT); }
__device__ __forceinline__ unsigned xb_add(unsigned* p, unsigned v) { return __hip_atomic_fetch_add(p, v, __ATOMIC_RELAXED, __HIP_MEMORY_SCOPE_AGENT); }
__device__ __forceinline__ unsigned xb_xcc_id() { return (unsigned)__builtin_amdgcn_s_getreg((3 << 11) | 20) & 0xFu; }
#define XB_SPIN(cond, bar) do { unsigned _sp = 0; while (cond) { __builtin_amdgcn_s_sleep(1); \
    if ((++_sp & 255u) == 0u) { if (xb_ld(&(bar)[XB_TMO])) break; if (_sp > XB_SPIN_CAP) { atomicAdd(&(bar)[XB_TMO], 1u); break; } } } } while (0)
struct XcdBarrier { unsigned* bar; unsigned x; volatile LAS unsigned* st; };
__device__ __forceinline__ XcdBarrier xcd_barrier_post(unsigned* bar, volatile LAS unsigned* st) {
    XcdBarrier b; b.bar = bar; b.x = xb_xcc_id(); b.st = st;
    if (threadIdx.x == 0) (void)xb_add(&bar[XB_XCNT(b.x)], 1u);
    return b;
}
__device__ __forceinline__ void xcd_barrier_complete(unsigned* bar, unsigned x, unsigned& nloc, unsigned& nx) {
    const unsigned G = gridDim.x * gridDim.y * gridDim.z;
    unsigned sum, cnt, mine, sp = 0u;
    for (;;) {
        sum = 0u; cnt = 0u; mine = 0u;
#pragma unroll
        for (unsigned j = 0; j < 16; ++j) { const unsigned c = xb_ld(&bar[XB_XCNT(j)]); sum += c; cnt += (c > 0u) ? 1u : 0u; mine = (j == x) ? c : mine; }
        if (sum == G) break;
        __builtin_amdgcn_s_sleep(1);
        if ((++sp & 255u) == 0u) { if (xb_ld(&bar[XB_TMO])) break; if (sp > XB_SPIN_CAP) { atomicAdd(&bar[XB_TMO], 1u); break; } }
    }
    nloc = mine > 0u ? mine : 1u; nx = cnt > 0u ? cnt : 1u;
}
__device__ __forceinline__ void xcd_barrier(const XcdBarrier& b) {
    asm volatile("s_waitcnt vmcnt(0)" ::: "memory");
    __syncthreads();
    if (threadIdx.x == 0) {
        unsigned* bar = b.bar;
        __builtin_amdgcn_s_waitcnt(0);
        unsigned nloc = b.st[0], nx = b.st[1];
        if (nloc == 0u) { xcd_barrier_complete(bar, b.x, nloc, nx); b.st[0] = nloc; b.st[1] = nx; }
        const unsigned old = xb_add(&bar[XB_XSUB(b.x)], 1u);
        const unsigned gen = old / nloc;
        if (old + 1u == (gen + 1u) * nloc) {
            __builtin_amdgcn_fence(__ATOMIC_RELEASE, "agent");
            asm volatile("s_waitcnt vmcnt(0)" ::: "memory");
            const unsigned og = xb_add(&bar[XB_TOP], 1u);
            const unsigned tg = og / nx;
            if (og + 1u == (tg + 1u) * nx) xb_add(&bar[XB_TOPGEN], 1u);
            else XB_SPIN(xb_ld(&bar[XB_TOPGEN]) == tg, bar);
            __builtin_amdgcn_fence(__ATOMIC_ACQUIRE, "agent");
            xb_add(&bar[XB_XGEN(b.x)], 1u);
            asm volatile("s_waitcnt vmcnt(0)" ::: "memory");
        } else {
            XB_SPIN(xb_ld(&bar[XB_XGEN(b.x)]) == gen, bar);
            __builtin_amdgcn_fence(__ATOMIC_ACQUIRE, "agent");
            asm volatile("s_waitcnt vmcnt(0)" ::: "memory");
        }
    }
    __syncthreads();
}

template <int MODE>
__device__ __forceinline__ void skinny(LAS unsigned char* lds, int bid, int G, int wave, int lane, const bf16_t* A, int lda, const bf16_t* Bt, int ldb, int K,
                                       float* Ys, const float* res, float alpha, float scale, const bf16_t* Zs, bf16_t* MBs) {
    const int fr = lane & 15, fq = lane >> 4, tw = wave & 3, kh = wave >> 2;
    LAS f32x4* red = (LAS f32x4*)lds;
    for (int T0 = bid * 4; T0 < 1024; T0 += G * 4) {
        const int T = T0 + tw, rt = T >> 7, ct = T & 127;
        f32x4 tot = (f32x4){0.f, 0.f, 0.f, 0.f};
        if (MODE == 0) {
            const int kb = kh * (K / 2);
            const bf16_t* ap = A + (size_t)(rt * 16 + fr) * lda + kb + fq * 8;
            const bf16_t* bp = Bt + (size_t)(ct * 16 + fr) * ldb + kb + fq * 8;
#pragma unroll 16
            for (int ks = 0; ks < K / 64; ++ks) {
                const bf16x8 af = *(const bf16x8*)(ap + ks * 32), bfv = *(const bf16x8*)(bp + ks * 32);
                tot = __builtin_amdgcn_mfma_f32_16x16x32_bf16(bfv, af, tot, 0, 0, 0);
            }
        } else {
#pragma unroll
            for (int k = 0; k < 3; ++k) {
                const int kb = kh * (BW / 2);
                const bf16_t* ap = A + (size_t)(rt * 16 + fr) * lda + k * BW + kb + fq * 8;
                const bf16_t* bp = Bt + (size_t)k * D * BW + (size_t)(ct * 16 + fr) * ldb + kb + fq * 8;
                f32x4 acc = (f32x4){0.f, 0.f, 0.f, 0.f};
#pragma unroll 8
                for (int ks = 0; ks < BW / 64; ++ks) {
                    const bf16x8 af = *(const bf16x8*)(ap + ks * 32), bfv = *(const bf16x8*)(bp + ks * 32);
                    acc = __builtin_amdgcn_mfma_f32_16x16x32_bf16(bfv, af, acc, 0, 0, 0);
                }
                const u32x2 gw = *(const u32x2*)(Zs + (size_t)(rt * 16 + fr) * NZ + 5120 + k * 2048 + ct * 16 + 4 * fq);
                tot += acc * (f32x4){bflo(gw.x), bfhi(gw.x), bflo(gw.y), bfhi(gw.y)};
            }
        }
        if (kh == 1) red[tw * 64 + lane] = tot;
        __syncthreads();
        if (kh == 0) {
            tot += red[tw * 64 + lane];
            const size_t off = (size_t)(rt * 16 + fr) * D + ct * 16 + 4 * fq;
            if (MODE == 0) { const f32x4 xv = *(const f32x4*)(res + off); *(f32x4*)(Ys + off) = xv * alpha + tot * scale; }
            else { u32x2 w; w.x = cvt_pk_bf16(tot[0], tot[1]); w.y = cvt_pk_bf16(tot[2], tot[3]); *(u32x2*)(MBs + off) = w; }
        }
        __syncthreads();
    }
}

#define WGU1 ((bf16_t*)(P.ws + WS_WGU1))
#define WD1 ((bf16_t*)(P.ws + WS_WD1))
#define WIN ((bf16_t*)(P.ws + WS_WIN))
#define WKV ((bf16_t*)(P.ws + WS_WKV))
#define WBR ((bf16_t*)(P.ws + WS_WBR))
#define WOUT ((bf16_t*)(P.ws + WS_WOUT))
#define WGU2 ((bf16_t*)(P.ws + WS_WGU2))
#define WD2 ((bf16_t*)(P.ws + WS_WD2))
#define WLRU ((bf16_t*)(P.ws + WS_WLRU))
#define WSP ((bf16_t*)(P.ws + WS_WSP))
#define XB ((bf16_t*)(P.ws + WS_XB))
#define Z ((bf16_t*)(P.ws + WS_ZH))
#define H ((bf16_t*)(P.ws + WS_ZH))
#define Y ((float*)(P.ws + WS_Y))
#define X1 ((float*)(P.ws + WS_X1))
#define VP ((bf16_t*)(P.ws + WS_VP))
#define HL ((float*)(P.ws + WS_HL))
#define AC ((float*)(P.ws + WS_AC))
#define SUM ((float*)(P.ws + WS_SUM))
#define YS ((bf16_t*)(P.ws + WS_YS))
#define MEMLN ((bf16_t*)(P.ws + WS_MEMLN))
#define KB ((bf16_t*)(P.ws + WS_KB))
#define VT ((bf16_t*)(P.ws + WS_VT))
__device__ __forceinline__ void p5d_sample_attn(const Params& P, LAS unsigned char* lds, int bid, int G, int tid_in) {
    int tid = tid_in; asm volatile("" : "+v"(tid));
    const int lane = tid & 63, wave = __builtin_amdgcn_readfirstlane(tid >> 6);

        LAS float* sS = (LAS float*)(lds + 131072);
        LAS float* sO = (LAS float*)(lds + 131072 + 1024);
        const int vb = (G % 8 == 0) ? (bid & 7) * (G >> 3) + (bid >> 3) : bid;
        for (int it = vb; it < 512; it += G) {
            const int b = it >> 2, h = it & 3;
            const u32x2 qw = *(const u32x2*)(Z + (size_t)(MP + b) * NZ + 4096 + h * HD + 4 * lane);
            const f32x4 q = (f32x4){bflo(qw.x), bfhi(qw.x), bflo(qw.y), bfhi(qw.y)};
            const float* kbase = P.in[I_CK] + ((size_t)(b * NMEM + 32 * wave) * NH + h) * HD + 4 * lane;
            const float* vbase = P.in[I_CV] + ((size_t)(b * NMEM + 32 * wave) * NH + h) * HD + 4 * lane;
            float d[32];
#pragma unroll
            for (int mi = 0; mi < 32; ++mi) {
                const f32x4 kv = __builtin_nontemporal_load((const f32x4*)(kbase + (size_t)mi * (NH * HD)));
                d[mi] = (kv[0] * q[0] + kv[1] * q[1]) + (kv[2] * q[2] + kv[3] * q[3]);
                if (mi == 15) asm volatile("" ::: "memory");
            }
#pragma unroll
            for (int i = 0; i < 16; ++i) { const bool hi = (lane & 32) != 0; const float snd = hi ? d[i] : d[i + 16], kp = hi ? d[i + 16] : d[i]; d[i] = kp + __shfl_xor(snd, 32); }
#pragma unroll
            for (int i = 0; i < 8; ++i) { const bool hi = (lane & 16) != 0; const float snd = hi ? d[i] : d[i + 8], kp = hi ? d[i + 8] : d[i]; d[i] = kp + __shfl_xor(snd, 16); }
#pragma unroll
            for (int i = 0; i < 4; ++i) { const bool hi = (lane & 8) != 0; const float snd = hi ? d[i] : d[i + 4], kp = hi ? d[i + 4] : d[i]; d[i] = kp + __shfl_xor(snd, 8); }
#pragma unroll
            for (int i = 0; i < 2; ++i) { const bool hi = (lane & 4) != 0; const float snd = hi ? d[i] : d[i + 2], kp = hi ? d[i + 2] : d[i]; d[i] = kp + __shfl_xor(snd, 4); }
            { const bool hi = (lane & 2) != 0; const float snd = hi ? d[0] : d[1], kp = hi ? d[1] : d[0]; d[0] = kp + __shfl_xor(snd, 2); }
            d[0] += __shfl_xor(d[0], 1);
            if ((lane & 1) == 0) sS[32 * wave + (lane >> 1)] = d[0] * 0.0625f;
            f32x4 vv[16];
#pragma unroll
            for (int mi = 0; mi < 16; ++mi) vv[mi] = __builtin_nontemporal_load((const f32x4*)(vbase + (size_t)mi * (NH * HD)));
            __syncthreads();
            float mx = fmaxf(fmaxf(sS[lane], sS[lane + 64]), fmaxf(sS[lane + 128], sS[lane + 192]));
            mx = wave_max(mx);
            float sm = __expf(sS[lane] - mx) + __expf(sS[lane + 64] - mx) + __expf(sS[lane + 128] - mx) + __expf(sS[lane + 192] - mx);
            sm = wave_sum(sm);
            const float inv = 1.0f / sm;
            f32x4 o = (f32x4){0.f, 0.f, 0.f, 0.f};
            f32x4 vw[16];
#pragma unroll
            for (int mi = 0; mi < 16; ++mi) vw[mi] = __builtin_nontemporal_load((const f32x4*)(vbase + (size_t)(16 + mi) * (NH * HD)));
#pragma unroll
            for (int mi = 0; mi < 16; ++mi) { const float p = __expf(sS[32 * wave + mi] - mx) * inv; o += vv[mi] * p; }
#pragma unroll
            for (int mi = 0; mi < 16; ++mi) { const float p = __expf(sS[32 * wave + 16 + mi] - mx) * inv; o += vw[mi] * p; }
            *(LAS f32x4*)(sO + wave * 256 + 4 * lane) = o;
            __syncthreads();
            if (tid < 256) {
                float a = 0.f;
#pragma unroll
                for (int w = 0; w < 8; ++w) a += sO[w * 256 + tid];
                YS[(size_t)(MP + b) * 3072 + 2048 + h * HD + tid] = (bf16_t)(cvt_pk_bf16(a, 0.f) & 0xffffu);
            }
            __syncthreads();
        }
}

__global__ void __launch_bounds__(NTHREADS, 2) fwd_kernel(Params P) {
    extern __shared__ __attribute__((aligned(16))) unsigned char lds_raw[];
    LAS unsigned char* lds = (LAS unsigned char*)lds_raw;
    cg::grid_group grid = cg::this_grid();
    const int tid = threadIdx.x, lane = tid & 63, wave = __builtin_amdgcn_readfirstlane(tid >> 6);
    const int G = gridDim.x, bid = blockIdx.x;
    const int gw = bid * NWAVES + wave, NGW = G * NWAVES;
    float* out = P.out;
    volatile LAS unsigned* bst = (volatile LAS unsigned*)(lds + LDS_BYTES - 64);
    if (tid == 0) { bst[0] = 0u; bst[1] = 0u; }
    __syncthreads();
    const XcdBarrier gbar = xcd_barrier_post((unsigned*)(P.ws + WS_BAR), bst);
#define GRID_BAR() xcd_barrier(gbar)

    if (PHON(0)) {
        LAS float* scr = (LAS float*)(lds + wave * 16384);
        constexpr int IT_GU = (D / 64) * (NZ / 32), IT_DN = (FF / 64) * (D / 32), IT_SQ = (D / 64) * (D / 32), IT_BR = (BW / 64) * (D / 32), IT_LR = 2 * 4;
        constexpr int IT_TOTAL = 3 * IT_GU + 2 * IT_DN + 2 * IT_SQ + 3 * IT_BR + 16 * IT_LR;
        for (int it = gw; it < IT_TOTAL; it += NGW) {
            int r = it; const float* W; bf16_t* WT; int N, ldk, mode = 0;
            if (r < IT_GU) { W = P.in[I_WIN]; WT = WIN; N = NZ; ldk = D; }
            else if ((r -= IT_GU) < IT_SQ) { W = P.in[I_WKV]; WT = WKV; N = D; ldk = D; }
            else if ((r -= IT_SQ) < 3 * IT_BR) { const int k = r / IT_BR; r -= k * IT_BR; W = P.in[I_WBR] + (size_t)k * BW * D; WT = WBR + (size_t)k * D * BW; N = D; ldk = BW; }
            else if ((r -= 3 * IT_BR) < IT_SQ) { W = P.in[I_WOUT]; WT = WOUT; N = D; ldk = D; }
            else if ((r -= IT_SQ) < IT_GU) { W = P.in[I_GU2]; WT = WGU2; N = NZ; ldk = D; mode = 1; }
            else if ((r -= IT_GU) < IT_DN) { W = P.in[I_DN2]; WT = WD2; N = D; ldk = FF; }
            else if ((r -= IT_DN) < 16 * IT_LR) { const int m = r / IT_LR; r -= m * IT_LR; const int k = m >> 1, x = m & 1;
                W = (x ? P.in[I_LWX] : P.in[I_LWA]) + (size_t)k * 128 * 128; WT = WLRU + (size_t)k * 256 * 128 + x * 128 * 128; N = 128; ldk = 128; }
            else if ((r -= 16 * IT_LR) < IT_DN) { W = P.in[I_DN1]; WT = WD1; N = D; ldk = FF; }
            else { r -= IT_DN; W = P.in[I_GU1]; WT = WGU1; N = NZ; ldk = D; mode = 1; }
            const int nblk = N / 32, kb = r / nblk, nb = r % nblk, n0 = 32 * nb;
            int dr = n0;
            if (mode == 1) dr = (n0 < FF) ? (n0 / 128) * 256 + (n0 % 128) : ((n0 - FF) / 128) * 256 + 128 + ((n0 - FF) % 128);
            transpose_item(W, N, WT, ldk, 64 * kb, n0, dr, scr, lane);
        }
        for (int i = gw * 64 + lane; i < 4 * 128 * 128; i += NGW * 64) { const int t = (i >> 7) & 127, s = i & 127; const float w = P.in[I_WS][i]; WSP[i] = (bf16_t)(cvt_pk_bf16(s <= t ? w : 0.f, 0.f) & 0xffffu); }
        for (size_t i = (size_t)gw * 64 + lane; i < (size_t)MPAD * D / 8; i += (size_t)NGW * 64) {
            const size_t e = i * 8; const int r = (int)(e / D);
            u32x4 w = (u32x4){0u, 0u, 0u, 0u};
            if (r < MR) { const float* src = (r < MP) ? P.in[I_XP] + e : P.in[I_XS] + (e - (size_t)MP * D);
                const f32x4 a = __builtin_nontemporal_load((const f32x4*)src), b = __builtin_nontemporal_load((const f32x4*)(src + 4));
                w.x = cvt_pk_bf16(a[0], a[1]); w.y = cvt_pk_bf16(a[2], a[3]); w.z = cvt_pk_bf16(b[0], b[1]); w.w = cvt_pk_bf16(b[2], b[3]); }
            *(u32x4*)(XB + e) = w;
        }
        for (int r = gw; r < 1024; r += NGW) ln_row(P.in[I_MEM] + (size_t)r * D, P.in[I_MLNG], P.in[I_MLNB], nullptr, MEMLN + (size_t)r * D, lane);
    }
    if (P.ws == nullptr) grid.sync();
    GRID_BAR();

    if (PHON(1)) {
        pg8::PlainSched S{XB, WGU1, 33, 44, D, D, G, bid};
        pg8::EpiSwiglu E{H, FF};
        pg8::gemm_phase<pg8::PlainSched, pg8::EpiSwiglu, true, true>(lds, D, D, D, S, E);
    }
    GRID_BAR();
    if (PHON(2)) {
        skinny<0>(lds, bid, G, wave, lane, H + (size_t)MP * FF, FF, WD1, FF, FF, Y + (size_t)MP * D, P.in[I_XS], ALPHA, 0.5f, nullptr, nullptr);
        pg8::PlainSched S{H, WD1, 32, 8, FF, FF, G, bid};
        pg8::EpiResid E{Y, P.in[I_XP], ALPHA, 0.5f, true};
        pg8::gemm_phase<pg8::PlainSched, pg8::EpiResid, true, true>(lds, FF, FF, FF, S, E);
    }
    GRID_BAR();
    if (PHON(3)) for (int r = gw; r < MR; r += NGW) ln_row(Y + (size_t)r * D, P.in[I_LN1G], P.in[I_LN1B], X1 + (size_t)r * D, XB + (size_t)r * D, lane);
    GRID_BAR();

    if (PHON(4)) {
        LAS float* gbl = (LAS float*)(lds + 131072);
        for (int i = tid; i < 3 * D / 4; i += NTHREADS) *(LAS f32x4*)(gbl + 4 * i) = *(const f32x4*)(P.in[I_GATEB] + 4 * i);
        __syncthreads();
        pg8::WinSched S{XB, WIN, MEMLN, WKV, G, bid};
        pg8::EpiWin E{Z, gbl, out + O_MK, out + O_MV, KB, VT};
        pg8::gemm_phase<pg8::WinSched, pg8::EpiWin, true, true>(lds, D, D, D, S, E);
    }
    GRID_BAR();

    const bool dfirst_ = ((bid >> 5) & 1) != 0;
    if (dfirst_ && PHON(8)) p5d_sample_attn(P, lds, bid, G, tid);
    if (PHON(5)) for (int r = gw; r < MR; r += NGW) {
        const bf16_t* zr = Z + (size_t)r * NZ + 1024;
        float v[16]; float s = 0.f;
#pragma unroll
        for (int h = 0; h < 2; ++h) { const u32x4 w = *(const u32x4*)(zr + 8 * lane + 512 * h);
            v[8 * h + 0] = bflo(w.x); v[8 * h + 1] = bfhi(w.x); v[8 * h + 2] = bflo(w.y); v[8 * h + 3] = bfhi(w.y); v[8 * h + 4] = bflo(w.z); v[8 * h + 5] = bfhi(w.z); v[8 * h + 6] = bflo(w.w); v[8 * h + 7] = bfhi(w.w); }
#pragma unroll
        for (int j = 0; j < 16; ++j) s += v[j];
        const float mean = wave_sum(s) * (1.f / BW); float s2 = 0.f;
#pragma unroll
        for (int j = 0; j < 16; ++j) { v[j] -= mean; s2 += v[j] * v[j]; }
        const float rstd = 1.0f / sqrtf(wave_sum(s2) * (1.f / BW) + LN_EPS);
#pragma unroll
        for (int h = 0; h < 2; ++h) {
            const int c0 = 8 * lane + 512 * h; float o[8];
#pragma unroll
            for (int j = 0; j < 8; ++j) o[j] = v[8 * h + j] * rstd * P.in[I_GLNG][c0 + j] + P.in[I_GLNB][c0 + j];
            u32x4 w; w.x = cvt_pk_bf16(o[0], o[1]); w.y = cvt_pk_bf16(o[2], o[3]); w.z = cvt_pk_bf16(o[4], o[5]); w.w = cvt_pk_bf16(o[6], o[7]);
            *(u32x4*)(VP + (size_t)r * BW + c0) = w;
            if (r >= MP) { float* ov = out + O_VS + (size_t)(r - MP) * BW + c0; *(f32x4*)ov = (f32x4){o[0], o[1], o[2], o[3]}; *(f32x4*)(ov + 4) = (f32x4){o[4], o[5], o[6], o[7]}; }
        }
    }
    if (PHON(6)) {
        LAS bf16_t* XCB = (LAS bf16_t*)lds;
        LAS float* AARR = (LAS float*)lds;
        LAS float* XCF = (LAS float*)(lds + 65536);
        for (int it = bid; it < 65 * 8; it += G) {
            const int c = it >> 3, k = it & 7; const bool smp = (c == 64);
            const int r0 = c * 128, ch0 = k * 128;
            int lane_o = lane; asm volatile("" : "+v"(lane_o));
            const int fr = lane_o & 15, fq = lane_o >> 4, rh = wave >> 2, cq = wave & 3;
            bf16x8 wfr[4][4];
            {
                const bf16_t* wb = WLRU + (size_t)k * 256 * 128;
#pragma unroll
                for (int ct = 0; ct < 4; ++ct)
#pragma unroll
                    for (int ks = 0; ks < 4; ++ks) wfr[ct][ks] = *(const bf16x8*)(wb + (size_t)((ct >> 1) * 128 + 32 * cq + 16 * (ct & 1) + fr) * 128 + ks * 32 + fq * 8);
            }
            LAS float* prm = (LAS float*)(lds + 131072 + 4096);
            if (tid < 128) { prm[tid] = P.in[I_LBA][ch0 + tid]; prm[128 + tid] = P.in[I_LBX][ch0 + tid]; prm[256 + tid] = __logf(1.0f + __expf(-P.in[I_LAM][ch0 + tid])); }
            {
                const int c4 = (tid & 31) * 4, rg = tid >> 5;
                const int ch = ch0 + c4;
                const f32x4 w0 = *(const f32x4*)(P.in[I_CONVW] + 0 * BW + ch), w1 = *(const f32x4*)(P.in[I_CONVW] + 1 * BW + ch), w2 = *(const f32x4*)(P.in[I_CONVW] + 2 * BW + ch), w3 = *(const f32x4*)(P.in[I_CONVW] + 3 * BW + ch);
                const f32x4 cb = *(const f32x4*)(P.in[I_CONVB] + ch);
                if (!smp) {
                    const bool first = ((c & 15) == 0);
                    const int rs = rg * 8;
                    const bool hist = !(first && rs == 0);
                    u32x2 zr[11];
#pragma unroll
                    for (int i = 0; i < 11; ++i) { zr[i] = (u32x2){0u, 0u}; if (i >= 3 || hist) zr[i] = *(const u32x2*)(Z + (size_t)(r0 + rs - 3 + i) * NZ + 2048 + ch); }
#define ZF(i) ((f32x4){bflo(zr[i].x), bfhi(zr[i].x), bflo(zr[i].y), bfhi(zr[i].y)})
#pragma unroll
                    for (int i = 0; i < 8; ++i) {
                        const int row = rs + i;
                        const f32x4 x0 = ZF(i + 3);
                        const f32x4 xc = cb + w3 * x0 + w2 * ZF(i + 2) + w1 * ZF(i + 1) + w0 * ZF(i);
                        *(LAS f32x4*)(XCF + row * 128 + c4) = xc;
                        u32x2 w; w.x = cvt_pk_bf16(xc[0], xc[1]); w.y = cvt_pk_bf16(xc[2], xc[3]);
                        *(LAS u32x2*)(XCB + row * 136 + c4) = w;
                        if ((c & 15) == 15 && row >= 125) *(f32x4*)(out + O_CP + (size_t)((c >> 4) * 3 + (row - 125)) * BW + ch) = x0;
                    }
#undef ZF
                } else {
#pragma unroll 4
                    for (int i = 0; i < 8; ++i) {
                        const int row = rg * 8 + i;
                        const float* sc = P.in[I_SCONV] + (size_t)row * 3 * BW + ch;
                        const f32x4 b0 = *(const f32x4*)sc, b1 = *(const f32x4*)(sc + BW), b2 = *(const f32x4*)(sc + 2 * BW);
                        const u32x2 a = *(const u32x2*)(Z + (size_t)(MP + row) * NZ + 2048 + ch);
                        const f32x4 x0 = (f32x4){bflo(a.x), bfhi(a.x), bflo(a.y), bfhi(a.y)};
                        const f32x4 xc = cb + w3 * x0 + w2 * b2 + w1 * b1 + w0 * b0;
                        *(LAS f32x4*)(XCF + row * 128 + c4) = xc;
                        u32x2 w; w.x = cvt_pk_bf16(xc[0], xc[1]); w.y = cvt_pk_bf16(xc[2], xc[3]);
                        *(LAS u32x2*)(XCB + row * 136 + c4) = w;
                        float* oc = out + O_CS + (size_t)row * 3 * BW + ch;
                        *(f32x4*)oc = b1; *(f32x4*)(oc + BW) = b2; *(f32x4*)(oc + 2 * BW) = x0;
                    }
                }
            }
            __syncthreads();
            f32x4 ga[4][4];
#pragma unroll
            for (int rt = 0; rt < 4; ++rt)
#pragma unroll
                for (int ct = 0; ct < 4; ++ct) ga[rt][ct] = (f32x4){0.f, 0.f, 0.f, 0.f};
#pragma unroll
            for (int rt = 0; rt < 4; ++rt) {
                bf16x8 af[4];
#pragma unroll
                for (int ks = 0; ks < 4; ++ks) af[ks] = *(const LAS bf16x8*)(XCB + (64 * rh + 16 * rt + fr) * 136 + ks * 32 + fq * 8);
#pragma unroll
                for (int ct = 0; ct < 4; ++ct)
#pragma unroll
                    for (int ks = 0; ks < 4; ++ks) ga[rt][ct] = __builtin_amdgcn_mfma_f32_16x16x32_bf16(af[ks], wfr[ct][ks], ga[rt][ct], 0, 0, 0);
            }
            __syncthreads();
#pragma unroll
            for (int cl = 0; cl < 2; ++cl) {
                const int chl = 32 * cq + 16 * cl + fr, chg = ch0 + chl;
                const float ba = prm[chl], bx = prm[128 + chl], sp = prm[256 + chl];
#pragma unroll
                for (int rt = 0; rt < 4; ++rt)
#pragma unroll
                    for (int j = 0; j < 4; ++j) {
                        const int row = 64 * rh + 16 * rt + 4 * fq + j;
                        const float rr = sigmoidf_(ga[rt][cl][j] + ba), ii = sigmoidf_(ga[rt][2 + cl][j] + bx);
                        const float la = -8.0f * rr * sp;
                        const float a = __expf(la);
                        const float xc = XCF[row * 128 + chl];
                        const float bt = __builtin_amdgcn_sqrtf(fmaxf(1.0f - a * a, 0.f)) * (ii * xc);
                        if (smp) {
                            const float h = a * P.in[I_SLRU][(size_t)row * BW + chg] + bt;
                            out[O_HS + (size_t)row * BW + chg] = h;
                            const float rgv = bf2f(Z[(size_t)(MP + row) * NZ + 3072 + chg]);
                            YS[(size_t)(MP + row) * 3072 + 1024 + chg] = (bf16_t)(cvt_pk_bf16(rgv * h, 0.f) & 0xffffu);
                        } else {
                            AARR[row * 128 + chl] = a; XCF[row * 128 + chl] = bt;
                        }
                        if (j == 3) asm volatile("" ::: "memory");
                    }
            }
            __syncthreads();
            if (!smp) {
                {
                    LAS float* segA = (LAS float*)(lds + 131072); LAS float* segH = segA + 512;
                    const int seg = tid >> 7, chn = tid & 127;
                    float h = 0.f, pa = 1.f;
#pragma unroll 8
                    for (int i = 0; i < 32; ++i) { const int o = (32 * seg + i) * 128 + chn; const float a = AARR[o], b = XCF[o]; h = a * h + b; pa *= a; XCF[o] = h; AARR[o] = pa; }
                    segA[tid] = pa; segH[tid] = h;
                    __syncthreads();
                    float cA = 1.f, cH = 0.f;
                    for (int sg = 0; sg < seg; ++sg) { const float sa = segA[sg * 128 + chn]; cH = sa * cH + segH[sg * 128 + chn]; cA *= sa; }
                    if (seg > 0) {
#pragma unroll 8
                        for (int i = 0; i < 32; ++i) { const int o = (32 * seg + i) * 128 + chn; const float hl = XCF[o], pc = AARR[o]; XCF[o] = hl + pc * cH; AARR[o] = pc * cA; }
                    }
                    if (seg == 3) { SUM[(size_t)(c * 2 + 0) * BW + ch0 + chn] = pa * cA; SUM[(size_t)(c * 2 + 1) * BW + ch0 + chn] = h + pa * cH; }
                }
                __syncthreads();
#pragma unroll
                for (int i = 0; i < 8; ++i) { const int e = (i * 512 + tid) * 4, row = e >> 7, cc = e & 127;
                    *(f32x4*)(HL + (size_t)(r0 + row) * BW + ch0 + cc) = *(const LAS f32x4*)(XCF + e);
                    *(f32x4*)(AC + (size_t)(r0 + row) * BW + ch0 + cc) = *(const LAS f32x4*)(AARR + e); }
            }
            __syncthreads();
        }
    }
    if (PHON(7)) for (int it = bid; it < 256; it += G) {
        const int b = it >> 6, h = (it >> 4) & 3, qt = it & 15;
        int lane_o = lane; asm volatile("" : "+v"(lane_o));
        const int fr = lane_o & 15, fq = lane_o >> 4;
        const int row0 = b * SEQ + qt * 128 + wave * 16;
        bf16x8 qf[8];
#pragma unroll
        for (int ks = 0; ks < 8; ++ks) qf[ks] = *(const bf16x8*)(Z + (size_t)(row0 + fr) * NZ + 4096 + h * HD + ks * 32 + fq * 8);
        f32x4 s[16];
        LAS bf16_t* KL = (LAS bf16_t*)lds;
        __syncthreads();
        {
            const bf16_t* kb = KB + (size_t)(b * NMEM) * 1024 + h * HD;
            u32x4 t[16];
#pragma unroll
            for (int i = 0; i < 16; ++i) { const int e = tid + i * NTHREADS, m = e >> 5, c8 = (e & 31) * 8; t[i] = *(const u32x4*)(kb + (size_t)m * 1024 + c8); }
#pragma unroll
            for (int i = 0; i < 16; ++i) { const int e = tid + i * NTHREADS, m = e >> 5, c8 = (e & 31) * 8; *(LAS u32x4*)(KL + m * 264 + c8) = t[i]; }
        }
        asm volatile("" ::: "memory");
        u32x4 tv[16];
        {
            const bf16_t* vt0 = VT + (size_t)(h * HD) * 1024 + b * NMEM;
#pragma unroll
            for (int i = 0; i < 16; ++i) { const int e = tid + i * NTHREADS, dd = e >> 5, c8 = (e & 31) * 8; tv[i] = *(const u32x4*)(vt0 + (size_t)dd * 1024 + c8); }
        }
        __syncthreads();
#pragma unroll
        for (int mt = 0; mt < 16; ++mt) {
            s[mt] = (f32x4){0.f, 0.f, 0.f, 0.f};
#pragma unroll
            for (int ks = 0; ks < 8; ++ks) {
                const bf16x8 kf = *(const LAS bf16x8*)(KL + (mt * 16 + fr) * 264 + ks * 32 + fq * 8);
                s[mt] = __builtin_amdgcn_mfma_f32_16x16x32_bf16(kf, qf[ks], s[mt], 0, 0, 0);
            }
        }
        __syncthreads();
#pragma unroll
        for (int i = 0; i < 16; ++i) { const int e = tid + i * NTHREADS, dd = e >> 5, c8 = (e & 31) * 8; *(LAS u32x4*)(KL + dd * 264 + c8) = tv[i]; }
        float mx = -3.0e38f;
#pragma unroll
        for (int mt = 0; mt < 16; ++mt) mx = fmaxf(mx, fmaxf(fmaxf(s[mt][0], s[mt][1]), fmaxf(s[mt][2], s[mt][3])));
        mx = fmaxf(mx, __shfl_xor(mx, 16)); mx = fmaxf(mx, __shfl_xor(mx, 32));
        float sm = 0.f;
#pragma unroll
        for (int mt = 0; mt < 16; ++mt)
#pragma unroll
            for (int j = 0; j < 4; ++j) { const float p = __expf((s[mt][j] - mx) * 0.0625f); s[mt][j] = p; sm += p; }
        sm += __shfl_xor(sm, 16); sm += __shfl_xor(sm, 32);
        const float inv = 1.0f / sm;
        bf16x8 pf[8];
#pragma unroll
        for (int ks = 0; ks < 8; ++ks) {
            u32x4 w; w.x = cvt_pk_bf16(s[2 * ks][0], s[2 * ks][1]); w.y = cvt_pk_bf16(s[2 * ks][2], s[2 * ks][3]); w.z = cvt_pk_bf16(s[2 * ks + 1][0], s[2 * ks + 1][1]); w.w = cvt_pk_bf16(s[2 * ks + 1][2], s[2 * ks + 1][3]);
            pf[ks] = __builtin_bit_cast(bf16x8, w);
        }
        __syncthreads();
#pragma unroll 4
        for (int dt = 0; dt < 16; ++dt) {
            f32x4 o = (f32x4){0.f, 0.f, 0.f, 0.f};
#pragma unroll
            for (int ks = 0; ks < 8; ++ks) {
                const LAS bf16_t* vp = KL + (dt * 16 + fr) * 264 + ks * 32 + 4 * fq;
                const u32x2 lo = *(const LAS u32x2*)vp, hi = *(const LAS u32x2*)(vp + 16);
                const u32x4 w = (u32x4){lo.x, lo.y, hi.x, hi.y};
                o = __builtin_amdgcn_mfma_f32_16x16x32_bf16(__builtin_bit_cast(bf16x8, w), pf[ks], o, 0, 0, 0);
            }
            u32x2 w; w.x = cvt_pk_bf16(o[0] * inv, o[1] * inv); w.y = cvt_pk_bf16(o[2] * inv, o[3] * inv);
            *(u32x2*)(YS + (size_t)(row0 + fr) * 3072 + 2048 + h * HD + dt * 16 + 4 * fq) = w;
        }
    }
    if (!dfirst_ && PHON(8)) p5d_sample_attn(P, lds, bid, G, tid);
    GRID_BAR();

    if (PHON(9)) for (int it = bid; it < 256; it += G) {
        const int c = it >> 2, rq = it & 3, n = c & 15, cb = c & ~15;
        const int ch = 2 * tid;
        f32x2 carry = (f32x2){0.f, 0.f};
        {
            f32x2 pa[15], hh[15];
#pragma unroll
            for (int j = 0; j < 15; ++j) { pa[j] = (f32x2){1.f, 1.f}; hh[j] = (f32x2){0.f, 0.f};
                if (j < n) { pa[j] = *(const f32x2*)(SUM + (size_t)((cb + j) * 2 + 0) * BW + ch); hh[j] = *(const f32x2*)(SUM + (size_t)((cb + j) * 2 + 1) * BW + ch); } }
#pragma unroll
            for (int j = 0; j < 15; ++j) carry = pa[j] * carry + hh[j];
        }
#pragma unroll 8
        for (int i = 0; i < 32; ++i) {
            const int r = c * 128 + rq * 32 + i;
            const f32x2 hl = __builtin_nontemporal_load((const f32x2*)(HL + (size_t)r * BW + ch)), ac = __builtin_nontemporal_load((const f32x2*)(AC + (size_t)r * BW + ch));
            const f32x2 hv = hl + ac * carry;
            const unsigned rw = *(const unsigned*)(Z + (size_t)r * NZ + 3072 + ch);
            *(unsigned*)(YS + (size_t)r * 3072 + 1024 + ch) = cvt_pk_bf16(bflo(rw) * hv[0], bfhi(rw) * hv[1]);
            if (n == 15 && rq == 3 && i == 31) *(f32x2*)(out + O_HP + (size_t)(c >> 4) * BW + ch) = hv;
        }
    }
    if (PHON(10)) {
        LAS bf16_t* VL = (LAS bf16_t*)lds;
        for (int e = bid * NTHREADS + tid; e < MS * BW / 2; e += G * NTHREADS) {
            const int r = e / (BW / 2), c2 = (e % (BW / 2)) * 2, g = c2 >> 8;
            const float w00 = P.in[I_WS][(size_t)g * 128 * 128], b0 = P.in[I_BS][g * 128];
            const unsigned vw = *(const unsigned*)(VP + (size_t)(MP + r) * BW + c2), uw = *(const unsigned*)(Z + (size_t)(MP + r) * NZ + c2);
            *(unsigned*)(YS + (size_t)(MP + r) * 3072 + c2) = cvt_pk_bf16(bflo(uw) * (w00 * bflo(vw) + b0), bfhi(uw) * (w00 * bfhi(vw) + b0));
        }
        for (int it = bid; it < 256; it += G) {
            const int g = it & 3, cn = it >> 2;
            const int r0 = cn * 128;
            __syncthreads();
            {
                u32x4 vt8[8];
#pragma unroll
                for (int i = 0; i < 8; ++i) { const int e = tid + i * NTHREADS, s = e >> 5, c8 = (e & 31) * 8; vt8[i] = *(const u32x4*)(VP + (size_t)(r0 + s) * BW + g * 256 + c8); }
#pragma unroll
                for (int i = 0; i < 8; ++i) { const int e = tid + i * NTHREADS, s = e >> 5, c8 = (e & 31) * 8; *(LAS u32x4*)(VL + s * 264 + c8) = vt8[i]; }
            }
            __syncthreads();
            const int fr = lane & 15, fq = lane >> 4;
            bf16x8 vf[2][4];
#pragma unroll
            for (int ct = 0; ct < 2; ++ct)
#pragma unroll
                for (int ks = 0; ks < 4; ++ks) {
                    bf16x8 t;
#pragma unroll
                    for (int j = 0; j < 8; ++j) t[j] = (short)VL[(ks * 32 + fq * 8 + j) * 264 + (2 * wave + ct) * 16 + fr];
                    vf[ct][ks] = t;
                }
            const bf16_t* wsp = WSP + (size_t)g * 128 * 128;
            u32x2 uwp[8][2];
#pragma unroll
            for (int tt = 0; tt < 8; ++tt)
#pragma unroll
                for (int ct = 0; ct < 2; ++ct) uwp[tt][ct] = *(const u32x2*)(Z + (size_t)(r0 + tt * 16 + fr) * NZ + g * 256 + (2 * wave + ct) * 16 + 4 * fq);
#pragma unroll
            for (int tt = 0; tt < 8; ++tt) {
                f32x4 o0 = (f32x4){0.f, 0.f, 0.f, 0.f}, o1 = o0;
#pragma unroll
                for (int ks = 0; ks < 4; ++ks) {
                    const bf16x8 wf = *(const bf16x8*)(wsp + (size_t)(tt * 16 + fr) * 128 + ks * 32 + fq * 8);
                    o0 = __builtin_amdgcn_mfma_f32_16x16x32_bf16(vf[0][ks], wf, o0, 0, 0, 0);
                    o1 = __builtin_amdgcn_mfma_f32_16x16x32_bf16(vf[1][ks], wf, o1, 0, 0, 0);
                }
                if ((tt & 3) == 3) asm volatile("" ::: "memory");
                const int t = tt * 16 + fr; const float bs = P.in[I_BS][g * 128 + t];
                const size_t r = (size_t)(r0 + t);
#pragma unroll
                for (int ct = 0; ct < 2; ++ct) {
                    const f32x4 o = ct ? o1 : o0;
                    const int cc = g * 256 + (2 * wave + ct) * 16 + 4 * fq;
                    const u32x2 uw = uwp[tt][ct];
                    u32x2 w; w.x = cvt_pk_bf16(bflo(uw.x) * (o[0] + bs), bfhi(uw.x) * (o[1] + bs)); w.y = cvt_pk_bf16(bflo(uw.y) * (o[2] + bs), bfhi(uw.y) * (o[3] + bs));
                    *(u32x2*)(YS + r * 3072 + cc) = w;
                }
            }
        }
        __syncthreads();
    }
    GRID_BAR();

    if (PHON(11)) {
        skinny<1>(lds, bid, G, wave, lane, YS + (size_t)MP * 3 * BW, 3 * BW, WBR, BW, BW, nullptr, nullptr, 0.f, 0.f, Z + (size_t)MP * NZ, XB + (size_t)MP * D);
        pg8::BranchSched S{YS, WBR, G, bid};
        pg8::EpiMerge E{Z, XB};
        pg8::gemm_phase<pg8::BranchSched, pg8::EpiMerge, true, true>(lds, BW, 3 * BW, BW, S, E);
    }
    GRID_BAR();
    if (PHON(12)) {
        skinny<0>(lds, bid, G, wave, lane, XB + (size_t)MP * D, D, WOUT, D, D, Y + (size_t)MP * D, X1 + (size_t)MP * D, ALPHA, 1.0f, nullptr, nullptr);
        pg8::PlainSched S{XB, WOUT, 32, 8, D, D, G, bid};
        pg8::EpiResid E{Y, X1, ALPHA, 1.0f, false};
        pg8::gemm_phase<pg8::PlainSched, pg8::EpiResid, true, true>(lds, D, D, D, S, E);
    }
    GRID_BAR();
    if (PHON(13)) for (int r = gw; r < MR; r += NGW) ln_row(Y + (size_t)r * D, P.in[I_LN2G], P.in[I_LN2B], X1 + (size_t)r * D, XB + (size_t)r * D, lane);
    GRID_BAR();
    if (PHON(14)) {
        pg8::PlainSched S{XB, WGU2, 33, 44, D, D, G, bid};
        pg8::EpiSwiglu E{H, FF};
        pg8::gemm_phase<pg8::PlainSched, pg8::EpiSwiglu, true, true>(lds, D, D, D, S, E);
    }
    GRID_BAR();
    if (PHON(15)) {
        skinny<0>(lds, bid, G, wave, lane, H + (size_t)MP * FF, FF, WD2, FF, FF, Y + (size_t)MP * D, X1 + (size_t)MP * D, ALPHA, 0.5f, nullptr, nullptr);
        pg8::PlainSched S{H, WD2, 32, 8, FF, FF, G, bid};
        pg8::EpiResid E{Y, X1, ALPHA, 0.5f, false};
        pg8::gemm_phase<pg8::PlainSched, pg8::EpiResid, true, true>(lds, FF, FF, FF, S, E);
    }
    GRID_BAR();
    if (PHON(16)) for (int r = gw; r < MR; r += NGW) ln_row(Y + (size_t)r * D, P.in[I_LN3G], P.in[I_LN3B], out + O_Y + (size_t)r * D, nullptr, lane);
}

extern "C" void kernel_launch(void* const* d_in, const int* in_sizes, int n_in, void* d_out, int out_size, void* d_ws, size_t ws_size, hipStream_t stream) {
    static int grid = 0;
    if (grid == 0) {
        if (n_in != 35 || (size_t)out_size != O_END || ws_size < WS_END) { fprintf(stderr, "kernel_launch: unexpected shapes: n_in %d out %d (want %zu) ws %zu (need %zu)\n", n_in, out_size, (size_t)O_END, ws_size, (size_t)WS_END); grid = -1; return; }
        int dev = 0, cus = 0, per_cu = 0;
        hipGetDevice(&dev);
        hipDeviceGetAttribute(&cus, hipDeviceAttributeMultiprocessorCount, dev);
        hipFuncSetAttribute((const void*)fwd_kernel, hipFuncAttributeMaxDynamicSharedMemorySize, LDS_BYTES);
        hipOccupancyMaxActiveBlocksPerMultiprocessor(&per_cu, (const void*)fwd_kernel, NTHREADS, LDS_BYTES);
        if (per_cu < 1) { fprintf(stderr, "kernel_launch: occupancy query says %d blocks/CU\n", per_cu); per_cu = 1; }
        (void)hipGetLastError();
        grid = cus;
    }
    if (grid < 0) return;
    Params p{};
    for (int i = 0; i < 35; ++i) p.in[i] = (const float*)d_in[i];
    p.out = (float*)d_out; p.ws = (unsigned char*)d_ws;
    (void)hipMemsetAsync((char*)d_ws + WS_BAR, 0, (size_t)XCD_BAR_WORDS_ * 4, stream);
    void* args[] = {&p};
    hipError_t e = hipLaunchCooperativeKernel((const void*)fwd_kernel, dim3(grid), dim3(NTHREADS), args, LDS_BYTES, stream);
    if (e != hipSuccess) fprintf(stderr, "cooperative launch failed: %s (grid %d)\n", hipGetErrorString(e), grid);
}
```

```cpp
#include <hip/hip_runtime.h>
#include <hip/hip_cooperative_groups.h>
#include <cstdio>
#include <cstdint>
namespace cg = cooperative_groups;

#define LAS __attribute__((address_space(3)))
typedef unsigned short bf16_t;
typedef short bf16x8 __attribute__((ext_vector_type(8)));
typedef short bf16x4 __attribute__((ext_vector_type(4)));
typedef float f32x4 __attribute__((ext_vector_type(4)));
typedef float f32x2 __attribute__((ext_vector_type(2)));
typedef unsigned u32x4 __attribute__((ext_vector_type(4)));
typedef unsigned u32x2 __attribute__((ext_vector_type(2)));

constexpr int D = 2048, FF = 5632, BW = 1024, NZ = 11264;
constexpr int MP = 8192, MS = 128, MR = MP + MS, MPAD = 8448;
constexpr int SEQ = 2048, NB = 4, NMEM = 256, NH = 4, HD = 256;
constexpr float LN_EPS = 1e-5f;
constexpr float ALPHA = 1.189207115002721f;
constexpr int NTHREADS = 512, NWAVES = 8;

constexpr int XCD_BAR_WORDS_ = 3456;
constexpr size_t al256(size_t x) { return (x + 255) & ~(size_t)255; }
constexpr size_t WS_WGU1 = 0;
constexpr size_t WS_WD1 = WS_WGU1 + al256((size_t)NZ * D * 2);
constexpr size_t WS_WIN = WS_WD1 + al256((size_t)D * FF * 2);
constexpr size_t WS_WKV = WS_WIN + al256((size_t)NZ * D * 2);
constexpr size_t WS_WBR = WS_WKV + al256((size_t)D * D * 2);
constexpr size_t WS_WOUT = WS_WBR + al256((size_t)3 * D * BW * 2);
constexpr size_t WS_WGU2 = WS_WOUT + al256((size_t)D * D * 2);
constexpr size_t WS_WD2 = WS_WGU2 + al256((size_t)NZ * D * 2);
constexpr size_t WS_WLRU = WS_WD2 + al256((size_t)D * FF * 2);
constexpr size_t WS_WSP = WS_WLRU + al256((size_t)8 * 256 * 128 * 2);
constexpr size_t WS_XB = WS_WSP + al256((size_t)4 * 128 * 128 * 2);
constexpr size_t WS_ZH = WS_XB + al256((size_t)MPAD * D * 2);
constexpr size_t WS_Y = WS_ZH + al256((size_t)MPAD * NZ * 2);
constexpr size_t WS_X1 = WS_Y + al256((size_t)MPAD * D * 4);
constexpr size_t WS_VP = WS_X1 + al256((size_t)MPAD * D * 4);
constexpr size_t WS_HL = WS_VP + al256((size_t)MPAD * BW * 2);
constexpr size_t WS_AC = WS_HL + al256((size_t)MP * BW * 4);
constexpr size_t WS_SUM = WS_AC + al256((size_t)MP * BW * 4);
constexpr size_t WS_YS = WS_SUM + al256((size_t)64 * 2 * BW * 4);
constexpr size_t WS_MEMLN = WS_YS + al256((size_t)MPAD * 3 * BW * 2);
constexpr size_t WS_KB = WS_MEMLN + al256((size_t)1024 * D * 2);
constexpr size_t WS_VT = WS_KB + al256((size_t)1024 * 1024 * 2);
constexpr size_t WS_BAR = WS_VT + al256((size_t)1024 * 1024 * 2);
constexpr size_t WS_CS = WS_BAR + al256((size_t)XCD_BAR_WORDS_ * 4);
constexpr size_t WS_RS = WS_CS + al256((size_t)2 * 2 * NZ * 4);
constexpr size_t WS_END = WS_RS + al256((size_t)2 * MPAD * 2 * 4);

constexpr size_t O_Y = 0;
constexpr size_t O_MK = (size_t)MR * D;
constexpr size_t O_MV = O_MK + (size_t)1024 * 1024;
constexpr size_t O_CP = O_MV + (size_t)1024 * 1024;
constexpr size_t O_HP = O_CP + (size_t)4 * 3 * 1024;
constexpr size_t O_CS = O_HP + (size_t)4 * 1024;
constexpr size_t O_HS = O_CS + (size_t)128 * 3 * 1024;
constexpr size_t O_VS = O_HS + (size_t)128 * 1024;
constexpr size_t O_END = O_VS + (size_t)128 * 1024;

constexpr int LDS_BYTES = 159744;

struct Params { const float* in[35]; float* out; unsigned char* ws; };
enum { I_XP = 0, I_XS, I_MEM, I_CK, I_CV, I_SCONV, I_SLRU, I_GU1, I_DN1, I_LN1G, I_LN1B, I_WIN, I_GATEB, I_GLNG, I_GLNB, I_WS, I_BS, I_CONVW, I_CONVB,
       I_LWA, I_LBA, I_LWX, I_LBX, I_LAM, I_MLNG, I_MLNB, I_WKV, I_WBR, I_WOUT, I_LN2G, I_LN2B, I_GU2, I_DN2, I_LN3G, I_LN3B };

__device__ __forceinline__ unsigned cvt_pk_bf16(float lo, float hi) { unsigned r; asm volatile("v_cvt_pk_bf16_f32 %0, %1, %2" : "=v"(r) : "v"(lo), "v"(hi)); return r; }
__device__ __forceinline__ float bf2f(unsigned short b) { return __uint_as_float(((unsigned)b) << 16); }
__device__ __forceinline__ float bflo(unsigned w) { return __uint_as_float(w << 16); }
__device__ __forceinline__ float bfhi(unsigned w) { return __uint_as_float(w & 0xffff0000u); }
__device__ __forceinline__ float sigmoidf_(float x) { return __builtin_amdgcn_rcpf(1.0f + __expf(-x)); }
__device__ __forceinline__ float siluf_(float x) { return x * sigmoidf_(x); }
__device__ __forceinline__ float gelu_tanh(float x) { return x * sigmoidf_(1.5957691216057308f * (x + 0.044715f * x * x * x)); }
__device__ __forceinline__ f32x2 ln_stats(f32x2 sm) { const float mu = sm[0] * (1.f / D); const float var = fmaxf(sm[1] * (1.f / D) - mu * mu, 0.f); return (f32x2){mu, 1.0f / sqrtf(var + LN_EPS)}; }
__device__ __forceinline__ float wave_sum(float v) {
#pragma unroll
    for (int o = 1; o < 64; o <<= 1) v += __shfl_xor(v, o);
    return v;
}
__device__ __forceinline__ float wave_max(float v) {
#pragma unroll
    for (int o = 1; o < 64; o <<= 1) v = fmaxf(v, __shfl_xor(v, o));
    return v;
}

namespace pg8 {
constexpr int BM = 256, BK = 64, HALF = 128, HTB = HALF * BK * 2, STAGE_BYTES = 8 * HTB, NXCD = 8, WGM = 8;
__host__ __device__ __forceinline__ int lds_byte(int r, int c) { const int st = (r >> 4) * 2 + (c >> 5), rr = r & 15, cc = c & 31, ob = rr * 64 + cc * 2; return st * 1024 + (ob ^ (((ob >> 9) & 1) << 5)); }
__host__ __device__ __forceinline__ void stage_rc(int b, int& R, int& C) { const int st = b / 1024, sb = b % 1024, swz = sb ^ (((sb >> 9) & 1) << 5); R = (st >> 1) * 16 + swz / 64; C = (st & 1) * 32 + (swz % 64) / 2; }
__host__ __device__ __forceinline__ int perm32(int rho) { const int n = rho >> 4, i = rho & 15; return 8 * (i >> 2) + 4 * n + (i & 3); }

struct Unit { const char* A; const char* B; int pm, pn, kind; };

__device__ __forceinline__ void tile_of(int wgid, int nM, int nN, int& pm, int& pn) {
    const int nwg = nM * nN;
    { const int q = nwg / NXCD, r = nwg % NXCD, xcd = wgid % NXCD, off = wgid / NXCD; wgid = (xcd < r ? xcd * (q + 1) : r * (q + 1) + (xcd - r) * q) + off; }
    const int nig = WGM * nN, gid = wgid / nig, fm = gid * WGM, gsz = (nM - fm) < WGM ? (nM - fm) : WGM;
    pm = fm + ((wgid % nig) % gsz); pn = (wgid % nig) / gsz;
}
struct PlainSched {
    const bf16_t* A; const bf16_t* Bt; int nM, nN, lda, ldb, G, c;
    __device__ __forceinline__ bool next(int i, Unit& u) const {
        const int L = i * G + c; if (L >= nM * nN) return false;
        tile_of(L, nM, nN, u.pm, u.pn); u.kind = 0;
        u.A = (const char*)(A + (size_t)u.pm * BM * lda); u.B = (const char*)(Bt + (size_t)u.pn * BM * ldb); return true;
    }
};
struct WinSched {
    const bf16_t* XB_; const bf16_t* WIN_; const bf16_t* MEMLN_; const bf16_t* WKV_; int G, c;
    __device__ __forceinline__ bool next(int i, Unit& u) const {
        const int L = i * G + c; constexpr int NZU = 33 * 44;
        if (L < NZU) { tile_of(L, 33, 44, u.pm, u.pn); u.kind = 0; u.A = (const char*)(XB_ + (size_t)u.pm * BM * D); u.B = (const char*)(WIN_ + (size_t)u.pn * BM * D); return true; }
        if (L < NZU + 32) { const int j = L - NZU; u.pm = j >> 3; u.pn = j & 7; u.kind = 1; u.A = (const char*)(MEMLN_ + (size_t)u.pm * BM * D); u.B = (const char*)(WKV_ + (size_t)u.pn * BM * D); return true; }
        if (L < NZU + 48) { const int j = L - NZU - 32; u.pm = j >> 2; u.pn = j & 3; u.kind = 2; u.A = (const char*)(WKV_ + (size_t)(1024 + u.pm * BM) * D); u.B = (const char*)(MEMLN_ + (size_t)u.pn * BM * D); return true; }
        return false;
    }
};
struct BranchSched {
    const bf16_t* YS_; const bf16_t* WBR_; int G, c;
    __device__ __forceinline__ bool next(int i, Unit& u) const {
        const int t = (i / 3) * G + c, k = i % 3; if (t >= 256) return false;
        tile_of(t, 32, 8, u.pm, u.pn); u.kind = k;
        u.A = (const char*)(YS_ + (size_t)u.pm * BM * (3 * BW) + k * BW); u.B = (const char*)(WBR_ + (size_t)k * D * BW + (size_t)u.pn * BM * BW); return true;
    }
};

template <class Sched, class Epi, bool ALIGN_EPI, bool SP2>
__device__ __forceinline__ void gemm_phase(LAS unsigned char* lds, const int K, const int lda, const int ldb, const Sched& S, const Epi& E) {
    int tid = threadIdx.x; asm volatile("" : "+v"(tid));
    const int wid = __builtin_amdgcn_readfirstlane(tid >> 6), lane = tid & 63, wr = wid >> 2, wc = wid & 3, fr = lane & 15, fq = lane >> 4;
    const int nt = K / BK;
    unsigned voffA[2], voffB[2];
#pragma unroll
    for (int i = 0; i < 2; ++i) { int R, C; stage_rc(tid * 16 + i * 8192, R, C); const int Rb = Epi::PERM ? ((R & ~31) + perm32(R & 31)) : R;
        voffA[i] = (unsigned)(R * lda + C) * 2u; voffB[i] = (unsigned)(Rb * ldb + C) * 2u; }
    const size_t kstep = (size_t)(BK * 2);
    const size_t hstepA = (size_t)HALF * lda * 2, hstepB = (size_t)HALF * ldb * 2;
    const unsigned ldsw = (unsigned)wid * 1024u;
    const int aoff = lds_byte(wr * 64 + fr, fq * 8), boff = lds_byte(wc * 32 + fr, fq * 8);
#define PG8_SA(b, h) (((b) * 2 + (h)) * HTB)
#define PG8_SB(b, h) ((4 + (b) * 2 + (h)) * HTB)
#define PG8_STAGE(bufoff, gbase, voff) do { _Pragma("unroll") for (int _i = 0; _i < 2; ++_i) \
        __builtin_amdgcn_global_load_lds((const unsigned*)((const char*)(gbase) + (voff)[_i]), (LAS unsigned*)(lds + (bufoff) + ldsw + _i * 8192), 16, 0, 0); } while (0)
#define PG8_LDA(dst, b, h) do { _Pragma("unroll") for (int m = 0; m < 4; ++m) _Pragma("unroll") for (int k = 0; k < 2; ++k) dst[m][k] = *(const LAS bf16x8*)(lds + PG8_SA(b, h) + aoff + m * 2048 + k * 1024); } while (0)
#define PG8_LDB(dst, b, h) do { _Pragma("unroll") for (int n = 0; n < 2; ++n) _Pragma("unroll") for (int k = 0; k < 2; ++k) dst[n][k] = *(const LAS bf16x8*)(lds + PG8_SB(b, h) + boff + n * 2048 + k * 1024); } while (0)
#define PG8_MMA(ai, bj, At, Bt) do { __builtin_amdgcn_s_setprio(1); _Pragma("unroll") for (int m = 0; m < 4; ++m) _Pragma("unroll") for (int n = 0; n < 2; ++n) _Pragma("unroll") for (int k = 0; k < 2; ++k) \
        acc[ai][bj][m][n] = __builtin_amdgcn_mfma_f32_16x16x32_bf16(Bt[n][k], At[m][k], acc[ai][bj][m][n], 0, 0, 0); __builtin_amdgcn_s_setprio(0); } while (0)
#define PG8_WAIT_V(n) asm volatile("s_waitcnt vmcnt(" #n ")" ::: "memory")
#define PG8_WAIT_L(n) asm volatile("s_waitcnt lgkmcnt(" #n ")" ::: "memory")
#define PG8_BAR __builtin_amdgcn_s_barrier()
#define PG8_SCHED __builtin_amdgcn_sched_barrier(0)
    Unit cur, nxt; int ui = 0;
    if (!S.next(0, cur)) return;
    f32x4 acc[2][2][4][2];
#pragma unroll
    for (int a = 0; a < 2; ++a)
#pragma unroll
        for (int b = 0; b < 2; ++b)
#pragma unroll
            for (int m = 0; m < 4; ++m)
#pragma unroll
                for (int n = 0; n < 2; ++n) acc[a][b][m][n] = (f32x4){0.f, 0.f, 0.f, 0.f};
    bf16x8 At[4][2], B0[2][2], B1[2][2];
    const char* cA = cur.A; const char* cB = cur.B;
    if constexpr (SP2) {
        PG8_STAGE(PG8_SB(0, 0), cB, voffB); PG8_STAGE(PG8_SB(0, 1), cB + hstepB, voffB); PG8_STAGE(PG8_SA(0, 0), cA, voffA); PG8_STAGE(PG8_SA(0, 1), cA + hstepA, voffA);
        if (wr == 1) PG8_BAR;
        PG8_WAIT_V(2); PG8_BAR;
        PG8_STAGE(PG8_SB(1, 0), cB + kstep, voffB); PG8_STAGE(PG8_SA(1, 0), cA + kstep, voffA); PG8_STAGE(PG8_SB(1, 1), cB + hstepB + kstep, voffB);
        PG8_WAIT_V(6); PG8_BAR;
    } else {
        PG8_STAGE(PG8_SB(0, 0), cB, voffB); PG8_STAGE(PG8_SA(0, 0), cA, voffA); PG8_STAGE(PG8_SB(0, 1), cB + hstepB, voffB); PG8_STAGE(PG8_SA(0, 1), cA + hstepA, voffA);
        if (wr == 1) PG8_BAR;
        PG8_WAIT_V(4); PG8_BAR;
        PG8_STAGE(PG8_SB(1, 0), cB + kstep, voffB); PG8_STAGE(PG8_SA(1, 0), cA + kstep, voffA); PG8_STAGE(PG8_SB(1, 1), cB + hstepB + kstep, voffB);
        PG8_WAIT_V(6); PG8_BAR;
    }
    for (;;) {
        const bool has_next = S.next(ui + 1, nxt);
        const char* nA = has_next ? nxt.A : cA; const char* nB = has_next ? nxt.B : cB;
        for (int t = 0; t < nt; t += 2) {
            const bool last = (t == nt - 2);
            const char* a1 = cA + (size_t)(t + 1) * kstep;
            const char* a2 = last ? nA : cA + (size_t)(t + 2) * kstep; const char* b2 = last ? nB : cB + (size_t)(t + 2) * kstep;
            const char* a3 = a2 + kstep; const char* b3 = b2 + kstep;
            if constexpr (SP2) {
            PG8_LDB(B0, 0, 0); PG8_LDB(B1, 0, 1); PG8_SCHED; PG8_LDA(At, 0, 0); PG8_STAGE(PG8_SA(1, 1), a1 + hstepA, voffA);
            PG8_WAIT_V(8); PG8_WAIT_L(0); PG8_BAR; PG8_MMA(0, 0, At, B0); PG8_MMA(0, 1, At, B1); PG8_BAR; PG8_SCHED;
            PG8_LDA(At, 0, 1); PG8_STAGE(PG8_SB(0, 0), b2, voffB); PG8_STAGE(PG8_SB(0, 1), b2 + hstepB, voffB); PG8_STAGE(PG8_SA(0, 0), a2, voffA);
            PG8_WAIT_V(8); PG8_WAIT_L(0); PG8_BAR; PG8_MMA(1, 0, At, B0); PG8_MMA(1, 1, At, B1); PG8_BAR; PG8_SCHED;
            PG8_LDB(B0, 1, 0); PG8_LDB(B1, 1, 1); PG8_SCHED; PG8_LDA(At, 1, 0); PG8_STAGE(PG8_SA(0, 1), a2 + hstepA, voffA);
            PG8_WAIT_V(8); PG8_WAIT_L(0); PG8_BAR; PG8_MMA(0, 0, At, B0); PG8_MMA(0, 1, At, B1); PG8_BAR; PG8_SCHED;
            PG8_LDA(At, 1, 1); PG8_STAGE(PG8_SB(1, 0), b3, voffB); PG8_STAGE(PG8_SB(1, 1), b3 + hstepB, voffB); PG8_STAGE(PG8_SA(1, 0), a3, voffA);
            PG8_WAIT_V(8); PG8_WAIT_L(0); PG8_BAR; PG8_MMA(1, 0, At, B0); PG8_MMA(1, 1, At, B1); PG8_BAR; PG8_SCHED;
            } else {
            PG8_LDB(B0, 0, 0); PG8_SCHED; PG8_LDA(At, 0, 0); PG8_STAGE(PG8_SA(1, 1), a1 + hstepA, voffA);
            PG8_WAIT_L(8); PG8_BAR; PG8_WAIT_L(0); PG8_MMA(0, 0, At, B0); PG8_BAR; PG8_SCHED;
            PG8_LDB(B1, 0, 1); PG8_STAGE(PG8_SB(0, 0), b2, voffB);
            PG8_BAR; PG8_WAIT_L(0); PG8_MMA(0, 1, At, B1); PG8_BAR;
            PG8_LDA(At, 0, 1); PG8_STAGE(PG8_SA(0, 0), a2, voffA);
            PG8_BAR; PG8_WAIT_L(0); PG8_MMA(1, 0, At, B0); PG8_BAR; PG8_SCHED;
            PG8_STAGE(PG8_SB(0, 1), b2 + hstepB, voffB);
            PG8_WAIT_V(6); PG8_BAR; PG8_MMA(1, 1, At, B1); PG8_BAR;
            PG8_LDB(B0, 1, 0); PG8_SCHED; PG8_LDA(At, 1, 0); PG8_STAGE(PG8_SA(0, 1), a2 + hstepA, voffA);
            PG8_WAIT_L(8); PG8_BAR; PG8_WAIT_L(0); PG8_MMA(0, 0, At, B0); PG8_BAR; PG8_SCHED;
            PG8_LDB(B1, 1, 1); PG8_STAGE(PG8_SB(1, 0), b3, voffB);
            PG8_BAR; PG8_WAIT_L(0); PG8_MMA(0, 1, At, B1); PG8_BAR;
            PG8_LDA(At, 1, 1); PG8_STAGE(PG8_SA(1, 0), a3, voffA);
            PG8_BAR; PG8_WAIT_L(0); PG8_MMA(1, 0, At, B0); PG8_BAR; PG8_SCHED;
            PG8_STAGE(PG8_SB(1, 1), b3 + hstepB, voffB);
            PG8_WAIT_V(6); PG8_BAR; PG8_MMA(1, 1, At, B1); PG8_BAR;
            }
        }
        if constexpr (ALIGN_EPI) { if (wr == 0) PG8_BAR; }
        E(acc, cur, wr, wc, fr, fq);
        if (!has_next) break;
        bool keep = false;
        if constexpr (Epi::CAN_KEEP) keep = (cur.kind < 2);
        if (!keep) {
#pragma unroll
        for (int a = 0; a < 2; ++a)
#pragma unroll
            for (int b = 0; b < 2; ++b)
#pragma unroll
                for (int m = 0; m < 4; ++m)
#pragma unroll
                    for (int n = 0; n < 2; ++n) acc[a][b][m][n] = (f32x4){0.f, 0.f, 0.f, 0.f};
        }
        cur = nxt; cA = nA; cB = nB; ++ui;
        if constexpr (ALIGN_EPI) { if (wr == 1) PG8_BAR; }
    }
    PG8_WAIT_V(0);
    if constexpr (!ALIGN_EPI) { if (wr == 0) PG8_BAR; }
    PG8_BAR;
#undef PG8_SA
#undef PG8_SB
#undef PG8_STAGE
#undef PG8_LDA
#undef PG8_LDB
#undef PG8_MMA
#undef PG8_WAIT_V
#undef PG8_WAIT_L
#undef PG8_BAR
#undef PG8_SCHED
}


struct EpiSwiglu {
    static constexpr bool PERM = true, CAN_KEEP = false;
    bf16_t* H; int ldh;
    const float* rsum; const float* cs;
    __device__ __forceinline__ void operator()(const f32x4 (&acc)[2][2][4][2], const Unit& u, int wr, int wc, int fr, int fq) const {
        const int row0 = u.pm * BM + wr * 64 + fr, col0 = u.pn * HALF + wc * 32 + 8 * fq;
        f32x4 s1[2][2], s2[2][2];
#pragma unroll
        for (int bj = 0; bj < 2; ++bj)
#pragma unroll
            for (int n = 0; n < 2; ++n) { s1[bj][n] = (f32x4){0.f, 0.f, 0.f, 0.f}; s2[bj][n] = s1[bj][n];
                if (rsum) { const int ci = u.pn * BM + bj * HALF + wc * 32 + 8 * fq + 4 * n; s1[bj][n] = *(const f32x4*)(cs + ci); s2[bj][n] = *(const f32x4*)(cs + NZ + ci); } }
#pragma unroll
        for (int ai = 0; ai < 2; ++ai)
#pragma unroll
            for (int m = 0; m < 4; ++m) {
                const int r = row0 + ai * HALF + m * 16;
                bf16_t* rowp = H + (size_t)r * ldh + col0;
                f32x2 st = (f32x2){0.f, 1.f};
                if (rsum) st = ln_stats(*(const f32x2*)(rsum + 2 * (size_t)r));
                f32x4 v0, v1;
#pragma unroll
                for (int j = 0; j < 4; ++j) {
                    const float g0 = st[1] * (acc[ai][0][m][0][j] - st[0] * s1[0][0][j]) + s2[0][0][j], u0 = st[1] * (acc[ai][1][m][0][j] - st[0] * s1[1][0][j]) + s2[1][0][j];
                    const float g1 = st[1] * (acc[ai][0][m][1][j] - st[0] * s1[0][1][j]) + s2[0][1][j], u1 = st[1] * (acc[ai][1][m][1][j] - st[0] * s1[1][1][j]) + s2[1][1][j];
                    v0[j] = siluf_(g0) * u0; v1[j] = siluf_(g1) * u1;
                }
                u32x4 w; w.x = cvt_pk_bf16(v0[0], v0[1]); w.y = cvt_pk_bf16(v0[2], v0[3]); w.z = cvt_pk_bf16(v1[0], v1[1]); w.w = cvt_pk_bf16(v1[2], v1[3]);
                *(u32x4*)rowp = w;
            }
    }
};
struct EpiResid {
    static constexpr bool PERM = false, CAN_KEEP = false;
    float* Y; const float* res; const float* rin; const float* lg; const float* lb; float alpha, scale; bf16_t* yb; float* rout; bool stream;
    __device__ __forceinline__ void operator()(const f32x4 (&acc)[2][2][4][2], const Unit& u, int wr, int wc, int fr, int fq) const {
        const int row0 = u.pm * BM + wr * 64 + fr, col0 = u.pn * BM + wc * 32 + 4 * fq;
        f32x4 gg[2][2], bb[2][2];
#pragma unroll
        for (int bj = 0; bj < 2; ++bj)
#pragma unroll
            for (int n = 0; n < 2; ++n) { gg[bj][n] = (f32x4){1.f, 1.f, 1.f, 1.f}; bb[bj][n] = (f32x4){0.f, 0.f, 0.f, 0.f};
                if (rin) { gg[bj][n] = *(const f32x4*)(lg + col0 + bj * HALF + n * 16); bb[bj][n] = *(const f32x4*)(lb + col0 + bj * HALF + n * 16); } }
#pragma unroll
        for (int ai = 0; ai < 2; ++ai)
#pragma unroll
            for (int m2 = 0; m2 < 2; ++m2) {
                f32x4 xv[2][2][2]; f32x2 st[2];
#pragma unroll
                for (int mm = 0; mm < 2; ++mm) {
                    const int r = row0 + ai * HALF + (2 * m2 + mm) * 16;
                    st[mm] = (f32x2){0.f, 1.f};
                    if (rin) st[mm] = ln_stats(*(const f32x2*)(rin + 2 * (size_t)r));
#pragma unroll
                    for (int bj = 0; bj < 2; ++bj)
#pragma unroll
                        for (int n = 0; n < 2; ++n) { const f32x4* rp = (const f32x4*)(res + (size_t)r * D + col0 + bj * HALF + n * 16); xv[mm][bj][n] = stream ? __builtin_nontemporal_load(rp) : *rp; }
                }
#pragma unroll
                for (int mm = 0; mm < 2; ++mm) {
                    const int r = row0 + ai * HALF + (2 * m2 + mm) * 16;
                    float ps = 0.f, pq = 0.f;
#pragma unroll
                    for (int bj = 0; bj < 2; ++bj)
#pragma unroll
                        for (int n = 0; n < 2; ++n) {
                            const f32x4 x = (xv[mm][bj][n] - st[mm][0]) * (gg[bj][n] * st[mm][1]) + bb[bj][n];
                            const f32x4 o = x * alpha + acc[ai][bj][2 * m2 + mm][n] * scale;
                            const size_t off = (size_t)r * D + col0 + bj * HALF + n * 16;
                            *(f32x4*)(Y + off) = o;
                            if (yb) { u32x2 w; w.x = cvt_pk_bf16(o[0], o[1]); w.y = cvt_pk_bf16(o[2], o[3]); *(u32x2*)(yb + off) = w; }
                            ps += (o[0] + o[1]) + (o[2] + o[3]); pq += (o[0] * o[0] + o[1] * o[1]) + (o[2] * o[2] + o[3] * o[3]);
                        }
                    if (rout) {
                        ps += __shfl_xor(ps, 16); pq += __shfl_xor(pq, 16); ps += __shfl_xor(ps, 32); pq += __shfl_xor(pq, 32);
                        if (fq == 0) { atomicAdd(rout + 2 * (size_t)r, ps); atomicAdd(rout + 2 * (size_t)r + 1, pq); }
                    }
                }
            }
    }
};
struct EpiWin {
    static constexpr bool PERM = true, CAN_KEEP = false;
    bf16_t* Z; const LAS float* gate_b; float* outK; float* outV; bf16_t* KB; bf16_t* VT; const float* rsum; const float* cs;
    __device__ __forceinline__ void operator()(const f32x4 (&acc)[2][2][4][2], const Unit& u, int wr, int wc, int fr, int fq) const {
        const int row0 = u.pm * BM + wr * 64 + fr, col0 = u.pn * BM + wc * 32 + 8 * fq;
        if (u.kind == 0) {
            const int mode = (u.pn < 8) ? 1 : (u.pn < 12) ? 0 : (u.pn < 16) ? 1 : (u.pn < 20) ? 0 : 2;
            f32x4 gb[2][2];
#pragma unroll
            for (int bj = 0; bj < 2; ++bj)
#pragma unroll
                for (int n = 0; n < 2; ++n) gb[bj][n] = (mode == 2) ? *(const LAS f32x4*)(gate_b + (col0 - 5120) + bj * HALF + 4 * n) : (f32x4){0.f, 0.f, 0.f, 0.f};
            f32x4 s1[2][2], s2[2][2];
#pragma unroll
            for (int bj = 0; bj < 2; ++bj)
#pragma unroll
                for (int n = 0; n < 2; ++n) { s1[bj][n] = *(const f32x4*)(cs + col0 + bj * HALF + 4 * n); s2[bj][n] = *(const f32x4*)(cs + NZ + col0 + bj * HALF + 4 * n); }
#pragma unroll
            for (int ai = 0; ai < 2; ++ai)
#pragma unroll
                for (int m = 0; m < 4; ++m) {
                    const int r = row0 + ai * HALF + m * 16;
                    bf16_t* rowp = Z + (size_t)r * NZ + col0;
                    const f32x2 st = ln_stats(*(const f32x2*)(rsum + 2 * (size_t)r));
#pragma unroll
                    for (int bj = 0; bj < 2; ++bj) {
                        f32x4 v0 = (acc[ai][bj][m][0] - s1[bj][0] * st[0]) * st[1] + s2[bj][0], v1 = (acc[ai][bj][m][1] - s1[bj][1] * st[0]) * st[1] + s2[bj][1];
                        if (mode == 1) {
#pragma unroll
                            for (int j = 0; j < 4; ++j) { v0[j] = gelu_tanh(v0[j]); v1[j] = gelu_tanh(v1[j]); }
                        } else if (mode == 2) {
#pragma unroll
                            for (int j = 0; j < 4; ++j) { v0[j] = sigmoidf_(v0[j] + gb[bj][0][j]); v1[j] = sigmoidf_(v1[j] + gb[bj][1][j]); }
                        }
                        u32x4 w; w.x = cvt_pk_bf16(v0[0], v0[1]); w.y = cvt_pk_bf16(v0[2], v0[3]); w.z = cvt_pk_bf16(v1[0], v1[1]); w.w = cvt_pk_bf16(v1[2], v1[3]);
                        *(u32x4*)(rowp + bj * HALF) = w;
                    }
                }
        } else if (u.kind == 1) {
            const bool isk = u.pn < 4; const int c0 = col0 - (isk ? 0 : 1024);
            float* ob = isk ? outK : outV;
#pragma unroll
            for (int ai = 0; ai < 2; ++ai)
#pragma unroll
                for (int m = 0; m < 4; ++m) {
                    const size_t off = (size_t)(row0 + ai * HALF + m * 16) * 1024 + c0;
#pragma unroll
                    for (int bj = 0; bj < 2; ++bj) {
                        const f32x4 v0 = acc[ai][bj][m][0], v1 = acc[ai][bj][m][1];
                        __builtin_nontemporal_store(v0, (f32x4*)(ob + off + bj * HALF)); __builtin_nontemporal_store(v1, (f32x4*)(ob + off + bj * HALF + 4));
                        if (isk) { u32x4 w; w.x = cvt_pk_bf16(v0[0], v0[1]); w.y = cvt_pk_bf16(v0[2], v0[3]); w.z = cvt_pk_bf16(v1[0], v1[1]); w.w = cvt_pk_bf16(v1[2], v1[3]); *(u32x4*)(KB + off + bj * HALF) = w; }
                    }
                }
        } else {
#pragma unroll
            for (int ai = 0; ai < 2; ++ai)
#pragma unroll
                for (int m = 0; m < 4; ++m) {
                    bf16_t* rowp = VT + (size_t)(row0 + ai * HALF + m * 16) * 1024 + col0;
#pragma unroll
                    for (int bj = 0; bj < 2; ++bj) {
                        const f32x4 v0 = acc[ai][bj][m][0], v1 = acc[ai][bj][m][1];
                        u32x4 w; w.x = cvt_pk_bf16(v0[0], v0[1]); w.y = cvt_pk_bf16(v0[2], v0[3]); w.z = cvt_pk_bf16(v1[0], v1[1]); w.w = cvt_pk_bf16(v1[2], v1[3]);
                        *(u32x4*)(rowp + bj * HALF) = w;
                    }
                }
        }
    }
};
struct EpiMerge {
    static constexpr bool PERM = true, CAN_KEEP = true;
    const bf16_t* Z; bf16_t* MB;
    __device__ __forceinline__ void operator()(f32x4 (&acc)[2][2][4][2], const Unit& u, int wr, int wc, int fr, int fq) const {
        const int row0 = u.pm * BM + wr * 64 + fr, col0 = u.pn * BM + wc * 32 + 8 * fq;
        const bool last = (u.kind == 2);
        const int koff = 5120 + u.kind * 2048, noff = last ? 0 : 2048;
#pragma unroll
        for (int ai = 0; ai < 2; ++ai)
#pragma unroll
            for (int m2 = 0; m2 < 2; ++m2) {
                u32x4 ga[2][2], gb[2][2];
#pragma unroll
                for (int mm = 0; mm < 2; ++mm)
#pragma unroll
                    for (int bj = 0; bj < 2; ++bj) {
                        const bf16_t* zp = Z + (size_t)(row0 + ai * HALF + (2 * m2 + mm) * 16) * NZ + koff + col0 + bj * HALF;
                        ga[mm][bj] = *(const u32x4*)zp;
                        gb[mm][bj] = *(const u32x4*)(zp + noff);
                    }
#pragma unroll
                for (int mm = 0; mm < 2; ++mm)
#pragma unroll
                    for (int bj = 0; bj < 2; ++bj) {
                        const int m = 2 * m2 + mm;
                        const u32x4 a4 = ga[mm][bj], b4 = gb[mm][bj];
                        f32x4 g0 = (f32x4){bflo(a4.x), bfhi(a4.x), bflo(a4.y), bfhi(a4.y)}, g1 = (f32x4){bflo(a4.z), bfhi(a4.z), bflo(a4.w), bfhi(a4.w)};
                        const f32x4 h0 = (f32x4){bflo(b4.x), bfhi(b4.x), bflo(b4.y), bfhi(b4.y)}, h1 = (f32x4){bflo(b4.z), bfhi(b4.z), bflo(b4.w), bfhi(b4.w)};
#pragma unroll
                        for (int j = 0; j < 4; ++j) {
                            g0[j] = fmaxf(g0[j], 1e-6f) * (last ? 1.0f : __builtin_amdgcn_rcpf(fmaxf(h0[j], 1e-6f)));
                            g1[j] = fmaxf(g1[j], 1e-6f) * (last ? 1.0f : __builtin_amdgcn_rcpf(fmaxf(h1[j], 1e-6f)));
                        }
                        acc[ai][bj][m][0] *= g0; acc[ai][bj][m][1] *= g1;
                        if (last) {
                            const f32x4 v0 = acc[ai][bj][m][0], v1 = acc[ai][bj][m][1];
                            u32x4 w; w.x = cvt_pk_bf16(v0[0], v0[1]); w.y = cvt_pk_bf16(v0[2], v0[3]); w.z = cvt_pk_bf16(v1[0], v1[1]); w.w = cvt_pk_bf16(v1[2], v1[3]);
                            *(u32x4*)(MB + (size_t)(row0 + ai * HALF + m * 16) * D + col0 + bj * HALF) = w;
                        }
                    }
            }
    }
};
}

#ifndef PHMASK
#define PHMASK 0xFFFFFFFFu
#endif
#ifndef GREP
#define GREP 1
#endif
#ifndef NREP
#define NREP 1
#endif
#define PHON(n) (((PHMASK) >> (n)) & 1u)
#define LDS_WAIT() asm volatile("s_waitcnt lgkmcnt(0)" ::: "memory")

__device__ __forceinline__ void transpose_item(const float* W, int N, bf16_t* WT, int ldk, int k0, int n0, int dst_row0, LAS float* scr, int lane, const float* fg, const float* fb, float* cs) {
    f32x4 v[8];
    const int n4 = (lane & 7) * 4, kr = lane >> 3;
#pragma unroll
    for (int i = 0; i < 8; ++i) v[i] = __builtin_nontemporal_load((const f32x4*)(W + (size_t)(k0 + kr + 8 * i) * N + n0 + n4));
#pragma unroll
    for (int i = 0; i < 8; ++i) { LAS float* d = scr + (kr + 8 * i) * 33 + n4; d[0] = v[i][0]; d[1] = v[i][1]; d[2] = v[i][2]; d[3] = v[i][3]; }
    LDS_WAIT(); asm volatile("" ::: "memory");
    const int c = lane & 7;
    f32x4 g0 = (f32x4){1.f, 1.f, 1.f, 1.f}, g1 = g0, b0 = (f32x4){0.f, 0.f, 0.f, 0.f}, b1 = b0;
    if (fg) { g0 = *(const f32x4*)(fg + k0 + 8 * c); g1 = *(const f32x4*)(fg + k0 + 8 * c + 4); b0 = *(const f32x4*)(fb + k0 + 8 * c); b1 = *(const f32x4*)(fb + k0 + 8 * c + 4); }
#pragma unroll
    for (int j = 0; j < 4; ++j) { const int n = (lane >> 3) + 8 * j; const LAS float* s = scr + (8 * c) * 33 + n;
        const f32x4 w0 = (f32x4){s[0 * 33], s[1 * 33], s[2 * 33], s[3 * 33]}, w1 = (f32x4){s[4 * 33], s[5 * 33], s[6 * 33], s[7 * 33]};
        const f32x4 f0 = w0 * g0, f1 = w1 * g1;
        u32x4 o; o.x = cvt_pk_bf16(f0[0], f0[1]); o.y = cvt_pk_bf16(f0[2], f0[3]); o.z = cvt_pk_bf16(f1[0], f1[1]); o.w = cvt_pk_bf16(f1[2], f1[3]);
        *(u32x4*)(WT + (size_t)(dst_row0 + n) * ldk + k0 + 8 * c) = o;
        if (fg) {
            float p1 = ((bflo(o.x) + bfhi(o.x)) + (bflo(o.y) + bfhi(o.y))) + ((bflo(o.z) + bfhi(o.z)) + (bflo(o.w) + bfhi(o.w)));
            const f32x4 t0 = w0 * b0, t1 = w1 * b1;
            float p2 = ((t0[0] + t0[1]) + (t0[2] + t0[3])) + ((t1[0] + t1[1]) + (t1[2] + t1[3]));
            p1 += __shfl_xor(p1, 1); p2 += __shfl_xor(p2, 1); p1 += __shfl_xor(p1, 2); p2 += __shfl_xor(p2, 2); p1 += __shfl_xor(p1, 4); p2 += __shfl_xor(p2, 4);
            if (c == 0) { atomicAdd(cs + dst_row0 + n, p1); atomicAdd(cs + NZ + dst_row0 + n, p2); }
        } }
    LDS_WAIT(); asm volatile("" ::: "memory");
}
__device__ __forceinline__ void ln_row(const float* yrow, const float* g, const float* b, float* of, bf16_t* ob, int lane) {
    f32x4 v[8]; float s = 0.f;
#pragma unroll
    for (int j = 0; j < 8; ++j) { v[j] = *(const f32x4*)(yrow + 4 * lane + 256 * j); s += (v[j][0] + v[j][1]) + (v[j][2] + v[j][3]); }
    const float mean = wave_sum(s) * (1.f / D); float s2 = 0.f;
#pragma unroll
    for (int j = 0; j < 8; ++j) { v[j] = v[j] - mean; s2 += (v[j][0] * v[j][0] + v[j][1] * v[j][1]) + (v[j][2] * v[j][2] + v[j][3] * v[j][3]); }
    const float rstd = 1.0f / sqrtf(wave_sum(s2) * (1.f / D) + LN_EPS);
#pragma unroll
    for (int j = 0; j < 8; ++j) {
        const f32x4 gg = *(const f32x4*)(g + 4 * lane + 256 * j), bb = *(const f32x4*)(b + 4 * lane + 256 * j);
        const f32x4 o = v[j] * rstd * gg + bb;
        if (of) __builtin_nontemporal_store(o, (f32x4*)(of + 4 * lane + 256 * j));
        if (ob) { u32x2 w; w.x = cvt_pk_bf16(o[0], o[1]); w.y = cvt_pk_bf16(o[2], o[3]); *(u32x2*)(ob + 4 * lane + 256 * j) = w; }
    }
}

#define XB_TMO      128
#define XB_XCNT(j)  (256  + 64 * (j))
#define XB_XSUB(j)  (1280 + 64 * (j))
#define XB_XGEN(j)  (2304 + 64 * (j))
#define XB_TOP      3328
#define XB_TOPGEN   3392
#define XCD_BAR_WORDS 3456
#define XB_SPIN_CAP (1u << 22)
__device__ __forceinline__ unsigned xb_ld(unsigned* p)              { return __hip_atomic_load(p, __ATOMIC_RELAXED, __HIP_MEMORY_SCOPE_AGENT); }
__device__ __forceinline__ unsigned xb_add(unsigned* p, unsigned v) { return __hip_atomic_fetch_add(p, v, __ATOMIC_RELAXED, __HIP_MEMORY_SCOPE_AGENT); }
__device__ __forceinline__ unsigned xb_xcc_id() { return (unsigned)__builtin_amdgcn_s_getreg((3 << 11) | 20) & 0xFu; }
#define XB_SPIN(cond, bar) do { unsigned _sp = 0; while (cond) { __builtin_amdgcn_s_sleep(1); \
    if ((++_sp & 255u) == 0u) { if (xb_ld(&(bar)[XB_TMO])) break; if (_sp > XB_SPIN_CAP) { atomicAdd(&(bar)[XB_TMO], 1u); break; } } } } while (0)
struct XcdBarrier { unsigned* bar; unsigned x; volatile LAS unsigned* st; };
__device__ __forceinline__ XcdBarrier xcd_barrier_post(unsigned* bar, volatile LAS unsigned* st) {
    XcdBarrier b; b.bar = bar; b.x = xb_xcc_id(); b.st = st;
    if (threadIdx.x == 0) (void)xb_add(&bar[XB_XCNT(b.x)], 1u);
    return b;
}
__device__ __forceinline__ void xcd_barrier_complete(unsigned* bar, unsigned x, unsigned& nloc, unsigned& nx) {
    const unsigned G = gridDim.x * gridDim.y * gridDim.z;
    unsigned sum, cnt, mine, sp = 0u;
    for (;;) {
        sum = 0u; cnt = 0u; mine = 0u;
#pragma unroll
        for (unsigned j = 0; j < 16; ++j) { const unsigned c = xb_ld(&bar[XB_XCNT(j)]); sum += c; cnt += (c > 0u) ? 1u : 0u; mine = (j == x) ? c : mine; }
        if (sum == G) break;
        __builtin_amdgcn_s_sleep(1);
        if ((++sp & 255u) == 0u) { if (xb_ld(&bar[XB_TMO])) break; if (sp > XB_SPIN_CAP) { atomicAdd(&bar[XB_TMO], 1u); break; } }
    }
    nloc = mine > 0u ? mine : 1u; nx = cnt > 0u ? cnt : 1u;
}
__device__ __forceinline__ void xcd_barrier(const XcdBarrier& b) {
    asm volatile("s_waitcnt vmcnt(0)" ::: "memory");
    __syncthreads();
    if (threadIdx.x == 0) {
        unsigned* bar = b.bar;
        __builtin_amdgcn_s_waitcnt(0);
        unsigned nloc = b.st[0], nx = b.st[1];
        if (nloc == 0u) { xcd_barrier_complete(bar, b.x, nloc, nx); b.st[0] = nloc; b.st[1] = nx; }
        const unsigned old = xb_add(&bar[XB_XSUB(b.x)], 1u);
        const unsigned gen = old / nloc;
        if (old + 1u == (gen + 1u) * nloc) {
            __builtin_amdgcn_fence(__ATOMIC_RELEASE, "agent");
            asm volatile("s_waitcnt vmcnt(0)" ::: "memory");
            const unsigned og = xb_add(&bar[XB_TOP], 1u);
            const unsigned tg = og / nx;
            if (og + 1u == (tg + 1u) * nx) xb_add(&bar[XB_TOPGEN], 1u);
            else XB_SPIN(xb_ld(&bar[XB_TOPGEN]) == tg, bar);
            __builtin_amdgcn_fence(__ATOMIC_ACQUIRE, "agent");
            xb_add(&bar[XB_XGEN(b.x)], 1u);
            asm volatile("s_waitcnt vmcnt(0)" ::: "memory");
        } else {
            XB_SPIN(xb_ld(&bar[XB_XGEN(b.x)]) == gen, bar);
            __builtin_amdgcn_fence(__ATOMIC_ACQUIRE, "agent");
            asm volatile("s_waitcnt vmcnt(0)" ::: "memory");
        }
    }
    __syncthreads();
}

template <int MODE>
__device__ __forceinline__ void skinny(LAS unsigned char* lds, int bid, int G, int wave, int lane, const bf16_t* A, int lda, const bf16_t* Bt, int ldb, int K,
                                       float* Ys, const float* res, float alpha, float scale, const bf16_t* Zs, bf16_t* MBs,
                                       const float* rin, const float* lg, const float* lb, bf16_t* ybs, float* rout) {
    const int fr = lane & 15, fq = lane >> 4, tw = wave & 3, kh = wave >> 2;
    LAS f32x4* red = (LAS f32x4*)lds;
    for (int T0 = bid * 4; T0 < 1024; T0 += G * 4) {
        const int T = T0 + tw, rt = T >> 7, ct = T & 127;
        f32x4 tot = (f32x4){0.f, 0.f, 0.f, 0.f};
        if (MODE == 0) {
            const int kb = kh * (K / 2);
            const bf16_t* ap = A + (size_t)(rt * 16 + fr) * lda + kb + fq * 8;
            const bf16_t* bp = Bt + (size_t)(ct * 16 + fr) * ldb + kb + fq * 8;
#pragma unroll 16
            for (int ks = 0; ks < K / 64; ++ks) {
                const bf16x8 af = *(const bf16x8*)(ap + ks * 32), bfv = *(const bf16x8*)(bp + ks * 32);
                tot = __builtin_amdgcn_mfma_f32_16x16x32_bf16(bfv, af, tot, 0, 0, 0);
            }
        } else {
#pragma unroll
            for (int k = 0; k < 3; ++k) {
                const int kb = kh * (BW / 2);
                const bf16_t* ap = A + (size_t)(rt * 16 + fr) * lda + k * BW + kb + fq * 8;
                const bf16_t* bp = Bt + (size_t)k * D * BW + (size_t)(ct * 16 + fr) * ldb + kb + fq * 8;
                f32x4 acc = (f32x4){0.f, 0.f, 0.f, 0.f};
#pragma unroll 8
                for (int ks = 0; ks < BW / 64; ++ks) {
                    const bf16x8 af = *(const bf16x8*)(ap + ks * 32), bfv = *(const bf16x8*)(bp + ks * 32);
                    acc = __builtin_amdgcn_mfma_f32_16x16x32_bf16(bfv, af, acc, 0, 0, 0);
                }
                const u32x2 gw = *(const u32x2*)(Zs + (size_t)(rt * 16 + fr) * NZ + 5120 + k * 2048 + ct * 16 + 4 * fq);
                tot += acc * (f32x4){bflo(gw.x), bfhi(gw.x), bflo(gw.y), bfhi(gw.y)};
            }
        }
        if (kh == 1) red[tw * 64 + lane] = tot;
        __syncthreads();
        if (kh == 0) {
            tot += red[tw * 64 + lane];
            const size_t off = (size_t)(rt * 16 + fr) * D + ct * 16 + 4 * fq;
            if (MODE == 0) {
                f32x4 xv = *(const f32x4*)(res + off);
                if (rin) { const f32x2 st = ln_stats(*(const f32x2*)(rin + 2 * (rt * 16 + fr))); const int cc = ct * 16 + 4 * fq;
                    xv = (xv - st[0]) * (*(const f32x4*)(lg + cc) * st[1]) + *(const f32x4*)(lb + cc); }
                const f32x4 o = xv * alpha + tot * scale;
                *(f32x4*)(Ys + off) = o;
                if (ybs) { u32x2 w; w.x = cvt_pk_bf16(o[0], o[1]); w.y = cvt_pk_bf16(o[2], o[3]); *(u32x2*)(ybs + off) = w; }
                if (rout) { float ps = (o[0] + o[1]) + (o[2] + o[3]), pq = (o[0] * o[0] + o[1] * o[1]) + (o[2] * o[2] + o[3] * o[3]);
                    ps += __shfl_xor(ps, 16); pq += __shfl_xor(pq, 16); ps += __shfl_xor(ps, 32); pq += __shfl_xor(pq, 32);
                    if (fq == 0) { atomicAdd(rout + 2 * (rt * 16 + fr), ps); atomicAdd(rout + 2 * (rt * 16 + fr) + 1, pq); } }
            }
            else { u32x2 w; w.x = cvt_pk_bf16(tot[0], tot[1]); w.y = cvt_pk_bf16(tot[2], tot[3]); *(u32x2*)(MBs + off) = w; }
        }
        __syncthreads();
    }
}

#define WGU1 ((bf16_t*)(P.ws + WS_WGU1))
#define WD1 ((bf16_t*)(P.ws + WS_WD1))
#define WIN ((bf16_t*)(P.ws + WS_WIN))
#define WKV ((bf16_t*)(P.ws + WS_WKV))
#define WBR ((bf16_t*)(P.ws + WS_WBR))
#define WOUT ((bf16_t*)(P.ws + WS_WOUT))
#define WGU2 ((bf16_t*)(P.ws + WS_WGU2))
#define WD2 ((bf16_t*)(P.ws + WS_WD2))
#define WLRU ((bf16_t*)(P.ws + WS_WLRU))
#define WSP ((bf16_t*)(P.ws + WS_WSP))
#define XB ((bf16_t*)(P.ws + WS_XB))
#define Z ((bf16_t*)(P.ws + WS_ZH))
#define H ((bf16_t*)(P.ws + WS_ZH))
#define Y ((float*)(P.ws + WS_Y))
#define X1 ((float*)(P.ws + WS_X1))
#define CSUM ((float*)(P.ws + WS_CS))
#define YB2 ((bf16_t*)(P.ws + WS_X1))
#define RSUM ((float*)(P.ws + WS_RS))
#define VP ((bf16_t*)(P.ws + WS_VP))
#define HL ((float*)(P.ws + WS_HL))
#define AC ((float*)(P.ws + WS_AC))
#define SUM ((float*)(P.ws + WS_SUM))
#define YS ((bf16_t*)(P.ws + WS_YS))
#define MEMLN ((bf16_t*)(P.ws + WS_MEMLN))
#define KB ((bf16_t*)(P.ws + WS_KB))
#define VT ((bf16_t*)(P.ws + WS_VT))
__device__ __forceinline__ void p5d_sample_attn(const Params& P, LAS unsigned char* lds, int bid, int G, int tid_in) {
    int tid = tid_in; asm volatile("" : "+v"(tid));
    const int lane = tid & 63, wave = __builtin_amdgcn_readfirstlane(tid >> 6);

        LAS float* sS = (LAS float*)(lds + 131072);
        LAS float* sO = (LAS float*)(lds + 131072 + 1024);
        const int vb = (G % 8 == 0) ? (bid & 7) * (G >> 3) + (bid >> 3) : bid;
        for (int it = vb; it < 512; it += G) {
            const int b = it >> 2, h = it & 3;
            const u32x2 qw = *(const u32x2*)(Z + (size_t)(MP + b) * NZ + 4096 + h * HD + 4 * lane);
            const f32x4 q = (f32x4){bflo(qw.x), bfhi(qw.x), bflo(qw.y), bfhi(qw.y)};
            const float* kbase = P.in[I_CK] + ((size_t)(b * NMEM + 32 * wave) * NH + h) * HD + 4 * lane;
            const float* vbase = P.in[I_CV] + ((size_t)(b * NMEM + 32 * wave) * NH + h) * HD + 4 * lane;
            float d[32];
#pragma unroll
            for (int mi = 0; mi < 32; ++mi) {
                const f32x4 kv = __builtin_nontemporal_load((const f32x4*)(kbase + (size_t)mi * (NH * HD)));
                d[mi] = (kv[0] * q[0] + kv[1] * q[1]) + (kv[2] * q[2] + kv[3] * q[3]);
                if (mi == 15) asm volatile("" ::: "memory");
            }
#pragma unroll
            for (int i = 0; i < 16; ++i) { const bool hi = (lane & 32) != 0; const float snd = hi ? d[i] : d[i + 16], kp = hi ? d[i + 16] : d[i]; d[i] = kp + __shfl_xor(snd, 32); }
#pragma unroll
            for (int i = 0; i < 8; ++i) { const bool hi = (lane & 16) != 0; const float snd = hi ? d[i] : d[i + 8], kp = hi ? d[i + 8] : d[i]; d[i] = kp + __shfl_xor(snd, 16); }
#pragma unroll
            for (int i = 0; i < 4; ++i) { const bool hi = (lane & 8) != 0; const float snd = hi ? d[i] : d[i + 4], kp = hi ? d[i + 4] : d[i]; d[i] = kp + __shfl_xor(snd, 8); }
#pragma unroll
            for (int i = 0; i < 2; ++i) { const bool hi = (lane & 4) != 0; const float snd = hi ? d[i] : d[i + 2], kp = hi ? d[i + 2] : d[i]; d[i] = kp + __shfl_xor(snd, 4); }
            { const bool hi = (lane & 2) != 0; const float snd = hi ? d[0] : d[1], kp = hi ? d[1] : d[0]; d[0] = kp + __shfl_xor(snd, 2); }
            d[0] += __shfl_xor(d[0], 1);
            if ((lane & 1) == 0) sS[32 * wave + (lane >> 1)] = d[0] * 0.0625f;
            f32x4 vv[16];
#pragma unroll
            for (int mi = 0; mi < 16; ++mi) vv[mi] = __builtin_nontemporal_load((const f32x4*)(vbase + (size_t)mi * (NH * HD)));
            __syncthreads();
            float mx = fmaxf(fmaxf(sS[lane], sS[lane + 64]), fmaxf(sS[lane + 128], sS[lane + 192]));
            mx = wave_max(mx);
            float sm = __expf(sS[lane] - mx) + __expf(sS[lane + 64] - mx) + __expf(sS[lane + 128] - mx) + __expf(sS[lane + 192] - mx);
            sm = wave_sum(sm);
            const float inv = 1.0f / sm;
            f32x4 o = (f32x4){0.f, 0.f, 0.f, 0.f};
            f32x4 vw[16];
#pragma unroll
            for (int mi = 0; mi < 16; ++mi) vw[mi] = __builtin_nontemporal_load((const f32x4*)(vbase + (size_t)(16 + mi) * (NH * HD)));
#pragma unroll
            for (int mi = 0; mi < 16; ++mi) { const float p = __expf(sS[32 * wave + mi] - mx) * inv; o += vv[mi] * p; }
#pragma unroll
            for (int mi = 0; mi < 16; ++mi) { const float p = __expf(sS[32 * wave + 16 + mi] - mx) * inv; o += vw[mi] * p; }
            *(LAS f32x4*)(sO + wave * 256 + 4 * lane) = o;
            __syncthreads();
            if (tid < 256) {
                float a = 0.f;
#pragma unroll
                for (int w = 0; w < 8; ++w) a += sO[w * 256 + tid];
                YS[(size_t)(MP + b) * 3072 + 2048 + h * HD + tid] = (bf16_t)(cvt_pk_bf16(a, 0.f) & 0xffffu);
            }
            __syncthreads();
        }
}

__global__ void __launch_bounds__(NTHREADS, 2) fwd_kernel(Params P) {
    extern __shared__ __attribute__((aligned(16))) unsigned char lds_raw[];
    LAS unsigned char* lds = (LAS unsigned char*)lds_raw;
    cg::grid_group grid = cg::this_grid();
    const int tid = threadIdx.x, lane = tid & 63, wave = __builtin_amdgcn_readfirstlane(tid >> 6);
    const int G = gridDim.x, bid = blockIdx.x;
    const int gw = bid * NWAVES + wave, NGW = G * NWAVES;
    float* out = P.out;
    volatile LAS unsigned* bst = (volatile LAS unsigned*)(lds + LDS_BYTES - 64);
    if (tid == 0) { bst[0] = 0u; bst[1] = 0u; }
    __syncthreads();
    const XcdBarrier gbar = xcd_barrier_post((unsigned*)(P.ws + WS_BAR), bst);
#define GRID_BAR() xcd_barrier(gbar)

    if (PHON(0)) {
        LAS float* scr = (LAS float*)(lds + wave * 16384);
        constexpr int IT_GU = (D / 64) * (NZ / 32), IT_DN = (FF / 64) * (D / 32), IT_SQ = (D / 64) * (D / 32), IT_BR = (BW / 64) * (D / 32), IT_LR = 2 * 4;
        constexpr int IT_TOTAL = 3 * IT_GU + 2 * IT_DN + 2 * IT_SQ + 3 * IT_BR + 16 * IT_LR;
        for (int it = gw; it < IT_TOTAL; it += NGW) {
            int r = it; const float* W; bf16_t* WT; int N, ldk, mode = 0; const float* fg = nullptr; const float* fb = nullptr; float* cs = nullptr;
            if (r < IT_GU) { W = P.in[I_WIN]; WT = WIN; N = NZ; ldk = D; fg = P.in[I_LN1G]; fb = P.in[I_LN1B]; cs = CSUM; }
            else if ((r -= IT_GU) < IT_SQ) { W = P.in[I_WKV]; WT = WKV; N = D; ldk = D; }
            else if ((r -= IT_SQ) < 3 * IT_BR) { const int k = r / IT_BR; r -= k * IT_BR; W = P.in[I_WBR] + (size_t)k * BW * D; WT = WBR + (size_t)k * D * BW; N = D; ldk = BW; }
            else if ((r -= 3 * IT_BR) < IT_SQ) { W = P.in[I_WOUT]; WT = WOUT; N = D; ldk = D; }
            else if ((r -= IT_SQ) < IT_GU) { W = P.in[I_GU2]; WT = WGU2; N = NZ; ldk = D; mode = 1; fg = P.in[I_LN2G]; fb = P.in[I_LN2B]; cs = CSUM + 2 * NZ; }
            else if ((r -= IT_GU) < IT_DN) { W = P.in[I_DN2]; WT = WD2; N = D; ldk = FF; }
            else if ((r -= IT_DN) < 16 * IT_LR) { const int m = r / IT_LR; r -= m * IT_LR; const int k = m >> 1, x = m & 1;
                W = (x ? P.in[I_LWX] : P.in[I_LWA]) + (size_t)k * 128 * 128; WT = WLRU + (size_t)k * 256 * 128 + x * 128 * 128; N = 128; ldk = 128; }
            else if ((r -= 16 * IT_LR) < IT_DN) { W = P.in[I_DN1]; WT = WD1; N = D; ldk = FF; }
            else { r -= IT_DN; W = P.in[I_GU1]; WT = WGU1; N = NZ; ldk = D; mode = 1; }
            const int nblk = N / 32, kb = r / nblk, nb = r % nblk, n0 = 32 * nb;
            int dr = n0;
            if (mode == 1) dr = (n0 < FF) ? (n0 / 128) * 256 + (n0 % 128) : ((n0 - FF) / 128) * 256 + 128 + ((n0 - FF) % 128);
            transpose_item(W, N, WT, ldk, 64 * kb, n0, dr, scr, lane, fg, fb, cs);
        }
        for (int i = gw * 64 + lane; i < 4 * 128 * 128; i += NGW * 64) { const int t = (i >> 7) & 127, s = i & 127; const float w = P.in[I_WS][i]; WSP[i] = (bf16_t)(cvt_pk_bf16(s <= t ? w : 0.f, 0.f) & 0xffffu); }
        for (size_t i = (size_t)gw * 64 + lane; i < (size_t)MPAD * D / 8; i += (size_t)NGW * 64) {
            const size_t e = i * 8; const int r = (int)(e / D);
            u32x4 w = (u32x4){0u, 0u, 0u, 0u};
            if (r < MR) { const float* src = (r < MP) ? P.in[I_XP] + e : P.in[I_XS] + (e - (size_t)MP * D);
                const f32x4 a = __builtin_nontemporal_load((const f32x4*)src), b = __builtin_nontemporal_load((const f32x4*)(src + 4));
                w.x = cvt_pk_bf16(a[0], a[1]); w.y = cvt_pk_bf16(a[2], a[3]); w.z = cvt_pk_bf16(b[0], b[1]); w.w = cvt_pk_bf16(b[2], b[3]); }
            *(u32x4*)(XB + e) = w;
        }
        for (int r = gw; r < 1024; r += NGW) ln_row(P.in[I_MEM] + (size_t)r * D, P.in[I_MLNG], P.in[I_MLNB], nullptr, MEMLN + (size_t)r * D, lane);
    }
    if (P.ws == nullptr) grid.sync();
    GRID_BAR();

    if (PHON(1)) {
        pg8::PlainSched S{XB, WGU1, 33, 44, D, D, G, bid};
        pg8::EpiSwiglu E{H, FF, nullptr, nullptr};
        pg8::gemm_phase<pg8::PlainSched, pg8::EpiSwiglu, true, true>(lds, D, D, D, S, E);
    }
    GRID_BAR();
    if (PHON(2)) {
        skinny<0>(lds, bid, G, wave, lane, H + (size_t)MP * FF, FF, WD1, FF, FF, Y + (size_t)MP * D, P.in[I_XS], ALPHA, 0.5f, nullptr, nullptr, nullptr, nullptr, nullptr, XB + (size_t)MP * D, RSUM + 2 * (size_t)MP);
        pg8::PlainSched S{H, WD1, 32, 8, FF, FF, G, bid};
        pg8::EpiResid E{Y, P.in[I_XP], nullptr, nullptr, nullptr, ALPHA, 0.5f, XB, RSUM, true};
        pg8::gemm_phase<pg8::PlainSched, pg8::EpiResid, true, true>(lds, FF, FF, FF, S, E);
    }
    GRID_BAR();

    if (PHON(4)) {
        LAS float* gbl = (LAS float*)(lds + 131072);
        for (int i = tid; i < 3 * D / 4; i += NTHREADS) *(LAS f32x4*)(gbl + 4 * i) = *(const f32x4*)(P.in[I_GATEB] + 4 * i);
        __syncthreads();
        pg8::WinSched S{XB, WIN, MEMLN, WKV, G, bid};
        pg8::EpiWin E{Z, gbl, out + O_MK, out + O_MV, KB, VT, RSUM, CSUM};
        pg8::gemm_phase<pg8::WinSched, pg8::EpiWin, true, true>(lds, D, D, D, S, E);
    }
    GRID_BAR();

    const bool dfirst_ = ((bid >> 5) & 1) != 0;
    if (dfirst_ && PHON(8)) p5d_sample_attn(P, lds, bid, G, tid);
    if (PHON(5)) for (int r = gw; r < MR; r += NGW) {
        const bf16_t* zr = Z + (size_t)r * NZ + 1024;
        float v[16]; float s = 0.f;
#pragma unroll
        for (int h = 0; h < 2; ++h) { const u32x4 w = *(const u32x4*)(zr + 8 * lane + 512 * h);
            v[8 * h + 0] = bflo(w.x); v[8 * h + 1] = bfhi(w.x); v[8 * h + 2] = bflo(w.y); v[8 * h + 3] = bfhi(w.y); v[8 * h + 4] = bflo(w.z); v[8 * h + 5] = bfhi(w.z); v[8 * h + 6] = bflo(w.w); v[8 * h + 7] = bfhi(w.w); }
#pragma unroll
        for (int j = 0; j < 16; ++j) s += v[j];
        const float mean = wave_sum(s) * (1.f / BW); float s2 = 0.f;
#pragma unroll
        for (int j = 0; j < 16; ++j) { v[j] -= mean; s2 += v[j] * v[j]; }
        const float rstd = 1.0f / sqrtf(wave_sum(s2) * (1.f / BW) + LN_EPS);
#pragma unroll
        for (int h = 0; h < 2; ++h) {
            const int c0 = 8 * lane + 512 * h; float o[8];
#pragma unroll
            for (int j = 0; j < 8; ++j) o[j] = v[8 * h + j] * rstd * P.in[I_GLNG][c0 + j] + P.in[I_GLNB][c0 + j];
            u32x4 w; w.x = cvt_pk_bf16(o[0], o[1]); w.y = cvt_pk_bf16(o[2], o[3]); w.z = cvt_pk_bf16(o[4], o[5]); w.w = cvt_pk_bf16(o[6], o[7]);
            *(u32x4*)(VP + (size_t)r * BW + c0) = w;
            if (r >= MP) { float* ov = out + O_VS + (size_t)(r - MP) * BW + c0; *(f32x4*)ov = (f32x4){o[0], o[1], o[2], o[3]}; *(f32x4*)(ov + 4) = (f32x4){o[4], o[5], o[6], o[7]}; }
        }
    }
    if (PHON(6)) {
        LAS bf16_t* XCB = (LAS bf16_t*)lds;
        LAS float* AARR = (LAS float*)lds;
        LAS float* XCF = (LAS float*)(lds + 65536);
        for (int it = bid; it < 65 * 8; it += G) {
            const int c = it >> 3, k = it & 7; const bool smp = (c == 64);
            const int r0 = c * 128, ch0 = k * 128;
            int lane_o = lane; asm volatile("" : "+v"(lane_o));
            const int fr = lane_o & 15, fq = lane_o >> 4, rh = wave >> 2, cq = wave & 3;
            bf16x8 wfr[4][4];
            {
                const bf16_t* wb = WLRU + (size_t)k * 256 * 128;
#pragma unroll
                for (int ct = 0; ct < 4; ++ct)
#pragma unroll
                    for (int ks = 0; ks < 4; ++ks) wfr[ct][ks] = *(const bf16x8*)(wb + (size_t)((ct >> 1) * 128 + 32 * cq + 16 * (ct & 1) + fr) * 128 + ks * 32 + fq * 8);
            }
            LAS float* prm = (LAS float*)(lds + 131072 + 4096);
            if (tid < 128) { prm[tid] = P.in[I_LBA][ch0 + tid]; prm[128 + tid] = P.in[I_LBX][ch0 + tid]; prm[256 + tid] = __logf(1.0f + __expf(-P.in[I_LAM][ch0 + tid])); }
            {
                const int c4 = (tid & 31) * 4, rg = tid >> 5;
                const int ch = ch0 + c4;
                const f32x4 w0 = *(const f32x4*)(P.in[I_CONVW] + 0 * BW + ch), w1 = *(const f32x4*)(P.in[I_CONVW] + 1 * BW + ch), w2 = *(const f32x4*)(P.in[I_CONVW] + 2 * BW + ch), w3 = *(const f32x4*)(P.in[I_CONVW] + 3 * BW + ch);
                const f32x4 cb = *(const f32x4*)(P.in[I_CONVB] + ch);
                if (!smp) {
                    const bool first = ((c & 15) == 0);
                    const int rs = rg * 8;
                    const bool hist = !(first && rs == 0);
                    u32x2 zr[11];
#pragma unroll
                    for (int i = 0; i < 11; ++i) { zr[i] = (u32x2){0u, 0u}; if (i >= 3 || hist) zr[i] = *(const u32x2*)(Z + (size_t)(r0 + rs - 3 + i) * NZ + 2048 + ch); }
#define ZF(i) ((f32x4){bflo(zr[i].x), bfhi(zr[i].x), bflo(zr[i].y), bfhi(zr[i].y)})
#pragma unroll
                    for (int i = 0; i < 8; ++i) {
                        const int row = rs + i;
                        const f32x4 x0 = ZF(i + 3);
                        const f32x4 xc = cb + w3 * x0 + w2 * ZF(i + 2) + w1 * ZF(i + 1) + w0 * ZF(i);
                        *(LAS f32x4*)(XCF + row * 128 + c4) = xc;
                        u32x2 w; w.x = cvt_pk_bf16(xc[0], xc[1]); w.y = cvt_pk_bf16(xc[2], xc[3]);
                        *(LAS u32x2*)(XCB + row * 136 + c4) = w;
                        if ((c & 15) == 15 && row >= 125) *(f32x4*)(out + O_CP + (size_t)((c >> 4) * 3 + (row - 125)) * BW + ch) = x0;
                    }
#undef ZF
                } else {
#pragma unroll 4
                    for (int i = 0; i < 8; ++i) {
                        const int row = rg * 8 + i;
                        const float* sc = P.in[I_SCONV] + (size_t)row * 3 * BW + ch;
                        const f32x4 b0 = *(const f32x4*)sc, b1 = *(const f32x4*)(sc + BW), b2 = *(const f32x4*)(sc + 2 * BW);
                        const u32x2 a = *(const u32x2*)(Z + (size_t)(MP + row) * NZ + 2048 + ch);
                        const f32x4 x0 = (f32x4){bflo(a.x), bfhi(a.x), bflo(a.y), bfhi(a.y)};
                        const f32x4 xc = cb + w3 * x0 + w2 * b2 + w1 * b1 + w0 * b0;
                        *(LAS f32x4*)(XCF + row * 128 + c4) = xc;
                        u32x2 w; w.x = cvt_pk_bf16(xc[0], xc[1]); w.y = cvt_pk_bf16(xc[2], xc[3]);
                        *(LAS u32x2*)(XCB + row * 136 + c4) = w;
                        float* oc = out + O_CS + (size_t)row * 3 * BW + ch;
                        *(f32x4*)oc = b1; *(f32x4*)(oc + BW) = b2; *(f32x4*)(oc + 2 * BW) = x0;
                    }
                }
            }
            __syncthreads();
            f32x4 ga[4][4];
#pragma unroll
            for (int rt = 0; rt < 4; ++rt)
#pragma unroll
                for (int ct = 0; ct < 4; ++ct) ga[rt][ct] = (f32x4){0.f, 0.f, 0.f, 0.f};
#pragma unroll
            for (int rt = 0; rt < 4; ++rt) {
                bf16x8 af[4];
#pragma unroll
                for (int ks = 0; ks < 4; ++ks) af[ks] = *(const LAS bf16x8*)(XCB + (64 * rh + 16 * rt + fr) * 136 + ks * 32 + fq * 8);
#pragma unroll
                for (int ct = 0; ct < 4; ++ct)
#pragma unroll
                    for (int ks = 0; ks < 4; ++ks) ga[rt][ct] = __builtin_amdgcn_mfma_f32_16x16x32_bf16(af[ks], wfr[ct][ks], ga[rt][ct], 0, 0, 0);
            }
            __syncthreads();
#pragma unroll
            for (int cl = 0; cl < 2; ++cl) {
                const int chl = 32 * cq + 16 * cl + fr, chg = ch0 + chl;
                const float ba = prm[chl], bx = prm[128 + chl], sp = prm[256 + chl];
#pragma unroll
                for (int rt = 0; rt < 4; ++rt)
#pragma unroll
                    for (int j = 0; j < 4; ++j) {
                        const int row = 64 * rh + 16 * rt + 4 * fq + j;
                        const float rr = sigmoidf_(ga[rt][cl][j] + ba), ii = sigmoidf_(ga[rt][2 + cl][j] + bx);
                        const float la = -8.0f * rr * sp;
                        const float a = __expf(la);
                        const float xc = XCF[row * 128 + chl];
                        const float bt = __builtin_amdgcn_sqrtf(fmaxf(1.0f - a * a, 0.f)) * (ii * xc);
                        if (smp) {
                            const float h = a * P.in[I_SLRU][(size_t)row * BW + chg] + bt;
                            out[O_HS + (size_t)row * BW + chg] = h;
                            const float rgv = bf2f(Z[(size_t)(MP + row) * NZ + 3072 + chg]);
                            YS[(size_t)(MP + row) * 3072 + 1024 + chg] = (bf16_t)(cvt_pk_bf16(rgv * h, 0.f) & 0xffffu);
                        } else {
                            AARR[row * 128 + chl] = a; XCF[row * 128 + chl] = bt;
                        }
                        if (j == 3) asm volatile("" ::: "memory");
                    }
            }
            __syncthreads();
            if (!smp) {
                {
                    LAS float* segA = (LAS float*)(lds + 131072); LAS float* segH = segA + 512;
                    const int seg = tid >> 7, chn = tid & 127;
                    float h = 0.f, pa = 1.f;
#pragma unroll 8
                    for (int i = 0; i < 32; ++i) { const int o = (32 * seg + i) * 128 + chn; const float a = AARR[o], b = XCF[o]; h = a * h + b; pa *= a; XCF[o] = h; AARR[o] = pa; }
                    segA[tid] = pa; segH[tid] = h;
                    __syncthreads();
                    float cA = 1.f, cH = 0.f;
                    for (int sg = 0; sg < seg; ++sg) { const float sa = segA[sg * 128 + chn]; cH = sa * cH + segH[sg * 128 + chn]; cA *= sa; }
                    if (seg > 0) {
#pragma unroll 8
                        for (int i = 0; i < 32; ++i) { const int o = (32 * seg + i) * 128 + chn; const float hl = XCF[o], pc = AARR[o]; XCF[o] = hl + pc * cH; AARR[o] = pc * cA; }
                    }
                    if (seg == 3) { SUM[(size_t)(c * 2 + 0) * BW + ch0 + chn] = pa * cA; SUM[(size_t)(c * 2 + 1) * BW + ch0 + chn] = h + pa * cH; }
                }
                __syncthreads();
#pragma unroll
                for (int i = 0; i < 8; ++i) { const int e = (i * 512 + tid) * 4, row = e >> 7, cc = e & 127;
                    *(f32x4*)(HL + (size_t)(r0 + row) * BW + ch0 + cc) = *(const LAS f32x4*)(XCF + e);
                    *(f32x4*)(AC + (size_t)(r0 + row) * BW + ch0 + cc) = *(const LAS f32x4*)(AARR + e); }
            }
            __syncthreads();
        }
    }
    if (PHON(7)) for (int it = bid; it < 256; it += G) {
        const int b = it >> 6, h = (it >> 4) & 3, qt = it & 15;
        int lane_o = lane; asm volatile("" : "+v"(lane_o));
        const int fr = lane_o & 15, fq = lane_o >> 4;
        const int row0 = b * SEQ + qt * 128 + wave * 16;
        bf16x8 qf[8];
#pragma unroll
        for (int ks = 0; ks < 8; ++ks) qf[ks] = *(const bf16x8*)(Z + (size_t)(row0 + fr) * NZ + 4096 + h * HD + ks * 32 + fq * 8);
        f32x4 s[16];
        LAS bf16_t* KL = (LAS bf16_t*)lds;
        __syncthreads();
        {
            const bf16_t* kb = KB + (size_t)(b * NMEM) * 1024 + h * HD;
            u32x4 t[16];
#pragma unroll
            for (int i = 0; i < 16; ++i) { const int e = tid + i * NTHREADS, m = e >> 5, c8 = (e & 31) * 8; t[i] = *(const u32x4*)(kb + (size_t)m * 1024 + c8); }
#pragma unroll
            for (int i = 0; i < 16; ++i) { const int e = tid + i * NTHREADS, m = e >> 5, c8 = (e & 31) * 8; *(LAS u32x4*)(KL + m * 264 + c8) = t[i]; }
        }
        asm volatile("" ::: "memory");
        u32x4 tv[16];
        {
            const bf16_t* vt0 = VT + (size_t)(h * HD) * 1024 + b * NMEM;
#pragma unroll
            for (int i = 0; i < 16; ++i) { const int e = tid + i * NTHREADS, dd = e >> 5, c8 = (e & 31) * 8; tv[i] = *(const u32x4*)(vt0 + (size_t)dd * 1024 + c8); }
        }
        __syncthreads();
#pragma unroll
        for (int mt = 0; mt < 16; ++mt) {
            s[mt] = (f32x4){0.f, 0.f, 0.f, 0.f};
#pragma unroll
            for (int ks = 0; ks < 8; ++ks) {
                const bf16x8 kf = *(const LAS bf16x8*)(KL + (mt * 16 + fr) * 264 + ks * 32 + fq * 8);
                s[mt] = __builtin_amdgcn_mfma_f32_16x16x32_bf16(kf, qf[ks], s[mt], 0, 0, 0);
            }
        }
        __syncthreads();
#pragma unroll
        for (int i = 0; i < 16; ++i) { const int e = tid + i * NTHREADS, dd = e >> 5, c8 = (e & 31) * 8; *(LAS u32x4*)(KL + dd * 264 + c8) = tv[i]; }
        float mx = -3.0e38f;
#pragma unroll
        for (int mt = 0; mt < 16; ++mt) mx = fmaxf(mx, fmaxf(fmaxf(s[mt][0], s[mt][1]), fmaxf(s[mt][2], s[mt][3])));
        mx = fmaxf(mx, __shfl_xor(mx, 16)); mx = fmaxf(mx, __shfl_xor(mx, 32));
        float sm = 0.f;
#pragma unroll
        for (int mt = 0; mt < 16; ++mt)
#pragma unroll
            for (int j = 0; j < 4; ++j) { const float p = __expf((s[mt][j] - mx) * 0.0625f); s[mt][j] = p; sm += p; }
        sm += __shfl_xor(sm, 16); sm += __shfl_xor(sm, 32);
        const float inv = 1.0f / sm;
        bf16x8 pf[8];
#pragma unroll
        for (int ks = 0; ks < 8; ++ks) {
            u32x4 w; w.x = cvt_pk_bf16(s[2 * ks][0], s[2 * ks][1]); w.y = cvt_pk_bf16(s[2 * ks][2], s[2 * ks][3]); w.z = cvt_pk_bf16(s[2 * ks + 1][0], s[2 * ks + 1][1]); w.w = cvt_pk_bf16(s[2 * ks + 1][2], s[2 * ks + 1][3]);
            pf[ks] = __builtin_bit_cast(bf16x8, w);
        }
        __syncthreads();
#pragma unroll 4
        for (int dt = 0; dt < 16; ++dt) {
            f32x4 o = (f32x4){0.f, 0.f, 0.f, 0.f};
#pragma unroll
            for (int ks = 0; ks < 8; ++ks) {
                const LAS bf16_t* vp = KL + (dt * 16 + fr) * 264 + ks * 32 + 4 * fq;
                const u32x2 lo = *(const LAS u32x2*)vp, hi = *(const LAS u32x2*)(vp + 16);
                const u32x4 w = (u32x4){lo.x, lo.y, hi.x, hi.y};
                o = __builtin_amdgcn_mfma_f32_16x16x32_bf16(__builtin_bit_cast(bf16x8, w), pf[ks], o, 0, 0, 0);
            }
            u32x2 w; w.x = cvt_pk_bf16(o[0] * inv, o[1] * inv); w.y = cvt_pk_bf16(o[2] * inv, o[3] * inv);
            *(u32x2*)(YS + (size_t)(row0 + fr) * 3072 + 2048 + h * HD + dt * 16 + 4 * fq) = w;
        }
    }
    if (!dfirst_ && PHON(8)) p5d_sample_attn(P, lds, bid, G, tid);
    GRID_BAR();

    if (PHON(9)) for (int it = bid; it < 256; it += G) {
        const int c = it >> 2, rq = it & 3, n = c & 15, cb = c & ~15;
        const int ch = 2 * tid;
        f32x2 carry = (f32x2){0.f, 0.f};
        {
            f32x2 pa[15], hh[15];
#pragma unroll
            for (int j = 0; j < 15; ++j) { pa[j] = (f32x2){1.f, 1.f}; hh[j] = (f32x2){0.f, 0.f};
                if (j < n) { pa[j] = *(const f32x2*)(SUM + (size_t)((cb + j) * 2 + 0) * BW + ch); hh[j] = *(const f32x2*)(SUM + (size_t)((cb + j) * 2 + 1) * BW + ch); } }
#pragma unroll
            for (int j = 0; j < 15; ++j) carry = pa[j] * carry + hh[j];
        }
#pragma unroll 8
        for (int i = 0; i < 32; ++i) {
            const int r = c * 128 + rq * 32 + i;
            const f32x2 hl = __builtin_nontemporal_load((const f32x2*)(HL + (size_t)r * BW + ch)), ac = __builtin_nontemporal_load((const f32x2*)(AC + (size_t)r * BW + ch));
            const f32x2 hv = hl + ac * carry;
            const unsigned rw = *(const unsigned*)(Z + (size_t)r * NZ + 3072 + ch);
            *(unsigned*)(YS + (size_t)r * 3072 + 1024 + ch) = cvt_pk_bf16(bflo(rw) * hv[0], bfhi(rw) * hv[1]);
            if (n == 15 && rq == 3 && i == 31) *(f32x2*)(out + O_HP + (size_t)(c >> 4) * BW + ch) = hv;
        }
    }
    if (PHON(10)) {
        LAS bf16_t* VL = (LAS bf16_t*)lds;
        for (int e = bid * NTHREADS + tid; e < MS * BW / 2; e += G * NTHREADS) {
            const int r = e / (BW / 2), c2 = (e % (BW / 2)) * 2, g = c2 >> 8;
            const float w00 = P.in[I_WS][(size_t)g * 128 * 128], b0 = P.in[I_BS][g * 128];
            const unsigned vw = *(const unsigned*)(VP + (size_t)(MP + r) * BW + c2), uw = *(const unsigned*)(Z + (size_t)(MP + r) * NZ + c2);
            *(unsigned*)(YS + (size_t)(MP + r) * 3072 + c2) = cvt_pk_bf16(bflo(uw) * (w00 * bflo(vw) + b0), bfhi(uw) * (w00 * bfhi(vw) + b0));
        }
        for (int it = bid; it < 256; it += G) {
            const int g = it & 3, cn = it >> 2;
            const int r0 = cn * 128;
            __syncthreads();
            {
                u32x4 vt8[8];
#pragma unroll
                for (int i = 0; i < 8; ++i) { const int e = tid + i * NTHREADS, s = e >> 5, c8 = (e & 31) * 8; vt8[i] = *(const u32x4*)(VP + (size_t)(r0 + s) * BW + g * 256 + c8); }
#pragma unroll
                for (int i = 0; i < 8; ++i) { const int e = tid + i * NTHREADS, s = e >> 5, c8 = (e & 31) * 8; *(LAS u32x4*)(VL + s * 264 + c8) = vt8[i]; }
            }
            __syncthreads();
            const int fr = lane & 15, fq = lane >> 4;
            bf16x8 vf[2][4];
#pragma unroll
            for (int ct = 0; ct < 2; ++ct)
#pragma unroll
                for (int ks = 0; ks < 4; ++ks) {
                    bf16x8 t;
#pragma unroll
                    for (int j = 0; j < 8; ++j) t[j] = (short)VL[(ks * 32 + fq * 8 + j) * 264 + (2 * wave + ct) * 16 + fr];
                    vf[ct][ks] = t;
                }
            const bf16_t* wsp = WSP + (size_t)g * 128 * 128;
            u32x2 uwp[8][2];
#pragma unroll
            for (int tt = 0; tt < 8; ++tt)
#pragma unroll
                for (int ct = 0; ct < 2; ++ct) uwp[tt][ct] = *(const u32x2*)(Z + (size_t)(r0 + tt * 16 + fr) * NZ + g * 256 + (2 * wave + ct) * 16 + 4 * fq);
#pragma unroll
            for (int tt = 0; tt < 8; ++tt) {
                f32x4 o0 = (f32x4){0.f, 0.f, 0.f, 0.f}, o1 = o0;
#pragma unroll
                for (int ks = 0; ks < 4; ++ks) {
                    const bf16x8 wf = *(const bf16x8*)(wsp + (size_t)(tt * 16 + fr) * 128 + ks * 32 + fq * 8);
                    o0 = __builtin_amdgcn_mfma_f32_16x16x32_bf16(vf[0][ks], wf, o0, 0, 0, 0);
                    o1 = __builtin_amdgcn_mfma_f32_16x16x32_bf16(vf[1][ks], wf, o1, 0, 0, 0);
                }
                if ((tt & 3) == 3) asm volatile("" ::: "memory");
                const int t = tt * 16 + fr; const float bs = P.in[I_BS][g * 128 + t];
                const size_t r = (size_t)(r0 + t);
#pragma unroll
                for (int ct = 0; ct < 2; ++ct) {
                    const f32x4 o = ct ? o1 : o0;
                    const int cc = g * 256 + (2 * wave + ct) * 16 + 4 * fq;
                    const u32x2 uw = uwp[tt][ct];
                    u32x2 w; w.x = cvt_pk_bf16(bflo(uw.x) * (o[0] + bs), bfhi(uw.x) * (o[1] + bs)); w.y = cvt_pk_bf16(bflo(uw.y) * (o[2] + bs), bfhi(uw.y) * (o[3] + bs));
                    *(u32x2*)(YS + r * 3072 + cc) = w;
                }
            }
        }
        __syncthreads();
    }
    GRID_BAR();

    if (PHON(11)) {
        skinny<1>(lds, bid, G, wave, lane, YS + (size_t)MP * 3 * BW, 3 * BW, WBR, BW, BW, nullptr, nullptr, 0.f, 0.f, Z + (size_t)MP * NZ, XB + (size_t)MP * D, nullptr, nullptr, nullptr, nullptr, nullptr);
        pg8::BranchSched S{YS, WBR, G, bid};
        pg8::EpiMerge E{Z, XB};
        pg8::gemm_phase<pg8::BranchSched, pg8::EpiMerge, true, true>(lds, BW, 3 * BW, BW, S, E);
    }
    GRID_BAR();
    if (PHON(12)) {
        skinny<0>(lds, bid, G, wave, lane, XB + (size_t)MP * D, D, WOUT, D, D, Y + (size_t)MP * D, Y + (size_t)MP * D, ALPHA, 1.0f, nullptr, nullptr, RSUM + 2 * (size_t)MP, P.in[I_LN1G], P.in[I_LN1B], YB2 + (size_t)MP * D, RSUM + 2 * (size_t)(MPAD + MP));
        pg8::PlainSched S{XB, WOUT, 32, 8, D, D, G, bid};
        pg8::EpiResid E{Y, Y, RSUM, P.in[I_LN1G], P.in[I_LN1B], ALPHA, 1.0f, YB2, RSUM + 2 * (size_t)MPAD, false};
        pg8::gemm_phase<pg8::PlainSched, pg8::EpiResid, true, true>(lds, D, D, D, S, E);
    }
    GRID_BAR();
    if (PHON(14)) {
        pg8::PlainSched S{YB2, WGU2, 33, 44, D, D, G, bid};
        pg8::EpiSwiglu E{H, FF, RSUM + 2 * (size_t)MPAD, CSUM + 2 * NZ};
        pg8::gemm_phase<pg8::PlainSched, pg8::EpiSwiglu, true, true>(lds, D, D, D, S, E);
    }
    GRID_BAR();
    if (PHON(15)) {
        skinny<0>(lds, bid, G, wave, lane, H + (size_t)MP * FF, FF, WD2, FF, FF, Y + (size_t)MP * D, Y + (size_t)MP * D, ALPHA, 0.5f, nullptr, nullptr, RSUM + 2 * (size_t)(MPAD + MP), P.in[I_LN2G], P.in[I_LN2B], nullptr, nullptr);
        pg8::PlainSched S{H, WD2, 32, 8, FF, FF, G, bid};
        pg8::EpiResid E{Y, Y, RSUM + 2 * (size_t)MPAD, P.in[I_LN2G], P.in[I_LN2B], ALPHA, 0.5f, nullptr, nullptr, false};
        pg8::gemm_phase<pg8::PlainSched, pg8::EpiResid, true, true>(lds, FF, FF, FF, S, E);
    }
    GRID_BAR();
    if (PHON(16)) for (int r = gw; r < MR; r += NGW) ln_row(Y + (size_t)r * D, P.in[I_LN3G], P.in[I_LN3B], out + O_Y + (size_t)r * D, nullptr, lane);
}

extern "C" void kernel_launch(void* const* d_in, const int* in_sizes, int n_in, void* d_out, int out_size, void* d_ws, size_t ws_size, hipStream_t stream) {
    static int grid = 0;
    if (grid == 0) {
        if (n_in != 35 || (size_t)out_size != O_END || ws_size < WS_END) { fprintf(stderr, "kernel_launch: unexpected shapes: n_in %d out %d (want %zu) ws %zu (need %zu)\n", n_in, out_size, (size_t)O_END, ws_size, (size_t)WS_END); grid = -1; return; }
        int dev = 0, cus = 0, per_cu = 0;
        hipGetDevice(&dev);
        hipDeviceGetAttribute(&cus, hipDeviceAttributeMultiprocessorCount, dev);
        hipFuncSetAttribute((const void*)fwd_kernel, hipFuncAttributeMaxDynamicSharedMemorySize, LDS_BYTES);
        hipOccupancyMaxActiveBlocksPerMultiprocessor(&per_cu, (const void*)fwd_kernel, NTHREADS, LDS_BYTES);
        if (per_cu < 1) { fprintf(stderr, "kernel_launch: occupancy query says %d blocks/CU\n", per_cu); per_cu = 1; }
        (void)hipGetLastError();
        grid = cus;
    }
    if (grid < 0) return;
    Params p{};
    for (int i = 0; i < 35; ++i) p.in[i] = (const float*)d_in[i];
    p.out = (float*)d_out; p.ws = (unsigned char*)d_ws;
    (void)hipMemsetAsync((char*)d_ws + WS_BAR, 0, WS_END - WS_BAR, stream);
    void* args[] = {&p};
    hipError_t e = hipLaunchCooperativeKernel((const void*)fwd_kernel, dim3(grid), dim3(NTHREADS), args, LDS_BYTES, stream);
    if (e != hipSuccess) fprintf(stderr, "cooperative launch failed: %s (grid %d)\n", hipGetErrorString(e), grid);
}
```

```cpp
#include <hip/hip_runtime.h>
#include <hip/hip_cooperative_groups.h>
#include <cstdio>
#include <cstdint>
namespace cg = cooperative_groups;

#define LAS __attribute__((address_space(3)))
typedef unsigned short bf16_t;
typedef short bf16x8 __attribute__((ext_vector_type(8)));
typedef short bf16x4 __attribute__((ext_vector_type(4)));
typedef float f32x4 __attribute__((ext_vector_type(4)));
typedef float f32x2 __attribute__((ext_vector_type(2)));
typedef unsigned u32x4 __attribute__((ext_vector_type(4)));
typedef unsigned u32x2 __attribute__((ext_vector_type(2)));

constexpr int D = 2048, FF = 5632, BW = 1024, NZ = 11264;
constexpr int MP = 8192, MS = 128, MR = MP + MS, MPAD = 8448;
constexpr int SEQ = 2048, NB = 4, NMEM = 256, NH = 4, HD = 256;
constexpr float LN_EPS = 1e-5f;
constexpr float ALPHA = 1.189207115002721f;
constexpr int NTHREADS = 512, NWAVES = 8;

constexpr int XCD_BAR_WORDS_ = 3456;
constexpr size_t al256(size_t x) { return (x + 255) & ~(size_t)255; }
constexpr size_t WS_WGU1 = 0;
constexpr size_t WS_WD1 = WS_WGU1 + al256((size_t)NZ * D * 2);
constexpr size_t WS_WIN = WS_WD1 + al256((size_t)D * FF * 2);
constexpr size_t WS_WKV = WS_WIN + al256((size_t)NZ * D * 2);
constexpr size_t WS_WBR = WS_WKV + al256((size_t)D * D * 2);
constexpr size_t WS_WOUT = WS_WBR + al256((size_t)3 * D * BW * 2);
constexpr size_t WS_WGU2 = WS_WOUT + al256((size_t)D * D * 2);
constexpr size_t WS_WD2 = WS_WGU2 + al256((size_t)NZ * D * 2);
constexpr size_t WS_WLRU = WS_WD2 + al256((size_t)D * FF * 2);
constexpr size_t WS_WSP = WS_WLRU + al256((size_t)8 * 256 * 128 * 2);
constexpr size_t WS_XB = WS_WSP + al256((size_t)4 * 128 * 128 * 2);
constexpr size_t WS_ZH = WS_XB + al256((size_t)MPAD * D * 2);
constexpr size_t WS_Y = WS_ZH + al256((size_t)MPAD * NZ * 2);
constexpr size_t WS_X1 = WS_Y + al256((size_t)MPAD * D * 4);
constexpr size_t WS_VP = WS_X1 + al256((size_t)MPAD * D * 4);
constexpr size_t WS_HL = WS_VP + al256((size_t)MPAD * BW * 2);
constexpr size_t WS_AC = WS_HL + al256((size_t)MP * BW * 4);
constexpr size_t WS_SUM = WS_AC + al256((size_t)MP * BW * 4);
constexpr size_t WS_YS = WS_SUM + al256((size_t)64 * 2 * BW * 4);
constexpr size_t WS_MEMLN = WS_YS + al256((size_t)MPAD * 3 * BW * 2);
constexpr size_t WS_KB = WS_MEMLN + al256((size_t)1024 * D * 2);
constexpr size_t WS_VT = WS_KB + al256((size_t)1024 * 1024 * 2);
constexpr size_t WS_BAR = WS_VT + al256((size_t)1024 * 1024 * 2);
constexpr size_t WS_CS = WS_BAR + al256((size_t)XCD_BAR_WORDS_ * 4);
constexpr size_t WS_RS = WS_CS + al256((size_t)2 * 2 * NZ * 4);
constexpr size_t WS_GSB = WS_RS + al256((size_t)2 * MPAD * 2 * 4);
constexpr size_t WS_END = WS_GSB + al256((size_t)3 * MS * BW * 4);

constexpr size_t O_Y = 0;
constexpr size_t O_MK = (size_t)MR * D;
constexpr size_t O_MV = O_MK + (size_t)1024 * 1024;
constexpr size_t O_CP = O_MV + (size_t)1024 * 1024;
constexpr size_t O_HP = O_CP + (size_t)4 * 3 * 1024;
constexpr size_t O_CS = O_HP + (size_t)4 * 1024;
constexpr size_t O_HS = O_CS + (size_t)128 * 3 * 1024;
constexpr size_t O_VS = O_HS + (size_t)128 * 1024;
constexpr size_t O_END = O_VS + (size_t)128 * 1024;

constexpr int LDS_BYTES = 159744;

struct Params { const float* in[35]; float* out; unsigned char* ws; };
enum { I_XP = 0, I_XS, I_MEM, I_CK, I_CV, I_SCONV, I_SLRU, I_GU1, I_DN1, I_LN1G, I_LN1B, I_WIN, I_GATEB, I_GLNG, I_GLNB, I_WS, I_BS, I_CONVW, I_CONVB,
       I_LWA, I_LBA, I_LWX, I_LBX, I_LAM, I_MLNG, I_MLNB, I_WKV, I_WBR, I_WOUT, I_LN2G, I_LN2B, I_GU2, I_DN2, I_LN3G, I_LN3B };

__device__ __forceinline__ unsigned cvt_pk_bf16(float lo, float hi) { unsigned r; asm volatile("v_cvt_pk_bf16_f32 %0, %1, %2" : "=v"(r) : "v"(lo), "v"(hi)); return r; }
__device__ __forceinline__ float bf2f(unsigned short b) { return __uint_as_float(((unsigned)b) << 16); }
__device__ __forceinline__ float bflo(unsigned w) { return __uint_as_float(w << 16); }
__device__ __forceinline__ float bfhi(unsigned w) { return __uint_as_float(w & 0xffff0000u); }
__device__ __forceinline__ float sigmoidf_(float x) { return __builtin_amdgcn_rcpf(1.0f + __expf(-x)); }
__device__ __forceinline__ float siluf_(float x) { return x * sigmoidf_(x); }
__device__ __forceinline__ float gelu_tanh(float x) { return x * sigmoidf_(1.5957691216057308f * (x + 0.044715f * x * x * x)); }
__device__ __forceinline__ f32x2 ln_stats(f32x2 sm) { const float mu = sm[0] * (1.f / D); const float var = fmaxf(sm[1] * (1.f / D) - mu * mu, 0.f); return (f32x2){mu, 1.0f / sqrtf(var + LN_EPS)}; }
__device__ __forceinline__ float wave_sum(float v) {
#pragma unroll
    for (int o = 1; o < 64; o <<= 1) v += __shfl_xor(v, o);
    return v;
}
__device__ __forceinline__ float wave_max(float v) {
#pragma unroll
    for (int o = 1; o < 64; o <<= 1) v = fmaxf(v, __shfl_xor(v, o));
    return v;
}

namespace pg8 {
constexpr int BM = 256, BK = 64, HALF = 128, HTB = HALF * BK * 2, STAGE_BYTES = 8 * HTB, NXCD = 8, WGM = 8;
__host__ __device__ __forceinline__ int lds_byte(int r, int c) { const int st = (r >> 4) * 2 + (c >> 5), rr = r & 15, cc = c & 31, ob = rr * 64 + cc * 2; return st * 1024 + (ob ^ (((ob >> 9) & 1) << 5)); }
__host__ __device__ __forceinline__ void stage_rc(int b, int& R, int& C) { const int st = b / 1024, sb = b % 1024, swz = sb ^ (((sb >> 9) & 1) << 5); R = (st >> 1) * 16 + swz / 64; C = (st & 1) * 32 + (swz % 64) / 2; }
__host__ __device__ __forceinline__ int perm32(int rho) { const int n = rho >> 4, i = rho & 15; return 8 * (i >> 2) + 4 * n + (i & 3); }

struct Unit { const char* A; const char* B; int pm, pn, kind; };

__device__ __forceinline__ void tile_of(int wgid, int nM, int nN, int& pm, int& pn) {
    const int nwg = nM * nN;
    { const int q = nwg / NXCD, r = nwg % NXCD, xcd = wgid % NXCD, off = wgid / NXCD; wgid = (xcd < r ? xcd * (q + 1) : r * (q + 1) + (xcd - r) * q) + off; }
    const int nig = WGM * nN, gid = wgid / nig, fm = gid * WGM, gsz = (nM - fm) < WGM ? (nM - fm) : WGM;
    pm = fm + ((wgid % nig) % gsz); pn = (wgid % nig) / gsz;
}
struct PlainSched {
    const bf16_t* A; const bf16_t* Bt; int nM, nN, lda, ldb, G, c;
    __device__ __forceinline__ bool next(int i, Unit& u) const {
        const int L = i * G + c; if (L >= nM * nN) return false;
        tile_of(L, nM, nN, u.pm, u.pn); u.kind = 0;
        u.A = (const char*)(A + (size_t)u.pm * BM * lda); u.B = (const char*)(Bt + (size_t)u.pn * BM * ldb); return true;
    }
};
struct WinSched {
    const bf16_t* XB_; const bf16_t* WIN_; const bf16_t* MEMLN_; const bf16_t* WKV_; int G, c;
    __device__ __forceinline__ bool next(int i, Unit& u) const {
        const int L = i * G + c; constexpr int NZU = 33 * 44;
        if (L < NZU) { tile_of(L, 33, 44, u.pm, u.pn); u.kind = 0; u.A = (const char*)(XB_ + (size_t)u.pm * BM * D); u.B = (const char*)(WIN_ + (size_t)u.pn * BM * D); return true; }
        if (L < NZU + 32) { const int j = L - NZU; u.pm = j >> 3; u.pn = j & 7; u.kind = 1; u.A = (const char*)(MEMLN_ + (size_t)u.pm * BM * D); u.B = (const char*)(WKV_ + (size_t)u.pn * BM * D); return true; }
        if (L < NZU + 48) { const int j = L - NZU - 32; u.pm = j >> 2; u.pn = j & 3; u.kind = 2; u.A = (const char*)(WKV_ + (size_t)(1024 + u.pm * BM) * D); u.B = (const char*)(MEMLN_ + (size_t)u.pn * BM * D); return true; }
        return false;
    }
};
struct BranchSched {
    const bf16_t* YS_; const bf16_t* WBR_; int G, c;
    __device__ __forceinline__ bool next(int i, Unit& u) const {
        const int t = (i / 3) * G + c, k = i % 3; if (t >= 256) return false;
        tile_of(t, 32, 8, u.pm, u.pn); u.kind = k;
        u.A = (const char*)(YS_ + (size_t)u.pm * BM * (3 * BW) + k * BW); u.B = (const char*)(WBR_ + (size_t)k * D * BW + (size_t)u.pn * BM * BW); return true;
    }
};

template <class Sched, class Epi, bool ALIGN_EPI, bool SP2>
__device__ __forceinline__ void gemm_phase(LAS unsigned char* lds, const int K, const int lda, const int ldb, const Sched& S, const Epi& E) {
    int tid = threadIdx.x; asm volatile("" : "+v"(tid));
    const int wid = __builtin_amdgcn_readfirstlane(tid >> 6), lane = tid & 63, wr = wid >> 2, wc = wid & 3, fr = lane & 15, fq = lane >> 4;
    const int nt = K / BK;
    unsigned voffA[2], voffB[2];
#pragma unroll
    for (int i = 0; i < 2; ++i) { int R, C; stage_rc(tid * 16 + i * 8192, R, C); const int Rb = Epi::PERM ? ((R & ~31) + perm32(R & 31)) : R;
        voffA[i] = (unsigned)(R * lda + C) * 2u; voffB[i] = (unsigned)(Rb * ldb + C) * 2u; }
    const size_t kstep = (size_t)(BK * 2);
    const size_t hstepA = (size_t)HALF * lda * 2, hstepB = (size_t)HALF * ldb * 2;
    const unsigned ldsw = (unsigned)wid * 1024u;
    const int aoff = lds_byte(wr * 64 + fr, fq * 8), boff = lds_byte(wc * 32 + fr, fq * 8);
#define PG8_SA(b, h) (((b) * 2 + (h)) * HTB)
#define PG8_SB(b, h) ((4 + (b) * 2 + (h)) * HTB)
#define PG8_STAGE(bufoff, gbase, voff) do { _Pragma("unroll") for (int _i = 0; _i < 2; ++_i) \
        __builtin_amdgcn_global_load_lds((const unsigned*)((const char*)(gbase) + (voff)[_i]), (LAS unsigned*)(lds + (bufoff) + ldsw + _i * 8192), 16, 0, 0); } while (0)
#define PG8_LDA(dst, b, h) do { _Pragma("unroll") for (int m = 0; m < 4; ++m) _Pragma("unroll") for (int k = 0; k < 2; ++k) dst[m][k] = *(const LAS bf16x8*)(lds + PG8_SA(b, h) + aoff + m * 2048 + k * 1024); } while (0)
#define PG8_LDB(dst, b, h) do { _Pragma("unroll") for (int n = 0; n < 2; ++n) _Pragma("unroll") for (int k = 0; k < 2; ++k) dst[n][k] = *(const LAS bf16x8*)(lds + PG8_SB(b, h) + boff + n * 2048 + k * 1024); } while (0)
#define PG8_MMA(ai, bj, At, Bt) do { __builtin_amdgcn_s_setprio(1); _Pragma("unroll") for (int m = 0; m < 4; ++m) _Pragma("unroll") for (int n = 0; n < 2; ++n) _Pragma("unroll") for (int k = 0; k < 2; ++k) \
        acc[ai][bj][m][n] = __builtin_amdgcn_mfma_f32_16x16x32_bf16(Bt[n][k], At[m][k], acc[ai][bj][m][n], 0, 0, 0); __builtin_amdgcn_s_setprio(0); } while (0)
#define PG8_WAIT_V(n) asm volatile("s_waitcnt vmcnt(" #n ")" ::: "memory")
#define PG8_WAIT_L(n) asm volatile("s_waitcnt lgkmcnt(" #n ")" ::: "memory")
#define PG8_BAR __builtin_amdgcn_s_barrier()
#define PG8_SCHED __builtin_amdgcn_sched_barrier(0)
    Unit cur, nxt; int ui = 0;
    if (!S.next(0, cur)) return;
    f32x4 acc[2][2][4][2];
#pragma unroll
    for (int a = 0; a < 2; ++a)
#pragma unroll
        for (int b = 0; b < 2; ++b)
#pragma unroll
            for (int m = 0; m < 4; ++m)
#pragma unroll
                for (int n = 0; n < 2; ++n) acc[a][b][m][n] = (f32x4){0.f, 0.f, 0.f, 0.f};
    bf16x8 At[4][2], B0[2][2], B1[2][2];
    const char* cA = cur.A; const char* cB = cur.B;
    if constexpr (SP2) {
        PG8_STAGE(PG8_SB(0, 0), cB, voffB); PG8_STAGE(PG8_SB(0, 1), cB + hstepB, voffB); PG8_STAGE(PG8_SA(0, 0), cA, voffA); PG8_STAGE(PG8_SA(0, 1), cA + hstepA, voffA);
        if (wr == 1) PG8_BAR;
        PG8_WAIT_V(2); PG8_BAR;
        PG8_STAGE(PG8_SB(1, 0), cB + kstep, voffB); PG8_STAGE(PG8_SA(1, 0), cA + kstep, voffA); PG8_STAGE(PG8_SB(1, 1), cB + hstepB + kstep, voffB);
        PG8_WAIT_V(6); PG8_BAR;
    } else {
        PG8_STAGE(PG8_SB(0, 0), cB, voffB); PG8_STAGE(PG8_SA(0, 0), cA, voffA); PG8_STAGE(PG8_SB(0, 1), cB + hstepB, voffB); PG8_STAGE(PG8_SA(0, 1), cA + hstepA, voffA);
        if (wr == 1) PG8_BAR;
        PG8_WAIT_V(4); PG8_BAR;
        PG8_STAGE(PG8_SB(1, 0), cB + kstep, voffB); PG8_STAGE(PG8_SA(1, 0), cA + kstep, voffA); PG8_STAGE(PG8_SB(1, 1), cB + hstepB + kstep, voffB);
        PG8_WAIT_V(6); PG8_BAR;
    }
    for (;;) {
        const bool has_next = S.next(ui + 1, nxt);
        const char* nA = has_next ? nxt.A : cA; const char* nB = has_next ? nxt.B : cB;
        for (int t = 0; t < nt; t += 2) {
            const bool last = (t == nt - 2);
            const char* a1 = cA + (size_t)(t + 1) * kstep;
            const char* a2 = last ? nA : cA + (size_t)(t + 2) * kstep; const char* b2 = last ? nB : cB + (size_t)(t + 2) * kstep;
            const char* a3 = a2 + kstep; const char* b3 = b2 + kstep;
            if constexpr (SP2) {
            PG8_LDB(B0, 0, 0); PG8_LDB(B1, 0, 1); PG8_SCHED; PG8_LDA(At, 0, 0); PG8_STAGE(PG8_SA(1, 1), a1 + hstepA, voffA);
            PG8_WAIT_V(8); PG8_WAIT_L(0); PG8_BAR; PG8_MMA(0, 0, At, B0); PG8_MMA(0, 1, At, B1); PG8_BAR; PG8_SCHED;
            PG8_LDA(At, 0, 1); PG8_STAGE(PG8_SB(0, 0), b2, voffB); PG8_STAGE(PG8_SB(0, 1), b2 + hstepB, voffB); PG8_STAGE(PG8_SA(0, 0), a2, voffA);
            PG8_WAIT_V(8); PG8_WAIT_L(0); PG8_BAR; PG8_MMA(1, 0, At, B0); PG8_MMA(1, 1, At, B1); PG8_BAR; PG8_SCHED;
            PG8_LDB(B0, 1, 0); PG8_LDB(B1, 1, 1); PG8_SCHED; PG8_LDA(At, 1, 0); PG8_STAGE(PG8_SA(0, 1), a2 + hstepA, voffA);
            PG8_WAIT_V(8); PG8_WAIT_L(0); PG8_BAR; PG8_MMA(0, 0, At, B0); PG8_MMA(0, 1, At, B1); PG8_BAR; PG8_SCHED;
            PG8_LDA(At, 1, 1); PG8_STAGE(PG8_SB(1, 0), b3, voffB); PG8_STAGE(PG8_SB(1, 1), b3 + hstepB, voffB); PG8_STAGE(PG8_SA(1, 0), a3, voffA);
            PG8_WAIT_V(8); PG8_WAIT_L(0); PG8_BAR; PG8_MMA(1, 0, At, B0); PG8_MMA(1, 1, At, B1); PG8_BAR; PG8_SCHED;
            } else {
            PG8_LDB(B0, 0, 0); PG8_SCHED; PG8_LDA(At, 0, 0); PG8_STAGE(PG8_SA(1, 1), a1 + hstepA, voffA);
            PG8_WAIT_L(8); PG8_BAR; PG8_WAIT_L(0); PG8_MMA(0, 0, At, B0); PG8_BAR; PG8_SCHED;
            PG8_LDB(B1, 0, 1); PG8_STAGE(PG8_SB(0, 0), b2, voffB);
            PG8_BAR; PG8_WAIT_L(0); PG8_MMA(0, 1, At, B1); PG8_BAR;
            PG8_LDA(At, 0, 1); PG8_STAGE(PG8_SA(0, 0), a2, voffA);
            PG8_BAR; PG8_WAIT_L(0); PG8_MMA(1, 0, At, B0); PG8_BAR; PG8_SCHED;
            PG8_STAGE(PG8_SB(0, 1), b2 + hstepB, voffB);
            PG8_WAIT_V(6); PG8_BAR; PG8_MMA(1, 1, At, B1); PG8_BAR;
            PG8_LDB(B0, 1, 0); PG8_SCHED; PG8_LDA(At, 1, 0); PG8_STAGE(PG8_SA(0, 1), a2 + hstepA, voffA);
            PG8_WAIT_L(8); PG8_BAR; PG8_WAIT_L(0); PG8_MMA(0, 0, At, B0); PG8_BAR; PG8_SCHED;
            PG8_LDB(B1, 1, 1); PG8_STAGE(PG8_SB(1, 0), b3, voffB);
            PG8_BAR; PG8_WAIT_L(0); PG8_MMA(0, 1, At, B1); PG8_BAR;
            PG8_LDA(At, 1, 1); PG8_STAGE(PG8_SA(1, 0), a3, voffA);
            PG8_BAR; PG8_WAIT_L(0); PG8_MMA(1, 0, At, B0); PG8_BAR; PG8_SCHED;
            PG8_STAGE(PG8_SB(1, 1), b3 + hstepB, voffB);
            PG8_WAIT_V(6); PG8_BAR; PG8_MMA(1, 1, At, B1); PG8_BAR;
            }
        }
        if constexpr (ALIGN_EPI) { if (wr == 0) PG8_BAR; }
        E(acc, cur, wr, wc, fr, fq);
        if (!has_next) break;
        bool keep = false;
        if constexpr (Epi::CAN_KEEP) keep = (cur.kind < 2);
        if (!keep) {
#pragma unroll
        for (int a = 0; a < 2; ++a)
#pragma unroll
            for (int b = 0; b < 2; ++b)
#pragma unroll
                for (int m = 0; m < 4; ++m)
#pragma unroll
                    for (int n = 0; n < 2; ++n) acc[a][b][m][n] = (f32x4){0.f, 0.f, 0.f, 0.f};
        }
        cur = nxt; cA = nA; cB = nB; ++ui;
        if constexpr (ALIGN_EPI) { if (wr == 1) PG8_BAR; }
    }
    PG8_WAIT_V(0);
    if constexpr (!ALIGN_EPI) { if (wr == 0) PG8_BAR; }
    PG8_BAR;
#undef PG8_SA
#undef PG8_SB
#undef PG8_STAGE
#undef PG8_LDA
#undef PG8_LDB
#undef PG8_MMA
#undef PG8_WAIT_V
#undef PG8_WAIT_L
#undef PG8_BAR
#undef PG8_SCHED
}


struct EpiSwiglu {
    static constexpr bool PERM = true, CAN_KEEP = false;
    bf16_t* H; int ldh;
    const float* rsum; const float* cs;
    __device__ __forceinline__ void operator()(const f32x4 (&acc)[2][2][4][2], const Unit& u, int wr, int wc, int fr, int fq) const {
        const int row0 = u.pm * BM + wr * 64 + fr, col0 = u.pn * HALF + wc * 32 + 8 * fq;
        f32x4 s1[2][2], s2[2][2];
#pragma unroll
        for (int bj = 0; bj < 2; ++bj)
#pragma unroll
            for (int n = 0; n < 2; ++n) { s1[bj][n] = (f32x4){0.f, 0.f, 0.f, 0.f}; s2[bj][n] = s1[bj][n];
                if (rsum) { const int ci = u.pn * BM + bj * HALF + wc * 32 + 8 * fq + 4 * n; s1[bj][n] = *(const f32x4*)(cs + ci); s2[bj][n] = *(const f32x4*)(cs + NZ + ci); } }
#pragma unroll
        for (int ai = 0; ai < 2; ++ai)
#pragma unroll
            for (int m = 0; m < 4; ++m) {
                const int r = row0 + ai * HALF + m * 16;
                bf16_t* rowp = H + (size_t)r * ldh + col0;
                f32x2 st = (f32x2){0.f, 1.f};
                if (rsum) st = ln_stats(*(const f32x2*)(rsum + 2 * (size_t)r));
                f32x4 v0, v1;
#pragma unroll
                for (int j = 0; j < 4; ++j) {
                    const float g0 = st[1] * (acc[ai][0][m][0][j] - st[0] * s1[0][0][j]) + s2[0][0][j], u0 = st[1] * (acc[ai][1][m][0][j] - st[0] * s1[1][0][j]) + s2[1][0][j];
                    const float g1 = st[1] * (acc[ai][0][m][1][j] - st[0] * s1[0][1][j]) + s2[0][1][j], u1 = st[1] * (acc[ai][1][m][1][j] - st[0] * s1[1][1][j]) + s2[1][1][j];
                    v0[j] = siluf_(g0) * u0; v1[j] = siluf_(g1) * u1;
                }
                u32x4 w; w.x = cvt_pk_bf16(v0[0], v0[1]); w.y = cvt_pk_bf16(v0[2], v0[3]); w.z = cvt_pk_bf16(v1[0], v1[1]); w.w = cvt_pk_bf16(v1[2], v1[3]);
                *(u32x4*)rowp = w;
            }
    }
};
struct EpiResid {
    static constexpr bool PERM = false, CAN_KEEP = false;
    float* Y; const float* res; const float* rin; const float* lg; const float* lb; float alpha, scale; bf16_t* yb; float* rout; bool stream;
    __device__ __forceinline__ void operator()(const f32x4 (&acc)[2][2][4][2], const Unit& u, int wr, int wc, int fr, int fq) const {
        const int row0 = u.pm * BM + wr * 64 + fr, col0 = u.pn * BM + wc * 32 + 4 * fq;
        f32x4 gg[2][2], bb[2][2];
#pragma unroll
        for (int bj = 0; bj < 2; ++bj)
#pragma unroll
            for (int n = 0; n < 2; ++n) { gg[bj][n] = (f32x4){1.f, 1.f, 1.f, 1.f}; bb[bj][n] = (f32x4){0.f, 0.f, 0.f, 0.f};
                if (rin) { gg[bj][n] = *(const f32x4*)(lg + col0 + bj * HALF + n * 16); bb[bj][n] = *(const f32x4*)(lb + col0 + bj * HALF + n * 16); } }
#pragma unroll
        for (int ai = 0; ai < 2; ++ai)
#pragma unroll
            for (int m2 = 0; m2 < 2; ++m2) {
                f32x4 xv[2][2][2]; f32x2 st[2];
#pragma unroll
                for (int mm = 0; mm < 2; ++mm) {
                    const int r = row0 + ai * HALF + (2 * m2 + mm) * 16;
                    st[mm] = (f32x2){0.f, 1.f};
                    if (rin) st[mm] = ln_stats(*(const f32x2*)(rin + 2 * (size_t)r));
#pragma unroll
                    for (int bj = 0; bj < 2; ++bj)
#pragma unroll
                        for (int n = 0; n < 2; ++n) { const f32x4* rp = (const f32x4*)(res + (size_t)r * D + col0 + bj * HALF + n * 16); xv[mm][bj][n] = stream ? __builtin_nontemporal_load(rp) : *rp; }
                }
#pragma unroll
                for (int mm = 0; mm < 2; ++mm) {
                    const int r = row0 + ai * HALF + (2 * m2 + mm) * 16;
                    float ps = 0.f, pq = 0.f;
#pragma unroll
                    for (int bj = 0; bj < 2; ++bj)
#pragma unroll
                        for (int n = 0; n < 2; ++n) {
                            const f32x4 x = (xv[mm][bj][n] - st[mm][0]) * (gg[bj][n] * st[mm][1]) + bb[bj][n];
                            const f32x4 o = x * alpha + acc[ai][bj][2 * m2 + mm][n] * scale;
                            const size_t off = (size_t)r * D + col0 + bj * HALF + n * 16;
                            *(f32x4*)(Y + off) = o;
                            if (yb) { u32x2 w; w.x = cvt_pk_bf16(o[0], o[1]); w.y = cvt_pk_bf16(o[2], o[3]); *(u32x2*)(yb + off) = w; }
                            ps += (o[0] + o[1]) + (o[2] + o[3]); pq += (o[0] * o[0] + o[1] * o[1]) + (o[2] * o[2] + o[3] * o[3]);
                        }
                    if (rout) {
                        ps += __shfl_xor(ps, 16); pq += __shfl_xor(pq, 16); ps += __shfl_xor(ps, 32); pq += __shfl_xor(pq, 32);
                        if (fq == 0) { atomicAdd(rout + 2 * (size_t)r, ps); atomicAdd(rout + 2 * (size_t)r + 1, pq); }
                    }
                }
            }
    }
};
struct EpiWin {
    static constexpr bool PERM = true, CAN_KEEP = false;
    bf16_t* Z; const LAS float* gate_b; float* outK; float* outV; bf16_t* KB; bf16_t* VT; const float* rsum; const float* cs;
    __device__ __forceinline__ void operator()(const f32x4 (&acc)[2][2][4][2], const Unit& u, int wr, int wc, int fr, int fq) const {
        const int row0 = u.pm * BM + wr * 64 + fr, col0 = u.pn * BM + wc * 32 + 8 * fq;
        if (u.kind == 0) {
            const int mode = (u.pn < 8) ? 1 : (u.pn < 12) ? 0 : (u.pn < 16) ? 1 : (u.pn < 20) ? 0 : 2;
            f32x4 gb[2][2];
#pragma unroll
            for (int bj = 0; bj < 2; ++bj)
#pragma unroll
                for (int n = 0; n < 2; ++n) gb[bj][n] = (mode == 2) ? *(const LAS f32x4*)(gate_b + (col0 - 5120) + bj * HALF + 4 * n) : (f32x4){0.f, 0.f, 0.f, 0.f};
            f32x4 s1[2][2], s2[2][2];
#pragma unroll
            for (int bj = 0; bj < 2; ++bj)
#pragma unroll
                for (int n = 0; n < 2; ++n) { s1[bj][n] = *(const f32x4*)(cs + col0 + bj * HALF + 4 * n); s2[bj][n] = *(const f32x4*)(cs + NZ + col0 + bj * HALF + 4 * n); }
#pragma unroll
            for (int ai = 0; ai < 2; ++ai)
#pragma unroll
                for (int m = 0; m < 4; ++m) {
                    const int r = row0 + ai * HALF + m * 16;
                    bf16_t* rowp = Z + (size_t)r * NZ + col0;
                    const f32x2 st = ln_stats(*(const f32x2*)(rsum + 2 * (size_t)r));
#pragma unroll
                    for (int bj = 0; bj < 2; ++bj) {
                        f32x4 v0 = (acc[ai][bj][m][0] - s1[bj][0] * st[0]) * st[1] + s2[bj][0], v1 = (acc[ai][bj][m][1] - s1[bj][1] * st[0]) * st[1] + s2[bj][1];
                        if (mode == 1) {
#pragma unroll
                            for (int j = 0; j < 4; ++j) { v0[j] = gelu_tanh(v0[j]); v1[j] = gelu_tanh(v1[j]); }
                        } else if (mode == 2) {
#pragma unroll
                            for (int j = 0; j < 4; ++j) { v0[j] = sigmoidf_(v0[j] + gb[bj][0][j]); v1[j] = sigmoidf_(v1[j] + gb[bj][1][j]); }
                        }
                        u32x4 w; w.x = cvt_pk_bf16(v0[0], v0[1]); w.y = cvt_pk_bf16(v0[2], v0[3]); w.z = cvt_pk_bf16(v1[0], v1[1]); w.w = cvt_pk_bf16(v1[2], v1[3]);
                        *(u32x4*)(rowp + bj * HALF) = w;
                    }
                }
        } else if (u.kind == 1) {
            const bool isk = u.pn < 4; const int c0 = col0 - (isk ? 0 : 1024);
            float* ob = isk ? outK : outV;
#pragma unroll
            for (int ai = 0; ai < 2; ++ai)
#pragma unroll
                for (int m = 0; m < 4; ++m) {
                    const size_t off = (size_t)(row0 + ai * HALF + m * 16) * 1024 + c0;
#pragma unroll
                    for (int bj = 0; bj < 2; ++bj) {
                        const f32x4 v0 = acc[ai][bj][m][0], v1 = acc[ai][bj][m][1];
                        __builtin_nontemporal_store(v0, (f32x4*)(ob + off + bj * HALF)); __builtin_nontemporal_store(v1, (f32x4*)(ob + off + bj * HALF + 4));
                        if (isk) { u32x4 w; w.x = cvt_pk_bf16(v0[0], v0[1]); w.y = cvt_pk_bf16(v0[2], v0[3]); w.z = cvt_pk_bf16(v1[0], v1[1]); w.w = cvt_pk_bf16(v1[2], v1[3]); *(u32x4*)(KB + off + bj * HALF) = w; }
                    }
                }
        } else {
#pragma unroll
            for (int ai = 0; ai < 2; ++ai)
#pragma unroll
                for (int m = 0; m < 4; ++m) {
                    bf16_t* rowp = VT + (size_t)(row0 + ai * HALF + m * 16) * 1024 + col0;
#pragma unroll
                    for (int bj = 0; bj < 2; ++bj) {
                        const f32x4 v0 = acc[ai][bj][m][0], v1 = acc[ai][bj][m][1];
                        u32x4 w; w.x = cvt_pk_bf16(v0[0], v0[1]); w.y = cvt_pk_bf16(v0[2], v0[3]); w.z = cvt_pk_bf16(v1[0], v1[1]); w.w = cvt_pk_bf16(v1[2], v1[3]);
                        *(u32x4*)(rowp + bj * HALF) = w;
                    }
                }
        }
    }
};
struct EpiMerge {
    static constexpr bool PERM = true, CAN_KEEP = true;
    const bf16_t* Z; bf16_t* MB;
    __device__ __forceinline__ void operator()(f32x4 (&acc)[2][2][4][2], const Unit& u, int wr, int wc, int fr, int fq) const {
        const int row0 = u.pm * BM + wr * 64 + fr, col0 = u.pn * BM + wc * 32 + 8 * fq;
        const bool last = (u.kind == 2);
        const int koff = 5120 + u.kind * 2048, noff = last ? 0 : 2048;
#pragma unroll
        for (int ai = 0; ai < 2; ++ai)
#pragma unroll
            for (int m2 = 0; m2 < 2; ++m2) {
                u32x4 ga[2][2], gb[2][2];
#pragma unroll
                for (int mm = 0; mm < 2; ++mm)
#pragma unroll
                    for (int bj = 0; bj < 2; ++bj) {
                        const bf16_t* zp = Z + (size_t)(row0 + ai * HALF + (2 * m2 + mm) * 16) * NZ + koff + col0 + bj * HALF;
                        ga[mm][bj] = *(const u32x4*)zp;
                        gb[mm][bj] = *(const u32x4*)(zp + noff);
                    }
#pragma unroll
                for (int mm = 0; mm < 2; ++mm)
#pragma unroll
                    for (int bj = 0; bj < 2; ++bj) {
                        const int m = 2 * m2 + mm;
                        const u32x4 a4 = ga[mm][bj], b4 = gb[mm][bj];
                        f32x4 g0 = (f32x4){bflo(a4.x), bfhi(a4.x), bflo(a4.y), bfhi(a4.y)}, g1 = (f32x4){bflo(a4.z), bfhi(a4.z), bflo(a4.w), bfhi(a4.w)};
                        const f32x4 h0 = (f32x4){bflo(b4.x), bfhi(b4.x), bflo(b4.y), bfhi(b4.y)}, h1 = (f32x4){bflo(b4.z), bfhi(b4.z), bflo(b4.w), bfhi(b4.w)};
#pragma unroll
                        for (int j = 0; j < 4; ++j) {
                            g0[j] = fmaxf(g0[j], 1e-6f) * (last ? 1.0f : __builtin_amdgcn_rcpf(fmaxf(h0[j], 1e-6f)));
                            g1[j] = fmaxf(g1[j], 1e-6f) * (last ? 1.0f : __builtin_amdgcn_rcpf(fmaxf(h1[j], 1e-6f)));
                        }
                        acc[ai][bj][m][0] *= g0; acc[ai][bj][m][1] *= g1;
                        if (last) {
                            const f32x4 v0 = acc[ai][bj][m][0], v1 = acc[ai][bj][m][1];
                            u32x4 w; w.x = cvt_pk_bf16(v0[0], v0[1]); w.y = cvt_pk_bf16(v0[2], v0[3]); w.z = cvt_pk_bf16(v1[0], v1[1]); w.w = cvt_pk_bf16(v1[2], v1[3]);
                            *(u32x4*)(MB + (size_t)(row0 + ai * HALF + m * 16) * D + col0 + bj * HALF) = w;
                        }
                    }
            }
    }
};
}

#ifndef PHMASK
#define PHMASK 0xFFFFFFFFu
#endif
#ifndef GREP
#define GREP 1
#endif
#ifndef NREP
#define NREP 1
#endif
#define PHON(n) (((PHMASK) >> (n)) & 1u)
#define LDS_WAIT() asm volatile("s_waitcnt lgkmcnt(0)" ::: "memory")

__device__ __forceinline__ void transpose_item(const float* W, int N, bf16_t* WT, int ldk, int k0, int n0, int dst_row0, LAS float* scr, int lane, const float* fg, const float* fb, float* cs) {
    f32x4 v[8];
    const int n4 = (lane & 7) * 4, kr = lane >> 3;
#pragma unroll
    for (int i = 0; i < 8; ++i) v[i] = __builtin_nontemporal_load((const f32x4*)(W + (size_t)(k0 + kr + 8 * i) * N + n0 + n4));
#pragma unroll
    for (int i = 0; i < 8; ++i) { LAS float* d = scr + (kr + 8 * i) * 33 + n4; d[0] = v[i][0]; d[1] = v[i][1]; d[2] = v[i][2]; d[3] = v[i][3]; }
    LDS_WAIT(); asm volatile("" ::: "memory");
    const int c = lane & 7;
    f32x4 g0 = (f32x4){1.f, 1.f, 1.f, 1.f}, g1 = g0, b0 = (f32x4){0.f, 0.f, 0.f, 0.f}, b1 = b0;
    if (fg) { g0 = *(const f32x4*)(fg + k0 + 8 * c); g1 = *(const f32x4*)(fg + k0 + 8 * c + 4); b0 = *(const f32x4*)(fb + k0 + 8 * c); b1 = *(const f32x4*)(fb + k0 + 8 * c + 4); }
#pragma unroll
    for (int j = 0; j < 4; ++j) { const int n = (lane >> 3) + 8 * j; const LAS float* s = scr + (8 * c) * 33 + n;
        const f32x4 w0 = (f32x4){s[0 * 33], s[1 * 33], s[2 * 33], s[3 * 33]}, w1 = (f32x4){s[4 * 33], s[5 * 33], s[6 * 33], s[7 * 33]};
        const f32x4 f0 = w0 * g0, f1 = w1 * g1;
        u32x4 o; o.x = cvt_pk_bf16(f0[0], f0[1]); o.y = cvt_pk_bf16(f0[2], f0[3]); o.z = cvt_pk_bf16(f1[0], f1[1]); o.w = cvt_pk_bf16(f1[2], f1[3]);
        *(u32x4*)(WT + (size_t)(dst_row0 + n) * ldk + k0 + 8 * c) = o;
        if (fg) {
            float p1 = ((bflo(o.x) + bfhi(o.x)) + (bflo(o.y) + bfhi(o.y))) + ((bflo(o.z) + bfhi(o.z)) + (bflo(o.w) + bfhi(o.w)));
            const f32x4 t0 = w0 * b0, t1 = w1 * b1;
            float p2 = ((t0[0] + t0[1]) + (t0[2] + t0[3])) + ((t1[0] + t1[1]) + (t1[2] + t1[3]));
            p1 += __shfl_xor(p1, 1); p2 += __shfl_xor(p2, 1); p1 += __shfl_xor(p1, 2); p2 += __shfl_xor(p2, 2); p1 += __shfl_xor(p1, 4); p2 += __shfl_xor(p2, 4);
            if (c == 0) { atomicAdd(cs + dst_row0 + n, p1); atomicAdd(cs + NZ + dst_row0 + n, p2); }
        } }
    LDS_WAIT(); asm volatile("" ::: "memory");
}
__device__ __forceinline__ void ln_row(const float* yrow, const float* g, const float* b, float* of, bf16_t* ob, int lane) {
    f32x4 v[8]; float s = 0.f;
#pragma unroll
    for (int j = 0; j < 8; ++j) { v[j] = *(const f32x4*)(yrow + 4 * lane + 256 * j); s += (v[j][0] + v[j][1]) + (v[j][2] + v[j][3]); }
    const float mean = wave_sum(s) * (1.f / D); float s2 = 0.f;
#pragma unroll
    for (int j = 0; j < 8; ++j) { v[j] = v[j] - mean; s2 += (v[j][0] * v[j][0] + v[j][1] * v[j][1]) + (v[j][2] * v[j][2] + v[j][3] * v[j][3]); }
    const float rstd = 1.0f / sqrtf(wave_sum(s2) * (1.f / D) + LN_EPS);
#pragma unroll
    for (int j = 0; j < 8; ++j) {
        const f32x4 gg = *(const f32x4*)(g + 4 * lane + 256 * j), bb = *(const f32x4*)(b + 4 * lane + 256 * j);
        const f32x4 o = v[j] * rstd * gg + bb;
        if (of) __builtin_nontemporal_store(o, (f32x4*)(of + 4 * lane + 256 * j));
        if (ob) { u32x2 w; w.x = cvt_pk_bf16(o[0], o[1]); w.y = cvt_pk_bf16(o[2], o[3]); *(u32x2*)(ob + 4 * lane + 256 * j) = w; }
    }
}

#define XB_TMO      128
#define XB_XCNT(j)  (256  + 64 * (j))
#define XB_XSUB(j)  (1280 + 64 * (j))
#define XB_XGEN(j)  (2304 + 64 * (j))
#define XB_TOP      3328
#define XB_TOPGEN   3392
#define XCD_BAR_WORDS 3456
#define XB_SPIN_CAP (1u << 22)
__device__ __forceinline__ unsigned xb_ld(unsigned* p)              { return __hip_atomic_load(p, __ATOMIC_RELAXED, __HIP_MEMORY_SCOPE_AGENT); }
__device__ __forceinline__ unsigned xb_add(unsigned* p, unsigned v) { return __hip_atomic_fetch_add(p, v, __ATOMIC_RELAXED, __HIP_MEMORY_SCOPE_AGENT); }
__device__ __forceinline__ unsigned xb_xcc_id() { return (unsigned)__builtin_amdgcn_s_getreg((3 << 11) | 20) & 0xFu; }
#define XB_SPIN(cond, bar) do { unsigned _sp = 0; while (cond) { __builtin_amdgcn_s_sleep(1); \
    if ((++_sp & 255u) == 0u) { if (xb_ld(&(bar)[XB_TMO])) break; if (_sp > XB_SPIN_CAP) { atomicAdd(&(bar)[XB_TMO], 1u); break; } } } } while (0)
struct XcdBarrier { unsigned* bar; unsigned x; volatile LAS unsigned* st; };
__device__ __forceinline__ XcdBarrier xcd_barrier_post(unsigned* bar, volatile LAS unsigned* st) {
    XcdBarrier b; b.bar = bar; b.x = xb_xcc_id(); b.st = st;
    if (threadIdx.x == 0) (void)xb_add(&bar[XB_XCNT(b.x)], 1u);
    return b;
}
__device__ __forceinline__ void xcd_barrier_complete(unsigned* bar, unsigned x, unsigned& nloc, unsigned& nx) {
    const unsigned G = gridDim.x * gridDim.y * gridDim.z;
    unsigned sum, cnt, mine, sp = 0u;
    for (;;) {
        sum = 0u; cnt = 0u; mine = 0u;
#pragma unroll
        for (unsigned j = 0; j < 16; ++j) { const unsigned c = xb_ld(&bar[XB_XCNT(j)]); sum += c; cnt += (c > 0u) ? 1u : 0u; mine = (j == x) ? c : mine; }
        if (sum == G) break;
        __builtin_amdgcn_s_sleep(1);
        if ((++sp & 255u) == 0u) { if (xb_ld(&bar[XB_TMO])) break; if (sp > XB_SPIN_CAP) { atomicAdd(&bar[XB_TMO], 1u); break; } }
    }
    nloc = mine > 0u ? mine : 1u; nx = cnt > 0u ? cnt : 1u;
}
__device__ __forceinline__ void xcd_barrier(const XcdBarrier& b) {
    asm volatile("s_waitcnt vmcnt(0)" ::: "memory");
    __syncthreads();
    if (threadIdx.x == 0) {
        unsigned* bar = b.bar;
        __builtin_amdgcn_s_waitcnt(0);
        unsigned nloc = b.st[0], nx = b.st[1];
        if (nloc == 0u) { xcd_barrier_complete(bar, b.x, nloc, nx); b.st[0] = nloc; b.st[1] = nx; }
        const unsigned old = xb_add(&bar[XB_XSUB(b.x)], 1u);
        const unsigned gen = old / nloc;
        if (old + 1u == (gen + 1u) * nloc) {
            __builtin_amdgcn_fence(__ATOMIC_RELEASE, "agent");
            asm volatile("s_waitcnt vmcnt(0)" ::: "memory");
            const unsigned og = xb_add(&bar[XB_TOP], 1u);
            const unsigned tg = og / nx;
            if (og + 1u == (tg + 1u) * nx) xb_add(&bar[XB_TOPGEN], 1u);
            else XB_SPIN(xb_ld(&bar[XB_TOPGEN]) == tg, bar);
            __builtin_amdgcn_fence(__ATOMIC_ACQUIRE, "agent");
            xb_add(&bar[XB_XGEN(b.x)], 1u);
            asm volatile("s_waitcnt vmcnt(0)" ::: "memory");
        } else {
            XB_SPIN(xb_ld(&bar[XB_XGEN(b.x)]) == gen, bar);
            __builtin_amdgcn_fence(__ATOMIC_ACQUIRE, "agent");
            asm volatile("s_waitcnt vmcnt(0)" ::: "memory");
        }
    }
    __syncthreads();
}

template <int MODE>
__device__ __forceinline__ void skinny(LAS unsigned char* lds, int bid, int G, int wave, int lane, const bf16_t* A, int lda, const bf16_t* Bt, int ldb, int K,
                                       float* Ys, const float* res, float alpha, float scale, const bf16_t* Zs, bf16_t* MBs,
                                       const float* rin, const float* lg, const float* lb, bf16_t* ybs, float* rout) {
    const int fr = lane & 15, fq = lane >> 4, tw = wave & 3, kh = wave >> 2;
    LAS f32x4* red = (LAS f32x4*)lds;
    for (int T0 = bid * 4; T0 < 1024; T0 += G * 4) {
        const int T = T0 + tw, rt = T >> 7, ct = T & 127;
        f32x4 tot = (f32x4){0.f, 0.f, 0.f, 0.f};
        if (MODE == 0) {
            const int kb = kh * (K / 2);
            const bf16_t* ap = A + (size_t)(rt * 16 + fr) * lda + kb + fq * 8;
            const bf16_t* bp = Bt + (size_t)(ct * 16 + fr) * ldb + kb + fq * 8;
#pragma unroll 16
            for (int ks = 0; ks < K / 64; ++ks) {
                const bf16x8 af = *(const bf16x8*)(ap + ks * 32), bfv = *(const bf16x8*)(bp + ks * 32);
                tot = __builtin_amdgcn_mfma_f32_16x16x32_bf16(bfv, af, tot, 0, 0, 0);
            }
        } else {
#pragma unroll
            for (int k = 0; k < 3; ++k) {
                const int kb = kh * (BW / 2);
                const bf16_t* ap = A + (size_t)(rt * 16 + fr) * lda + k * BW + kb + fq * 8;
                const bf16_t* bp = Bt + (size_t)k * D * BW + (size_t)(ct * 16 + fr) * ldb + kb + fq * 8;
                f32x4 acc = (f32x4){0.f, 0.f, 0.f, 0.f};
#pragma unroll 8
                for (int ks = 0; ks < BW / 64; ++ks) {
                    const bf16x8 af = *(const bf16x8*)(ap + ks * 32), bfv = *(const bf16x8*)(bp + ks * 32);
                    acc = __builtin_amdgcn_mfma_f32_16x16x32_bf16(bfv, af, acc, 0, 0, 0);
                }
                const u32x2 gw = *(const u32x2*)(Zs + (size_t)(rt * 16 + fr) * NZ + 5120 + k * 2048 + ct * 16 + 4 * fq);
                tot += acc * (f32x4){bflo(gw.x), bfhi(gw.x), bflo(gw.y), bfhi(gw.y)};
            }
        }
        if (kh == 1) red[tw * 64 + lane] = tot;
        __syncthreads();
        if (kh == 0) {
            tot += red[tw * 64 + lane];
            const size_t off = (size_t)(rt * 16 + fr) * D + ct * 16 + 4 * fq;
            if (MODE == 0) {
                f32x4 xv = *(const f32x4*)(res + off);
                if (rin) { const f32x2 st = ln_stats(*(const f32x2*)(rin + 2 * (rt * 16 + fr))); const int cc = ct * 16 + 4 * fq;
                    xv = (xv - st[0]) * (*(const f32x4*)(lg + cc) * st[1]) + *(const f32x4*)(lb + cc); }
                const f32x4 o = xv * alpha + tot * scale;
                *(f32x4*)(Ys + off) = o;
                if (ybs) { u32x2 w; w.x = cvt_pk_bf16(o[0], o[1]); w.y = cvt_pk_bf16(o[2], o[3]); *(u32x2*)(ybs + off) = w; }
                if (rout) { float ps = (o[0] + o[1]) + (o[2] + o[3]), pq = (o[0] * o[0] + o[1] * o[1]) + (o[2] * o[2] + o[3] * o[3]);
                    ps += __shfl_xor(ps, 16); pq += __shfl_xor(pq, 16); ps += __shfl_xor(ps, 32); pq += __shfl_xor(pq, 32);
                    if (fq == 0) { atomicAdd(rout + 2 * (rt * 16 + fr), ps); atomicAdd(rout + 2 * (rt * 16 + fr) + 1, pq); } }
            }
            else { u32x2 w; w.x = cvt_pk_bf16(tot[0], tot[1]); w.y = cvt_pk_bf16(tot[2], tot[3]); *(u32x2*)(MBs + off) = w; }
        }
        __syncthreads();
    }
}

#define WGU1 ((bf16_t*)(P.ws + WS_WGU1))
#define WD1 ((bf16_t*)(P.ws + WS_WD1))
#define WIN ((bf16_t*)(P.ws + WS_WIN))
#define WKV ((bf16_t*)(P.ws + WS_WKV))
#define WBR ((bf16_t*)(P.ws + WS_WBR))
#define WOUT ((bf16_t*)(P.ws + WS_WOUT))
#define WGU2 ((bf16_t*)(P.ws + WS_WGU2))
#define WD2 ((bf16_t*)(P.ws + WS_WD2))
#define WLRU ((bf16_t*)(P.ws + WS_WLRU))
#define WSP ((bf16_t*)(P.ws + WS_WSP))
#define XB ((bf16_t*)(P.ws + WS_XB))
#define Z ((bf16_t*)(P.ws + WS_ZH))
#define H ((bf16_t*)(P.ws + WS_ZH))
#define Y ((float*)(P.ws + WS_Y))
#define X1 ((float*)(P.ws + WS_X1))
#define CSUM ((float*)(P.ws + WS_CS))
#define GSB ((float*)(P.ws + WS_GSB))
#define YB2 ((bf16_t*)(P.ws + WS_X1))
#define RSUM ((float*)(P.ws + WS_RS))
#define VP ((bf16_t*)(P.ws + WS_VP))
#define HL ((float*)(P.ws + WS_HL))
#define AC ((float*)(P.ws + WS_AC))
#define SUM ((float*)(P.ws + WS_SUM))
#define YS ((bf16_t*)(P.ws + WS_YS))
#define MEMLN ((bf16_t*)(P.ws + WS_MEMLN))
#define KB ((bf16_t*)(P.ws + WS_KB))
#define VT ((bf16_t*)(P.ws + WS_VT))
__device__ __forceinline__ void p5d_sample_attn(const Params& P, LAS unsigned char* lds, int bid, int G, int tid_in) {
    int tid = tid_in; asm volatile("" : "+v"(tid));
    const int lane = tid & 63, wave = __builtin_amdgcn_readfirstlane(tid >> 6);

        LAS float* sS = (LAS float*)(lds + 131072);
        LAS float* sO = (LAS float*)(lds + 131072 + 1024);
        const int vb = (G % 8 == 0) ? (bid & 7) * (G >> 3) + (bid >> 3) : bid;
        for (int it = vb; it < 512; it += G) {
            const int b = it >> 2, h = it & 3;
            const u32x2 qw = *(const u32x2*)(Z + (size_t)(MP + b) * NZ + 4096 + h * HD + 4 * lane);
            const f32x4 q = (f32x4){bflo(qw.x), bfhi(qw.x), bflo(qw.y), bfhi(qw.y)};
            const float* kbase = P.in[I_CK] + ((size_t)(b * NMEM + 32 * wave) * NH + h) * HD + 4 * lane;
            const float* vbase = P.in[I_CV] + ((size_t)(b * NMEM + 32 * wave) * NH + h) * HD + 4 * lane;
            float d[32];
#pragma unroll
            for (int mi = 0; mi < 32; ++mi) {
                const f32x4 kv = __builtin_nontemporal_load((const f32x4*)(kbase + (size_t)mi * (NH * HD)));
                d[mi] = (kv[0] * q[0] + kv[1] * q[1]) + (kv[2] * q[2] + kv[3] * q[3]);
                if (mi == 15) asm volatile("" ::: "memory");
            }
#pragma unroll
            for (int i = 0; i < 16; ++i) { const bool hi = (lane & 32) != 0; const float snd = hi ? d[i] : d[i + 16], kp = hi ? d[i + 16] : d[i]; d[i] = kp + __shfl_xor(snd, 32); }
#pragma unroll
            for (int i = 0; i < 8; ++i) { const bool hi = (lane & 16) != 0; const float snd = hi ? d[i] : d[i + 8], kp = hi ? d[i + 8] : d[i]; d[i] = kp + __shfl_xor(snd, 16); }
#pragma unroll
            for (int i = 0; i < 4; ++i) { const bool hi = (lane & 8) != 0; const float snd = hi ? d[i] : d[i + 4], kp = hi ? d[i + 4] : d[i]; d[i] = kp + __shfl_xor(snd, 8); }
#pragma unroll
            for (int i = 0; i < 2; ++i) { const bool hi = (lane & 4) != 0; const float snd = hi ? d[i] : d[i + 2], kp = hi ? d[i + 2] : d[i]; d[i] = kp + __shfl_xor(snd, 4); }
            { const bool hi = (lane & 2) != 0; const float snd = hi ? d[0] : d[1], kp = hi ? d[1] : d[0]; d[0] = kp + __shfl_xor(snd, 2); }
            d[0] += __shfl_xor(d[0], 1);
            if ((lane & 1) == 0) sS[32 * wave + (lane >> 1)] = d[0] * 0.0625f;
            f32x4 vv[16];
#pragma unroll
            for (int mi = 0; mi < 16; ++mi) vv[mi] = __builtin_nontemporal_load((const f32x4*)(vbase + (size_t)mi * (NH * HD)));
            __syncthreads();
            float mx = fmaxf(fmaxf(sS[lane], sS[lane + 64]), fmaxf(sS[lane + 128], sS[lane + 192]));
            mx = wave_max(mx);
            float sm = __expf(sS[lane] - mx) + __expf(sS[lane + 64] - mx) + __expf(sS[lane + 128] - mx) + __expf(sS[lane + 192] - mx);
            sm = wave_sum(sm);
            const float inv = 1.0f / sm;
            f32x4 o = (f32x4){0.f, 0.f, 0.f, 0.f};
            f32x4 vw[16];
#pragma unroll
            for (int mi = 0; mi < 16; ++mi) vw[mi] = __builtin_nontemporal_load((const f32x4*)(vbase + (size_t)(16 + mi) * (NH * HD)));
#pragma unroll
            for (int mi = 0; mi < 16; ++mi) { const float p = __expf(sS[32 * wave + mi] - mx) * inv; o += vv[mi] * p; }
#pragma unroll
            for (int mi = 0; mi < 16; ++mi) { const float p = __expf(sS[32 * wave + 16 + mi] - mx) * inv; o += vw[mi] * p; }
            *(LAS f32x4*)(sO + wave * 256 + 4 * lane) = o;
            __syncthreads();
            if (tid < 256) {
                float a = 0.f;
#pragma unroll
                for (int w = 0; w < 8; ++w) a += sO[w * 256 + tid];
                YS[(size_t)(MP + b) * 3072 + 2048 + h * HD + tid] = (bf16_t)(cvt_pk_bf16(a, 0.f) & 0xffffu);
            }
            __syncthreads();
        }
}

__global__ void __launch_bounds__(NTHREADS, 2) fwd_kernel(Params P) {
    extern __shared__ __attribute__((aligned(16))) unsigned char lds_raw[];
    LAS unsigned char* lds = (LAS unsigned char*)lds_raw;
    cg::grid_group grid = cg::this_grid();
    const int tid = threadIdx.x, lane = tid & 63, wave = __builtin_amdgcn_readfirstlane(tid >> 6);
    const int G = gridDim.x, bid = blockIdx.x;
    const int gw = bid * NWAVES + wave, NGW = G * NWAVES;
    float* out = P.out;
    volatile LAS unsigned* bst = (volatile LAS unsigned*)(lds + LDS_BYTES - 64);
    if (tid == 0) { bst[0] = 0u; bst[1] = 0u; }
    __syncthreads();
    const XcdBarrier gbar = xcd_barrier_post((unsigned*)(P.ws + WS_BAR), bst);
#define GRID_BAR() xcd_barrier(gbar)

    if (PHON(0)) {
        LAS float* scr = (LAS float*)(lds + wave * 16384);
        constexpr int IT_GU = (D / 64) * (NZ / 32), IT_DN = (FF / 64) * (D / 32), IT_SQ = (D / 64) * (D / 32), IT_BR = (BW / 64) * (D / 32), IT_LR = 2 * 4;
        constexpr int IT_TOTAL = 3 * IT_GU + 2 * IT_DN + 2 * IT_SQ + 3 * IT_BR + 16 * IT_LR;
        for (int it = gw; it < IT_TOTAL; it += NGW) {
            int r = it; const float* W; bf16_t* WT; int N, ldk, mode = 0; const float* fg = nullptr; const float* fb = nullptr; float* cs = nullptr;
            if (r < IT_GU) { W = P.in[I_WIN]; WT = WIN; N = NZ; ldk = D; fg = P.in[I_LN1G]; fb = P.in[I_LN1B]; cs = CSUM; }
            else if ((r -= IT_GU) < IT_SQ) { W = P.in[I_WKV]; WT = WKV; N = D; ldk = D; }
            else if ((r -= IT_SQ) < 3 * IT_BR) { const int k = r / IT_BR; r -= k * IT_BR; W = P.in[I_WBR] + (size_t)k * BW * D; WT = WBR + (size_t)k * D * BW; N = D; ldk = BW; }
            else if ((r -= 3 * IT_BR) < IT_SQ) { W = P.in[I_WOUT]; WT = WOUT; N = D; ldk = D; }
            else if ((r -= IT_SQ) < IT_GU) { W = P.in[I_GU2]; WT = WGU2; N = NZ; ldk = D; mode = 1; fg = P.in[I_LN2G]; fb = P.in[I_LN2B]; cs = CSUM + 2 * NZ; }
            else if ((r -= IT_GU) < IT_DN) { W = P.in[I_DN2]; WT = WD2; N = D; ldk = FF; }
            else if ((r -= IT_DN) < 16 * IT_LR) { const int m = r / IT_LR; r -= m * IT_LR; const int k = m >> 1, x = m & 1;
                W = (x ? P.in[I_LWX] : P.in[I_LWA]) + (size_t)k * 128 * 128; WT = WLRU + (size_t)k * 256 * 128 + x * 128 * 128; N = 128; ldk = 128; }
            else if ((r -= 16 * IT_LR) < IT_DN) { W = P.in[I_DN1]; WT = WD1; N = D; ldk = FF; }
            else { r -= IT_DN; W = P.in[I_GU1]; WT = WGU1; N = NZ; ldk = D; mode = 1; }
            const int nblk = N / 32, kb = r / nblk, nb = r % nblk, n0 = 32 * nb;
            int dr = n0;
            if (mode == 1) dr = (n0 < FF) ? (n0 / 128) * 256 + (n0 % 128) : ((n0 - FF) / 128) * 256 + 128 + ((n0 - FF) % 128);
            transpose_item(W, N, WT, ldk, 64 * kb, n0, dr, scr, lane, fg, fb, cs);
        }
        for (int i = gw * 64 + lane; i < 4 * 128 * 128; i += NGW * 64) { const int t = (i >> 7) & 127, s = i & 127; const float w = P.in[I_WS][i]; WSP[i] = (bf16_t)(cvt_pk_bf16(s <= t ? w : 0.f, 0.f) & 0xffffu); }
        for (size_t i = (size_t)gw * 64 + lane; i < (size_t)MPAD * D / 8; i += (size_t)NGW * 64) {
            const size_t e = i * 8; const int r = (int)(e / D);
            u32x4 w = (u32x4){0u, 0u, 0u, 0u};
            if (r < MR) { const float* src = (r < MP) ? P.in[I_XP] + e : P.in[I_XS] + (e - (size_t)MP * D);
                const f32x4 a = __builtin_nontemporal_load((const f32x4*)src), b = __builtin_nontemporal_load((const f32x4*)(src + 4));
                w.x = cvt_pk_bf16(a[0], a[1]); w.y = cvt_pk_bf16(a[2], a[3]); w.z = cvt_pk_bf16(b[0], b[1]); w.w = cvt_pk_bf16(b[2], b[3]); }
            *(u32x4*)(XB + e) = w;
        }
        for (int r = gw; r < 1024; r += NGW) ln_row(P.in[I_MEM] + (size_t)r * D, P.in[I_MLNG], P.in[I_MLNB], nullptr, MEMLN + (size_t)r * D, lane);
    }
    if (P.ws == nullptr) grid.sync();
    GRID_BAR();

    if (PHON(1)) {
        pg8::PlainSched S{XB, WGU1, 33, 44, D, D, G, bid};
        pg8::EpiSwiglu E{H, FF, nullptr, nullptr};
        pg8::gemm_phase<pg8::PlainSched, pg8::EpiSwiglu, true, true>(lds, D, D, D, S, E);
    }
    GRID_BAR();
    if (PHON(2)) {
        skinny<0>(lds, bid, G, wave, lane, H + (size_t)MP * FF, FF, WD1, FF, FF, Y + (size_t)MP * D, P.in[I_XS], ALPHA, 0.5f, nullptr, nullptr, nullptr, nullptr, nullptr, XB + (size_t)MP * D, RSUM + 2 * (size_t)MP);
        pg8::PlainSched S{H, WD1, 32, 8, FF, FF, G, bid};
        pg8::EpiResid E{Y, P.in[I_XP], nullptr, nullptr, nullptr, ALPHA, 0.5f, XB, RSUM, true};
        pg8::gemm_phase<pg8::PlainSched, pg8::EpiResid, true, true>(lds, FF, FF, FF, S, E);
    }
    GRID_BAR();

    if (PHON(4)) {
        LAS float* gbl = (LAS float*)(lds + 131072);
        for (int i = tid; i < 3 * D / 4; i += NTHREADS) *(LAS f32x4*)(gbl + 4 * i) = *(const f32x4*)(P.in[I_GATEB] + 4 * i);
        __syncthreads();
        pg8::WinSched S{XB, WIN, MEMLN, WKV, G, bid};
        pg8::EpiWin E{Z, gbl, out + O_MK, out + O_MV, KB, VT, RSUM, CSUM};
        pg8::gemm_phase<pg8::WinSched, pg8::EpiWin, true, true>(lds, D, D, D, S, E);
    }
    GRID_BAR();

    const bool dfirst_ = ((bid >> 5) & 1) != 0;
    if (dfirst_ && PHON(8)) p5d_sample_attn(P, lds, bid, G, tid);
    if (PHON(5)) for (int r = gw; r < MR; r += NGW) {
        const bf16_t* zr = Z + (size_t)r * NZ + 1024;
        float v[16]; float s = 0.f;
#pragma unroll
        for (int h = 0; h < 2; ++h) { const u32x4 w = *(const u32x4*)(zr + 8 * lane + 512 * h);
            v[8 * h + 0] = bflo(w.x); v[8 * h + 1] = bfhi(w.x); v[8 * h + 2] = bflo(w.y); v[8 * h + 3] = bfhi(w.y); v[8 * h + 4] = bflo(w.z); v[8 * h + 5] = bfhi(w.z); v[8 * h + 6] = bflo(w.w); v[8 * h + 7] = bfhi(w.w); }
#pragma unroll
        for (int j = 0; j < 16; ++j) s += v[j];
        const float mean = wave_sum(s) * (1.f / BW); float s2 = 0.f;
#pragma unroll
        for (int j = 0; j < 16; ++j) { v[j] -= mean; s2 += v[j] * v[j]; }
        const float rstd = 1.0f / sqrtf(wave_sum(s2) * (1.f / BW) + LN_EPS);
#pragma unroll
        for (int h = 0; h < 2; ++h) {
            const int c0 = 8 * lane + 512 * h; float o[8];
#pragma unroll
            for (int j = 0; j < 8; ++j) o[j] = v[8 * h + j] * rstd * P.in[I_GLNG][c0 + j] + P.in[I_GLNB][c0 + j];
            u32x4 w; w.x = cvt_pk_bf16(o[0], o[1]); w.y = cvt_pk_bf16(o[2], o[3]); w.z = cvt_pk_bf16(o[4], o[5]); w.w = cvt_pk_bf16(o[6], o[7]);
            *(u32x4*)(VP + (size_t)r * BW + c0) = w;
            if (r >= MP) { float* ov = out + O_VS + (size_t)(r - MP) * BW + c0; *(f32x4*)ov = (f32x4){o[0], o[1], o[2], o[3]}; *(f32x4*)(ov + 4) = (f32x4){o[4], o[5], o[6], o[7]}; }
        }
    }
    if (PHON(6)) {
        LAS bf16_t* XCB = (LAS bf16_t*)lds;
        LAS float* AARR = (LAS float*)lds;
        LAS float* XCF = (LAS float*)(lds + 65536);
        for (int it = bid; it < 65 * 8; it += G) {
            const int c = it >> 3, k = it & 7; const bool smp = (c == 64);
            const int r0 = c * 128, ch0 = k * 128;
            int lane_o = lane; asm volatile("" : "+v"(lane_o));
            const int fr = lane_o & 15, fq = lane_o >> 4, rh = wave >> 2, cq = wave & 3;
            bf16x8 wfr[4][4];
            {
                const bf16_t* wb = WLRU + (size_t)k * 256 * 128;
#pragma unroll
                for (int ct = 0; ct < 4; ++ct)
#pragma unroll
                    for (int ks = 0; ks < 4; ++ks) wfr[ct][ks] = *(const bf16x8*)(wb + (size_t)((ct >> 1) * 128 + 32 * cq + 16 * (ct & 1) + fr) * 128 + ks * 32 + fq * 8);
            }
            LAS float* prm = (LAS float*)(lds + 131072 + 4096);
            if (tid < 128) { prm[tid] = P.in[I_LBA][ch0 + tid]; prm[128 + tid] = P.in[I_LBX][ch0 + tid]; prm[256 + tid] = __logf(1.0f + __expf(-P.in[I_LAM][ch0 + tid])); }
            {
                const int c4 = (tid & 31) * 4, rg = tid >> 5;
                const int ch = ch0 + c4;
                const f32x4 w0 = *(const f32x4*)(P.in[I_CONVW] + 0 * BW + ch), w1 = *(const f32x4*)(P.in[I_CONVW] + 1 * BW + ch), w2 = *(const f32x4*)(P.in[I_CONVW] + 2 * BW + ch), w3 = *(const f32x4*)(P.in[I_CONVW] + 3 * BW + ch);
                const f32x4 cb = *(const f32x4*)(P.in[I_CONVB] + ch);
                if (!smp) {
                    const bool first = ((c & 15) == 0);
                    const int rs = rg * 8;
                    const bool hist = !(first && rs == 0);
                    u32x2 zr[11];
#pragma unroll
                    for (int i = 0; i < 11; ++i) { zr[i] = (u32x2){0u, 0u}; if (i >= 3 || hist) zr[i] = *(const u32x2*)(Z + (size_t)(r0 + rs - 3 + i) * NZ + 2048 + ch); }
#define ZF(i) ((f32x4){bflo(zr[i].x), bfhi(zr[i].x), bflo(zr[i].y), bfhi(zr[i].y)})
#pragma unroll
                    for (int i = 0; i < 8; ++i) {
                        const int row = rs + i;
                        const f32x4 x0 = ZF(i + 3);
                        const f32x4 xc = cb + w3 * x0 + w2 * ZF(i + 2) + w1 * ZF(i + 1) + w0 * ZF(i);
                        *(LAS f32x4*)(XCF + row * 128 + c4) = xc;
                        u32x2 w; w.x = cvt_pk_bf16(xc[0], xc[1]); w.y = cvt_pk_bf16(xc[2], xc[3]);
                        *(LAS u32x2*)(XCB + row * 136 + c4) = w;
                        if ((c & 15) == 15 && row >= 125) *(f32x4*)(out + O_CP + (size_t)((c >> 4) * 3 + (row - 125)) * BW + ch) = x0;
                    }
#undef ZF
                } else {
#pragma unroll 4
                    for (int i = 0; i < 8; ++i) {
                        const int row = rg * 8 + i;
                        const float* sc = P.in[I_SCONV] + (size_t)row * 3 * BW + ch;
                        const f32x4 b0 = *(const f32x4*)sc, b1 = *(const f32x4*)(sc + BW), b2 = *(const f32x4*)(sc + 2 * BW);
                        const u32x2 a = *(const u32x2*)(Z + (size_t)(MP + row) * NZ + 2048 + ch);
                        const f32x4 x0 = (f32x4){bflo(a.x), bfhi(a.x), bflo(a.y), bfhi(a.y)};
                        const f32x4 xc = cb + w3 * x0 + w2 * b2 + w1 * b1 + w0 * b0;
                        *(LAS f32x4*)(XCF + row * 128 + c4) = xc;
                        u32x2 w; w.x = cvt_pk_bf16(xc[0], xc[1]); w.y = cvt_pk_bf16(xc[2], xc[3]);
                        *(LAS u32x2*)(XCB + row * 136 + c4) = w;
                        float* oc = out + O_CS + (size_t)row * 3 * BW + ch;
                        *(f32x4*)oc = b1; *(f32x4*)(oc + BW) = b2; *(f32x4*)(oc + 2 * BW) = x0;
                    }
                }
            }
            __syncthreads();
            f32x4 ga[4][4];
#pragma unroll
            for (int rt = 0; rt < 4; ++rt)
#pragma unroll
                for (int ct = 0; ct < 4; ++ct) ga[rt][ct] = (f32x4){0.f, 0.f, 0.f, 0.f};
#pragma unroll
            for (int rt = 0; rt < 4; ++rt) {
                bf16x8 af[4];
#pragma unroll
                for (int ks = 0; ks < 4; ++ks) af[ks] = *(const LAS bf16x8*)(XCB + (64 * rh + 16 * rt + fr) * 136 + ks * 32 + fq * 8);
#pragma unroll
                for (int ct = 0; ct < 4; ++ct)
#pragma unroll
                    for (int ks = 0; ks < 4; ++ks) ga[rt][ct] = __builtin_amdgcn_mfma_f32_16x16x32_bf16(af[ks], wfr[ct][ks], ga[rt][ct], 0, 0, 0);
            }
            __syncthreads();
            if (smp) {
#pragma unroll
                for (int cl = 0; cl < 2; ++cl) {
                    const int chl = 32 * cq + 16 * cl + fr, chg = ch0 + chl;
#pragma unroll
                    for (int rt = 0; rt < 4; ++rt)
#pragma unroll
                        for (int j = 0; j < 4; ++j) {
                            const int row = 64 * rh + 16 * rt + 4 * fq + j; const size_t o = (size_t)row * BW + chg;
                            GSB[o] = ga[rt][cl][j]; GSB[(size_t)MS * BW + o] = ga[rt][2 + cl][j]; GSB[(size_t)2 * MS * BW + o] = XCF[row * 128 + chl];
                        }
                }
            } else {
#pragma unroll
            for (int cl = 0; cl < 2; ++cl) {
                const int chl = 32 * cq + 16 * cl + fr;
                const float ba = prm[chl], bx = prm[128 + chl], sp = prm[256 + chl];
#pragma unroll
                for (int rt = 0; rt < 4; ++rt)
#pragma unroll
                    for (int j = 0; j < 4; ++j) {
                        const int row = 64 * rh + 16 * rt + 4 * fq + j;
                        const float rr = sigmoidf_(ga[rt][cl][j] + ba), ii = sigmoidf_(ga[rt][2 + cl][j] + bx);
                        const float la = -8.0f * rr * sp;
                        const float a = __expf(la);
                        const float xc = XCF[row * 128 + chl];
                        const float bt = __builtin_amdgcn_sqrtf(fmaxf(1.0f - a * a, 0.f)) * (ii * xc);
                        AARR[row * 128 + chl] = a; XCF[row * 128 + chl] = bt;
                    }
            }
            }
            __syncthreads();
            if (!smp) {
                {
                    LAS float* segA = (LAS float*)(lds + 131072); LAS float* segH = segA + 512;
                    const int seg = tid >> 7, chn = tid & 127;
                    float h = 0.f, pa = 1.f;
#pragma unroll 8
                    for (int i = 0; i < 32; ++i) { const int o = (32 * seg + i) * 128 + chn; const float a = AARR[o], b = XCF[o]; h = a * h + b; pa *= a; XCF[o] = h; AARR[o] = pa; }
                    segA[tid] = pa; segH[tid] = h;
                    __syncthreads();
                    float cA = 1.f, cH = 0.f;
                    for (int sg = 0; sg < seg; ++sg) { const float sa = segA[sg * 128 + chn]; cH = sa * cH + segH[sg * 128 + chn]; cA *= sa; }
                    if (seg > 0) {
#pragma unroll 8
                        for (int i = 0; i < 32; ++i) { const int o = (32 * seg + i) * 128 + chn; const float hl = XCF[o], pc = AARR[o]; XCF[o] = hl + pc * cH; AARR[o] = pc * cA; }
                    }
                    if (seg == 3) { SUM[(size_t)(c * 2 + 0) * BW + ch0 + chn] = pa * cA; SUM[(size_t)(c * 2 + 1) * BW + ch0 + chn] = h + pa * cH; }
                }
                __syncthreads();
#pragma unroll
                for (int i = 0; i < 8; ++i) { const int e = (i * 512 + tid) * 4, row = e >> 7, cc = e & 127;
                    *(f32x4*)(HL + (size_t)(r0 + row) * BW + ch0 + cc) = *(const LAS f32x4*)(XCF + e);
                    *(f32x4*)(AC + (size_t)(r0 + row) * BW + ch0 + cc) = *(const LAS f32x4*)(AARR + e); }
            }
            __syncthreads();
        }
    }
    if (PHON(7)) for (int it = bid; it < 256; it += G) {
        const int b = it >> 6, h = (it >> 4) & 3, qt = it & 15;
        int lane_o = lane; asm volatile("" : "+v"(lane_o));
        const int fr = lane_o & 15, fq = lane_o >> 4;
        const int row0 = b * SEQ + qt * 128 + wave * 16;
        bf16x8 qf[8];
#pragma unroll
        for (int ks = 0; ks < 8; ++ks) qf[ks] = *(const bf16x8*)(Z + (size_t)(row0 + fr) * NZ + 4096 + h * HD + ks * 32 + fq * 8);
        f32x4 s[16];
        LAS bf16_t* KL = (LAS bf16_t*)lds;
        __syncthreads();
        {
            const bf16_t* kb = KB + (size_t)(b * NMEM) * 1024 + h * HD;
            u32x4 t[16];
#pragma unroll
            for (int i = 0; i < 16; ++i) { const int e = tid + i * NTHREADS, m = e >> 5, c8 = (e & 31) * 8; t[i] = *(const u32x4*)(kb + (size_t)m * 1024 + c8); }
#pragma unroll
            for (int i = 0; i < 16; ++i) { const int e = tid + i * NTHREADS, m = e >> 5, c8 = (e & 31) * 8; *(LAS u32x4*)(KL + m * 264 + c8) = t[i]; }
        }
        asm volatile("" ::: "memory");
        u32x4 tv[16];
        {
            const bf16_t* vt0 = VT + (size_t)(h * HD) * 1024 + b * NMEM;
#pragma unroll
            for (int i = 0; i < 16; ++i) { const int e = tid + i * NTHREADS, dd = e >> 5, c8 = (e & 31) * 8; tv[i] = *(const u32x4*)(vt0 + (size_t)dd * 1024 + c8); }
        }
        __syncthreads();
#pragma unroll
        for (int mt = 0; mt < 16; ++mt) {
            s[mt] = (f32x4){0.f, 0.f, 0.f, 0.f};
#pragma unroll
            for (int ks = 0; ks < 8; ++ks) {
                const bf16x8 kf = *(const LAS bf16x8*)(KL + (mt * 16 + fr) * 264 + ks * 32 + fq * 8);
                s[mt] = __builtin_amdgcn_mfma_f32_16x16x32_bf16(kf, qf[ks], s[mt], 0, 0, 0);
            }
        }
        __syncthreads();
#pragma unroll
        for (int i = 0; i < 16; ++i) { const int e = tid + i * NTHREADS, dd = e >> 5, c8 = (e & 31) * 8; *(LAS u32x4*)(KL + dd * 264 + c8) = tv[i]; }
        float mx = -3.0e38f;
#pragma unroll
        for (int mt = 0; mt < 16; ++mt) mx = fmaxf(mx, fmaxf(fmaxf(s[mt][0], s[mt][1]), fmaxf(s[mt][2], s[mt][3])));
        mx = fmaxf(mx, __shfl_xor(mx, 16)); mx = fmaxf(mx, __shfl_xor(mx, 32));
        float sm = 0.f;
#pragma unroll
        for (int mt = 0; mt < 16; ++mt)
#pragma unroll
            for (int j = 0; j < 4; ++j) { const float p = __expf((s[mt][j] - mx) * 0.0625f); s[mt][j] = p; sm += p; }
        sm += __shfl_xor(sm, 16); sm += __shfl_xor(sm, 32);
        const float inv = 1.0f / sm;
        bf16x8 pf[8];
#pragma unroll
        for (int ks = 0; ks < 8; ++ks) {
            u32x4 w; w.x = cvt_pk_bf16(s[2 * ks][0], s[2 * ks][1]); w.y = cvt_pk_bf16(s[2 * ks][2], s[2 * ks][3]); w.z = cvt_pk_bf16(s[2 * ks + 1][0], s[2 * ks + 1][1]); w.w = cvt_pk_bf16(s[2 * ks + 1][2], s[2 * ks + 1][3]);
            pf[ks] = __builtin_bit_cast(bf16x8, w);
        }
        __syncthreads();
#pragma unroll 4
        for (int dt = 0; dt < 16; ++dt) {
            f32x4 o = (f32x4){0.f, 0.f, 0.f, 0.f};
#pragma unroll
            for (int ks = 0; ks < 8; ++ks) {
                const LAS bf16_t* vp = KL + (dt * 16 + fr) * 264 + ks * 32 + 4 * fq;
                const u32x2 lo = *(const LAS u32x2*)vp, hi = *(const LAS u32x2*)(vp + 16);
                const u32x4 w = (u32x4){lo.x, lo.y, hi.x, hi.y};
                o = __builtin_amdgcn_mfma_f32_16x16x32_bf16(__builtin_bit_cast(bf16x8, w), pf[ks], o, 0, 0, 0);
            }
            u32x2 w; w.x = cvt_pk_bf16(o[0] * inv, o[1] * inv); w.y = cvt_pk_bf16(o[2] * inv, o[3] * inv);
            *(u32x2*)(YS + (size_t)(row0 + fr) * 3072 + 2048 + h * HD + dt * 16 + 4 * fq) = w;
        }
    }
    if (!dfirst_ && PHON(8)) p5d_sample_attn(P, lds, bid, G, tid);
    GRID_BAR();

    if (PHON(9)) for (int it = bid; it < 256; it += G) {
        const int c = it >> 2, rq = it & 3, n = c & 15, cb = c & ~15;
        const int ch = 2 * tid;
        f32x2 carry = (f32x2){0.f, 0.f};
        {
            f32x2 pa[15], hh[15];
#pragma unroll
            for (int j = 0; j < 15; ++j) { pa[j] = (f32x2){1.f, 1.f}; hh[j] = (f32x2){0.f, 0.f};
                if (j < n) { pa[j] = *(const f32x2*)(SUM + (size_t)((cb + j) * 2 + 0) * BW + ch); hh[j] = *(const f32x2*)(SUM + (size_t)((cb + j) * 2 + 1) * BW + ch); } }
#pragma unroll
            for (int j = 0; j < 15; ++j) carry = pa[j] * carry + hh[j];
        }
#pragma unroll 8
        for (int i = 0; i < 32; ++i) {
            const int r = c * 128 + rq * 32 + i;
            const f32x2 hl = __builtin_nontemporal_load((const f32x2*)(HL + (size_t)r * BW + ch)), ac = __builtin_nontemporal_load((const f32x2*)(AC + (size_t)r * BW + ch));
            const f32x2 hv = hl + ac * carry;
            const unsigned rw = *(const unsigned*)(Z + (size_t)r * NZ + 3072 + ch);
            *(unsigned*)(YS + (size_t)r * 3072 + 1024 + ch) = cvt_pk_bf16(bflo(rw) * hv[0], bfhi(rw) * hv[1]);
            if (n == 15 && rq == 3 && i == 31) *(f32x2*)(out + O_HP + (size_t)(c >> 4) * BW + ch) = hv;
        }
    }
    if (PHON(9)) for (int e = bid * NTHREADS + tid; e < MS * BW; e += G * NTHREADS) {
        const int row = e >> 10, ch = e & (BW - 1);
        const float rr = sigmoidf_(GSB[e] + P.in[I_LBA][ch]), ii = sigmoidf_(GSB[(size_t)MS * BW + e] + P.in[I_LBX][ch]);
        const float la = -8.0f * rr * __logf(1.0f + __expf(-P.in[I_LAM][ch]));
        const float a = __expf(la);
        const float h = a * P.in[I_SLRU][e] + __builtin_amdgcn_sqrtf(fmaxf(1.0f - a * a, 0.f)) * (ii * GSB[(size_t)2 * MS * BW + e]);
        out[O_HS + e] = h;
        const float rgv = bf2f(Z[(size_t)(MP + row) * NZ + 3072 + ch]);
        YS[(size_t)(MP + row) * 3072 + 1024 + ch] = (bf16_t)(cvt_pk_bf16(rgv * h, 0.f) & 0xffffu);
    }
    if (PHON(10)) {
        LAS bf16_t* VL = (LAS bf16_t*)lds;
        for (int e = bid * NTHREADS + tid; e < MS * BW / 2; e += G * NTHREADS) {
            const int r = e / (BW / 2), c2 = (e % (BW / 2)) * 2, g = c2 >> 8;
            const float w00 = P.in[I_WS][(size_t)g * 128 * 128], b0 = P.in[I_BS][g * 128];
            const unsigned vw = *(const unsigned*)(VP + (size_t)(MP + r) * BW + c2), uw = *(const unsigned*)(Z + (size_t)(MP + r) * NZ + c2);
            *(unsigned*)(YS + (size_t)(MP + r) * 3072 + c2) = cvt_pk_bf16(bflo(uw) * (w00 * bflo(vw) + b0), bfhi(uw) * (w00 * bfhi(vw) + b0));
        }
        for (int it = bid; it < 256; it += G) {
            const int g = it & 3, cn = it >> 2;
            const int r0 = cn * 128;
            __syncthreads();
            {
                u32x4 vt8[8];
#pragma unroll
                for (int i = 0; i < 8; ++i) { const int e = tid + i * NTHREADS, s = e >> 5, c8 = (e & 31) * 8; vt8[i] = *(const u32x4*)(VP + (size_t)(r0 + s) * BW + g * 256 + c8); }
#pragma unroll
                for (int i = 0; i < 8; ++i) { const int e = tid + i * NTHREADS, s = e >> 5, c8 = (e & 31) * 8; *(LAS u32x4*)(VL + s * 264 + c8) = vt8[i]; }
            }
            __syncthreads();
            const int fr = lane & 15, fq = lane >> 4;
            bf16x8 vf[2][4];
#pragma unroll
            for (int ct = 0; ct < 2; ++ct)
#pragma unroll
                for (int ks = 0; ks < 4; ++ks) {
                    bf16x8 t;
#pragma unroll
                    for (int j = 0; j < 8; ++j) t[j] = (short)VL[(ks * 32 + fq * 8 + j) * 264 + (2 * wave + ct) * 16 + fr];
                    vf[ct][ks] = t;
                }
            const bf16_t* wsp = WSP + (size_t)g * 128 * 128;
            u32x2 uwp[8][2];
#pragma unroll
            for (int tt = 0; tt < 8; ++tt)
#pragma unroll
                for (int ct = 0; ct < 2; ++ct) uwp[tt][ct] = *(const u32x2*)(Z + (size_t)(r0 + tt * 16 + fr) * NZ + g * 256 + (2 * wave + ct) * 16 + 4 * fq);
#pragma unroll
            for (int tt = 0; tt < 8; ++tt) {
                f32x4 o0 = (f32x4){0.f, 0.f, 0.f, 0.f}, o1 = o0;
#pragma unroll
                for (int ks = 0; ks < 4; ++ks) {
                    const bf16x8 wf = *(const bf16x8*)(wsp + (size_t)(tt * 16 + fr) * 128 + ks * 32 + fq * 8);
                    o0 = __builtin_amdgcn_mfma_f32_16x16x32_bf16(vf[0][ks], wf, o0, 0, 0, 0);
                    o1 = __builtin_amdgcn_mfma_f32_16x16x32_bf16(vf[1][ks], wf, o1, 0, 0, 0);
                }
                if ((tt & 3) == 3) asm volatile("" ::: "memory");
                const int t = tt * 16 + fr; const float bs = P.in[I_BS][g * 128 + t];
                const size_t r = (size_t)(r0 + t);
#pragma unroll
                for (int ct = 0; ct < 2; ++ct) {
                    const f32x4 o = ct ? o1 : o0;
                    const int cc = g * 256 + (2 * wave + ct) * 16 + 4 * fq;
                    const u32x2 uw = uwp[tt][ct];
                    u32x2 w; w.x = cvt_pk_bf16(bflo(uw.x) * (o[0] + bs), bfhi(uw.x) * (o[1] + bs)); w.y = cvt_pk_bf16(bflo(uw.y) * (o[2] + bs), bfhi(uw.y) * (o[3] + bs));
                    *(u32x2*)(YS + r * 3072 + cc) = w;
                }
            }
        }
        __syncthreads();
    }
    GRID_BAR();

    if (PHON(11)) {
        skinny<1>(lds, bid, G, wave, lane, YS + (size_t)MP * 3 * BW, 3 * BW, WBR, BW, BW, nullptr, nullptr, 0.f, 0.f, Z + (size_t)MP * NZ, XB + (size_t)MP * D, nullptr, nullptr, nullptr, nullptr, nullptr);
        pg8::BranchSched S{YS, WBR, G, bid};
        pg8::EpiMerge E{Z, XB};
        pg8::gemm_phase<pg8::BranchSched, pg8::EpiMerge, true, true>(lds, BW, 3 * BW, BW, S, E);
    }
    GRID_BAR();
    if (PHON(12)) {
        skinny<0>(lds, bid, G, wave, lane, XB + (size_t)MP * D, D, WOUT, D, D, Y + (size_t)MP * D, Y + (size_t)MP * D, ALPHA, 1.0f, nullptr, nullptr, RSUM + 2 * (size_t)MP, P.in[I_LN1G], P.in[I_LN1B], YB2 + (size_t)MP * D, RSUM + 2 * (size_t)(MPAD + MP));
        pg8::PlainSched S{XB, WOUT, 32, 8, D, D, G, bid};
        pg8::EpiResid E{Y, Y, RSUM, P.in[I_LN1G], P.in[I_LN1B], ALPHA, 1.0f, YB2, RSUM + 2 * (size_t)MPAD, false};
        pg8::gemm_phase<pg8::PlainSched, pg8::EpiResid, true, true>(lds, D, D, D, S, E);
    }
    GRID_BAR();
    if (PHON(14)) {
        pg8::PlainSched S{YB2, WGU2, 33, 44, D, D, G, bid};
        pg8::EpiSwiglu E{H, FF, RSUM + 2 * (size_t)MPAD, CSUM + 2 * NZ};
        pg8::gemm_phase<pg8::PlainSched, pg8::EpiSwiglu, true, true>(lds, D, D, D, S, E);
    }
    GRID_BAR();
    if (PHON(15)) {
        skinny<0>(lds, bid, G, wave, lane, H + (size_t)MP * FF, FF, WD2, FF, FF, Y + (size_t)MP * D, Y + (size_t)MP * D, ALPHA, 0.5f, nullptr, nullptr, RSUM + 2 * (size_t)(MPAD + MP), P.in[I_LN2G], P.in[I_LN2B], nullptr, nullptr);
        pg8::PlainSched S{H, WD2, 32, 8, FF, FF, G, bid};
        pg8::EpiResid E{Y, Y, RSUM + 2 * (size_t)MPAD, P.in[I_LN2G], P.in[I_LN2B], ALPHA, 0.5f, nullptr, nullptr, false};
        pg8::gemm_phase<pg8::PlainSched, pg8::EpiResid, true, true>(lds, FF, FF, FF, S, E);
    }
    GRID_BAR();
    if (PHON(16)) for (int r = gw; r < MR; r += NGW) ln_row(Y + (size_t)r * D, P.in[I_LN3G], P.in[I_LN3B], out + O_Y + (size_t)r * D, nullptr, lane);
}

extern "C" void kernel_launch(void* const* d_in, const int* in_sizes, int n_in, void* d_out, int out_size, void* d_ws, size_t ws_size, hipStream_t stream) {
    static int grid = 0;
    if (grid == 0) {
        if (n_in != 35 || (size_t)out_size != O_END || ws_size < WS_END) { fprintf(stderr, "kernel_launch: unexpected shapes: n_in %d out %d (want %zu) ws %zu (need %zu)\n", n_in, out_size, (size_t)O_END, ws_size, (size_t)WS_END); grid = -1; return; }
        int dev = 0, cus = 0, per_cu = 0;
        hipGetDevice(&dev);
        hipDeviceGetAttribute(&cus, hipDeviceAttributeMultiprocessorCount, dev);
        hipFuncSetAttribute((const void*)fwd_kernel, hipFuncAttributeMaxDynamicSharedMemorySize, LDS_BYTES);
        hipOccupancyMaxActiveBlocksPerMultiprocessor(&per_cu, (const void*)fwd_kernel, NTHREADS, LDS_BYTES);
        if (per_cu < 1) { fprintf(stderr, "kernel_launch: occupancy query says %d blocks/CU\n", per_cu); per_cu = 1; }
        (void)hipGetLastError();
        grid = cus;
    }
    if (grid < 0) return;
    Params p{};
    for (int i = 0; i < 35; ++i) p.in[i] = (const float*)d_in[i];
    p.out = (float*)d_out; p.ws = (unsigned char*)d_ws;
    (void)hipMemsetAsync((char*)d_ws + WS_BAR, 0, WS_GSB - WS_BAR, stream);
    void* args[] = {&p};
    hipError_t e = hipLaunchCooperativeKernel((const void*)fwd_kernel, dim3(grid), dim3(NTHREADS), args, LDS_BYTES, stream);
    if (e != hipSuccess) fprintf(stderr, "cooperative launch failed: %s (grid %d)\n", hipGetErrorString(e), grid);
}
```

```cpp
#include <hip/hip_runtime.h>
#include <hip/hip_cooperative_groups.h>
#include <cstdio>
#include <cstdint>
namespace cg = cooperative_groups;

#define LAS __attribute__((address_space(3)))
typedef unsigned short bf16_t;
typedef short bf16x8 __attribute__((ext_vector_type(8)));
typedef short bf16x4 __attribute__((ext_vector_type(4)));
typedef float f32x4 __attribute__((ext_vector_type(4)));
typedef float f32x2 __attribute__((ext_vector_type(2)));
typedef unsigned u32x4 __attribute__((ext_vector_type(4)));
typedef unsigned u32x2 __attribute__((ext_vector_type(2)));

constexpr int D = 2048, FF = 5632, BW = 1024, NZ = 11264;
constexpr int MP = 8192, MS = 128, MR = MP + MS, MPAD = 8448;
constexpr int SEQ = 2048, NB = 4, NMEM = 256, NH = 4, HD = 256;
constexpr float LN_EPS = 1e-5f;
constexpr float ALPHA = 1.189207115002721f;
constexpr int NTHREADS = 512, NWAVES = 8;

constexpr int XCD_BAR_WORDS_ = 3456;
constexpr size_t al256(size_t x) { return (x + 255) & ~(size_t)255; }
constexpr size_t WS_WGU1 = 0;
constexpr size_t WS_WD1 = WS_WGU1 + al256((size_t)NZ * D * 2);
constexpr size_t WS_WIN = WS_WD1 + al256((size_t)D * FF * 2);
constexpr size_t WS_WKV = WS_WIN + al256((size_t)NZ * D * 2);
constexpr size_t WS_WBR = WS_WKV + al256((size_t)D * D * 2);
constexpr size_t WS_WOUT = WS_WBR + al256((size_t)3 * D * BW * 2);
constexpr size_t WS_WGU2 = WS_WOUT + al256((size_t)D * D * 2);
constexpr size_t WS_WD2 = WS_WGU2 + al256((size_t)NZ * D * 2);
constexpr size_t WS_WLRU = WS_WD2 + al256((size_t)D * FF * 2);
constexpr size_t WS_WSP = WS_WLRU + al256((size_t)8 * 256 * 128 * 2);
constexpr size_t WS_XB = WS_WSP + al256((size_t)4 * 128 * 128 * 2);
constexpr size_t WS_ZH = WS_XB + al256((size_t)MPAD * D * 2);
constexpr size_t WS_Y = WS_ZH + al256((size_t)MPAD * NZ * 2);
constexpr size_t WS_X1 = WS_Y + al256((size_t)MPAD * D * 4);
constexpr size_t WS_VP = WS_X1 + al256((size_t)MPAD * D * 4);
constexpr size_t WS_HL = WS_VP + al256((size_t)MPAD * BW * 2);
constexpr size_t WS_AC = WS_HL + al256((size_t)MP * BW * 4);
constexpr size_t WS_SUM = WS_AC + al256((size_t)MP * BW * 4);
constexpr size_t WS_YS = WS_SUM + al256((size_t)64 * 2 * BW * 4);
constexpr size_t WS_MEMLN = WS_YS + al256((size_t)MPAD * 3 * BW * 2);
constexpr size_t WS_KB = WS_MEMLN + al256((size_t)1024 * D * 2);
constexpr size_t WS_VT = WS_KB + al256((size_t)1024 * 1024 * 2);
constexpr size_t WS_BAR = WS_VT + al256((size_t)1024 * 1024 * 2);
constexpr size_t WS_CS = WS_BAR + al256((size_t)XCD_BAR_WORDS_ * 4);
constexpr size_t WS_RS = WS_CS + al256((size_t)2 * 2 * NZ * 4);
constexpr size_t WS_GSB = WS_RS + al256((size_t)2 * MPAD * 2 * 4);
constexpr size_t WS_END = WS_GSB + al256((size_t)3 * MS * BW * 4);

constexpr size_t O_Y = 0;
constexpr size_t O_MK = (size_t)MR * D;
constexpr size_t O_MV = O_MK + (size_t)1024 * 1024;
constexpr size_t O_CP = O_MV + (size_t)1024 * 1024;
constexpr size_t O_HP = O_CP + (size_t)4 * 3 * 1024;
constexpr size_t O_CS = O_HP + (size_t)4 * 1024;
constexpr size_t O_HS = O_CS + (size_t)128 * 3 * 1024;
constexpr size_t O_VS = O_HS + (size_t)128 * 1024;
constexpr size_t O_END = O_VS + (size_t)128 * 1024;

constexpr int LDS_BYTES = 159744;

struct Params { const float* in[35]; float* out; unsigned char* ws; };
enum { I_XP = 0, I_XS, I_MEM, I_CK, I_CV, I_SCONV, I_SLRU, I_GU1, I_DN1, I_LN1G, I_LN1B, I_WIN, I_GATEB, I_GLNG, I_GLNB, I_WS, I_BS, I_CONVW, I_CONVB,
       I_LWA, I_LBA, I_LWX, I_LBX, I_LAM, I_MLNG, I_MLNB, I_WKV, I_WBR, I_WOUT, I_LN2G, I_LN2B, I_GU2, I_DN2, I_LN3G, I_LN3B };

__device__ __forceinline__ unsigned cvt_pk_bf16(float lo, float hi) { unsigned r; asm volatile("v_cvt_pk_bf16_f32 %0, %1, %2" : "=v"(r) : "v"(lo), "v"(hi)); return r; }
__device__ __forceinline__ float bf2f(unsigned short b) { return __uint_as_float(((unsigned)b) << 16); }
__device__ __forceinline__ float bflo(unsigned w) { return __uint_as_float(w << 16); }
__device__ __forceinline__ float bfhi(unsigned w) { return __uint_as_float(w & 0xffff0000u); }
__device__ __forceinline__ float sigmoidf_(float x) { return __builtin_amdgcn_rcpf(1.0f + __expf(-x)); }
__device__ __forceinline__ float siluf_(float x) { return x * sigmoidf_(x); }
__device__ __forceinline__ float gelu_tanh(float x) { return x * sigmoidf_(1.5957691216057308f * (x + 0.044715f * x * x * x)); }
__device__ __forceinline__ f32x2 ln_stats(f32x2 sm) { const float mu = sm[0] * (1.f / D); const float var = fmaxf(sm[1] * (1.f / D) - mu * mu, 0.f); return (f32x2){mu, 1.0f / sqrtf(var + LN_EPS)}; }
__device__ __forceinline__ float wave_sum(float v) {
#pragma unroll
    for (int o = 1; o < 64; o <<= 1) v += __shfl_xor(v, o);
    return v;
}
__device__ __forceinline__ float wave_max(float v) {
#pragma unroll
    for (int o = 1; o < 64; o <<= 1) v = fmaxf(v, __shfl_xor(v, o));
    return v;
}

namespace pg8 {
constexpr int BM = 256, BK = 64, HALF = 128, HTB = HALF * BK * 2, STAGE_BYTES = 8 * HTB, NXCD = 8, WGM = 8;
__host__ __device__ __forceinline__ int lds_byte(int r, int c) { const int st = (r >> 4) * 2 + (c >> 5), rr = r & 15, cc = c & 31, ob = rr * 64 + cc * 2; return st * 1024 + (ob ^ (((ob >> 9) & 1) << 5)); }
__host__ __device__ __forceinline__ void stage_rc(int b, int& R, int& C) { const int st = b / 1024, sb = b % 1024, swz = sb ^ (((sb >> 9) & 1) << 5); R = (st >> 1) * 16 + swz / 64; C = (st & 1) * 32 + (swz % 64) / 2; }
__host__ __device__ __forceinline__ int perm32(int rho) { const int n = rho >> 4, i = rho & 15; return 8 * (i >> 2) + 4 * n + (i & 3); }

struct Unit { const char* A; const char* B; int pm, pn, kind; };

__device__ __forceinline__ void tile_of(int wgid, int nM, int nN, int& pm, int& pn) {
    const int nwg = nM * nN;
    { const int q = nwg / NXCD, r = nwg % NXCD, xcd = wgid % NXCD, off = wgid / NXCD; wgid = (xcd < r ? xcd * (q + 1) : r * (q + 1) + (xcd - r) * q) + off; }
    const int nig = WGM * nN, gid = wgid / nig, fm = gid * WGM, gsz = (nM - fm) < WGM ? (nM - fm) : WGM;
    pm = fm + ((wgid % nig) % gsz); pn = (wgid % nig) / gsz;
}
struct PlainSched {
    const bf16_t* A; const bf16_t* Bt; int nM, nN, lda, ldb, G, c;
    __device__ __forceinline__ bool next(int i, Unit& u) const {
        const int L = i * G + c; if (L >= nM * nN) return false;
        tile_of(L, nM, nN, u.pm, u.pn); u.kind = 0;
        u.A = (const char*)(A + (size_t)u.pm * BM * lda); u.B = (const char*)(Bt + (size_t)u.pn * BM * ldb); return true;
    }
};
struct WinSched {
    const bf16_t* XB_; const bf16_t* WIN_; const bf16_t* MEMLN_; const bf16_t* WKV_; int G, c;
    __device__ __forceinline__ bool next(int i, Unit& u) const {
        const int L = i * G + c; constexpr int NZU = 33 * 44;
        if (L < NZU) { tile_of(L, 33, 44, u.pm, u.pn); u.kind = 0; u.A = (const char*)(XB_ + (size_t)u.pm * BM * D); u.B = (const char*)(WIN_ + (size_t)u.pn * BM * D); return true; }
        if (L < NZU + 32) { const int j = L - NZU; u.pm = j >> 3; u.pn = j & 7; u.kind = 1; u.A = (const char*)(MEMLN_ + (size_t)u.pm * BM * D); u.B = (const char*)(WKV_ + (size_t)u.pn * BM * D); return true; }
        if (L < NZU + 48) { const int j = L - NZU - 32; u.pm = j >> 2; u.pn = j & 3; u.kind = 2; u.A = (const char*)(WKV_ + (size_t)(1024 + u.pm * BM) * D); u.B = (const char*)(MEMLN_ + (size_t)u.pn * BM * D); return true; }
        return false;
    }
};
struct BranchSched {
    const bf16_t* YS_; const bf16_t* WBR_; int G, c;
    __device__ __forceinline__ bool next(int i, Unit& u) const {
        const int t = (i / 3) * G + c, k = i % 3; if (t >= 256) return false;
        tile_of(t, 32, 8, u.pm, u.pn); u.kind = k;
        u.A = (const char*)(YS_ + (size_t)u.pm * BM * (3 * BW) + k * BW); u.B = (const char*)(WBR_ + (size_t)k * D * BW + (size_t)u.pn * BM * BW); return true;
    }
};

template <class Sched, class Epi, bool ALIGN_EPI, bool SP2>
__device__ __forceinline__ void gemm_phase(LAS unsigned char* lds, const int K, const int lda, const int ldb, const Sched& S, const Epi& E) {
    int tid = threadIdx.x; asm volatile("" : "+v"(tid));
    const int wid = __builtin_amdgcn_readfirstlane(tid >> 6), lane = tid & 63, wr = wid >> 2, wc = wid & 3, fr = lane & 15, fq = lane >> 4;
    const int nt = K / BK;
    unsigned voffA[2], voffB[2];
#pragma unroll
    for (int i = 0; i < 2; ++i) { int R, C; stage_rc(tid * 16 + i * 8192, R, C); const int Rb = Epi::PERM ? ((R & ~31) + perm32(R & 31)) : R;
        voffA[i] = (unsigned)(R * lda + C) * 2u; voffB[i] = (unsigned)(Rb * ldb + C) * 2u; }
    const size_t kstep = (size_t)(BK * 2);
    const size_t hstepA = (size_t)HALF * lda * 2, hstepB = (size_t)HALF * ldb * 2;
    const unsigned ldsw = (unsigned)wid * 1024u;
    const int aoff = lds_byte(wr * 64 + fr, fq * 8), boff = lds_byte(wc * 32 + fr, fq * 8);
#define PG8_SA(b, h) (((b) * 2 + (h)) * HTB)
#define PG8_SB(b, h) ((4 + (b) * 2 + (h)) * HTB)
#define PG8_STAGE(bufoff, gbase, voff) do { _Pragma("unroll") for (int _i = 0; _i < 2; ++_i) \
        __builtin_amdgcn_global_load_lds((const unsigned*)((const char*)(gbase) + (voff)[_i]), (LAS unsigned*)(lds + (bufoff) + ldsw + _i * 8192), 16, 0, 0); } while (0)
#define PG8_LDA(dst, b, h) do { _Pragma("unroll") for (int m = 0; m < 4; ++m) _Pragma("unroll") for (int k = 0; k < 2; ++k) dst[m][k] = *(const LAS bf16x8*)(lds + PG8_SA(b, h) + aoff + m * 2048 + k * 1024); } while (0)
#define PG8_LDB(dst, b, h) do { _Pragma("unroll") for (int n = 0; n < 2; ++n) _Pragma("unroll") for (int k = 0; k < 2; ++k) dst[n][k] = *(const LAS bf16x8*)(lds + PG8_SB(b, h) + boff + n * 2048 + k * 1024); } while (0)
#define PG8_MMA(ai, bj, At, Bt) do { __builtin_amdgcn_s_setprio(1); _Pragma("unroll") for (int m = 0; m < 4; ++m) _Pragma("unroll") for (int n = 0; n < 2; ++n) _Pragma("unroll") for (int k = 0; k < 2; ++k) \
        acc[ai][bj][m][n] = __builtin_amdgcn_mfma_f32_16x16x32_bf16(Bt[n][k], At[m][k], acc[ai][bj][m][n], 0, 0, 0); __builtin_amdgcn_s_setprio(0); } while (0)
#define PG8_WAIT_V(n) asm volatile("s_waitcnt vmcnt(" #n ")" ::: "memory")
#define PG8_WAIT_L(n) asm volatile("s_waitcnt lgkmcnt(" #n ")" ::: "memory")
#define PG8_BAR __builtin_amdgcn_s_barrier()
#define PG8_SCHED __builtin_amdgcn_sched_barrier(0)
    Unit cur, nxt; int ui = 0;
    if (!S.next(0, cur)) return;
    f32x4 acc[2][2][4][2];
#pragma unroll
    for (int a = 0; a < 2; ++a)
#pragma unroll
        for (int b = 0; b < 2; ++b)
#pragma unroll
            for (int m = 0; m < 4; ++m)
#pragma unroll
                for (int n = 0; n < 2; ++n) acc[a][b][m][n] = (f32x4){0.f, 0.f, 0.f, 0.f};
    bf16x8 At[4][2], B0[2][2], B1[2][2];
    const char* cA = cur.A; const char* cB = cur.B;
    if constexpr (SP2) {
        PG8_STAGE(PG8_SB(0, 0), cB, voffB); PG8_STAGE(PG8_SB(0, 1), cB + hstepB, voffB); PG8_STAGE(PG8_SA(0, 0), cA, voffA); PG8_STAGE(PG8_SA(0, 1), cA + hstepA, voffA);
        if (wr == 1) PG8_BAR;
        PG8_WAIT_V(2); PG8_BAR;
        PG8_STAGE(PG8_SB(1, 0), cB + kstep, voffB); PG8_STAGE(PG8_SA(1, 0), cA + kstep, voffA); PG8_STAGE(PG8_SB(1, 1), cB + hstepB + kstep, voffB);
        PG8_WAIT_V(6); PG8_BAR;
    } else {
        PG8_STAGE(PG8_SB(0, 0), cB, voffB); PG8_STAGE(PG8_SA(0, 0), cA, voffA); PG8_STAGE(PG8_SB(0, 1), cB + hstepB, voffB); PG8_STAGE(PG8_SA(0, 1), cA + hstepA, voffA);
        if (wr == 1) PG8_BAR;
        PG8_WAIT_V(4); PG8_BAR;
        PG8_STAGE(PG8_SB(1, 0), cB + kstep, voffB); PG8_STAGE(PG8_SA(1, 0), cA + kstep, voffA); PG8_STAGE(PG8_SB(1, 1), cB + hstepB + kstep, voffB);
        PG8_WAIT_V(6); PG8_BAR;
    }
    for (;;) {
        const bool has_next = S.next(ui + 1, nxt);
        const char* nA = has_next ? nxt.A : cA; const char* nB = has_next ? nxt.B : cB;
        for (int t = 0; t < nt; t += 2) {
            const bool last = (t == nt - 2);
            const char* a1 = cA + (size_t)(t + 1) * kstep;
            const char* a2 = last ? nA : cA + (size_t)(t + 2) * kstep; const char* b2 = last ? nB : cB + (size_t)(t + 2) * kstep;
            const char* a3 = a2 + kstep; const char* b3 = b2 + kstep;
            if constexpr (SP2) {
            PG8_LDB(B0, 0, 0); PG8_LDB(B1, 0, 1); PG8_SCHED; PG8_LDA(At, 0, 0); PG8_STAGE(PG8_SA(1, 1), a1 + hstepA, voffA);
            PG8_WAIT_V(8); PG8_WAIT_L(0); PG8_BAR; PG8_MMA(0, 0, At, B0); PG8_MMA(0, 1, At, B1); PG8_BAR; PG8_SCHED;
            PG8_LDA(At, 0, 1); PG8_STAGE(PG8_SB(0, 0), b2, voffB); PG8_STAGE(PG8_SB(0, 1), b2 + hstepB, voffB); PG8_STAGE(PG8_SA(0, 0), a2, voffA);
            PG8_WAIT_V(8); PG8_WAIT_L(0); PG8_BAR; PG8_MMA(1, 0, At, B0); PG8_MMA(1, 1, At, B1); PG8_BAR; PG8_SCHED;
            PG8_LDB(B0, 1, 0); PG8_LDB(B1, 1, 1); PG8_SCHED; PG8_LDA(At, 1, 0); PG8_STAGE(PG8_SA(0, 1), a2 + hstepA, voffA);
            PG8_WAIT_V(8); PG8_WAIT_L(0); PG8_BAR; PG8_MMA(0, 0, At, B0); PG8_MMA(0, 1, At, B1); PG8_BAR; PG8_SCHED;
            PG8_LDA(At, 1, 1); PG8_STAGE(PG8_SB(1, 0), b3, voffB); PG8_STAGE(PG8_SB(1, 1), b3 + hstepB, voffB); PG8_STAGE(PG8_SA(1, 0), a3, voffA);
            PG8_WAIT_V(8); PG8_WAIT_L(0); PG8_BAR; PG8_MMA(1, 0, At, B0); PG8_MMA(1, 1, At, B1); PG8_BAR; PG8_SCHED;
            } else {
            PG8_LDB(B0, 0, 0); PG8_SCHED; PG8_LDA(At, 0, 0); PG8_STAGE(PG8_SA(1, 1), a1 + hstepA, voffA);
            PG8_WAIT_L(8); PG8_BAR; PG8_WAIT_L(0); PG8_MMA(0, 0, At, B0); PG8_BAR; PG8_SCHED;
            PG8_LDB(B1, 0, 1); PG8_STAGE(PG8_SB(0, 0), b2, voffB);
            PG8_BAR; PG8_WAIT_L(0); PG8_MMA(0, 1, At, B1); PG8_BAR;
            PG8_LDA(At, 0, 1); PG8_STAGE(PG8_SA(0, 0), a2, voffA);
            PG8_BAR; PG8_WAIT_L(0); PG8_MMA(1, 0, At, B0); PG8_BAR; PG8_SCHED;
            PG8_STAGE(PG8_SB(0, 1), b2 + hstepB, voffB);
            PG8_WAIT_V(6); PG8_BAR; PG8_MMA(1, 1, At, B1); PG8_BAR;
            PG8_LDB(B0, 1, 0); PG8_SCHED; PG8_LDA(At, 1, 0); PG8_STAGE(PG8_SA(0, 1), a2 + hstepA, voffA);
            PG8_WAIT_L(8); PG8_BAR; PG8_WAIT_L(0); PG8_MMA(0, 0, At, B0); PG8_BAR; PG8_SCHED;
            PG8_LDB(B1, 1, 1); PG8_STAGE(PG8_SB(1, 0), b3, voffB);
            PG8_BAR; PG8_WAIT_L(0); PG8_MMA(0, 1, At, B1); PG8_BAR;
            PG8_LDA(At, 1, 1); PG8_STAGE(PG8_SA(1, 0), a3, voffA);
            PG8_BAR; PG8_WAIT_L(0); PG8_MMA(1, 0, At, B0); PG8_BAR; PG8_SCHED;
            PG8_STAGE(PG8_SB(1, 1), b3 + hstepB, voffB);
            PG8_WAIT_V(6); PG8_BAR; PG8_MMA(1, 1, At, B1); PG8_BAR;
            }
        }
        if constexpr (ALIGN_EPI) { if (wr == 0) PG8_BAR; }
        E(acc, cur, wr, wc, fr, fq);
        if (!has_next) break;
        bool keep = false;
        if constexpr (Epi::CAN_KEEP) keep = (cur.kind < 2);
        if (!keep) {
#pragma unroll
        for (int a = 0; a < 2; ++a)
#pragma unroll
            for (int b = 0; b < 2; ++b)
#pragma unroll
                for (int m = 0; m < 4; ++m)
#pragma unroll
                    for (int n = 0; n < 2; ++n) acc[a][b][m][n] = (f32x4){0.f, 0.f, 0.f, 0.f};
        }
        cur = nxt; cA = nA; cB = nB; ++ui;
        if constexpr (ALIGN_EPI) { if (wr == 1) PG8_BAR; }
    }
    PG8_WAIT_V(0);
    if constexpr (!ALIGN_EPI) { if (wr == 0) PG8_BAR; }
    PG8_BAR;
#undef PG8_SA
#undef PG8_SB
#undef PG8_STAGE
#undef PG8_LDA
#undef PG8_LDB
#undef PG8_MMA
#undef PG8_WAIT_V
#undef PG8_WAIT_L
#undef PG8_BAR
#undef PG8_SCHED
}


struct EpiSwiglu {
    static constexpr bool PERM = true, CAN_KEEP = false;
    bf16_t* H; int ldh;
    const float* rsum; const float* cs;
    __device__ __forceinline__ void operator()(const f32x4 (&acc)[2][2][4][2], const Unit& u, int wr, int wc, int fr, int fq) const {
        const int row0 = u.pm * BM + wr * 64 + fr, col0 = u.pn * HALF + wc * 32 + 8 * fq;
        f32x4 s1[2][2], s2[2][2];
#pragma unroll
        for (int bj = 0; bj < 2; ++bj)
#pragma unroll
            for (int n = 0; n < 2; ++n) { s1[bj][n] = (f32x4){0.f, 0.f, 0.f, 0.f}; s2[bj][n] = s1[bj][n];
                if (rsum) { const int ci = u.pn * BM + bj * HALF + wc * 32 + 8 * fq + 4 * n; s1[bj][n] = *(const f32x4*)(cs + ci); s2[bj][n] = *(const f32x4*)(cs + NZ + ci); } }
#pragma unroll
        for (int ai = 0; ai < 2; ++ai)
#pragma unroll
            for (int m = 0; m < 4; ++m) {
                const int r = row0 + ai * HALF + m * 16;
                bf16_t* rowp = H + (size_t)r * ldh + col0;
                f32x2 st = (f32x2){0.f, 1.f};
                if (rsum) st = ln_stats(*(const f32x2*)(rsum + 2 * (size_t)r));
                f32x4 v0, v1;
#pragma unroll
                for (int j = 0; j < 4; ++j) {
                    const float g0 = st[1] * (acc[ai][0][m][0][j] - st[0] * s1[0][0][j]) + s2[0][0][j], u0 = st[1] * (acc[ai][1][m][0][j] - st[0] * s1[1][0][j]) + s2[1][0][j];
                    const float g1 = st[1] * (acc[ai][0][m][1][j] - st[0] * s1[0][1][j]) + s2[0][1][j], u1 = st[1] * (acc[ai][1][m][1][j] - st[0] * s1[1][1][j]) + s2[1][1][j];
                    v0[j] = siluf_(g0) * u0; v1[j] = siluf_(g1) * u1;
                }
                u32x4 w; w.x = cvt_pk_bf16(v0[0], v0[1]); w.y = cvt_pk_bf16(v0[2], v0[3]); w.z = cvt_pk_bf16(v1[0], v1[1]); w.w = cvt_pk_bf16(v1[2], v1[3]);
                *(u32x4*)rowp = w;
            }
    }
};
struct EpiResid {
    static constexpr bool PERM = false, CAN_KEEP = false;
    float* Y; const float* res; const float* rin; const float* lg; const float* lb; float alpha, scale; bf16_t* yb; float* rout; bool stream;
    __device__ __forceinline__ void operator()(const f32x4 (&acc)[2][2][4][2], const Unit& u, int wr, int wc, int fr, int fq) const {
        const int row0 = u.pm * BM + wr * 64 + fr, col0 = u.pn * BM + wc * 32 + 4 * fq;
        f32x4 gg[2][2], bb[2][2];
#pragma unroll
        for (int bj = 0; bj < 2; ++bj)
#pragma unroll
            for (int n = 0; n < 2; ++n) { gg[bj][n] = (f32x4){1.f, 1.f, 1.f, 1.f}; bb[bj][n] = (f32x4){0.f, 0.f, 0.f, 0.f};
                if (rin) { gg[bj][n] = *(const f32x4*)(lg + col0 + bj * HALF + n * 16); bb[bj][n] = *(const f32x4*)(lb + col0 + bj * HALF + n * 16); } }
#pragma unroll
        for (int ai = 0; ai < 2; ++ai)
#pragma unroll
            for (int m2 = 0; m2 < 2; ++m2) {
                f32x4 xv[2][2][2]; f32x2 st[2];
#pragma unroll
                for (int mm = 0; mm < 2; ++mm) {
                    const int r = row0 + ai * HALF + (2 * m2 + mm) * 16;
                    st[mm] = (f32x2){0.f, 1.f};
                    if (rin) st[mm] = ln_stats(*(const f32x2*)(rin + 2 * (size_t)r));
#pragma unroll
                    for (int bj = 0; bj < 2; ++bj)
#pragma unroll
                        for (int n = 0; n < 2; ++n) { const f32x4* rp = (const f32x4*)(res + (size_t)r * D + col0 + bj * HALF + n * 16); xv[mm][bj][n] = stream ? __builtin_nontemporal_load(rp) : *rp; }
                }
#pragma unroll
                for (int mm = 0; mm < 2; ++mm) {
                    const int r = row0 + ai * HALF + (2 * m2 + mm) * 16;
                    float ps = 0.f, pq = 0.f;
#pragma unroll
                    for (int bj = 0; bj < 2; ++bj)
#pragma unroll
                        for (int n = 0; n < 2; ++n) {
                            const f32x4 x = (xv[mm][bj][n] - st[mm][0]) * (gg[bj][n] * st[mm][1]) + bb[bj][n];
                            const f32x4 o = x * alpha + acc[ai][bj][2 * m2 + mm][n] * scale;
                            const size_t off = (size_t)r * D + col0 + bj * HALF + n * 16;
                            *(f32x4*)(Y + off) = o;
                            if (yb) { u32x2 w; w.x = cvt_pk_bf16(o[0], o[1]); w.y = cvt_pk_bf16(o[2], o[3]); *(u32x2*)(yb + off) = w; }
                            ps += (o[0] + o[1]) + (o[2] + o[3]); pq += (o[0] * o[0] + o[1] * o[1]) + (o[2] * o[2] + o[3] * o[3]);
                        }
                    if (rout) {
                        ps += __shfl_xor(ps, 16); pq += __shfl_xor(pq, 16); ps += __shfl_xor(ps, 32); pq += __shfl_xor(pq, 32);
                        if (fq == 0) { atomicAdd(rout + 2 * (size_t)r, ps); atomicAdd(rout + 2 * (size_t)r + 1, pq); }
                    }
                }
            }
    }
};
struct EpiWin {
    static constexpr bool PERM = true, CAN_KEEP = false;
    bf16_t* Z; const LAS float* gate_b; float* outK; float* outV; bf16_t* KB; bf16_t* VT; const float* rsum; const float* cs;
    __device__ __forceinline__ void operator()(const f32x4 (&acc)[2][2][4][2], const Unit& u, int wr, int wc, int fr, int fq) const {
        const int row0 = u.pm * BM + wr * 64 + fr, col0 = u.pn * BM + wc * 32 + 8 * fq;
        if (u.kind == 0) {
            const int mode = (u.pn < 8) ? 1 : (u.pn < 12) ? 0 : (u.pn < 16) ? 1 : (u.pn < 20) ? 0 : 2;
            f32x4 gb[2][2];
#pragma unroll
            for (int bj = 0; bj < 2; ++bj)
#pragma unroll
                for (int n = 0; n < 2; ++n) gb[bj][n] = (mode == 2) ? *(const LAS f32x4*)(gate_b + (col0 - 5120) + bj * HALF + 4 * n) : (f32x4){0.f, 0.f, 0.f, 0.f};
            f32x4 s1[2][2], s2[2][2];
#pragma unroll
            for (int bj = 0; bj < 2; ++bj)
#pragma unroll
                for (int n = 0; n < 2; ++n) { s1[bj][n] = *(const f32x4*)(cs + col0 + bj * HALF + 4 * n); s2[bj][n] = *(const f32x4*)(cs + NZ + col0 + bj * HALF + 4 * n); }
#pragma unroll
            for (int ai = 0; ai < 2; ++ai)
#pragma unroll
                for (int m = 0; m < 4; ++m) {
                    const int r = row0 + ai * HALF + m * 16;
                    bf16_t* rowp = Z + (size_t)r * NZ + col0;
                    const f32x2 st = ln_stats(*(const f32x2*)(rsum + 2 * (size_t)r));
#pragma unroll
                    for (int bj = 0; bj < 2; ++bj) {
                        f32x4 v0 = (acc[ai][bj][m][0] - s1[bj][0] * st[0]) * st[1] + s2[bj][0], v1 = (acc[ai][bj][m][1] - s1[bj][1] * st[0]) * st[1] + s2[bj][1];
                        if (mode == 1) {
#pragma unroll
                            for (int j = 0; j < 4; ++j) { v0[j] = gelu_tanh(v0[j]); v1[j] = gelu_tanh(v1[j]); }
                        } else if (mode == 2) {
#pragma unroll
                            for (int j = 0; j < 4; ++j) { v0[j] = sigmoidf_(v0[j] + gb[bj][0][j]); v1[j] = sigmoidf_(v1[j] + gb[bj][1][j]); }
                        }
                        u32x4 w; w.x = cvt_pk_bf16(v0[0], v0[1]); w.y = cvt_pk_bf16(v0[2], v0[3]); w.z = cvt_pk_bf16(v1[0], v1[1]); w.w = cvt_pk_bf16(v1[2], v1[3]);
                        *(u32x4*)(rowp + bj * HALF) = w;
                    }
                }
        } else if (u.kind == 1) {
            const bool isk = u.pn < 4; const int c0 = col0 - (isk ? 0 : 1024);
            float* ob = isk ? outK : outV;
#pragma unroll
            for (int ai = 0; ai < 2; ++ai)
#pragma unroll
                for (int m = 0; m < 4; ++m) {
                    const size_t off = (size_t)(row0 + ai * HALF + m * 16) * 1024 + c0;
#pragma unroll
                    for (int bj = 0; bj < 2; ++bj) {
                        const f32x4 v0 = acc[ai][bj][m][0], v1 = acc[ai][bj][m][1];
                        __builtin_nontemporal_store(v0, (f32x4*)(ob + off + bj * HALF)); __builtin_nontemporal_store(v1, (f32x4*)(ob + off + bj * HALF + 4));
                        if (isk) { u32x4 w; w.x = cvt_pk_bf16(v0[0], v0[1]); w.y = cvt_pk_bf16(v0[2], v0[3]); w.z = cvt_pk_bf16(v1[0], v1[1]); w.w = cvt_pk_bf16(v1[2], v1[3]); *(u32x4*)(KB + off + bj * HALF) = w; }
                    }
                }
        } else {
#pragma unroll
            for (int ai = 0; ai < 2; ++ai)
#pragma unroll
                for (int m = 0; m < 4; ++m) {
                    bf16_t* rowp = VT + (size_t)(row0 + ai * HALF + m * 16) * 1024 + col0;
#pragma unroll
                    for (int bj = 0; bj < 2; ++bj) {
                        const f32x4 v0 = acc[ai][bj][m][0], v1 = acc[ai][bj][m][1];
                        u32x4 w; w.x = cvt_pk_bf16(v0[0], v0[1]); w.y = cvt_pk_bf16(v0[2], v0[3]); w.z = cvt_pk_bf16(v1[0], v1[1]); w.w = cvt_pk_bf16(v1[2], v1[3]);
                        *(u32x4*)(rowp + bj * HALF) = w;
                    }
                }
        }
    }
};
struct EpiMerge {
    static constexpr bool PERM = true, CAN_KEEP = true;
    const bf16_t* Z; bf16_t* MB;
    __device__ __forceinline__ void operator()(f32x4 (&acc)[2][2][4][2], const Unit& u, int wr, int wc, int fr, int fq) const {
        const int row0 = u.pm * BM + wr * 64 + fr, col0 = u.pn * BM + wc * 32 + 8 * fq;
        const bool last = (u.kind == 2);
        const int koff = 5120 + u.kind * 2048, noff = last ? 0 : 2048;
#pragma unroll
        for (int ai = 0; ai < 2; ++ai)
#pragma unroll
            for (int m2 = 0; m2 < 2; ++m2) {
                u32x4 ga[2][2], gb[2][2];
#pragma unroll
                for (int mm = 0; mm < 2; ++mm)
#pragma unroll
                    for (int bj = 0; bj < 2; ++bj) {
                        const bf16_t* zp = Z + (size_t)(row0 + ai * HALF + (2 * m2 + mm) * 16) * NZ + koff + col0 + bj * HALF;
                        ga[mm][bj] = *(const u32x4*)zp;
                        gb[mm][bj] = *(const u32x4*)(zp + noff);
                    }
#pragma unroll
                for (int mm = 0; mm < 2; ++mm)
#pragma unroll
                    for (int bj = 0; bj < 2; ++bj) {
                        const int m = 2 * m2 + mm;
                        const u32x4 a4 = ga[mm][bj], b4 = gb[mm][bj];
                        f32x4 g0 = (f32x4){bflo(a4.x), bfhi(a4.x), bflo(a4.y), bfhi(a4.y)}, g1 = (f32x4){bflo(a4.z), bfhi(a4.z), bflo(a4.w), bfhi(a4.w)};
                        const f32x4 h0 = (f32x4){bflo(b4.x), bfhi(b4.x), bflo(b4.y), bfhi(b4.y)}, h1 = (f32x4){bflo(b4.z), bfhi(b4.z), bflo(b4.w), bfhi(b4.w)};
#pragma unroll
                        for (int j = 0; j < 4; ++j) {
                            g0[j] = fmaxf(g0[j], 1e-6f) * (last ? 1.0f : __builtin_amdgcn_rcpf(fmaxf(h0[j], 1e-6f)));
                            g1[j] = fmaxf(g1[j], 1e-6f) * (last ? 1.0f : __builtin_amdgcn_rcpf(fmaxf(h1[j], 1e-6f)));
                        }
                        acc[ai][bj][m][0] *= g0; acc[ai][bj][m][1] *= g1;
                        if (last) {
                            const f32x4 v0 = acc[ai][bj][m][0], v1 = acc[ai][bj][m][1];
                            u32x4 w; w.x = cvt_pk_bf16(v0[0], v0[1]); w.y = cvt_pk_bf16(v0[2], v0[3]); w.z = cvt_pk_bf16(v1[0], v1[1]); w.w = cvt_pk_bf16(v1[2], v1[3]);
                            *(u32x4*)(MB + (size_t)(row0 + ai * HALF + m * 16) * D + col0 + bj * HALF) = w;
                        }
                    }
            }
    }
};
}

#ifndef PHMASK
#define PHMASK 0xFFFFFFFFu
#endif
#ifndef GREP
#define GREP 1
#endif
#ifndef NREP
#define NREP 1
#endif
#define PHON(n) (((PHMASK) >> (n)) & 1u)
#define LDS_WAIT() asm volatile("s_waitcnt lgkmcnt(0)" ::: "memory")

__device__ __forceinline__ void transpose_item(const float* W, int N, bf16_t* WT, int ldk, int k0, int n0, int dst_row0, LAS float* scr, int lane, const float* fg, const float* fb, float* cs) {
    f32x4 v[8];
    const int n4 = (lane & 7) * 4, kr = lane >> 3;
#pragma unroll
    for (int i = 0; i < 8; ++i) v[i] = __builtin_nontemporal_load((const f32x4*)(W + (size_t)(k0 + kr + 8 * i) * N + n0 + n4));
#pragma unroll
    for (int i = 0; i < 8; ++i) { LAS float* d = scr + (kr + 8 * i) * 33 + n4; d[0] = v[i][0]; d[1] = v[i][1]; d[2] = v[i][2]; d[3] = v[i][3]; }
    LDS_WAIT(); asm volatile("" ::: "memory");
    const int c = lane & 7;
    f32x4 g0 = (f32x4){1.f, 1.f, 1.f, 1.f}, g1 = g0, b0 = (f32x4){0.f, 0.f, 0.f, 0.f}, b1 = b0;
    if (fg) { g0 = *(const f32x4*)(fg + k0 + 8 * c); g1 = *(const f32x4*)(fg + k0 + 8 * c + 4); b0 = *(const f32x4*)(fb + k0 + 8 * c); b1 = *(const f32x4*)(fb + k0 + 8 * c + 4); }
#pragma unroll
    for (int j = 0; j < 4; ++j) { const int n = (lane >> 3) + 8 * j; const LAS float* s = scr + (8 * c) * 33 + n;
        const f32x4 w0 = (f32x4){s[0 * 33], s[1 * 33], s[2 * 33], s[3 * 33]}, w1 = (f32x4){s[4 * 33], s[5 * 33], s[6 * 33], s[7 * 33]};
        const f32x4 f0 = w0 * g0, f1 = w1 * g1;
        u32x4 o; o.x = cvt_pk_bf16(f0[0], f0[1]); o.y = cvt_pk_bf16(f0[2], f0[3]); o.z = cvt_pk_bf16(f1[0], f1[1]); o.w = cvt_pk_bf16(f1[2], f1[3]);
        *(u32x4*)(WT + (size_t)(dst_row0 + n) * ldk + k0 + 8 * c) = o;
        if (fg) {
            float p1 = ((bflo(o.x) + bfhi(o.x)) + (bflo(o.y) + bfhi(o.y))) + ((bflo(o.z) + bfhi(o.z)) + (bflo(o.w) + bfhi(o.w)));
            const f32x4 t0 = w0 * b0, t1 = w1 * b1;
            float p2 = ((t0[0] + t0[1]) + (t0[2] + t0[3])) + ((t1[0] + t1[1]) + (t1[2] + t1[3]));
            p1 += __shfl_xor(p1, 1); p2 += __shfl_xor(p2, 1); p1 += __shfl_xor(p1, 2); p2 += __shfl_xor(p2, 2); p1 += __shfl_xor(p1, 4); p2 += __shfl_xor(p2, 4);
            if (c == 0) { atomicAdd(cs + dst_row0 + n, p1); atomicAdd(cs + NZ + dst_row0 + n, p2); }
        } }
    LDS_WAIT(); asm volatile("" ::: "memory");
}
__device__ __forceinline__ void ln_row(const float* yrow, const float* g, const float* b, float* of, bf16_t* ob, int lane) {
    f32x4 v[8]; float s = 0.f;
#pragma unroll
    for (int j = 0; j < 8; ++j) { v[j] = *(const f32x4*)(yrow + 4 * lane + 256 * j); s += (v[j][0] + v[j][1]) + (v[j][2] + v[j][3]); }
    const float mean = wave_sum(s) * (1.f / D); float s2 = 0.f;
#pragma unroll
    for (int j = 0; j < 8; ++j) { v[j] = v[j] - mean; s2 += (v[j][0] * v[j][0] + v[j][1] * v[j][1]) + (v[j][2] * v[j][2] + v[j][3] * v[j][3]); }
    const float rstd = 1.0f / sqrtf(wave_sum(s2) * (1.f / D) + LN_EPS);
#pragma unroll
    for (int j = 0; j < 8; ++j) {
        const f32x4 gg = *(const f32x4*)(g + 4 * lane + 256 * j), bb = *(const f32x4*)(b + 4 * lane + 256 * j);
        const f32x4 o = v[j] * rstd * gg + bb;
        if (of) __builtin_nontemporal_store(o, (f32x4*)(of + 4 * lane + 256 * j));
        if (ob) { u32x2 w; w.x = cvt_pk_bf16(o[0], o[1]); w.y = cvt_pk_bf16(o[2], o[3]); *(u32x2*)(ob + 4 * lane + 256 * j) = w; }
    }
}

#define XB_TMO      128
#define XB_XCNT(j)  (256  + 64 * (j))
#define XB_XSUB(j)  (1280 + 64 * (j))
#define XB_XGEN(j)  (2304 + 64 * (j))
#define XB_TOP      3328
#define XB_TOPGEN   3392
#define XCD_BAR_WORDS 3456
#define XB_SPIN_CAP (1u << 22)
__device__ __forceinline__ unsigned xb_ld(unsigned* p)              { return __hip_atomic_load(p, __ATOMIC_RELAXED, __HIP_MEMORY_SCOPE_AGENT); }
__device__ __forceinline__ unsigned xb_add(unsigned* p, unsigned v) { return __hip_atomic_fetch_add(p, v, __ATOMIC_RELAXED, __HIP_MEMORY_SCOPE_AGENT); }
__device__ __forceinline__ unsigned xb_xcc_id() { return (unsigned)__builtin_amdgcn_s_getreg((3 << 11) | 20) & 0xFu; }
#define XB_SPIN(cond, bar) do { unsigned _sp = 0; while (cond) { __builtin_amdgcn_s_sleep(1); \
    if ((++_sp & 255u) == 0u) { if (xb_ld(&(bar)[XB_TMO])) break; if (_sp > XB_SPIN_CAP) { atomicAdd(&(bar)[XB_TMO], 1u); break; } } } } while (0)
struct XcdBarrier { unsigned* bar; unsigned x; volatile LAS unsigned* st; };
__device__ __forceinline__ XcdBarrier xcd_barrier_post(unsigned* bar, volatile LAS unsigned* st) {
    XcdBarrier b; b.bar = bar; b.x = xb_xcc_id(); b.st = st;
    if (threadIdx.x == 0) (void)xb_add(&bar[XB_XCNT(b.x)], 1u);
    return b;
}
__device__ __forceinline__ void xcd_barrier_complete(unsigned* bar, unsigned x, unsigned& nloc, unsigned& nx) {
    const unsigned G = gridDim.x * gridDim.y * gridDim.z;
    unsigned sum, cnt, mine, sp = 0u;
    for (;;) {
        sum = 0u; cnt = 0u; mine = 0u;
#pragma unroll
        for (unsigned j = 0; j < 16; ++j) { const unsigned c = xb_ld(&bar[XB_XCNT(j)]); sum += c; cnt += (c > 0u) ? 1u : 0u; mine = (j == x) ? c : mine; }
        if (sum == G) break;
        __builtin_amdgcn_s_sleep(1);
        if ((++sp & 255u) == 0u) { if (xb_ld(&bar[XB_TMO])) break; if (sp > XB_SPIN_CAP) { atomicAdd(&bar[XB_TMO], 1u); break; } }
    }
    nloc = mine > 0u ? mine : 1u; nx = cnt > 0u ? cnt : 1u;
}
__device__ __forceinline__ void xcd_barrier(const XcdBarrier& b) {
    asm volatile("s_waitcnt vmcnt(0)" ::: "memory");
    __syncthreads();
    if (threadIdx.x == 0) {
        unsigned* bar = b.bar;
        __builtin_amdgcn_s_waitcnt(0);
        unsigned nloc = b.st[0], nx = b.st[1];
        if (nloc == 0u) { xcd_barrier_complete(bar, b.x, nloc, nx); b.st[0] = nloc; b.st[1] = nx; }
        const unsigned old = xb_add(&bar[XB_XSUB(b.x)], 1u);
        const unsigned gen = old / nloc;
        if (old + 1u == (gen + 1u) * nloc) {
            __builtin_amdgcn_fence(__ATOMIC_RELEASE, "agent");
            asm volatile("s_waitcnt vmcnt(0)" ::: "memory");
            const unsigned og = xb_add(&bar[XB_TOP], 1u);
            const unsigned tg = og / nx;
            if (og + 1u == (tg + 1u) * nx) xb_add(&bar[XB_TOPGEN], 1u);
            else XB_SPIN(xb_ld(&bar[XB_TOPGEN]) == tg, bar);
            __builtin_amdgcn_fence(__ATOMIC_ACQUIRE, "agent");
            xb_add(&bar[XB_XGEN(b.x)], 1u);
            asm volatile("s_waitcnt vmcnt(0)" ::: "memory");
        } else {
            XB_SPIN(xb_ld(&bar[XB_XGEN(b.x)]) == gen, bar);
            __builtin_amdgcn_fence(__ATOMIC_ACQUIRE, "agent");
            asm volatile("s_waitcnt vmcnt(0)" ::: "memory");
        }
    }
    __syncthreads();
}

template <int MODE>
__device__ __forceinline__ void skinny(LAS unsigned char* lds, int bid, int G, int wave, int lane, const bf16_t* A, int lda, const bf16_t* Bt, int ldb, int K,
                                       float* Ys, const float* res, float alpha, float scale, const bf16_t* Zs, bf16_t* MBs,
                                       const float* rin, const float* lg, const float* lb, bf16_t* ybs, float* rout) {
    const int fr = lane & 15, fq = lane >> 4, tw = wave & 3, kh = wave >> 2;
    LAS f32x4* red = (LAS f32x4*)lds;
    for (int T0 = bid * 4; T0 < 1024; T0 += G * 4) {
        const int T = T0 + tw, rt = T >> 7, ct = T & 127;
        f32x4 tot = (f32x4){0.f, 0.f, 0.f, 0.f};
        if (MODE == 0) {
            const int kb = kh * (K / 2);
            const bf16_t* ap = A + (size_t)(rt * 16 + fr) * lda + kb + fq * 8;
            const bf16_t* bp = Bt + (size_t)(ct * 16 + fr) * ldb + kb + fq * 8;
#pragma unroll 16
            for (int ks = 0; ks < K / 64; ++ks) {
                const bf16x8 af = *(const bf16x8*)(ap + ks * 32), bfv = *(const bf16x8*)(bp + ks * 32);
                tot = __builtin_amdgcn_mfma_f32_16x16x32_bf16(bfv, af, tot, 0, 0, 0);
            }
        } else {
#pragma unroll
            for (int k = 0; k < 3; ++k) {
                const int kb = kh * (BW / 2);
                const bf16_t* ap = A + (size_t)(rt * 16 + fr) * lda + k * BW + kb + fq * 8;
                const bf16_t* bp = Bt + (size_t)k * D * BW + (size_t)(ct * 16 + fr) * ldb + kb + fq * 8;
                f32x4 acc = (f32x4){0.f, 0.f, 0.f, 0.f};
#pragma unroll 8
                for (int ks = 0; ks < BW / 64; ++ks) {
                    const bf16x8 af = *(const bf16x8*)(ap + ks * 32), bfv = *(const bf16x8*)(bp + ks * 32);
                    acc = __builtin_amdgcn_mfma_f32_16x16x32_bf16(bfv, af, acc, 0, 0, 0);
                }
                const u32x2 gw = *(const u32x2*)(Zs + (size_t)(rt * 16 + fr) * NZ + 5120 + k * 2048 + ct * 16 + 4 * fq);
                tot += acc * (f32x4){bflo(gw.x), bfhi(gw.x), bflo(gw.y), bfhi(gw.y)};
            }
        }
        if (kh == 1) red[tw * 64 + lane] = tot;
        __syncthreads();
        if (kh == 0) {
            tot += red[tw * 64 + lane];
            const size_t off = (size_t)(rt * 16 + fr) * D + ct * 16 + 4 * fq;
            if (MODE == 0) {
                f32x4 xv = *(const f32x4*)(res + off);
                if (rin) { const f32x2 st = ln_stats(*(const f32x2*)(rin + 2 * (rt * 16 + fr))); const int cc = ct * 16 + 4 * fq;
                    xv = (xv - st[0]) * (*(const f32x4*)(lg + cc) * st[1]) + *(const f32x4*)(lb + cc); }
                const f32x4 o = xv * alpha + tot * scale;
                *(f32x4*)(Ys + off) = o;
                if (ybs) { u32x2 w; w.x = cvt_pk_bf16(o[0], o[1]); w.y = cvt_pk_bf16(o[2], o[3]); *(u32x2*)(ybs + off) = w; }
                if (rout) { float ps = (o[0] + o[1]) + (o[2] + o[3]), pq = (o[0] * o[0] + o[1] * o[1]) + (o[2] * o[2] + o[3] * o[3]);
                    ps += __shfl_xor(ps, 16); pq += __shfl_xor(pq, 16); ps += __shfl_xor(ps, 32); pq += __shfl_xor(pq, 32);
                    if (fq == 0) { atomicAdd(rout + 2 * (rt * 16 + fr), ps); atomicAdd(rout + 2 * (rt * 16 + fr) + 1, pq); } }
            }
            else { u32x2 w; w.x = cvt_pk_bf16(tot[0], tot[1]); w.y = cvt_pk_bf16(tot[2], tot[3]); *(u32x2*)(MBs + off) = w; }
        }
        __syncthreads();
    }
}

#define WGU1 ((bf16_t*)(P.ws + WS_WGU1))
#define WD1 ((bf16_t*)(P.ws + WS_WD1))
#define WIN ((bf16_t*)(P.ws + WS_WIN))
#define WKV ((bf16_t*)(P.ws + WS_WKV))
#define WBR ((bf16_t*)(P.ws + WS_WBR))
#define WOUT ((bf16_t*)(P.ws + WS_WOUT))
#define WGU2 ((bf16_t*)(P.ws + WS_WGU2))
#define WD2 ((bf16_t*)(P.ws + WS_WD2))
#define WLRU ((bf16_t*)(P.ws + WS_WLRU))
#define WSP ((bf16_t*)(P.ws + WS_WSP))
#define XB ((bf16_t*)(P.ws + WS_XB))
#define Z ((bf16_t*)(P.ws + WS_ZH))
#define H ((bf16_t*)(P.ws + WS_ZH))
#define Y ((float*)(P.ws + WS_Y))
#define X1 ((float*)(P.ws + WS_X1))
#define CSUM ((float*)(P.ws + WS_CS))
#define GSB ((float*)(P.ws + WS_GSB))
#define YB2 ((bf16_t*)(P.ws + WS_X1))
#define RSUM ((float*)(P.ws + WS_RS))
#define VP ((bf16_t*)(P.ws + WS_VP))
#define HL ((float*)(P.ws + WS_HL))
#define AC ((float*)(P.ws + WS_AC))
#define SUM ((float*)(P.ws + WS_SUM))
#define YS ((bf16_t*)(P.ws + WS_YS))
#define MEMLN ((bf16_t*)(P.ws + WS_MEMLN))
#define KB ((bf16_t*)(P.ws + WS_KB))
#define VT ((bf16_t*)(P.ws + WS_VT))
__device__ __forceinline__ void p5d_sample_attn(const Params& P, LAS unsigned char* lds, int bid, int G, int tid_in) {
    int tid = tid_in; asm volatile("" : "+v"(tid));
    const int lane = tid & 63, wave = __builtin_amdgcn_readfirstlane(tid >> 6);

        LAS float* sS = (LAS float*)(lds + 131072);
        LAS float* sO = (LAS float*)(lds + 131072 + 1024);
        const int vb = (G % 8 == 0) ? (bid & 7) * (G >> 3) + (bid >> 3) : bid;
        for (int it = vb; it < 512; it += G) {
            const int b = it >> 2, h = it & 3;
            const u32x2 qw = *(const u32x2*)(Z + (size_t)(MP + b) * NZ + 4096 + h * HD + 4 * lane);
            const f32x4 q = (f32x4){bflo(qw.x), bfhi(qw.x), bflo(qw.y), bfhi(qw.y)};
            const float* kbase = P.in[I_CK] + ((size_t)(b * NMEM + 32 * wave) * NH + h) * HD + 4 * lane;
            const float* vbase = P.in[I_CV] + ((size_t)(b * NMEM + 32 * wave) * NH + h) * HD + 4 * lane;
            float d[32];
#pragma unroll
            for (int mi = 0; mi < 32; ++mi) {
                const f32x4 kv = __builtin_nontemporal_load((const f32x4*)(kbase + (size_t)mi * (NH * HD)));
                d[mi] = (kv[0] * q[0] + kv[1] * q[1]) + (kv[2] * q[2] + kv[3] * q[3]);
                if (mi == 15) asm volatile("" ::: "memory");
            }
#pragma unroll
            for (int i = 0; i < 16; ++i) { const bool hi = (lane & 32) != 0; const float snd = hi ? d[i] : d[i + 16], kp = hi ? d[i + 16] : d[i]; d[i] = kp + __shfl_xor(snd, 32); }
#pragma unroll
            for (int i = 0; i < 8; ++i) { const bool hi = (lane & 16) != 0; const float snd = hi ? d[i] : d[i + 8], kp = hi ? d[i + 8] : d[i]; d[i] = kp + __shfl_xor(snd, 16); }
#pragma unroll
            for (int i = 0; i < 4; ++i) { const bool hi = (lane & 8) != 0; const float snd = hi ? d[i] : d[i + 4], kp = hi ? d[i + 4] : d[i]; d[i] = kp + __shfl_xor(snd, 8); }
#pragma unroll
            for (int i = 0; i < 2; ++i) { const bool hi = (lane & 4) != 0; const float snd = hi ? d[i] : d[i + 2], kp = hi ? d[i + 2] : d[i]; d[i] = kp + __shfl_xor(snd, 4); }
            { const bool hi = (lane & 2) != 0; const float snd = hi ? d[0] : d[1], kp = hi ? d[1] : d[0]; d[0] = kp + __shfl_xor(snd, 2); }
            d[0] += __shfl_xor(d[0], 1);
            if ((lane & 1) == 0) sS[32 * wave + (lane >> 1)] = d[0] * 0.0625f;
            f32x4 vv[16];
#pragma unroll
            for (int mi = 0; mi < 16; ++mi) vv[mi] = __builtin_nontemporal_load((const f32x4*)(vbase + (size_t)mi * (NH * HD)));
            __syncthreads();
            float mx = fmaxf(fmaxf(sS[lane], sS[lane + 64]), fmaxf(sS[lane + 128], sS[lane + 192]));
            mx = wave_max(mx);
            float sm = __expf(sS[lane] - mx) + __expf(sS[lane + 64] - mx) + __expf(sS[lane + 128] - mx) + __expf(sS[lane + 192] - mx);
            sm = wave_sum(sm);
            const float inv = 1.0f / sm;
            f32x4 o = (f32x4){0.f, 0.f, 0.f, 0.f};
            f32x4 vw[16];
#pragma unroll
            for (int mi = 0; mi < 16; ++mi) vw[mi] = __builtin_nontemporal_load((const f32x4*)(vbase + (size_t)(16 + mi) * (NH * HD)));
#pragma unroll
            for (int mi = 0; mi < 16; ++mi) { const float p = __expf(sS[32 * wave + mi] - mx) * inv; o += vv[mi] * p; }
#pragma unroll
            for (int mi = 0; mi < 16; ++mi) { const float p = __expf(sS[32 * wave + 16 + mi] - mx) * inv; o += vw[mi] * p; }
            *(LAS f32x4*)(sO + wave * 256 + 4 * lane) = o;
            __syncthreads();
            if (tid < 256) {
                float a = 0.f;
#pragma unroll
                for (int w = 0; w < 8; ++w) a += sO[w * 256 + tid];
                YS[(size_t)(MP + b) * 3072 + 2048 + h * HD + tid] = (bf16_t)(cvt_pk_bf16(a, 0.f) & 0xffffu);
            }
            __syncthreads();
        }
}

__global__ void __launch_bounds__(NTHREADS, 2) fwd_kernel(Params P) {
    extern __shared__ __attribute__((aligned(16))) unsigned char lds_raw[];
    LAS unsigned char* lds = (LAS unsigned char*)lds_raw;
    cg::grid_group grid = cg::this_grid();
    const int tid = threadIdx.x, lane = tid & 63, wave = __builtin_amdgcn_readfirstlane(tid >> 6);
    const int G = gridDim.x, bid = blockIdx.x;
    const int gw = bid * NWAVES + wave, NGW = G * NWAVES;
    float* out = P.out;
    volatile LAS unsigned* bst = (volatile LAS unsigned*)(lds + LDS_BYTES - 64);
    if (tid == 0) { bst[0] = 0u; bst[1] = 0u; }
    __syncthreads();
    const XcdBarrier gbar = xcd_barrier_post((unsigned*)(P.ws + WS_BAR), bst);
#define GRID_BAR() xcd_barrier(gbar)

    if (PHON(0)) {
        LAS float* scr = (LAS float*)(lds + wave * 16384);
        constexpr int IT_GU = (D / 64) * (NZ / 32), IT_DN = (FF / 64) * (D / 32), IT_SQ = (D / 64) * (D / 32), IT_BR = (BW / 64) * (D / 32), IT_LR = 2 * 4;
        constexpr int IT_TOTAL = 3 * IT_GU + 2 * IT_DN + 2 * IT_SQ + 3 * IT_BR + 16 * IT_LR;
        for (int it = gw; it < IT_TOTAL; it += NGW) {
            int r = it; const float* W; bf16_t* WT; int N, ldk, mode = 0; const float* fg = nullptr; const float* fb = nullptr; float* cs = nullptr;
            if (r < IT_GU) { W = P.in[I_WIN]; WT = WIN; N = NZ; ldk = D; fg = P.in[I_LN1G]; fb = P.in[I_LN1B]; cs = CSUM; }
            else if ((r -= IT_GU) < IT_SQ) { W = P.in[I_WKV]; WT = WKV; N = D; ldk = D; }
            else if ((r -= IT_SQ) < 3 * IT_BR) { const int k = r / IT_BR; r -= k * IT_BR; W = P.in[I_WBR] + (size_t)k * BW * D; WT = WBR + (size_t)k * D * BW; N = D; ldk = BW; }
            else if ((r -= 3 * IT_BR) < IT_SQ) { W = P.in[I_WOUT]; WT = WOUT; N = D; ldk = D; }
            else if ((r -= IT_SQ) < IT_GU) { W = P.in[I_GU2]; WT = WGU2; N = NZ; ldk = D; mode = 1; fg = P.in[I_LN2G]; fb = P.in[I_LN2B]; cs = CSUM + 2 * NZ; }
            else if ((r -= IT_GU) < IT_DN) { W = P.in[I_DN2]; WT = WD2; N = D; ldk = FF; }
            else if ((r -= IT_DN) < 16 * IT_LR) { const int m = r / IT_LR; r -= m * IT_LR; const int k = m >> 1, x = m & 1;
                W = (x ? P.in[I_LWX] : P.in[I_LWA]) + (size_t)k * 128 * 128; WT = WLRU + (size_t)k * 256 * 128 + x * 128 * 128; N = 128; ldk = 128; }
            else if ((r -= 16 * IT_LR) < IT_DN) { W = P.in[I_DN1]; WT = WD1; N = D; ldk = FF; }
            else { r -= IT_DN; W = P.in[I_GU1]; WT = WGU1; N = NZ; ldk = D; mode = 1; }
            const int nblk = N / 32, kb = r / nblk, nb = r % nblk, n0 = 32 * nb;
            int dr = n0;
            if (mode == 1) dr = (n0 < FF) ? (n0 / 128) * 256 + (n0 % 128) : ((n0 - FF) / 128) * 256 + 128 + ((n0 - FF) % 128);
            transpose_item(W, N, WT, ldk, 64 * kb, n0, dr, scr, lane, fg, fb, cs);
        }
        for (int i = gw * 64 + lane; i < 4 * 128 * 128; i += NGW * 64) { const int t = (i >> 7) & 127, s = i & 127; const float w = P.in[I_WS][i]; WSP[i] = (bf16_t)(cvt_pk_bf16(s <= t ? w : 0.f, 0.f) & 0xffffu); }
        for (size_t i = (size_t)gw * 64 + lane; i < (size_t)MPAD * D / 8; i += (size_t)NGW * 64) {
            const size_t e = i * 8; const int r = (int)(e / D);
            u32x4 w = (u32x4){0u, 0u, 0u, 0u};
            if (r < MR) { const float* src = (r < MP) ? P.in[I_XP] + e : P.in[I_XS] + (e - (size_t)MP * D);
                const f32x4 a = __builtin_nontemporal_load((const f32x4*)src), b = __builtin_nontemporal_load((const f32x4*)(src + 4));
                w.x = cvt_pk_bf16(a[0], a[1]); w.y = cvt_pk_bf16(a[2], a[3]); w.z = cvt_pk_bf16(b[0], b[1]); w.w = cvt_pk_bf16(b[2], b[3]); }
            *(u32x4*)(XB + e) = w;
        }
        for (int r = gw; r < 1024; r += NGW) ln_row(P.in[I_MEM] + (size_t)r * D, P.in[I_MLNG], P.in[I_MLNB], nullptr, MEMLN + (size_t)r * D, lane);
    }
    if (P.ws == nullptr) grid.sync();
    GRID_BAR();

    if (PHON(1)) {
        pg8::PlainSched S{XB, WGU1, 33, 44, D, D, G, bid};
        pg8::EpiSwiglu E{H, FF, nullptr, nullptr};
        pg8::gemm_phase<pg8::PlainSched, pg8::EpiSwiglu, true, true>(lds, D, D, D, S, E);
    }
    GRID_BAR();
    if (PHON(2)) {
        skinny<0>(lds, bid, G, wave, lane, H + (size_t)MP * FF, FF, WD1, FF, FF, Y + (size_t)MP * D, P.in[I_XS], ALPHA, 0.5f, nullptr, nullptr, nullptr, nullptr, nullptr, XB + (size_t)MP * D, RSUM + 2 * (size_t)MP);
        pg8::PlainSched S{H, WD1, 32, 8, FF, FF, G, bid};
        pg8::EpiResid E{Y, P.in[I_XP], nullptr, nullptr, nullptr, ALPHA, 0.5f, XB, RSUM, true};
        pg8::gemm_phase<pg8::PlainSched, pg8::EpiResid, true, true>(lds, FF, FF, FF, S, E);
    }
    GRID_BAR();

    if (PHON(4)) {
        LAS float* gbl = (LAS float*)(lds + 131072);
        for (int i = tid; i < 3 * D / 4; i += NTHREADS) *(LAS f32x4*)(gbl + 4 * i) = *(const f32x4*)(P.in[I_GATEB] + 4 * i);
        __syncthreads();
        pg8::WinSched S{XB, WIN, MEMLN, WKV, G, bid};
        pg8::EpiWin E{Z, gbl, out + O_MK, out + O_MV, KB, VT, RSUM, CSUM};
        pg8::gemm_phase<pg8::WinSched, pg8::EpiWin, true, true>(lds, D, D, D, S, E);
    }
    GRID_BAR();

    const bool dfirst_ = ((bid >> 5) & 1) != 0;
    if (dfirst_ && PHON(8)) p5d_sample_attn(P, lds, bid, G, tid);
    if (PHON(5)) for (int r = gw; r < MR; r += NGW) {
        const bf16_t* zr = Z + (size_t)r * NZ + 1024;
        float v[16]; float s = 0.f;
#pragma unroll
        for (int h = 0; h < 2; ++h) { const u32x4 w = *(const u32x4*)(zr + 8 * lane + 512 * h);
            v[8 * h + 0] = bflo(w.x); v[8 * h + 1] = bfhi(w.x); v[8 * h + 2] = bflo(w.y); v[8 * h + 3] = bfhi(w.y); v[8 * h + 4] = bflo(w.z); v[8 * h + 5] = bfhi(w.z); v[8 * h + 6] = bflo(w.w); v[8 * h + 7] = bfhi(w.w); }
#pragma unroll
        for (int j = 0; j < 16; ++j) s += v[j];
        const float mean = wave_sum(s) * (1.f / BW); float s2 = 0.f;
#pragma unroll
        for (int j = 0; j < 16; ++j) { v[j] -= mean; s2 += v[j] * v[j]; }
        const float rstd = 1.0f / sqrtf(wave_sum(s2) * (1.f / BW) + LN_EPS);
#pragma unroll
        for (int h = 0; h < 2; ++h) {
            const int c0 = 8 * lane + 512 * h; float o[8];
#pragma unroll
            for (int j = 0; j < 8; ++j) o[j] = v[8 * h + j] * rstd * P.in[I_GLNG][c0 + j] + P.in[I_GLNB][c0 + j];
            u32x4 w; w.x = cvt_pk_bf16(o[0], o[1]); w.y = cvt_pk_bf16(o[2], o[3]); w.z = cvt_pk_bf16(o[4], o[5]); w.w = cvt_pk_bf16(o[6], o[7]);
            *(u32x4*)(VP + (size_t)r * BW + c0) = w;
            if (r >= MP) { float* ov = out + O_VS + (size_t)(r - MP) * BW + c0; *(f32x4*)ov = (f32x4){o[0], o[1], o[2], o[3]}; *(f32x4*)(ov + 4) = (f32x4){o[4], o[5], o[6], o[7]}; }
        }
    }
    if (PHON(6)) {
        LAS bf16_t* XCB = (LAS bf16_t*)lds;
        LAS float* AARR = (LAS float*)lds;
        LAS float* XCF = (LAS float*)(lds + 65536);
        for (int it = bid; it < 65 * 8; it += G) {
            const int c = it >> 3, k = it & 7; const bool smp = (c == 64);
            const int r0 = c * 128, ch0 = k * 128;
            int lane_o = lane; asm volatile("" : "+v"(lane_o));
            const int fr = lane_o & 15, fq = lane_o >> 4, rh = wave >> 2, cq = wave & 3;
            bf16x8 wfr[4][4];
            {
                const bf16_t* wb = WLRU + (size_t)k * 256 * 128;
#pragma unroll
                for (int ct = 0; ct < 4; ++ct)
#pragma unroll
                    for (int ks = 0; ks < 4; ++ks) wfr[ct][ks] = *(const bf16x8*)(wb + (size_t)((ct >> 1) * 128 + 32 * cq + 16 * (ct & 1) + fr) * 128 + ks * 32 + fq * 8);
            }
            LAS float* prm = (LAS float*)(lds + 131072 + 4096);
            if (tid < 128) { prm[tid] = P.in[I_LBA][ch0 + tid]; prm[128 + tid] = P.in[I_LBX][ch0 + tid]; prm[256 + tid] = __logf(1.0f + __expf(-P.in[I_LAM][ch0 + tid])); }
            {
                const int c4 = (tid & 31) * 4, rg = tid >> 5;
                const int ch = ch0 + c4;
                const f32x4 w0 = *(const f32x4*)(P.in[I_CONVW] + 0 * BW + ch), w1 = *(const f32x4*)(P.in[I_CONVW] + 1 * BW + ch), w2 = *(const f32x4*)(P.in[I_CONVW] + 2 * BW + ch), w3 = *(const f32x4*)(P.in[I_CONVW] + 3 * BW + ch);
                const f32x4 cb = *(const f32x4*)(P.in[I_CONVB] + ch);
                if (!smp) {
                    const bool first = ((c & 15) == 0);
                    const int rs = rg * 8;
                    const bool hist = !(first && rs == 0);
                    u32x2 zr[11];
#pragma unroll
                    for (int i = 0; i < 11; ++i) { zr[i] = (u32x2){0u, 0u}; if (i >= 3 || hist) zr[i] = *(const u32x2*)(Z + (size_t)(r0 + rs - 3 + i) * NZ + 2048 + ch); }
#define ZF(i) ((f32x4){bflo(zr[i].x), bfhi(zr[i].x), bflo(zr[i].y), bfhi(zr[i].y)})
#pragma unroll
                    for (int i = 0; i < 8; ++i) {
                        const int row = rs + i;
                        const f32x4 x0 = ZF(i + 3);
                        const f32x4 xc = cb + w3 * x0 + w2 * ZF(i + 2) + w1 * ZF(i + 1) + w0 * ZF(i);
                        *(LAS f32x4*)(XCF + row * 128 + c4) = xc;
                        u32x2 w; w.x = cvt_pk_bf16(xc[0], xc[1]); w.y = cvt_pk_bf16(xc[2], xc[3]);
                        *(LAS u32x2*)(XCB + row * 136 + c4) = w;
                        if ((c & 15) == 15 && row >= 125) *(f32x4*)(out + O_CP + (size_t)((c >> 4) * 3 + (row - 125)) * BW + ch) = x0;
                    }
#undef ZF
                } else {
#pragma unroll 4
                    for (int i = 0; i < 8; ++i) {
                        const int row = rg * 8 + i;
                        const float* sc = P.in[I_SCONV] + (size_t)row * 3 * BW + ch;
                        const f32x4 b0 = *(const f32x4*)sc, b1 = *(const f32x4*)(sc + BW), b2 = *(const f32x4*)(sc + 2 * BW);
                        const u32x2 a = *(const u32x2*)(Z + (size_t)(MP + row) * NZ + 2048 + ch);
                        const f32x4 x0 = (f32x4){bflo(a.x), bfhi(a.x), bflo(a.y), bfhi(a.y)};
                        const f32x4 xc = cb + w3 * x0 + w2 * b2 + w1 * b1 + w0 * b0;
                        *(LAS f32x4*)(XCF + row * 128 + c4) = xc;
                        u32x2 w; w.x = cvt_pk_bf16(xc[0], xc[1]); w.y = cvt_pk_bf16(xc[2], xc[3]);
                        *(LAS u32x2*)(XCB + row * 136 + c4) = w;
                        float* oc = out + O_CS + (size_t)row * 3 * BW + ch;
                        *(f32x4*)oc = b1; *(f32x4*)(oc + BW) = b2; *(f32x4*)(oc + 2 * BW) = x0;
                    }
                }
            }
            __syncthreads();
            f32x4 ga[4][4];
#pragma unroll
            for (int rt = 0; rt < 4; ++rt)
#pragma unroll
                for (int ct = 0; ct < 4; ++ct) ga[rt][ct] = (f32x4){0.f, 0.f, 0.f, 0.f};
#pragma unroll
            for (int rt = 0; rt < 4; ++rt) {
                bf16x8 af[4];
#pragma unroll
                for (int ks = 0; ks < 4; ++ks) af[ks] = *(const LAS bf16x8*)(XCB + (64 * rh + 16 * rt + fr) * 136 + ks * 32 + fq * 8);
#pragma unroll
                for (int ct = 0; ct < 4; ++ct)
#pragma unroll
                    for (int ks = 0; ks < 4; ++ks) ga[rt][ct] = __builtin_amdgcn_mfma_f32_16x16x32_bf16(af[ks], wfr[ct][ks], ga[rt][ct], 0, 0, 0);
            }
            __syncthreads();
            if (smp) {
#pragma unroll
                for (int cl = 0; cl < 2; ++cl) {
                    const int chl = 32 * cq + 16 * cl + fr, chg = ch0 + chl;
#pragma unroll
                    for (int rt = 0; rt < 4; ++rt)
#pragma unroll
                        for (int j = 0; j < 4; ++j) {
                            const int row = 64 * rh + 16 * rt + 4 * fq + j; const size_t o = (size_t)row * BW + chg;
                            GSB[o] = ga[rt][cl][j]; GSB[(size_t)MS * BW + o] = ga[rt][2 + cl][j]; GSB[(size_t)2 * MS * BW + o] = XCF[row * 128 + chl];
                        }
                }
            } else {
#pragma unroll
            for (int cl = 0; cl < 2; ++cl) {
                const int chl = 32 * cq + 16 * cl + fr;
                const float ba = prm[chl], bx = prm[128 + chl], sp = prm[256 + chl];
#pragma unroll
                for (int rt = 0; rt < 4; ++rt)
#pragma unroll
                    for (int j = 0; j < 4; ++j) {
                        const int row = 64 * rh + 16 * rt + 4 * fq + j;
                        const float rr = sigmoidf_(ga[rt][cl][j] + ba), ii = sigmoidf_(ga[rt][2 + cl][j] + bx);
                        const float la = -8.0f * rr * sp;
                        const float a = __expf(la);
                        const float xc = XCF[row * 128 + chl];
                        const float bt = __builtin_amdgcn_sqrtf(fmaxf(1.0f - a * a, 0.f)) * (ii * xc);
                        AARR[row * 128 + chl] = a; XCF[row * 128 + chl] = bt;
                    }
            }
            }
            __syncthreads();
            if (!smp) {
                {
                    LAS float* segA = (LAS float*)(lds + 131072); LAS float* segH = segA + 512;
                    const int seg = tid >> 7, chn = tid & 127;
                    float h = 0.f, pa = 1.f;
#pragma unroll 8
                    for (int i = 0; i < 32; ++i) { const int o = (32 * seg + i) * 128 + chn; const float a = AARR[o], b = XCF[o]; h = a * h + b; pa *= a; XCF[o] = h; AARR[o] = pa; }
                    segA[tid] = pa; segH[tid] = h;
                    __syncthreads();
                    float cA = 1.f, cH = 0.f;
                    for (int sg = 0; sg < seg; ++sg) { const float sa = segA[sg * 128 + chn]; cH = sa * cH + segH[sg * 128 + chn]; cA *= sa; }
                    if (seg > 0) {
#pragma unroll 8
                        for (int i = 0; i < 32; ++i) { const int o = (32 * seg + i) * 128 + chn; const float hl = XCF[o], pc = AARR[o]; XCF[o] = hl + pc * cH; AARR[o] = pc * cA; }
                    }
                    if (seg == 3) { SUM[(size_t)(c * 2 + 0) * BW + ch0 + chn] = pa * cA; SUM[(size_t)(c * 2 + 1) * BW + ch0 + chn] = h + pa * cH; }
                }
                __syncthreads();
#pragma unroll
                for (int i = 0; i < 8; ++i) { const int e = (i * 512 + tid) * 4, row = e >> 7, cc = e & 127;
                    *(f32x4*)(HL + (size_t)(r0 + row) * BW + ch0 + cc) = *(const LAS f32x4*)(XCF + e);
                    *(f32x4*)(AC + (size_t)(r0 + row) * BW + ch0 + cc) = *(const LAS f32x4*)(AARR + e); }
            }
            __syncthreads();
        }
    }
    if (PHON(7)) for (int it = bid; it < 256; it += G) {
        const int b = it >> 6, h = (it >> 4) & 3, qt = it & 15;
        int lane_o = lane; asm volatile("" : "+v"(lane_o));
        const int fr = lane_o & 15, fq = lane_o >> 4;
        const int row0 = b * SEQ + qt * 128 + wave * 16;
        bf16x8 qf[8];
#pragma unroll
        for (int ks = 0; ks < 8; ++ks) qf[ks] = *(const bf16x8*)(Z + (size_t)(row0 + fr) * NZ + 4096 + h * HD + ks * 32 + fq * 8);
        f32x4 s[16];
        LAS bf16_t* KL = (LAS bf16_t*)lds;
        __syncthreads();
        {
            const bf16_t* kb = KB + (size_t)(b * NMEM) * 1024 + h * HD;
            u32x4 t[16];
#pragma unroll
            for (int i = 0; i < 16; ++i) { const int e = tid + i * NTHREADS, m = e >> 5, c8 = (e & 31) * 8; t[i] = *(const u32x4*)(kb + (size_t)m * 1024 + c8); }
#pragma unroll
            for (int i = 0; i < 16; ++i) { const int e = tid + i * NTHREADS, m = e >> 5, c8 = (e & 31) * 8; *(LAS u32x4*)(KL + m * 264 + c8) = t[i]; }
        }
        asm volatile("" ::: "memory");
        u32x4 tv[16];
        {
            const bf16_t* vt0 = VT + (size_t)(h * HD) * 1024 + b * NMEM;
#pragma unroll
            for (int i = 0; i < 16; ++i) { const int e = tid + i * NTHREADS, dd = e >> 5, c8 = (e & 31) * 8; tv[i] = *(const u32x4*)(vt0 + (size_t)dd * 1024 + c8); }
        }
        __syncthreads();
#pragma unroll
        for (int mt = 0; mt < 16; ++mt) {
            s[mt] = (f32x4){0.f, 0.f, 0.f, 0.f};
#pragma unroll
            for (int ks = 0; ks < 8; ++ks) {
                const bf16x8 kf = *(const LAS bf16x8*)(KL + (mt * 16 + fr) * 264 + ks * 32 + fq * 8);
                s[mt] = __builtin_amdgcn_mfma_f32_16x16x32_bf16(kf, qf[ks], s[mt], 0, 0, 0);
            }
        }
        __syncthreads();
#pragma unroll
        for (int i = 0; i < 16; ++i) { const int e = tid + i * NTHREADS, dd = e >> 5, c8 = (e & 31) * 8; *(LAS u32x4*)(KL + dd * 264 + c8) = tv[i]; }
        float mx = -3.0e38f;
#pragma unroll
        for (int mt = 0; mt < 16; ++mt) mx = fmaxf(mx, fmaxf(fmaxf(s[mt][0], s[mt][1]), fmaxf(s[mt][2], s[mt][3])));
        mx = fmaxf(mx, __shfl_xor(mx, 16)); mx = fmaxf(mx, __shfl_xor(mx, 32));
        float sm = 0.f;
#pragma unroll
        for (int mt = 0; mt < 16; ++mt)
#pragma unroll
            for (int j = 0; j < 4; ++j) { const float p = __expf((s[mt][j] - mx) * 0.0625f); s[mt][j] = p; sm += p; }
        sm += __shfl_xor(sm, 16); sm += __shfl_xor(sm, 32);
        const float inv = 1.0f / sm;
        bf16x8 pf[8];
#pragma unroll
        for (int ks = 0; ks < 8; ++ks) {
            u32x4 w; w.x = cvt_pk_bf16(s[2 * ks][0], s[2 * ks][1]); w.y = cvt_pk_bf16(s[2 * ks][2], s[2 * ks][3]); w.z = cvt_pk_bf16(s[2 * ks + 1][0], s[2 * ks + 1][1]); w.w = cvt_pk_bf16(s[2 * ks + 1][2], s[2 * ks + 1][3]);
            pf[ks] = __builtin_bit_cast(bf16x8, w);
        }
        __syncthreads();
#pragma unroll 4
        for (int dt = 0; dt < 16; ++dt) {
            f32x4 o = (f32x4){0.f, 0.f, 0.f, 0.f};
#pragma unroll
            for (int ks = 0; ks < 8; ++ks) {
                const LAS bf16_t* vp = KL + (dt * 16 + fr) * 264 + ks * 32 + 4 * fq;
                const u32x2 lo = *(const LAS u32x2*)vp, hi = *(const LAS u32x2*)(vp + 16);
                const u32x4 w = (u32x4){lo.x, lo.y, hi.x, hi.y};
                o = __builtin_amdgcn_mfma_f32_16x16x32_bf16(__builtin_bit_cast(bf16x8, w), pf[ks], o, 0, 0, 0);
            }
            u32x2 w; w.x = cvt_pk_bf16(o[0] * inv, o[1] * inv); w.y = cvt_pk_bf16(o[2] * inv, o[3] * inv);
            *(u32x2*)(YS + (size_t)(row0 + fr) * 3072 + 2048 + h * HD + dt * 16 + 4 * fq) = w;
        }
    }
    if (!dfirst_ && PHON(8)) p5d_sample_attn(P, lds, bid, G, tid);
    GRID_BAR();

    if (PHON(9)) for (int it = bid; it < 256; it += G) {
        const int c = it >> 2, rq = it & 3, n = c & 15, cb = c & ~15;
        const int ch = 2 * tid;
        f32x2 carry = (f32x2){0.f, 0.f};
        {
            f32x2 pa[15], hh[15];
#pragma unroll
            for (int j = 0; j < 15; ++j) { pa[j] = (f32x2){1.f, 1.f}; hh[j] = (f32x2){0.f, 0.f};
                if (j < n) { pa[j] = *(const f32x2*)(SUM + (size_t)((cb + j) * 2 + 0) * BW + ch); hh[j] = *(const f32x2*)(SUM + (size_t)((cb + j) * 2 + 1) * BW + ch); } }
#pragma unroll
            for (int j = 0; j < 15; ++j) carry = pa[j] * carry + hh[j];
        }
#pragma unroll 16
        for (int i = 0; i < 32; ++i) {
            const int r = c * 128 + rq * 32 + i;
            const f32x2 hl = __builtin_nontemporal_load((const f32x2*)(HL + (size_t)r * BW + ch)), ac = __builtin_nontemporal_load((const f32x2*)(AC + (size_t)r * BW + ch));
            const f32x2 hv = hl + ac * carry;
            const unsigned rw = *(const unsigned*)(Z + (size_t)r * NZ + 3072 + ch);
            *(unsigned*)(YS + (size_t)r * 3072 + 1024 + ch) = cvt_pk_bf16(bflo(rw) * hv[0], bfhi(rw) * hv[1]);
            if (n == 15 && rq == 3 && i == 31) *(f32x2*)(out + O_HP + (size_t)(c >> 4) * BW + ch) = hv;
        }
    }
    if (PHON(9)) for (int e = bid * NTHREADS + tid; e < MS * BW; e += G * NTHREADS) {
        const int row = e >> 10, ch = e & (BW - 1);
        const float rr = sigmoidf_(GSB[e] + P.in[I_LBA][ch]), ii = sigmoidf_(GSB[(size_t)MS * BW + e] + P.in[I_LBX][ch]);
        const float la = -8.0f * rr * __logf(1.0f + __expf(-P.in[I_LAM][ch]));
        const float a = __expf(la);
        const float h = a * P.in[I_SLRU][e] + __builtin_amdgcn_sqrtf(fmaxf(1.0f - a * a, 0.f)) * (ii * GSB[(size_t)2 * MS * BW + e]);
        out[O_HS + e] = h;
        const float rgv = bf2f(Z[(size_t)(MP + row) * NZ + 3072 + ch]);
        YS[(size_t)(MP + row) * 3072 + 1024 + ch] = (bf16_t)(cvt_pk_bf16(rgv * h, 0.f) & 0xffffu);
    }
    if (PHON(10)) {
        LAS bf16_t* VL = (LAS bf16_t*)lds;
        for (int e = bid * NTHREADS + tid; e < MS * BW / 2; e += G * NTHREADS) {
            const int r = e / (BW / 2), c2 = (e % (BW / 2)) * 2, g = c2 >> 8;
            const float w00 = P.in[I_WS][(size_t)g * 128 * 128], b0 = P.in[I_BS][g * 128];
            const unsigned vw = *(const unsigned*)(VP + (size_t)(MP + r) * BW + c2), uw = *(const unsigned*)(Z + (size_t)(MP + r) * NZ + c2);
            *(unsigned*)(YS + (size_t)(MP + r) * 3072 + c2) = cvt_pk_bf16(bflo(uw) * (w00 * bflo(vw) + b0), bfhi(uw) * (w00 * bfhi(vw) + b0));
        }
        for (int it = bid; it < 256; it += G) {
            const int g = it & 3, cn = it >> 2;
            const int r0 = cn * 128;
            __syncthreads();
            {
                u32x4 vt8[8];
#pragma unroll
                for (int i = 0; i < 8; ++i) { const int e = tid + i * NTHREADS, s = e >> 5, c8 = (e & 31) * 8; vt8[i] = *(const u32x4*)(VP + (size_t)(r0 + s) * BW + g * 256 + c8); }
#pragma unroll
                for (int i = 0; i < 8; ++i) { const int e = tid + i * NTHREADS, s = e >> 5, c8 = (e & 31) * 8; *(LAS u32x4*)(VL + s * 264 + c8) = vt8[i]; }
            }
            __syncthreads();
            const int fr = lane & 15, fq = lane >> 4;
            bf16x8 vf[2][4];
#pragma unroll
            for (int ct = 0; ct < 2; ++ct)
#pragma unroll
                for (int ks = 0; ks < 4; ++ks) {
                    bf16x8 t;
#pragma unroll
                    for (int j = 0; j < 8; ++j) t[j] = (short)VL[(ks * 32 + fq * 8 + j) * 264 + (2 * wave + ct) * 16 + fr];
                    vf[ct][ks] = t;
                }
            const bf16_t* wsp = WSP + (size_t)g * 128 * 128;
            u32x2 uwp[8][2];
#pragma unroll
            for (int tt = 0; tt < 8; ++tt)
#pragma unroll
                for (int ct = 0; ct < 2; ++ct) uwp[tt][ct] = *(const u32x2*)(Z + (size_t)(r0 + tt * 16 + fr) * NZ + g * 256 + (2 * wave + ct) * 16 + 4 * fq);
#pragma unroll
            for (int tt = 0; tt < 8; ++tt) {
                f32x4 o0 = (f32x4){0.f, 0.f, 0.f, 0.f}, o1 = o0;
#pragma unroll
                for (int ks = 0; ks < 4; ++ks) {
                    const bf16x8 wf = *(const bf16x8*)(wsp + (size_t)(tt * 16 + fr) * 128 + ks * 32 + fq * 8);
                    o0 = __builtin_amdgcn_mfma_f32_16x16x32_bf16(vf[0][ks], wf, o0, 0, 0, 0);
                    o1 = __builtin_amdgcn_mfma_f32_16x16x32_bf16(vf[1][ks], wf, o1, 0, 0, 0);
                }
                if ((tt & 3) == 3) asm volatile("" ::: "memory");
                const int t = tt * 16 + fr; const float bs = P.in[I_BS][g * 128 + t];
                const size_t r = (size_t)(r0 + t);
#pragma unroll
                for (int ct = 0; ct < 2; ++ct) {
                    const f32x4 o = ct ? o1 : o0;
                    const int cc = g * 256 + (2 * wave + ct) * 16 + 4 * fq;
                    const u32x2 uw = uwp[tt][ct];
                    u32x2 w; w.x = cvt_pk_bf16(bflo(uw.x) * (o[0] + bs), bfhi(uw.x) * (o[1] + bs)); w.y = cvt_pk_bf16(bflo(uw.y) * (o[2] + bs), bfhi(uw.y) * (o[3] + bs));
                    *(u32x2*)(YS + r * 3072 + cc) = w;
                }
            }
        }
        __syncthreads();
    }
    GRID_BAR();

    if (PHON(11)) {
        skinny<1>(lds, bid, G, wave, lane, YS + (size_t)MP * 3 * BW, 3 * BW, WBR, BW, BW, nullptr, nullptr, 0.f, 0.f, Z + (size_t)MP * NZ, XB + (size_t)MP * D, nullptr, nullptr, nullptr, nullptr, nullptr);
        pg8::BranchSched S{YS, WBR, G, bid};
        pg8::EpiMerge E{Z, XB};
        pg8::gemm_phase<pg8::BranchSched, pg8::EpiMerge, true, true>(lds, BW, 3 * BW, BW, S, E);
    }
    GRID_BAR();
    if (PHON(12)) {
        skinny<0>(lds, bid, G, wave, lane, XB + (size_t)MP * D, D, WOUT, D, D, Y + (size_t)MP * D, Y + (size_t)MP * D, ALPHA, 1.0f, nullptr, nullptr, RSUM + 2 * (size_t)MP, P.in[I_LN1G], P.in[I_LN1B], YB2 + (size_t)MP * D, RSUM + 2 * (size_t)(MPAD + MP));
        pg8::PlainSched S{XB, WOUT, 32, 8, D, D, G, bid};
        pg8::EpiResid E{Y, Y, RSUM, P.in[I_LN1G], P.in[I_LN1B], ALPHA, 1.0f, YB2, RSUM + 2 * (size_t)MPAD, false};
        pg8::gemm_phase<pg8::PlainSched, pg8::EpiResid, true, true>(lds, D, D, D, S, E);
    }
    GRID_BAR();
    if (PHON(14)) {
        pg8::PlainSched S{YB2, WGU2, 33, 44, D, D, G, bid};
        pg8::EpiSwiglu E{H, FF, RSUM + 2 * (size_t)MPAD, CSUM + 2 * NZ};
        pg8::gemm_phase<pg8::PlainSched, pg8::EpiSwiglu, true, true>(lds, D, D, D, S, E);
    }
    GRID_BAR();
    if (PHON(15)) {
        skinny<0>(lds, bid, G, wave, lane, H + (size_t)MP * FF, FF, WD2, FF, FF, Y + (size_t)MP * D, Y + (size_t)MP * D, ALPHA, 0.5f, nullptr, nullptr, RSUM + 2 * (size_t)(MPAD + MP), P.in[I_LN2G], P.in[I_LN2B], nullptr, nullptr);
        pg8::PlainSched S{H, WD2, 32, 8, FF, FF, G, bid};
        pg8::EpiResid E{Y, Y, RSUM + 2 * (size_t)MPAD, P.in[I_LN2G], P.in[I_LN2B], ALPHA, 0.5f, nullptr, nullptr, false};
        pg8::gemm_phase<pg8::PlainSched, pg8::EpiResid, true, true>(lds, FF, FF, FF, S, E);
    }
    GRID_BAR();
    if (PHON(16)) for (int r = gw; r < MR; r += NGW) ln_row(Y + (size_t)r * D, P.in[I_LN3G], P.in[I_LN3B], out + O_Y + (size_t)r * D, nullptr, lane);
}

extern "C" void kernel_launch(void* const* d_in, const int* in_sizes, int n_in, void* d_out, int out_size, void* d_ws, size_t ws_size, hipStream_t stream) {
    static int grid = 0;
    if (grid == 0) {
        if (n_in != 35 || (size_t)out_size != O_END || ws_size < WS_END) { fprintf(stderr, "kernel_launch: unexpected shapes: n_in %d out %d (want %zu) ws %zu (need %zu)\n", n_in, out_size, (size_t)O_END, ws_size, (size_t)WS_END); grid = -1; return; }
        int dev = 0, cus = 0, per_cu = 0;
        hipGetDevice(&dev);
        hipDeviceGetAttribute(&cus, hipDeviceAttributeMultiprocessorCount, dev);
        hipFuncSetAttribute((const void*)fwd_kernel, hipFuncAttributeMaxDynamicSharedMemorySize, LDS_BYTES);
        hipOccupancyMaxActiveBlocksPerMultiprocessor(&per_cu, (const void*)fwd_kernel, NTHREADS, LDS_BYTES);
        if (per_cu < 1) { fprintf(stderr, "kernel_launch: occupancy query says %d blocks/CU\n", per_cu); per_cu = 1; }
        (void)hipGetLastError();
        grid = cus;
    }
    if (grid < 0) return;
    Params p{};
    for (int i = 0; i < 35; ++i) p.in[i] = (const float*)d_in[i];
    p.out = (float*)d_out; p.ws = (unsigned char*)d_ws;
    (void)hipMemsetAsync((char*)d_ws + WS_BAR, 0, WS_GSB - WS_BAR, stream);
    void* args[] = {&p};
    hipError_t e = hipLaunchCooperativeKernel((const void*)fwd_kernel, dim3(grid), dim3(NTHREADS), args, LDS_BYTES, stream);
    if (e != hipSuccess) fprintf(stderr, "cooperative launch failed: %s (grid %d)\n", hipGetErrorString(e), grid);
}
```

```cpp
#include <hip/hip_runtime.h>
#include <hip/hip_cooperative_groups.h>
#include <cstdio>
#include <cstdint>
namespace cg = cooperative_groups;

#define LAS __attribute__((address_space(3)))
typedef unsigned short bf16_t;
typedef short bf16x8 __attribute__((ext_vector_type(8)));
typedef short bf16x4 __attribute__((ext_vector_type(4)));
typedef float f32x4 __attribute__((ext_vector_type(4)));
typedef float f32x2 __attribute__((ext_vector_type(2)));
typedef unsigned u32x4 __attribute__((ext_vector_type(4)));
typedef unsigned u32x2 __attribute__((ext_vector_type(2)));

constexpr int D = 2048, FF = 5632, BW = 1024, NZ = 11264;
constexpr int MP = 8192, MS = 128, MR = MP + MS, MPAD = 8448;
constexpr int SEQ = 2048, NB = 4, NMEM = 256, NH = 4, HD = 256;
constexpr float LN_EPS = 1e-5f;
constexpr float ALPHA = 1.189207115002721f;
constexpr int NTHREADS = 512, NWAVES = 8;

constexpr int XCD_BAR_WORDS_ = 3456;
constexpr size_t al256(size_t x) { return (x + 255) & ~(size_t)255; }
constexpr size_t WS_WGU1 = 0;
constexpr size_t WS_WD1 = WS_WGU1 + al256((size_t)NZ * D * 2);
constexpr size_t WS_WIN = WS_WD1 + al256((size_t)D * FF * 2);
constexpr size_t WS_WKV = WS_WIN + al256((size_t)NZ * D * 2);
constexpr size_t WS_WBR = WS_WKV + al256((size_t)D * D * 2);
constexpr size_t WS_WOUT = WS_WBR + al256((size_t)3 * D * BW * 2);
constexpr size_t WS_WGU2 = WS_WOUT + al256((size_t)D * D * 2);
constexpr size_t WS_WD2 = WS_WGU2 + al256((size_t)NZ * D * 2);
constexpr size_t WS_WLRU = WS_WD2 + al256((size_t)D * FF * 2);
constexpr size_t WS_WSP = WS_WLRU + al256((size_t)8 * 256 * 128 * 2);
constexpr size_t WS_XB = WS_WSP + al256((size_t)4 * 128 * 128 * 2);
constexpr size_t WS_ZH = WS_XB + al256((size_t)MPAD * D * 2);
constexpr size_t WS_Y = WS_ZH + al256((size_t)MPAD * NZ * 2);
constexpr size_t WS_X1 = WS_Y + al256((size_t)MPAD * D * 4);
constexpr size_t WS_VP = WS_X1 + al256((size_t)MPAD * D * 4);
constexpr size_t WS_HL = WS_VP + al256((size_t)MPAD * BW * 2);
constexpr size_t WS_AC = WS_HL + al256((size_t)MP * BW * 4);
constexpr size_t WS_SUM = WS_AC + al256((size_t)MP * BW * 4);
constexpr size_t WS_YS = WS_SUM + al256((size_t)64 * 2 * BW * 4);
constexpr size_t WS_MEMLN = WS_YS + al256((size_t)MPAD * 3 * BW * 2);
constexpr size_t WS_KB = WS_MEMLN + al256((size_t)1024 * D * 2);
constexpr size_t WS_VT = WS_KB + al256((size_t)1024 * 1024 * 2);
constexpr size_t WS_BAR = WS_VT + al256((size_t)1024 * 1024 * 2);
constexpr size_t WS_CS = WS_BAR + al256((size_t)XCD_BAR_WORDS_ * 4);
constexpr size_t WS_RS = WS_CS + al256((size_t)2 * 2 * NZ * 4);
constexpr size_t WS_GSB = WS_RS + al256((size_t)2 * MPAD * 2 * 4);
constexpr size_t WS_END = WS_GSB + al256((size_t)3 * MS * BW * 4);

constexpr size_t O_Y = 0;
constexpr size_t O_MK = (size_t)MR * D;
constexpr size_t O_MV = O_MK + (size_t)1024 * 1024;
constexpr size_t O_CP = O_MV + (size_t)1024 * 1024;
constexpr size_t O_HP = O_CP + (size_t)4 * 3 * 1024;
constexpr size_t O_CS = O_HP + (size_t)4 * 1024;
constexpr size_t O_HS = O_CS + (size_t)128 * 3 * 1024;
constexpr size_t O_VS = O_HS + (size_t)128 * 1024;
constexpr size_t O_END = O_VS + (size_t)128 * 1024;

constexpr int LDS_BYTES = 159744;

struct Params { const float* in[35]; float* out; unsigned char* ws; };
enum { I_XP = 0, I_XS, I_MEM, I_CK, I_CV, I_SCONV, I_SLRU, I_GU1, I_DN1, I_LN1G, I_LN1B, I_WIN, I_GATEB, I_GLNG, I_GLNB, I_WS, I_BS, I_CONVW, I_CONVB,
       I_LWA, I_LBA, I_LWX, I_LBX, I_LAM, I_MLNG, I_MLNB, I_WKV, I_WBR, I_WOUT, I_LN2G, I_LN2B, I_GU2, I_DN2, I_LN3G, I_LN3B };

__device__ __forceinline__ unsigned cvt_pk_bf16(float lo, float hi) { unsigned r; asm volatile("v_cvt_pk_bf16_f32 %0, %1, %2" : "=v"(r) : "v"(lo), "v"(hi)); return r; }
__device__ __forceinline__ float bf2f(unsigned short b) { return __uint_as_float(((unsigned)b) << 16); }
__device__ __forceinline__ float bflo(unsigned w) { return __uint_as_float(w << 16); }
__device__ __forceinline__ float bfhi(unsigned w) { return __uint_as_float(w & 0xffff0000u); }
__device__ __forceinline__ float sigmoidf_(float x) { return __builtin_amdgcn_rcpf(1.0f + __expf(-x)); }
__device__ __forceinline__ float siluf_(float x) { return x * sigmoidf_(x); }
__device__ __forceinline__ float gelu_tanh(float x) { return x * sigmoidf_(1.5957691216057308f * (x + 0.044715f * x * x * x)); }
__device__ __forceinline__ f32x2 ln_stats(f32x2 sm) { const float mu = sm[0] * (1.f / D); const float var = fmaxf(sm[1] * (1.f / D) - mu * mu, 0.f); return (f32x2){mu, 1.0f / sqrtf(var + LN_EPS)}; }
__device__ __forceinline__ float wave_sum(float v) {
#pragma unroll
    for (int o = 1; o < 64; o <<= 1) v += __shfl_xor(v, o);
    return v;
}
__device__ __forceinline__ float wave_max(float v) {
#pragma unroll
    for (int o = 1; o < 64; o <<= 1) v = fmaxf(v, __shfl_xor(v, o));
    return v;
}

namespace pg8 {
constexpr int BM = 256, BK = 64, HALF = 128, HTB = HALF * BK * 2, STAGE_BYTES = 8 * HTB, NXCD = 8, WGM = 8;
__host__ __device__ __forceinline__ int lds_byte(int r, int c) { const int st = (r >> 4) * 2 + (c >> 5), rr = r & 15, cc = c & 31, ob = rr * 64 + cc * 2; return st * 1024 + (ob ^ (((ob >> 9) & 1) << 5)); }
__host__ __device__ __forceinline__ void stage_rc(int b, int& R, int& C) { const int st = b / 1024, sb = b % 1024, swz = sb ^ (((sb >> 9) & 1) << 5); R = (st >> 1) * 16 + swz / 64; C = (st & 1) * 32 + (swz % 64) / 2; }
__host__ __device__ __forceinline__ int perm32(int rho) { const int n = rho >> 4, i = rho & 15; return 8 * (i >> 2) + 4 * n + (i & 3); }

struct Unit { const char* A; const char* B; int pm, pn, kind; };

__device__ __forceinline__ void tile_of(int wgid, int nM, int nN, int& pm, int& pn) {
    const int nwg = nM * nN;
    { const int q = nwg / NXCD, r = nwg % NXCD, xcd = wgid % NXCD, off = wgid / NXCD; wgid = (xcd < r ? xcd * (q + 1) : r * (q + 1) + (xcd - r) * q) + off; }
    const int nig = WGM * nN, gid = wgid / nig, fm = gid * WGM, gsz = (nM - fm) < WGM ? (nM - fm) : WGM;
    pm = fm + ((wgid % nig) % gsz); pn = (wgid % nig) / gsz;
}
struct PlainSched {
    const bf16_t* A; const bf16_t* Bt; int nM, nN, lda, ldb, G, c;
    __device__ __forceinline__ bool next(int i, Unit& u) const {
        const int L = i * G + c; if (L >= nM * nN) return false;
        tile_of(L, nM, nN, u.pm, u.pn); u.kind = 0;
        u.A = (const char*)(A + (size_t)u.pm * BM * lda); u.B = (const char*)(Bt + (size_t)u.pn * BM * ldb); return true;
    }
};
struct WinSched {
    const bf16_t* XB_; const bf16_t* WIN_; const bf16_t* MEMLN_; const bf16_t* WKV_; int G, c;
    __device__ __forceinline__ bool next(int i, Unit& u) const {
        const int L = i * G + c; constexpr int NZU = 33 * 44;
        if (L < NZU) { tile_of(L, 33, 44, u.pm, u.pn); u.kind = 0; u.A = (const char*)(XB_ + (size_t)u.pm * BM * D); u.B = (const char*)(WIN_ + (size_t)u.pn * BM * D); return true; }
        if (L < NZU + 32) { const int j = L - NZU; u.pm = j >> 3; u.pn = j & 7; u.kind = 1; u.A = (const char*)(MEMLN_ + (size_t)u.pm * BM * D); u.B = (const char*)(WKV_ + (size_t)u.pn * BM * D); return true; }
        if (L < NZU + 48) { const int j = L - NZU - 32; u.pm = j >> 2; u.pn = j & 3; u.kind = 2; u.A = (const char*)(WKV_ + (size_t)(1024 + u.pm * BM) * D); u.B = (const char*)(MEMLN_ + (size_t)u.pn * BM * D); return true; }
        return false;
    }
};
struct BranchSched {
    const bf16_t* YS_; const bf16_t* WBR_; int G, c;
    __device__ __forceinline__ bool next(int i, Unit& u) const {
        const int t = (i / 3) * G + c, k = i % 3; if (t >= 256) return false;
        tile_of(t, 32, 8, u.pm, u.pn); u.kind = k;
        u.A = (const char*)(YS_ + (size_t)u.pm * BM * (3 * BW) + k * BW); u.B = (const char*)(WBR_ + (size_t)k * D * BW + (size_t)u.pn * BM * BW); return true;
    }
};

template <class Sched, class Epi, bool ALIGN_EPI, bool SP2>
__device__ __forceinline__ void gemm_phase(LAS unsigned char* lds, const int K, const int lda, const int ldb, const Sched& S, const Epi& E) {
    int tid = threadIdx.x; asm volatile("" : "+v"(tid));
    const int wid = __builtin_amdgcn_readfirstlane(tid >> 6), lane = tid & 63, wr = wid >> 2, wc = wid & 3, fr = lane & 15, fq = lane >> 4;
    const int nt = K / BK;
    unsigned voffA[2], voffB[2];
#pragma unroll
    for (int i = 0; i < 2; ++i) { int R, C; stage_rc(tid * 16 + i * 8192, R, C); const int Rb = Epi::PERM ? ((R & ~31) + perm32(R & 31)) : R;
        voffA[i] = (unsigned)(R * lda + C) * 2u; voffB[i] = (unsigned)(Rb * ldb + C) * 2u; }
    const size_t kstep = (size_t)(BK * 2);
    const size_t hstepA = (size_t)HALF * lda * 2, hstepB = (size_t)HALF * ldb * 2;
    const unsigned ldsw = (unsigned)wid * 1024u;
    const int aoff = lds_byte(wr * 64 + fr, fq * 8), boff = lds_byte(wc * 32 + fr, fq * 8);
#define PG8_SA(b, h) (((b) * 2 + (h)) * HTB)
#define PG8_SB(b, h) ((4 + (b) * 2 + (h)) * HTB)
#define PG8_STAGE(bufoff, gbase, voff) do { _Pragma("unroll") for (int _i = 0; _i < 2; ++_i) \
        __builtin_amdgcn_global_load_lds((const unsigned*)((const char*)(gbase) + (voff)[_i]), (LAS unsigned*)(lds + (bufoff) + ldsw + _i * 8192), 16, 0, 0); } while (0)
#define PG8_LDA(dst, b, h) do { _Pragma("unroll") for (int m = 0; m < 4; ++m) _Pragma("unroll") for (int k = 0; k < 2; ++k) dst[m][k] = *(const LAS bf16x8*)(lds + PG8_SA(b, h) + aoff + m * 2048 + k * 1024); } while (0)
#define PG8_LDB(dst, b, h) do { _Pragma("unroll") for (int n = 0; n < 2; ++n) _Pragma("unroll") for (int k = 0; k < 2; ++k) dst[n][k] = *(const LAS bf16x8*)(lds + PG8_SB(b, h) + boff + n * 2048 + k * 1024); } while (0)
#define PG8_MMA(ai, bj, At, Bt) do { __builtin_amdgcn_s_setprio(1); _Pragma("unroll") for (int m = 0; m < 4; ++m) _Pragma("unroll") for (int n = 0; n < 2; ++n) _Pragma("unroll") for (int k = 0; k < 2; ++k) \
        acc[ai][bj][m][n] = __builtin_amdgcn_mfma_f32_16x16x32_bf16(Bt[n][k], At[m][k], acc[ai][bj][m][n], 0, 0, 0); __builtin_amdgcn_s_setprio(0); } while (0)
#define PG8_WAIT_V(n) asm volatile("s_waitcnt vmcnt(" #n ")" ::: "memory")
#define PG8_WAIT_L(n) asm volatile("s_waitcnt lgkmcnt(" #n ")" ::: "memory")
#define PG8_BAR __builtin_amdgcn_s_barrier()
#define PG8_SCHED __builtin_amdgcn_sched_barrier(0)
    Unit cur, nxt; int ui = 0;
    if (!S.next(0, cur)) return;
    f32x4 acc[2][2][4][2];
#pragma unroll
    for (int a = 0; a < 2; ++a)
#pragma unroll
        for (int b = 0; b < 2; ++b)
#pragma unroll
            for (int m = 0; m < 4; ++m)
#pragma unroll
                for (int n = 0; n < 2; ++n) acc[a][b][m][n] = (f32x4){0.f, 0.f, 0.f, 0.f};
    bf16x8 At[4][2], B0[2][2], B1[2][2];
    const char* cA = cur.A; const char* cB = cur.B;
    if constexpr (SP2) {
        PG8_STAGE(PG8_SB(0, 0), cB, voffB); PG8_STAGE(PG8_SB(0, 1), cB + hstepB, voffB); PG8_STAGE(PG8_SA(0, 0), cA, voffA); PG8_STAGE(PG8_SA(0, 1), cA + hstepA, voffA);
        if (wr == 1) PG8_BAR;
        PG8_WAIT_V(2); PG8_BAR;
        PG8_STAGE(PG8_SB(1, 0), cB + kstep, voffB); PG8_STAGE(PG8_SA(1, 0), cA + kstep, voffA); PG8_STAGE(PG8_SB(1, 1), cB + hstepB + kstep, voffB);
        PG8_WAIT_V(6); PG8_BAR;
    } else {
        PG8_STAGE(PG8_SB(0, 0), cB, voffB); PG8_STAGE(PG8_SA(0, 0), cA, voffA); PG8_STAGE(PG8_SB(0, 1), cB + hstepB, voffB); PG8_STAGE(PG8_SA(0, 1), cA + hstepA, voffA);
        if (wr == 1) PG8_BAR;
        PG8_WAIT_V(4); PG8_BAR;
        PG8_STAGE(PG8_SB(1, 0), cB + kstep, voffB); PG8_STAGE(PG8_SA(1, 0), cA + kstep, voffA); PG8_STAGE(PG8_SB(1, 1), cB + hstepB + kstep, voffB);
        PG8_WAIT_V(6); PG8_BAR;
    }
    for (;;) {
        const bool has_next = S.next(ui + 1, nxt);
        const char* nA = has_next ? nxt.A : cA; const char* nB = has_next ? nxt.B : cB;
        for (int t = 0; t < nt; t += 2) {
            const bool last = (t == nt - 2);
            const char* a1 = cA + (size_t)(t + 1) * kstep;
            const char* a2 = last ? nA : cA + (size_t)(t + 2) * kstep; const char* b2 = last ? nB : cB + (size_t)(t + 2) * kstep;
            const char* a3 = a2 + kstep; const char* b3 = b2 + kstep;
            if constexpr (SP2) {
            PG8_LDB(B0, 0, 0); PG8_LDB(B1, 0, 1); PG8_SCHED; PG8_LDA(At, 0, 0); PG8_STAGE(PG8_SA(1, 1), a1 + hstepA, voffA);
            PG8_WAIT_V(8); PG8_WAIT_L(0); PG8_BAR; PG8_MMA(0, 0, At, B0); PG8_MMA(0, 1, At, B1); PG8_BAR; PG8_SCHED;
            PG8_LDA(At, 0, 1); PG8_STAGE(PG8_SB(0, 0), b2, voffB); PG8_STAGE(PG8_SB(0, 1), b2 + hstepB, voffB); PG8_STAGE(PG8_SA(0, 0), a2, voffA);
            PG8_WAIT_V(8); PG8_WAIT_L(0); PG8_BAR; PG8_MMA(1, 0, At, B0); PG8_MMA(1, 1, At, B1); PG8_BAR; PG8_SCHED;
            PG8_LDB(B0, 1, 0); PG8_LDB(B1, 1, 1); PG8_SCHED; PG8_LDA(At, 1, 0); PG8_STAGE(PG8_SA(0, 1), a2 + hstepA, voffA);
            PG8_WAIT_V(8); PG8_WAIT_L(0); PG8_BAR; PG8_MMA(0, 0, At, B0); PG8_MMA(0, 1, At, B1); PG8_BAR; PG8_SCHED;
            PG8_LDA(At, 1, 1); PG8_STAGE(PG8_SB(1, 0), b3, voffB); PG8_STAGE(PG8_SB(1, 1), b3 + hstepB, voffB); PG8_STAGE(PG8_SA(1, 0), a3, voffA);
            PG8_WAIT_V(8); PG8_WAIT_L(0); PG8_BAR; PG8_MMA(1, 0, At, B0); PG8_MMA(1, 1, At, B1); PG8_BAR; PG8_SCHED;
            } else {
            PG8_LDB(B0, 0, 0); PG8_SCHED; PG8_LDA(At, 0, 0); PG8_STAGE(PG8_SA(1, 1), a1 + hstepA, voffA);
            PG8_WAIT_L(8); PG8_BAR; PG8_WAIT_L(0); PG8_MMA(0, 0, At, B0); PG8_BAR; PG8_SCHED;
            PG8_LDB(B1, 0, 1); PG8_STAGE(PG8_SB(0, 0), b2, voffB);
            PG8_BAR; PG8_WAIT_L(0); PG8_MMA(0, 1, At, B1); PG8_BAR;
            PG8_LDA(At, 0, 1); PG8_STAGE(PG8_SA(0, 0), a2, voffA);
            PG8_BAR; PG8_WAIT_L(0); PG8_MMA(1, 0, At, B0); PG8_BAR; PG8_SCHED;
            PG8_STAGE(PG8_SB(0, 1), b2 + hstepB, voffB);
            PG8_WAIT_V(6); PG8_BAR; PG8_MMA(1, 1, At, B1); PG8_BAR;
            PG8_LDB(B0, 1, 0); PG8_SCHED; PG8_LDA(At, 1, 0); PG8_STAGE(PG8_SA(0, 1), a2 + hstepA, voffA);
            PG8_WAIT_L(8); PG8_BAR; PG8_WAIT_L(0); PG8_MMA(0, 0, At, B0); PG8_BAR; PG8_SCHED;
            PG8_LDB(B1, 1, 1); PG8_STAGE(PG8_SB(1, 0), b3, voffB);
            PG8_BAR; PG8_WAIT_L(0); PG8_MMA(0, 1, At, B1); PG8_BAR;
            PG8_LDA(At, 1, 1); PG8_STAGE(PG8_SA(1, 0), a3, voffA);
            PG8_BAR; PG8_WAIT_L(0); PG8_MMA(1, 0, At, B0); PG8_BAR; PG8_SCHED;
            PG8_STAGE(PG8_SB(1, 1), b3 + hstepB, voffB);
            PG8_WAIT_V(6); PG8_BAR; PG8_MMA(1, 1, At, B1); PG8_BAR;
            }
        }
        if constexpr (ALIGN_EPI) { if (wr == 0) PG8_BAR; }
        E(acc, cur, wr, wc, fr, fq);
        if (!has_next) break;
        bool keep = false;
        if constexpr (Epi::CAN_KEEP) keep = (cur.kind < 2);
        if (!keep) {
#pragma unroll
        for (int a = 0; a < 2; ++a)
#pragma unroll
            for (int b = 0; b < 2; ++b)
#pragma unroll
                for (int m = 0; m < 4; ++m)
#pragma unroll
                    for (int n = 0; n < 2; ++n) acc[a][b][m][n] = (f32x4){0.f, 0.f, 0.f, 0.f};
        }
        cur = nxt; cA = nA; cB = nB; ++ui;
        if constexpr (ALIGN_EPI) { if (wr == 1) PG8_BAR; }
    }
    PG8_WAIT_V(0);
    if constexpr (!ALIGN_EPI) { if (wr == 0) PG8_BAR; }
    PG8_BAR;
#undef PG8_SA
#undef PG8_SB
#undef PG8_STAGE
#undef PG8_LDA
#undef PG8_LDB
#undef PG8_MMA
#undef PG8_WAIT_V
#undef PG8_WAIT_L
#undef PG8_BAR
#undef PG8_SCHED
}


struct EpiSwiglu {
    static constexpr bool PERM = true, CAN_KEEP = false;
    bf16_t* H; int ldh;
    const float* rsum; const float* cs;
    __device__ __forceinline__ void operator()(const f32x4 (&acc)[2][2][4][2], const Unit& u, int wr, int wc, int fr, int fq) const {
        const int row0 = u.pm * BM + wr * 64 + fr, col0 = u.pn * HALF + wc * 32 + 8 * fq;
        f32x4 s1[2][2], s2[2][2];
#pragma unroll
        for (int bj = 0; bj < 2; ++bj)
#pragma unroll
            for (int n = 0; n < 2; ++n) { s1[bj][n] = (f32x4){0.f, 0.f, 0.f, 0.f}; s2[bj][n] = s1[bj][n];
                if (rsum) { const int ci = u.pn * BM + bj * HALF + wc * 32 + 8 * fq + 4 * n; s1[bj][n] = *(const f32x4*)(cs + ci); s2[bj][n] = *(const f32x4*)(cs + NZ + ci); } }
#pragma unroll
        for (int ai = 0; ai < 2; ++ai)
#pragma unroll
            for (int m = 0; m < 4; ++m) {
                const int r = row0 + ai * HALF + m * 16;
                bf16_t* rowp = H + (size_t)r * ldh + col0;
                f32x2 st = (f32x2){0.f, 1.f};
                if (rsum) st = ln_stats(*(const f32x2*)(rsum + 2 * (size_t)r));
                f32x4 v0, v1;
#pragma unroll
                for (int j = 0; j < 4; ++j) {
                    const float g0 = st[1] * (acc[ai][0][m][0][j] - st[0] * s1[0][0][j]) + s2[0][0][j], u0 = st[1] * (acc[ai][1][m][0][j] - st[0] * s1[1][0][j]) + s2[1][0][j];
                    const float g1 = st[1] * (acc[ai][0][m][1][j] - st[0] * s1[0][1][j]) + s2[0][1][j], u1 = st[1] * (acc[ai][1][m][1][j] - st[0] * s1[1][1][j]) + s2[1][1][j];
                    v0[j] = siluf_(g0) * u0; v1[j] = siluf_(g1) * u1;
                }
                u32x4 w; w.x = cvt_pk_bf16(v0[0], v0[1]); w.y = cvt_pk_bf16(v0[2], v0[3]); w.z = cvt_pk_bf16(v1[0], v1[1]); w.w = cvt_pk_bf16(v1[2], v1[3]);
                *(u32x4*)rowp = w;
            }
    }
};
struct EpiResid {
    static constexpr bool PERM = false, CAN_KEEP = false;
    float* Y; const float* res; const float* rin; const float* lg; const float* lb; float alpha, scale; bf16_t* yb; float* rout; bool stream;
    __device__ __forceinline__ void operator()(const f32x4 (&acc)[2][2][4][2], const Unit& u, int wr, int wc, int fr, int fq) const {
        const int row0 = u.pm * BM + wr * 64 + fr, col0 = u.pn * BM + wc * 32 + 4 * fq;
        f32x4 gg[2][2], bb[2][2];
#pragma unroll
        for (int bj = 0; bj < 2; ++bj)
#pragma unroll
            for (int n = 0; n < 2; ++n) { gg[bj][n] = (f32x4){1.f, 1.f, 1.f, 1.f}; bb[bj][n] = (f32x4){0.f, 0.f, 0.f, 0.f};
                if (rin) { gg[bj][n] = *(const f32x4*)(lg + col0 + bj * HALF + n * 16); bb[bj][n] = *(const f32x4*)(lb + col0 + bj * HALF + n * 16); } }
#pragma unroll
        for (int ai = 0; ai < 2; ++ai)
#pragma unroll
            for (int m2 = 0; m2 < 2; ++m2) {
                f32x4 xv[2][2][2]; f32x2 st[2];
#pragma unroll
                for (int mm = 0; mm < 2; ++mm) {
                    const int r = row0 + ai * HALF + (2 * m2 + mm) * 16;
                    st[mm] = (f32x2){0.f, 1.f};
                    if (rin) st[mm] = ln_stats(*(const f32x2*)(rin + 2 * (size_t)r));
#pragma unroll
                    for (int bj = 0; bj < 2; ++bj)
#pragma unroll
                        for (int n = 0; n < 2; ++n) { const f32x4* rp = (const f32x4*)(res + (size_t)r * D + col0 + bj * HALF + n * 16); xv[mm][bj][n] = stream ? __builtin_nontemporal_load(rp) : *rp; }
                }
#pragma unroll
                for (int mm = 0; mm < 2; ++mm) {
                    const int r = row0 + ai * HALF + (2 * m2 + mm) * 16;
                    float ps = 0.f, pq = 0.f;
#pragma unroll
                    for (int bj = 0; bj < 2; ++bj)
#pragma unroll
                        for (int n = 0; n < 2; ++n) {
                            const f32x4 x = (xv[mm][bj][n] - st[mm][0]) * (gg[bj][n] * st[mm][1]) + bb[bj][n];
                            const f32x4 o = x * alpha + acc[ai][bj][2 * m2 + mm][n] * scale;
                            const size_t off = (size_t)r * D + col0 + bj * HALF + n * 16;
                            *(f32x4*)(Y + off) = o;
                            if (yb) { u32x2 w; w.x = cvt_pk_bf16(o[0], o[1]); w.y = cvt_pk_bf16(o[2], o[3]); *(u32x2*)(yb + off) = w; }
                            ps += (o[0] + o[1]) + (o[2] + o[3]); pq += (o[0] * o[0] + o[1] * o[1]) + (o[2] * o[2] + o[3] * o[3]);
                        }
                    if (rout) {
                        ps += __shfl_xor(ps, 16); pq += __shfl_xor(pq, 16); ps += __shfl_xor(ps, 32); pq += __shfl_xor(pq, 32);
                        if (fq == 0) { atomicAdd(rout + 2 * (size_t)r, ps); atomicAdd(rout + 2 * (size_t)r + 1, pq); }
                    }
                }
            }
    }
};
struct EpiWin {
    static constexpr bool PERM = true, CAN_KEEP = false;
    bf16_t* Z; const LAS float* gate_b; float* outK; float* outV; bf16_t* KB; bf16_t* VT; const float* rsum; const float* cs;
    __device__ __forceinline__ void operator()(const f32x4 (&acc)[2][2][4][2], const Unit& u, int wr, int wc, int fr, int fq) const {
        const int row0 = u.pm * BM + wr * 64 + fr, col0 = u.pn * BM + wc * 32 + 8 * fq;
        if (u.kind == 0) {
            const int mode = (u.pn < 8) ? 1 : (u.pn < 12) ? 0 : (u.pn < 16) ? 1 : (u.pn < 20) ? 0 : 2;
            f32x4 gb[2][2];
#pragma unroll
            for (int bj = 0; bj < 2; ++bj)
#pragma unroll
                for (int n = 0; n < 2; ++n) gb[bj][n] = (mode == 2) ? *(const LAS f32x4*)(gate_b + (col0 - 5120) + bj * HALF + 4 * n) : (f32x4){0.f, 0.f, 0.f, 0.f};
            f32x4 s1[2][2], s2[2][2];
#pragma unroll
            for (int bj = 0; bj < 2; ++bj)
#pragma unroll
                for (int n = 0; n < 2; ++n) { s1[bj][n] = *(const f32x4*)(cs + col0 + bj * HALF + 4 * n); s2[bj][n] = *(const f32x4*)(cs + NZ + col0 + bj * HALF + 4 * n); }
#pragma unroll
            for (int ai = 0; ai < 2; ++ai)
#pragma unroll
                for (int m = 0; m < 4; ++m) {
                    const int r = row0 + ai * HALF + m * 16;
                    bf16_t* rowp = Z + (size_t)r * NZ + col0;
                    const f32x2 st = ln_stats(*(const f32x2*)(rsum + 2 * (size_t)r));
#pragma unroll
                    for (int bj = 0; bj < 2; ++bj) {
                        f32x4 v0 = (acc[ai][bj][m][0] - s1[bj][0] * st[0]) * st[1] + s2[bj][0], v1 = (acc[ai][bj][m][1] - s1[bj][1] * st[0]) * st[1] + s2[bj][1];
                        if (mode == 1) {
#pragma unroll
                            for (int j = 0; j < 4; ++j) { v0[j] = gelu_tanh(v0[j]); v1[j] = gelu_tanh(v1[j]); }
                        } else if (mode == 2) {
#pragma unroll
                            for (int j = 0; j < 4; ++j) { v0[j] = sigmoidf_(v0[j] + gb[bj][0][j]); v1[j] = sigmoidf_(v1[j] + gb[bj][1][j]); }
                        }
                        u32x4 w; w.x = cvt_pk_bf16(v0[0], v0[1]); w.y = cvt_pk_bf16(v0[2], v0[3]); w.z = cvt_pk_bf16(v1[0], v1[1]); w.w = cvt_pk_bf16(v1[2], v1[3]);
                        *(u32x4*)(rowp + bj * HALF) = w;
                    }
                }
        } else if (u.kind == 1) {
            const bool isk = u.pn < 4; const int c0 = col0 - (isk ? 0 : 1024);
            float* ob = isk ? outK : outV;
#pragma unroll
            for (int ai = 0; ai < 2; ++ai)
#pragma unroll
                for (int m = 0; m < 4; ++m) {
                    const size_t off = (size_t)(row0 + ai * HALF + m * 16) * 1024 + c0;
#pragma unroll
                    for (int bj = 0; bj < 2; ++bj) {
                        const f32x4 v0 = acc[ai][bj][m][0], v1 = acc[ai][bj][m][1];
                        __builtin_nontemporal_store(v0, (f32x4*)(ob + off + bj * HALF)); __builtin_nontemporal_store(v1, (f32x4*)(ob + off + bj * HALF + 4));
                        if (isk) { u32x4 w; w.x = cvt_pk_bf16(v0[0], v0[1]); w.y = cvt_pk_bf16(v0[2], v0[3]); w.z = cvt_pk_bf16(v1[0], v1[1]); w.w = cvt_pk_bf16(v1[2], v1[3]); *(u32x4*)(KB + off + bj * HALF) = w; }
                    }
                }
        } else {
#pragma unroll
            for (int ai = 0; ai < 2; ++ai)
#pragma unroll
                for (int m = 0; m < 4; ++m) {
                    bf16_t* rowp = VT + (size_t)(row0 + ai * HALF + m * 16) * 1024 + col0;
#pragma unroll
                    for (int bj = 0; bj < 2; ++bj) {
                        const f32x4 v0 = acc[ai][bj][m][0], v1 = acc[ai][bj][m][1];
                        u32x4 w; w.x = cvt_pk_bf16(v0[0], v0[1]); w.y = cvt_pk_bf16(v0[2], v0[3]); w.z = cvt_pk_bf16(v1[0], v1[1]); w.w = cvt_pk_bf16(v1[2], v1[3]);
                        *(u32x4*)(rowp + bj * HALF) = w;
                    }
                }
        }
    }
};
struct EpiMerge {
    static constexpr bool PERM = true, CAN_KEEP = true;
    const bf16_t* Z; bf16_t* MB;
    __device__ __forceinline__ void operator()(f32x4 (&acc)[2][2][4][2], const Unit& u, int wr, int wc, int fr, int fq) const {
        const int row0 = u.pm * BM + wr * 64 + fr, col0 = u.pn * BM + wc * 32 + 8 * fq;
        const bool last = (u.kind == 2);
        const int koff = 5120 + u.kind * 2048, noff = last ? 0 : 2048;
#pragma unroll
        for (int ai = 0; ai < 2; ++ai)
#pragma unroll
            for (int m2 = 0; m2 < 2; ++m2) {
                u32x4 ga[2][2], gb[2][2];
#pragma unroll
                for (int mm = 0; mm < 2; ++mm)
#pragma unroll
                    for (int bj = 0; bj < 2; ++bj) {
                        const bf16_t* zp = Z + (size_t)(row0 + ai * HALF + (2 * m2 + mm) * 16) * NZ + koff + col0 + bj * HALF;
                        ga[mm][bj] = *(const u32x4*)zp;
                        gb[mm][bj] = *(const u32x4*)(zp + noff);
                    }
#pragma unroll
                for (int mm = 0; mm < 2; ++mm)
#pragma unroll
                    for (int bj = 0; bj < 2; ++bj) {
                        const int m = 2 * m2 + mm;
                        const u32x4 a4 = ga[mm][bj], b4 = gb[mm][bj];
                        f32x4 g0 = (f32x4){bflo(a4.x), bfhi(a4.x), bflo(a4.y), bfhi(a4.y)}, g1 = (f32x4){bflo(a4.z), bfhi(a4.z), bflo(a4.w), bfhi(a4.w)};
                        const f32x4 h0 = (f32x4){bflo(b4.x), bfhi(b4.x), bflo(b4.y), bfhi(b4.y)}, h1 = (f32x4){bflo(b4.z), bfhi(b4.z), bflo(b4.w), bfhi(b4.w)};
#pragma unroll
                        for (int j = 0; j < 4; ++j) {
                            g0[j] = fmaxf(g0[j], 1e-6f) * (last ? 1.0f : __builtin_amdgcn_rcpf(fmaxf(h0[j], 1e-6f)));
                            g1[j] = fmaxf(g1[j], 1e-6f) * (last ? 1.0f : __builtin_amdgcn_rcpf(fmaxf(h1[j], 1e-6f)));
                        }
                        acc[ai][bj][m][0] *= g0; acc[ai][bj][m][1] *= g1;
                        if (last) {
                            const f32x4 v0 = acc[ai][bj][m][0], v1 = acc[ai][bj][m][1];
                            u32x4 w; w.x = cvt_pk_bf16(v0[0], v0[1]); w.y = cvt_pk_bf16(v0[2], v0[3]); w.z = cvt_pk_bf16(v1[0], v1[1]); w.w = cvt_pk_bf16(v1[2], v1[3]);
                            *(u32x4*)(MB + (size_t)(row0 + ai * HALF + m * 16) * D + col0 + bj * HALF) = w;
                        }
                    }
            }
    }
};
}

#ifndef PHMASK
#define PHMASK 0xFFFFFFFFu
#endif
#ifndef GREP
#define GREP 1
#endif
#ifndef NREP
#define NREP 1
#endif
#define PHON(n) (((PHMASK) >> (n)) & 1u)
#define LDS_WAIT() asm volatile("s_waitcnt lgkmcnt(0)" ::: "memory")

__device__ __forceinline__ void transpose_item(const float* W, int N, bf16_t* WT, int ldk, int k0, int n0, int dst_row0, LAS float* scr, int lane, const float* fg, const float* fb, float* cs) {
    f32x4 v[8];
    const int n4 = (lane & 7) * 4, kr = lane >> 3;
#pragma unroll
    for (int i = 0; i < 8; ++i) v[i] = __builtin_nontemporal_load((const f32x4*)(W + (size_t)(k0 + kr + 8 * i) * N + n0 + n4));
#pragma unroll
    for (int i = 0; i < 8; ++i) { LAS float* d = scr + (kr + 8 * i) * 33 + n4; d[0] = v[i][0]; d[1] = v[i][1]; d[2] = v[i][2]; d[3] = v[i][3]; }
    LDS_WAIT(); asm volatile("" ::: "memory");
    const int c = lane & 7;
    f32x4 g0 = (f32x4){1.f, 1.f, 1.f, 1.f}, g1 = g0, b0 = (f32x4){0.f, 0.f, 0.f, 0.f}, b1 = b0;
    if (fg) { g0 = *(const f32x4*)(fg + k0 + 8 * c); g1 = *(const f32x4*)(fg + k0 + 8 * c + 4); b0 = *(const f32x4*)(fb + k0 + 8 * c); b1 = *(const f32x4*)(fb + k0 + 8 * c + 4); }
#pragma unroll
    for (int j = 0; j < 4; ++j) { const int n = (lane >> 3) + 8 * j; const LAS float* s = scr + (8 * c) * 33 + n;
        const f32x4 w0 = (f32x4){s[0 * 33], s[1 * 33], s[2 * 33], s[3 * 33]}, w1 = (f32x4){s[4 * 33], s[5 * 33], s[6 * 33], s[7 * 33]};
        const f32x4 f0 = w0 * g0, f1 = w1 * g1;
        u32x4 o; o.x = cvt_pk_bf16(f0[0], f0[1]); o.y = cvt_pk_bf16(f0[2], f0[3]); o.z = cvt_pk_bf16(f1[0], f1[1]); o.w = cvt_pk_bf16(f1[2], f1[3]);
        *(u32x4*)(WT + (size_t)(dst_row0 + n) * ldk + k0 + 8 * c) = o;
        if (fg) {
            float p1 = ((bflo(o.x) + bfhi(o.x)) + (bflo(o.y) + bfhi(o.y))) + ((bflo(o.z) + bfhi(o.z)) + (bflo(o.w) + bfhi(o.w)));
            const f32x4 t0 = w0 * b0, t1 = w1 * b1;
            float p2 = ((t0[0] + t0[1]) + (t0[2] + t0[3])) + ((t1[0] + t1[1]) + (t1[2] + t1[3]));
            p1 += __shfl_xor(p1, 1); p2 += __shfl_xor(p2, 1); p1 += __shfl_xor(p1, 2); p2 += __shfl_xor(p2, 2); p1 += __shfl_xor(p1, 4); p2 += __shfl_xor(p2, 4);
            if (c == 0) { atomicAdd(cs + dst_row0 + n, p1); atomicAdd(cs + NZ + dst_row0 + n, p2); }
        } }
    LDS_WAIT(); asm volatile("" ::: "memory");
}
__device__ __forceinline__ void ln_row(const float* yrow, const float* g, const float* b, float* of, bf16_t* ob, int lane) {
    f32x4 v[8]; float s = 0.f;
#pragma unroll
    for (int j = 0; j < 8; ++j) { v[j] = *(const f32x4*)(yrow + 4 * lane + 256 * j); s += (v[j][0] + v[j][1]) + (v[j][2] + v[j][3]); }
    const float mean = wave_sum(s) * (1.f / D); float s2 = 0.f;
#pragma unroll
    for (int j = 0; j < 8; ++j) { v[j] = v[j] - mean; s2 += (v[j][0] * v[j][0] + v[j][1] * v[j][1]) + (v[j][2] * v[j][2] + v[j][3] * v[j][3]); }
    const float rstd = 1.0f / sqrtf(wave_sum(s2) * (1.f / D) + LN_EPS);
#pragma unroll
    for (int j = 0; j < 8; ++j) {
        const f32x4 gg = *(const f32x4*)(g + 4 * lane + 256 * j), bb = *(const f32x4*)(b + 4 * lane + 256 * j);
        const f32x4 o = v[j] * rstd * gg + bb;
        if (of) __builtin_nontemporal_store(o, (f32x4*)(of + 4 * lane + 256 * j));
        if (ob) { u32x2 w; w.x = cvt_pk_bf16(o[0], o[1]); w.y = cvt_pk_bf16(o[2], o[3]); *(u32x2*)(ob + 4 * lane + 256 * j) = w; }
    }
}

#define XB_TMO      128
#define XB_XCNT(j)  (256  + 64 * (j))
#define XB_XSUB(j)  (1280 + 64 * (j))
#define XB_XGEN(j)  (2304 + 64 * (j))
#define XB_TOP      3328
#define XB_TOPGEN   3392
#define XCD_BAR_WORDS 3456
#define XB_SPIN_CAP (1u << 22)
__device__ __forceinline__ unsigned xb_ld(unsigned* p)              { return __hip_atomic_load(p, __ATOMIC_RELAXED, __HIP_MEMORY_SCOPE_AGENT); }
__device__ __forceinline__ unsigned xb_add(unsigned* p, unsigned v) { return __hip_atomic_fetch_add(p, v, __ATOMIC_RELAXED, __HIP_MEMORY_SCOPE_AGENT); }
__device__ __forceinline__ unsigned xb_xcc_id() { return (unsigned)__builtin_amdgcn_s_getreg((3 << 11) | 20) & 0xFu; }
#define XB_SPIN(cond, bar) do { unsigned _sp = 0; while (cond) { __builtin_amdgcn_s_sleep(1); \
    if ((++_sp & 255u) == 0u) { if (xb_ld(&(bar)[XB_TMO])) break; if (_sp > XB_SPIN_CAP) { atomicAdd(&(bar)[XB_TMO], 1u); break; } } } } while (0)
struct XcdBarrier { unsigned* bar; unsigned x; volatile LAS unsigned* st; };
__device__ __forceinline__ XcdBarrier xcd_barrier_post(unsigned* bar, volatile LAS unsigned* st) {
    XcdBarrier b; b.bar = bar; b.x = xb_xcc_id(); b.st = st;
    if (threadIdx.x == 0) (void)xb_add(&bar[XB_XCNT(b.x)], 1u);
    return b;
}
__device__ __forceinline__ void xcd_barrier_complete(unsigned* bar, unsigned x, unsigned& nloc, unsigned& nx) {
    const unsigned G = gridDim.x * gridDim.y * gridDim.z;
    unsigned sum, cnt, mine, sp = 0u;
    for (;;) {
        sum = 0u; cnt = 0u; mine = 0u;
#pragma unroll
        for (unsigned j = 0; j < 16; ++j) { const unsigned c = xb_ld(&bar[XB_XCNT(j)]); sum += c; cnt += (c > 0u) ? 1u : 0u; mine = (j == x) ? c : mine; }
        if (sum == G) break;
        __builtin_amdgcn_s_sleep(1);
        if ((++sp & 255u) == 0u) { if (xb_ld(&bar[XB_TMO])) break; if (sp > XB_SPIN_CAP) { atomicAdd(&bar[XB_TMO], 1u); break; } }
    }
    nloc = mine > 0u ? mine : 1u; nx = cnt > 0u ? cnt : 1u;
}
__device__ __forceinline__ void xcd_barrier(const XcdBarrier& b) {
    asm volatile("s_waitcnt vmcnt(0)" ::: "memory");
    __syncthreads();
    if (threadIdx.x == 0) {
        unsigned* bar = b.bar;
        __builtin_amdgcn_s_waitcnt(0);
        unsigned nloc = b.st[0], nx = b.st[1];
        if (nloc == 0u) { xcd_barrier_complete(bar, b.x, nloc, nx); b.st[0] = nloc; b.st[1] = nx; }
        const unsigned old = xb_add(&bar[XB_XSUB(b.x)], 1u);
        const unsigned gen = old / nloc;
        if (old + 1u == (gen + 1u) * nloc) {
            __builtin_amdgcn_fence(__ATOMIC_RELEASE, "agent");
            asm volatile("s_waitcnt vmcnt(0)" ::: "memory");
            const unsigned og = xb_add(&bar[XB_TOP], 1u);
            const unsigned tg = og / nx;
            if (og + 1u == (tg + 1u) * nx) xb_add(&bar[XB_TOPGEN], 1u);
            else XB_SPIN(xb_ld(&bar[XB_TOPGEN]) == tg, bar);
            __builtin_amdgcn_fence(__ATOMIC_ACQUIRE, "agent");
            xb_add(&bar[XB_XGEN(b.x)], 1u);
            asm volatile("s_waitcnt vmcnt(0)" ::: "memory");
        } else {
            XB_SPIN(xb_ld(&bar[XB_XGEN(b.x)]) == gen, bar);
            __builtin_amdgcn_fence(__ATOMIC_ACQUIRE, "agent");
            asm volatile("s_waitcnt vmcnt(0)" ::: "memory");
        }
    }
    __syncthreads();
}

template <int MODE>
__device__ __forceinline__ void skinny(LAS unsigned char* lds, int bid, int G, int wave, int lane, const bf16_t* A, int lda, const bf16_t* Bt, int ldb, int K,
                                       float* Ys, const float* res, float alpha, float scale, const bf16_t* Zs, bf16_t* MBs,
                                       const float* rin, const float* lg, const float* lb, bf16_t* ybs, float* rout) {
    const int fr = lane & 15, fq = lane >> 4, tw = wave & 3, kh = wave >> 2;
    LAS f32x4* red = (LAS f32x4*)lds;
    for (int T0 = bid * 4; T0 < 1024; T0 += G * 4) {
        const int T = T0 + tw, rt = T >> 7, ct = T & 127;
        f32x4 tot = (f32x4){0.f, 0.f, 0.f, 0.f};
        if (MODE == 0) {
            const int kb = kh * (K / 2);
            const bf16_t* ap = A + (size_t)(rt * 16 + fr) * lda + kb + fq * 8;
            const bf16_t* bp = Bt + (size_t)(ct * 16 + fr) * ldb + kb + fq * 8;
#pragma unroll 16
            for (int ks = 0; ks < K / 64; ++ks) {
                const bf16x8 af = *(const bf16x8*)(ap + ks * 32), bfv = *(const bf16x8*)(bp + ks * 32);
                tot = __builtin_amdgcn_mfma_f32_16x16x32_bf16(bfv, af, tot, 0, 0, 0);
            }
        } else {
#pragma unroll
            for (int k = 0; k < 3; ++k) {
                const int kb = kh * (BW / 2);
                const bf16_t* ap = A + (size_t)(rt * 16 + fr) * lda + k * BW + kb + fq * 8;
                const bf16_t* bp = Bt + (size_t)k * D * BW + (size_t)(ct * 16 + fr) * ldb + kb + fq * 8;
                f32x4 acc = (f32x4){0.f, 0.f, 0.f, 0.f};
#pragma unroll 8
                for (int ks = 0; ks < BW / 64; ++ks) {
                    const bf16x8 af = *(const bf16x8*)(ap + ks * 32), bfv = *(const bf16x8*)(bp + ks * 32);
                    acc = __builtin_amdgcn_mfma_f32_16x16x32_bf16(bfv, af, acc, 0, 0, 0);
                }
                const u32x2 gw = *(const u32x2*)(Zs + (size_t)(rt * 16 + fr) * NZ + 5120 + k * 2048 + ct * 16 + 4 * fq);
                tot += acc * (f32x4){bflo(gw.x), bfhi(gw.x), bflo(gw.y), bfhi(gw.y)};
            }
        }
        if (kh == 1) red[tw * 64 + lane] = tot;
        __syncthreads();
        if (kh == 0) {
            tot += red[tw * 64 + lane];
            const size_t off = (size_t)(rt * 16 + fr) * D + ct * 16 + 4 * fq;
            if (MODE == 0) {
                f32x4 xv = *(const f32x4*)(res + off);
                if (rin) { const f32x2 st = ln_stats(*(const f32x2*)(rin + 2 * (rt * 16 + fr))); const int cc = ct * 16 + 4 * fq;
                    xv = (xv - st[0]) * (*(const f32x4*)(lg + cc) * st[1]) + *(const f32x4*)(lb + cc); }
                const f32x4 o = xv * alpha + tot * scale;
                *(f32x4*)(Ys + off) = o;
                if (ybs) { u32x2 w; w.x = cvt_pk_bf16(o[0], o[1]); w.y = cvt_pk_bf16(o[2], o[3]); *(u32x2*)(ybs + off) = w; }
                if (rout) { float ps = (o[0] + o[1]) + (o[2] + o[3]), pq = (o[0] * o[0] + o[1] * o[1]) + (o[2] * o[2] + o[3] * o[3]);
                    ps += __shfl_xor(ps, 16); pq += __shfl_xor(pq, 16); ps += __shfl_xor(ps, 32); pq += __shfl_xor(pq, 32);
                    if (fq == 0) { atomicAdd(rout + 2 * (rt * 16 + fr), ps); atomicAdd(rout + 2 * (rt * 16 + fr) + 1, pq); } }
            }
            else { u32x2 w; w.x = cvt_pk_bf16(tot[0], tot[1]); w.y = cvt_pk_bf16(tot[2], tot[3]); *(u32x2*)(MBs + off) = w; }
        }
        __syncthreads();
    }
}

#define WGU1 ((bf16_t*)(P.ws + WS_WGU1))
#define WD1 ((bf16_t*)(P.ws + WS_WD1))
#define WIN ((bf16_t*)(P.ws + WS_WIN))
#define WKV ((bf16_t*)(P.ws + WS_WKV))
#define WBR ((bf16_t*)(P.ws + WS_WBR))
#define WOUT ((bf16_t*)(P.ws + WS_WOUT))
#define WGU2 ((bf16_t*)(P.ws + WS_WGU2))
#define WD2 ((bf16_t*)(P.ws + WS_WD2))
#define WLRU ((bf16_t*)(P.ws + WS_WLRU))
#define WSP ((bf16_t*)(P.ws + WS_WSP))
#define XB ((bf16_t*)(P.ws + WS_XB))
#define Z ((bf16_t*)(P.ws + WS_ZH))
#define H ((bf16_t*)(P.ws + WS_ZH))
#define Y ((float*)(P.ws + WS_Y))
#define X1 ((float*)(P.ws + WS_X1))
#define CSUM ((float*)(P.ws + WS_CS))
#define U1 ((bf16_t*)(P.ws + WS_HL))
#define U2 ((bf16_t*)(P.ws + WS_AC))
#define GSB ((float*)(P.ws + WS_GSB))
#define YB2 ((bf16_t*)(P.ws + WS_X1))
#define RSUM ((float*)(P.ws + WS_RS))
#define VP ((bf16_t*)(P.ws + WS_VP))
#define HL ((float*)(P.ws + WS_HL))
#define AC ((float*)(P.ws + WS_AC))
#define SUM ((float*)(P.ws + WS_SUM))
#define YS ((bf16_t*)(P.ws + WS_YS))
#define MEMLN ((bf16_t*)(P.ws + WS_MEMLN))
#define KB ((bf16_t*)(P.ws + WS_KB))
#define VT ((bf16_t*)(P.ws + WS_VT))
__device__ __forceinline__ void p5d_sample_attn(const Params& P, LAS unsigned char* lds, int bid, int G, int tid_in) {
    int tid = tid_in; asm volatile("" : "+v"(tid));
    const int lane = tid & 63, wave = __builtin_amdgcn_readfirstlane(tid >> 6);

        LAS float* sS = (LAS float*)(lds + 131072);
        LAS float* sO = (LAS float*)(lds + 131072 + 1024);
        const int vb = (G % 8 == 0) ? (bid & 7) * (G >> 3) + (bid >> 3) : bid;
        for (int it = vb; it < 512; it += G) {
            const int b = it >> 2, h = it & 3;
            const u32x2 qw = *(const u32x2*)(Z + (size_t)(MP + b) * NZ + 4096 + h * HD + 4 * lane);
            const f32x4 q = (f32x4){bflo(qw.x), bfhi(qw.x), bflo(qw.y), bfhi(qw.y)};
            const float* kbase = P.in[I_CK] + ((size_t)(b * NMEM + 32 * wave) * NH + h) * HD + 4 * lane;
            const float* vbase = P.in[I_CV] + ((size_t)(b * NMEM + 32 * wave) * NH + h) * HD + 4 * lane;
            float d[32];
#pragma unroll
            for (int mi = 0; mi < 32; ++mi) {
                const f32x4 kv = __builtin_nontemporal_load((const f32x4*)(kbase + (size_t)mi * (NH * HD)));
                d[mi] = (kv[0] * q[0] + kv[1] * q[1]) + (kv[2] * q[2] + kv[3] * q[3]);
                if (mi == 15) asm volatile("" ::: "memory");
            }
#pragma unroll
            for (int i = 0; i < 16; ++i) { const bool hi = (lane & 32) != 0; const float snd = hi ? d[i] : d[i + 16], kp = hi ? d[i + 16] : d[i]; d[i] = kp + __shfl_xor(snd, 32); }
#pragma unroll
            for (int i = 0; i < 8; ++i) { const bool hi = (lane & 16) != 0; const float snd = hi ? d[i] : d[i + 8], kp = hi ? d[i + 8] : d[i]; d[i] = kp + __shfl_xor(snd, 16); }
#pragma unroll
            for (int i = 0; i < 4; ++i) { const bool hi = (lane & 8) != 0; const float snd = hi ? d[i] : d[i + 4], kp = hi ? d[i + 4] : d[i]; d[i] = kp + __shfl_xor(snd, 8); }
#pragma unroll
            for (int i = 0; i < 2; ++i) { const bool hi = (lane & 4) != 0; const float snd = hi ? d[i] : d[i + 2], kp = hi ? d[i + 2] : d[i]; d[i] = kp + __shfl_xor(snd, 4); }
            { const bool hi = (lane & 2) != 0; const float snd = hi ? d[0] : d[1], kp = hi ? d[1] : d[0]; d[0] = kp + __shfl_xor(snd, 2); }
            d[0] += __shfl_xor(d[0], 1);
            if ((lane & 1) == 0) sS[32 * wave + (lane >> 1)] = d[0] * 0.0625f;
            f32x4 vv[16];
#pragma unroll
            for (int mi = 0; mi < 16; ++mi) vv[mi] = __builtin_nontemporal_load((const f32x4*)(vbase + (size_t)mi * (NH * HD)));
            __syncthreads();
            float mx = fmaxf(fmaxf(sS[lane], sS[lane + 64]), fmaxf(sS[lane + 128], sS[lane + 192]));
            mx = wave_max(mx);
            float sm = __expf(sS[lane] - mx) + __expf(sS[lane + 64] - mx) + __expf(sS[lane + 128] - mx) + __expf(sS[lane + 192] - mx);
            sm = wave_sum(sm);
            const float inv = 1.0f / sm;
            f32x4 o = (f32x4){0.f, 0.f, 0.f, 0.f};
            f32x4 vw[16];
#pragma unroll
            for (int mi = 0; mi < 16; ++mi) vw[mi] = __builtin_nontemporal_load((const f32x4*)(vbase + (size_t)(16 + mi) * (NH * HD)));
#pragma unroll
            for (int mi = 0; mi < 16; ++mi) { const float p = __expf(sS[32 * wave + mi] - mx) * inv; o += vv[mi] * p; }
#pragma unroll
            for (int mi = 0; mi < 16; ++mi) { const float p = __expf(sS[32 * wave + 16 + mi] - mx) * inv; o += vw[mi] * p; }
            *(LAS f32x4*)(sO + wave * 256 + 4 * lane) = o;
            __syncthreads();
            if (tid < 256) {
                float a = 0.f;
#pragma unroll
                for (int w = 0; w < 8; ++w) a += sO[w * 256 + tid];
                YS[(size_t)(MP + b) * 3072 + 2048 + h * HD + tid] = (bf16_t)(cvt_pk_bf16(a, 0.f) & 0xffffu);
            }
            __syncthreads();
        }
}

__global__ void __launch_bounds__(NTHREADS, 2) fwd_kernel(Params P) {
    extern __shared__ __attribute__((aligned(16))) unsigned char lds_raw[];
    LAS unsigned char* lds = (LAS unsigned char*)lds_raw;
    cg::grid_group grid = cg::this_grid();
    const int tid = threadIdx.x, lane = tid & 63, wave = __builtin_amdgcn_readfirstlane(tid >> 6);
    const int G = gridDim.x, bid = blockIdx.x;
    const int gw = bid * NWAVES + wave, NGW = G * NWAVES;
    float* out = P.out;
    volatile LAS unsigned* bst = (volatile LAS unsigned*)(lds + LDS_BYTES - 64);
    if (tid == 0) { bst[0] = 0u; bst[1] = 0u; }
    __syncthreads();
    const XcdBarrier gbar = xcd_barrier_post((unsigned*)(P.ws + WS_BAR), bst);
#define GRID_BAR() xcd_barrier(gbar)

    if (PHON(0)) {
        LAS float* scr = (LAS float*)(lds + wave * 16384);
        constexpr int IT_GU = (D / 64) * (NZ / 32), IT_DN = (FF / 64) * (D / 32), IT_SQ = (D / 64) * (D / 32), IT_BR = (BW / 64) * (D / 32), IT_LR = 2 * 4;
        constexpr int IT_TOTAL = 3 * IT_GU + 2 * IT_DN + 2 * IT_SQ + 3 * IT_BR + 16 * IT_LR;
        for (int it = gw; it < IT_TOTAL; it += NGW) {
            int r = it; const float* W; bf16_t* WT; int N, ldk, mode = 0; const float* fg = nullptr; const float* fb = nullptr; float* cs = nullptr;
            if (r < IT_GU) { W = P.in[I_WIN]; WT = WIN; N = NZ; ldk = D; fg = P.in[I_LN1G]; fb = P.in[I_LN1B]; cs = CSUM; }
            else if ((r -= IT_GU) < IT_SQ) { W = P.in[I_WKV]; WT = WKV; N = D; ldk = D; }
            else if ((r -= IT_SQ) < 3 * IT_BR) { const int k = r / IT_BR; r -= k * IT_BR; W = P.in[I_WBR] + (size_t)k * BW * D; WT = WBR + (size_t)k * D * BW; N = D; ldk = BW; }
            else if ((r -= 3 * IT_BR) < IT_SQ) { W = P.in[I_WOUT]; WT = WOUT; N = D; ldk = D; }
            else if ((r -= IT_SQ) < IT_GU) { W = P.in[I_GU2]; WT = WGU2; N = NZ; ldk = D; mode = 1; fg = P.in[I_LN2G]; fb = P.in[I_LN2B]; cs = CSUM + 2 * NZ; }
            else if ((r -= IT_GU) < IT_DN) { W = P.in[I_DN2]; WT = WD2; N = D; ldk = FF; }
            else if ((r -= IT_DN) < 16 * IT_LR) { const int m = r / IT_LR; r -= m * IT_LR; const int k = m >> 1, x = m & 1;
                W = (x ? P.in[I_LWX] : P.in[I_LWA]) + (size_t)k * 128 * 128; WT = WLRU + (size_t)k * 256 * 128 + x * 128 * 128; N = 128; ldk = 128; }
            else if ((r -= 16 * IT_LR) < IT_DN) { W = P.in[I_DN1]; WT = WD1; N = D; ldk = FF; }
            else { r -= IT_DN; W = P.in[I_GU1]; WT = WGU1; N = NZ; ldk = D; mode = 1; }
            const int nblk = N / 32, kb = r / nblk, nb = r % nblk, n0 = 32 * nb;
            int dr = n0;
            if (mode == 1) dr = (n0 < FF) ? (n0 / 128) * 256 + (n0 % 128) : ((n0 - FF) / 128) * 256 + 128 + ((n0 - FF) % 128);
            transpose_item(W, N, WT, ldk, 64 * kb, n0, dr, scr, lane, fg, fb, cs);
        }
        for (int i = gw * 64 + lane; i < 4 * 128 * 128; i += NGW * 64) { const int t = (i >> 7) & 127, s = i & 127; const float w = P.in[I_WS][i]; WSP[i] = (bf16_t)(cvt_pk_bf16(s <= t ? w : 0.f, 0.f) & 0xffffu); }
        for (size_t i = (size_t)gw * 64 + lane; i < (size_t)MPAD * D / 8; i += (size_t)NGW * 64) {
            const size_t e = i * 8; const int r = (int)(e / D);
            u32x4 w = (u32x4){0u, 0u, 0u, 0u};
            if (r < MR) { const float* src = (r < MP) ? P.in[I_XP] + e : P.in[I_XS] + (e - (size_t)MP * D);
                const f32x4 a = __builtin_nontemporal_load((const f32x4*)src), b = __builtin_nontemporal_load((const f32x4*)(src + 4));
                w.x = cvt_pk_bf16(a[0], a[1]); w.y = cvt_pk_bf16(a[2], a[3]); w.z = cvt_pk_bf16(b[0], b[1]); w.w = cvt_pk_bf16(b[2], b[3]); }
            *(u32x4*)(XB + e) = w;
        }
        for (int r = gw; r < 1024; r += NGW) ln_row(P.in[I_MEM] + (size_t)r * D, P.in[I_MLNG], P.in[I_MLNB], nullptr, MEMLN + (size_t)r * D, lane);
    }
    if (P.ws == nullptr) grid.sync();
    GRID_BAR();

    if (PHON(1)) {
        pg8::PlainSched S{XB, WGU1, 33, 44, D, D, G, bid};
        pg8::EpiSwiglu E{H, FF, nullptr, nullptr};
        pg8::gemm_phase<pg8::PlainSched, pg8::EpiSwiglu, true, true>(lds, D, D, D, S, E);
    }
    GRID_BAR();
    if (PHON(2)) {
        skinny<0>(lds, bid, G, wave, lane, H + (size_t)MP * FF, FF, WD1, FF, FF, Y + (size_t)MP * D, P.in[I_XS], ALPHA, 0.5f, nullptr, nullptr, nullptr, nullptr, nullptr, XB + (size_t)MP * D, RSUM + 2 * (size_t)MP);
        pg8::PlainSched S{H, WD1, 32, 8, FF, FF, G, bid};
        pg8::EpiResid E{Y, P.in[I_XP], nullptr, nullptr, nullptr, ALPHA, 0.5f, XB, RSUM, true};
        pg8::gemm_phase<pg8::PlainSched, pg8::EpiResid, true, true>(lds, FF, FF, FF, S, E);
    }
    GRID_BAR();

    if (PHON(4)) {
        LAS float* gbl = (LAS float*)(lds + 131072);
        for (int i = tid; i < 3 * D / 4; i += NTHREADS) *(LAS f32x4*)(gbl + 4 * i) = *(const f32x4*)(P.in[I_GATEB] + 4 * i);
        __syncthreads();
        pg8::WinSched S{XB, WIN, MEMLN, WKV, G, bid};
        pg8::EpiWin E{Z, gbl, out + O_MK, out + O_MV, KB, VT, RSUM, CSUM};
        pg8::gemm_phase<pg8::WinSched, pg8::EpiWin, true, true>(lds, D, D, D, S, E);
    }
    GRID_BAR();

    const bool dfirst_ = ((bid >> 5) & 1) != 0;
    if (dfirst_ && PHON(8)) p5d_sample_attn(P, lds, bid, G, tid);
    if (PHON(5)) for (int r = gw; r < MR; r += NGW) {
        const bf16_t* zr = Z + (size_t)r * NZ + 1024;
        float v[16]; float s = 0.f;
#pragma unroll
        for (int h = 0; h < 2; ++h) { const u32x4 w = *(const u32x4*)(zr + 8 * lane + 512 * h);
            v[8 * h + 0] = bflo(w.x); v[8 * h + 1] = bfhi(w.x); v[8 * h + 2] = bflo(w.y); v[8 * h + 3] = bfhi(w.y); v[8 * h + 4] = bflo(w.z); v[8 * h + 5] = bfhi(w.z); v[8 * h + 6] = bflo(w.w); v[8 * h + 7] = bfhi(w.w); }
#pragma unroll
        for (int j = 0; j < 16; ++j) s += v[j];
        const float mean = wave_sum(s) * (1.f / BW); float s2 = 0.f;
#pragma unroll
        for (int j = 0; j < 16; ++j) { v[j] -= mean; s2 += v[j] * v[j]; }
        const float rstd = 1.0f / sqrtf(wave_sum(s2) * (1.f / BW) + LN_EPS);
#pragma unroll
        for (int h = 0; h < 2; ++h) {
            const int c0 = 8 * lane + 512 * h; float o[8];
#pragma unroll
            for (int j = 0; j < 8; ++j) o[j] = v[8 * h + j] * rstd * P.in[I_GLNG][c0 + j] + P.in[I_GLNB][c0 + j];
            u32x4 w; w.x = cvt_pk_bf16(o[0], o[1]); w.y = cvt_pk_bf16(o[2], o[3]); w.z = cvt_pk_bf16(o[4], o[5]); w.w = cvt_pk_bf16(o[6], o[7]);
            *(u32x4*)(VP + (size_t)r * BW + c0) = w;
            if (r >= MP) { float* ov = out + O_VS + (size_t)(r - MP) * BW + c0; *(f32x4*)ov = (f32x4){o[0], o[1], o[2], o[3]}; *(f32x4*)(ov + 4) = (f32x4){o[4], o[5], o[6], o[7]}; }
        }
    }
    if (PHON(6)) {
        LAS bf16_t* XCB = (LAS bf16_t*)lds;
        LAS float* AARR = (LAS float*)lds;
        LAS float* XCF = (LAS float*)(lds + 65536);
        for (int it = bid; it < 65 * 8; it += G) {
            const int c = it >> 3, k = it & 7; const bool smp = (c == 64);
            const int r0 = c * 128, ch0 = k * 128;
            int lane_o = lane; asm volatile("" : "+v"(lane_o));
            const int fr = lane_o & 15, fq = lane_o >> 4, rh = wave >> 2, cq = wave & 3;
            bf16x8 wfr[4][4];
            {
                const bf16_t* wb = WLRU + (size_t)k * 256 * 128;
#pragma unroll
                for (int ct = 0; ct < 4; ++ct)
#pragma unroll
                    for (int ks = 0; ks < 4; ++ks) wfr[ct][ks] = *(const bf16x8*)(wb + (size_t)((ct >> 1) * 128 + 32 * cq + 16 * (ct & 1) + fr) * 128 + ks * 32 + fq * 8);
            }
            LAS float* prm = (LAS float*)(lds + 131072 + 4096);
            if (tid < 128) { prm[tid] = P.in[I_LBA][ch0 + tid]; prm[128 + tid] = P.in[I_LBX][ch0 + tid]; prm[256 + tid] = __logf(1.0f + __expf(-P.in[I_LAM][ch0 + tid])); }
            {
                const int c4 = (tid & 31) * 4, rg = tid >> 5;
                const int ch = ch0 + c4;
                const f32x4 w0 = *(const f32x4*)(P.in[I_CONVW] + 0 * BW + ch), w1 = *(const f32x4*)(P.in[I_CONVW] + 1 * BW + ch), w2 = *(const f32x4*)(P.in[I_CONVW] + 2 * BW + ch), w3 = *(const f32x4*)(P.in[I_CONVW] + 3 * BW + ch);
                const f32x4 cb = *(const f32x4*)(P.in[I_CONVB] + ch);
                if (!smp) {
                    const bool first = ((c & 15) == 0);
                    const int rs = rg * 8;
                    const bool hist = !(first && rs == 0);
                    u32x2 zr[11];
#pragma unroll
                    for (int i = 0; i < 11; ++i) { zr[i] = (u32x2){0u, 0u}; if (i >= 3 || hist) zr[i] = *(const u32x2*)(Z + (size_t)(r0 + rs - 3 + i) * NZ + 2048 + ch); }
#define ZF(i) ((f32x4){bflo(zr[i].x), bfhi(zr[i].x), bflo(zr[i].y), bfhi(zr[i].y)})
#pragma unroll
                    for (int i = 0; i < 8; ++i) {
                        const int row = rs + i;
                        const f32x4 x0 = ZF(i + 3);
                        const f32x4 xc = cb + w3 * x0 + w2 * ZF(i + 2) + w1 * ZF(i + 1) + w0 * ZF(i);
                        *(LAS f32x4*)(XCF + row * 128 + c4) = xc;
                        u32x2 w; w.x = cvt_pk_bf16(xc[0], xc[1]); w.y = cvt_pk_bf16(xc[2], xc[3]);
                        *(LAS u32x2*)(XCB + row * 136 + c4) = w;
                        if ((c & 15) == 15 && row >= 125) *(f32x4*)(out + O_CP + (size_t)((c >> 4) * 3 + (row - 125)) * BW + ch) = x0;
                    }
#undef ZF
                } else {
#pragma unroll 4
                    for (int i = 0; i < 8; ++i) {
                        const int row = rg * 8 + i;
                        const float* sc = P.in[I_SCONV] + (size_t)row * 3 * BW + ch;
                        const f32x4 b0 = *(const f32x4*)sc, b1 = *(const f32x4*)(sc + BW), b2 = *(const f32x4*)(sc + 2 * BW);
                        const u32x2 a = *(const u32x2*)(Z + (size_t)(MP + row) * NZ + 2048 + ch);
                        const f32x4 x0 = (f32x4){bflo(a.x), bfhi(a.x), bflo(a.y), bfhi(a.y)};
                        const f32x4 xc = cb + w3 * x0 + w2 * b2 + w1 * b1 + w0 * b0;
                        *(LAS f32x4*)(XCF + row * 128 + c4) = xc;
                        u32x2 w; w.x = cvt_pk_bf16(xc[0], xc[1]); w.y = cvt_pk_bf16(xc[2], xc[3]);
                        *(LAS u32x2*)(XCB + row * 136 + c4) = w;
                        float* oc = out + O_CS + (size_t)row * 3 * BW + ch;
                        *(f32x4*)oc = b1; *(f32x4*)(oc + BW) = b2; *(f32x4*)(oc + 2 * BW) = x0;
                    }
                }
            }
            __syncthreads();
            f32x4 ga[4][4];
#pragma unroll
            for (int rt = 0; rt < 4; ++rt)
#pragma unroll
                for (int ct = 0; ct < 4; ++ct) ga[rt][ct] = (f32x4){0.f, 0.f, 0.f, 0.f};
#pragma unroll
            for (int rt = 0; rt < 4; ++rt) {
                bf16x8 af[4];
#pragma unroll
                for (int ks = 0; ks < 4; ++ks) af[ks] = *(const LAS bf16x8*)(XCB + (64 * rh + 16 * rt + fr) * 136 + ks * 32 + fq * 8);
#pragma unroll
                for (int ct = 0; ct < 4; ++ct)
#pragma unroll
                    for (int ks = 0; ks < 4; ++ks) ga[rt][ct] = __builtin_amdgcn_mfma_f32_16x16x32_bf16(af[ks], wfr[ct][ks], ga[rt][ct], 0, 0, 0);
            }
            __syncthreads();
            if (smp) {
#pragma unroll
                for (int cl = 0; cl < 2; ++cl) {
                    const int chl = 32 * cq + 16 * cl + fr, chg = ch0 + chl;
#pragma unroll
                    for (int rt = 0; rt < 4; ++rt)
#pragma unroll
                        for (int j = 0; j < 4; ++j) {
                            const int row = 64 * rh + 16 * rt + 4 * fq + j; const size_t o = (size_t)row * BW + chg;
                            GSB[o] = ga[rt][cl][j]; GSB[(size_t)MS * BW + o] = ga[rt][2 + cl][j]; GSB[(size_t)2 * MS * BW + o] = XCF[row * 128 + chl];
                        }
                }
            } else {
#pragma unroll
            for (int cl = 0; cl < 2; ++cl) {
                const int chl = 32 * cq + 16 * cl + fr;
                const float ba = prm[chl], bx = prm[128 + chl], sp = prm[256 + chl];
#pragma unroll
                for (int rt = 0; rt < 4; ++rt)
#pragma unroll
                    for (int j = 0; j < 4; ++j) {
                        const int row = 64 * rh + 16 * rt + 4 * fq + j;
                        const float rr = sigmoidf_(ga[rt][cl][j] + ba), ii = sigmoidf_(ga[rt][2 + cl][j] + bx);
                        const float la = -8.0f * rr * sp;
                        const float a = __expf(la);
                        const float xc = XCF[row * 128 + chl];
                        const float bt = __builtin_amdgcn_sqrtf(fmaxf(1.0f - a * a, 0.f)) * (ii * xc);
                        AARR[row * 128 + chl] = a; XCF[row * 128 + chl] = bt;
                    }
            }
            }
            __syncthreads();
            if (!smp) {
                {
                    LAS float* segA = (LAS float*)(lds + 131072); LAS float* segH = segA + 512;
                    const int seg = tid >> 7, chn = tid & 127;
                    float h = 0.f, pa = 1.f;
#pragma unroll 8
                    for (int i = 0; i < 32; ++i) { const int o = (32 * seg + i) * 128 + chn; const float a = AARR[o], b = XCF[o]; h = a * h + b; pa *= a; XCF[o] = h; AARR[o] = pa; }
                    segA[tid] = pa; segH[tid] = h;
                    __syncthreads();
                    float cA = 1.f, cH = 0.f;
                    for (int sg = 0; sg < seg; ++sg) { const float sa = segA[sg * 128 + chn]; cH = sa * cH + segH[sg * 128 + chn]; cA *= sa; }
                    if (seg > 0) {
#pragma unroll 8
                        for (int i = 0; i < 32; ++i) { const int o = (32 * seg + i) * 128 + chn; const float hl = XCF[o], pc = AARR[o]; XCF[o] = hl + pc * cH; AARR[o] = pc * cA; }
                    }
                    if (seg == 3) { SUM[(size_t)(c * 2 + 0) * BW + ch0 + chn] = pa * cA; SUM[(size_t)(c * 2 + 1) * BW + ch0 + chn] = h + pa * cH; }
                }
                __syncthreads();
                {
                    u32x2 rgz[8];
#pragma unroll
                    for (int i = 0; i < 8; ++i) { const int e = (i * 512 + tid) * 4, row = e >> 7, cc = e & 127; rgz[i] = *(const u32x2*)(Z + (size_t)(r0 + row) * NZ + 3072 + ch0 + cc); }
#pragma unroll
                    for (int i = 0; i < 8; ++i) { const int e = (i * 512 + tid) * 4, row = e >> 7, cc = e & 127;
                        const f32x4 g4 = (f32x4){bflo(rgz[i].x), bfhi(rgz[i].x), bflo(rgz[i].y), bfhi(rgz[i].y)};
                        const f32x4 a1 = g4 * *(const LAS f32x4*)(XCF + e), a2 = g4 * *(const LAS f32x4*)(AARR + e);
                        u32x2 w1, w2; w1.x = cvt_pk_bf16(a1[0], a1[1]); w1.y = cvt_pk_bf16(a1[2], a1[3]); w2.x = cvt_pk_bf16(a2[0], a2[1]); w2.y = cvt_pk_bf16(a2[2], a2[3]);
                        *(u32x2*)(U1 + (size_t)(r0 + row) * BW + ch0 + cc) = w1; *(u32x2*)(U2 + (size_t)(r0 + row) * BW + ch0 + cc) = w2; }
                }
            }
            __syncthreads();
        }
    }
    if (PHON(7)) for (int it = bid; it < 256; it += G) {
        const int b = it >> 6, h = (it >> 4) & 3, qt = it & 15;
        int lane_o = lane; asm volatile("" : "+v"(lane_o));
        const int fr = lane_o & 15, fq = lane_o >> 4;
        const int row0 = b * SEQ + qt * 128 + wave * 16;
        bf16x8 qf[8];
#pragma unroll
        for (int ks = 0; ks < 8; ++ks) qf[ks] = *(const bf16x8*)(Z + (size_t)(row0 + fr) * NZ + 4096 + h * HD + ks * 32 + fq * 8);
        f32x4 s[16];
        LAS bf16_t* KL = (LAS bf16_t*)lds;
        __syncthreads();
        {
            const bf16_t* kb = KB + (size_t)(b * NMEM) * 1024 + h * HD;
            u32x4 t[16];
#pragma unroll
            for (int i = 0; i < 16; ++i) { const int e = tid + i * NTHREADS, m = e >> 5, c8 = (e & 31) * 8; t[i] = *(const u32x4*)(kb + (size_t)m * 1024 + c8); }
#pragma unroll
            for (int i = 0; i < 16; ++i) { const int e = tid + i * NTHREADS, m = e >> 5, c8 = (e & 31) * 8; *(LAS u32x4*)(KL + m * 264 + c8) = t[i]; }
        }
        asm volatile("" ::: "memory");
        u32x4 tv[16];
        {
            const bf16_t* vt0 = VT + (size_t)(h * HD) * 1024 + b * NMEM;
#pragma unroll
            for (int i = 0; i < 16; ++i) { const int e = tid + i * NTHREADS, dd = e >> 5, c8 = (e & 31) * 8; tv[i] = *(const u32x4*)(vt0 + (size_t)dd * 1024 + c8); }
        }
        __syncthreads();
#pragma unroll
        for (int mt = 0; mt < 16; ++mt) {
            s[mt] = (f32x4){0.f, 0.f, 0.f, 0.f};
#pragma unroll
            for (int ks = 0; ks < 8; ++ks) {
                const bf16x8 kf = *(const LAS bf16x8*)(KL + (mt * 16 + fr) * 264 + ks * 32 + fq * 8);
                s[mt] = __builtin_amdgcn_mfma_f32_16x16x32_bf16(kf, qf[ks], s[mt], 0, 0, 0);
            }
        }
        __syncthreads();
#pragma unroll
        for (int i = 0; i < 16; ++i) { const int e = tid + i * NTHREADS, dd = e >> 5, c8 = (e & 31) * 8; *(LAS u32x4*)(KL + dd * 264 + c8) = tv[i]; }
        float mx = -3.0e38f;
#pragma unroll
        for (int mt = 0; mt < 16; ++mt) mx = fmaxf(mx, fmaxf(fmaxf(s[mt][0], s[mt][1]), fmaxf(s[mt][2], s[mt][3])));
        mx = fmaxf(mx, __shfl_xor(mx, 16)); mx = fmaxf(mx, __shfl_xor(mx, 32));
        float sm = 0.f;
#pragma unroll
        for (int mt = 0; mt < 16; ++mt)
#pragma unroll
            for (int j = 0; j < 4; ++j) { const float p = __expf((s[mt][j] - mx) * 0.0625f); s[mt][j] = p; sm += p; }
        sm += __shfl_xor(sm, 16); sm += __shfl_xor(sm, 32);
        const float inv = 1.0f / sm;
        bf16x8 pf[8];
#pragma unroll
        for (int ks = 0; ks < 8; ++ks) {
            u32x4 w; w.x = cvt_pk_bf16(s[2 * ks][0], s[2 * ks][1]); w.y = cvt_pk_bf16(s[2 * ks][2], s[2 * ks][3]); w.z = cvt_pk_bf16(s[2 * ks + 1][0], s[2 * ks + 1][1]); w.w = cvt_pk_bf16(s[2 * ks + 1][2], s[2 * ks + 1][3]);
            pf[ks] = __builtin_bit_cast(bf16x8, w);
        }
        __syncthreads();
#pragma unroll 4
        for (int dt = 0; dt < 16; ++dt) {
            f32x4 o = (f32x4){0.f, 0.f, 0.f, 0.f};
#pragma unroll
            for (int ks = 0; ks < 8; ++ks) {
                const LAS bf16_t* vp = KL + (dt * 16 + fr) * 264 + ks * 32 + 4 * fq;
                const u32x2 lo = *(const LAS u32x2*)vp, hi = *(const LAS u32x2*)(vp + 16);
                const u32x4 w = (u32x4){lo.x, lo.y, hi.x, hi.y};
                o = __builtin_amdgcn_mfma_f32_16x16x32_bf16(__builtin_bit_cast(bf16x8, w), pf[ks], o, 0, 0, 0);
            }
            u32x2 w; w.x = cvt_pk_bf16(o[0] * inv, o[1] * inv); w.y = cvt_pk_bf16(o[2] * inv, o[3] * inv);
            *(u32x2*)(YS + (size_t)(row0 + fr) * 3072 + 2048 + h * HD + dt * 16 + 4 * fq) = w;
        }
    }
    if (!dfirst_ && PHON(8)) p5d_sample_attn(P, lds, bid, G, tid);
    GRID_BAR();

    if (PHON(9)) for (int it = bid; it < 256; it += G) {
        const int c = it >> 2, rq = it & 3, n = c & 15, cb = c & ~15;
        const int ch = 4 * (tid & 255), rhf = tid >> 8;
        f32x4 carry = (f32x4){0.f, 0.f, 0.f, 0.f};
        {
            f32x4 pa[15], hh[15];
#pragma unroll
            for (int j = 0; j < 15; ++j) { pa[j] = (f32x4){1.f, 1.f, 1.f, 1.f}; hh[j] = (f32x4){0.f, 0.f, 0.f, 0.f};
                if (j < n) { pa[j] = *(const f32x4*)(SUM + (size_t)((cb + j) * 2 + 0) * BW + ch); hh[j] = *(const f32x4*)(SUM + (size_t)((cb + j) * 2 + 1) * BW + ch); } }
#pragma unroll
            for (int j = 0; j < 15; ++j) carry = pa[j] * carry + hh[j];
        }
        const int rbase = c * 128 + rq * 32 + rhf * 16;
        u32x2 v1[16], v2[16];
#pragma unroll
        for (int i = 0; i < 16; ++i) { v1[i] = *(const u32x2*)(U1 + (size_t)(rbase + i) * BW + ch); v2[i] = *(const u32x2*)(U2 + (size_t)(rbase + i) * BW + ch); }
#pragma unroll
        for (int i = 0; i < 16; ++i) {
            const f32x4 a1 = (f32x4){bflo(v1[i].x), bfhi(v1[i].x), bflo(v1[i].y), bfhi(v1[i].y)}, a2 = (f32x4){bflo(v2[i].x), bfhi(v2[i].x), bflo(v2[i].y), bfhi(v2[i].y)};
            const f32x4 y = a1 + a2 * carry;
            u32x2 w; w.x = cvt_pk_bf16(y[0], y[1]); w.y = cvt_pk_bf16(y[2], y[3]);
            *(u32x2*)(YS + (size_t)(rbase + i) * 3072 + 1024 + ch) = w;
        }
        if (n == 15 && rq == 3 && rhf == 1) {
            const f32x4 pe = *(const f32x4*)(SUM + (size_t)(c * 2 + 0) * BW + ch), he = *(const f32x4*)(SUM + (size_t)(c * 2 + 1) * BW + ch);
            *(f32x4*)(out + O_HP + (size_t)(c >> 4) * BW + ch) = he + pe * carry;
        }
    }
    if (PHON(9)) for (int e = bid * NTHREADS + tid; e < MS * BW; e += G * NTHREADS) {
        const int row = e >> 10, ch = e & (BW - 1);
        const float rr = sigmoidf_(GSB[e] + P.in[I_LBA][ch]), ii = sigmoidf_(GSB[(size_t)MS * BW + e] + P.in[I_LBX][ch]);
        const float la = -8.0f * rr * __logf(1.0f + __expf(-P.in[I_LAM][ch]));
        const float a = __expf(la);
        const float h = a * P.in[I_SLRU][e] + __builtin_amdgcn_sqrtf(fmaxf(1.0f - a * a, 0.f)) * (ii * GSB[(size_t)2 * MS * BW + e]);
        out[O_HS + e] = h;
        const float rgv = bf2f(Z[(size_t)(MP + row) * NZ + 3072 + ch]);
        YS[(size_t)(MP + row) * 3072 + 1024 + ch] = (bf16_t)(cvt_pk_bf16(rgv * h, 0.f) & 0xffffu);
    }
    if (PHON(10)) {
        LAS bf16_t* VL = (LAS bf16_t*)lds;
        for (int e = bid * NTHREADS + tid; e < MS * BW / 2; e += G * NTHREADS) {
            const int r = e / (BW / 2), c2 = (e % (BW / 2)) * 2, g = c2 >> 8;
            const float w00 = P.in[I_WS][(size_t)g * 128 * 128], b0 = P.in[I_BS][g * 128];
            const unsigned vw = *(const unsigned*)(VP + (size_t)(MP + r) * BW + c2), uw = *(const unsigned*)(Z + (size_t)(MP + r) * NZ + c2);
            *(unsigned*)(YS + (size_t)(MP + r) * 3072 + c2) = cvt_pk_bf16(bflo(uw) * (w00 * bflo(vw) + b0), bfhi(uw) * (w00 * bfhi(vw) + b0));
        }
        for (int it = bid; it < 256; it += G) {
            const int g = it & 3, cn = it >> 2;
            const int r0 = cn * 128;
            __syncthreads();
            {
                u32x4 vt8[8];
#pragma unroll
                for (int i = 0; i < 8; ++i) { const int e = tid + i * NTHREADS, s = e >> 5, c8 = (e & 31) * 8; vt8[i] = *(const u32x4*)(VP + (size_t)(r0 + s) * BW + g * 256 + c8); }
#pragma unroll
                for (int i = 0; i < 8; ++i) { const int e = tid + i * NTHREADS, s = e >> 5, c8 = (e & 31) * 8; *(LAS u32x4*)(VL + s * 264 + c8) = vt8[i]; }
            }
            __syncthreads();
            const int fr = lane & 15, fq = lane >> 4;
            bf16x8 vf[2][4];
#pragma unroll
            for (int ct = 0; ct < 2; ++ct)
#pragma unroll
                for (int ks = 0; ks < 4; ++ks) {
                    bf16x8 t;
#pragma unroll
                    for (int j = 0; j < 8; ++j) t[j] = (short)VL[(ks * 32 + fq * 8 + j) * 264 + (2 * wave + ct) * 16 + fr];
                    vf[ct][ks] = t;
                }
            const bf16_t* wsp = WSP + (size_t)g * 128 * 128;
            u32x2 uwp[8][2];
#pragma unroll
            for (int tt = 0; tt < 8; ++tt)
#pragma unroll
                for (int ct = 0; ct < 2; ++ct) uwp[tt][ct] = *(const u32x2*)(Z + (size_t)(r0 + tt * 16 + fr) * NZ + g * 256 + (2 * wave + ct) * 16 + 4 * fq);
#pragma unroll
            for (int tt = 0; tt < 8; ++tt) {
                f32x4 o0 = (f32x4){0.f, 0.f, 0.f, 0.f}, o1 = o0;
#pragma unroll
                for (int ks = 0; ks < 4; ++ks) {
                    const bf16x8 wf = *(const bf16x8*)(wsp + (size_t)(tt * 16 + fr) * 128 + ks * 32 + fq * 8);
                    o0 = __builtin_amdgcn_mfma_f32_16x16x32_bf16(vf[0][ks], wf, o0, 0, 0, 0);
                    o1 = __builtin_amdgcn_mfma_f32_16x16x32_bf16(vf[1][ks], wf, o1, 0, 0, 0);
                }
                if ((tt & 3) == 3) asm volatile("" ::: "memory");
                const int t = tt * 16 + fr; const float bs = P.in[I_BS][g * 128 + t];
                const size_t r = (size_t)(r0 + t);
#pragma unroll
                for (int ct = 0; ct < 2; ++ct) {
                    const f32x4 o = ct ? o1 : o0;
                    const int cc = g * 256 + (2 * wave + ct) * 16 + 4 * fq;
                    const u32x2 uw = uwp[tt][ct];
                    u32x2 w; w.x = cvt_pk_bf16(bflo(uw.x) * (o[0] + bs), bfhi(uw.x) * (o[1] + bs)); w.y = cvt_pk_bf16(bflo(uw.y) * (o[2] + bs), bfhi(uw.y) * (o[3] + bs));
                    *(u32x2*)(YS + r * 3072 + cc) = w;
                }
            }
        }
        __syncthreads();
    }
    GRID_BAR();

    if (PHON(11)) {
        skinny<1>(lds, bid, G, wave, lane, YS + (size_t)MP * 3 * BW, 3 * BW, WBR, BW, BW, nullptr, nullptr, 0.f, 0.f, Z + (size_t)MP * NZ, XB + (size_t)MP * D, nullptr, nullptr, nullptr, nullptr, nullptr);
        pg8::BranchSched S{YS, WBR, G, bid};
        pg8::EpiMerge E{Z, XB};
        pg8::gemm_phase<pg8::BranchSched, pg8::EpiMerge, true, true>(lds, BW, 3 * BW, BW, S, E);
    }
    GRID_BAR();
    if (PHON(12)) {
        skinny<0>(lds, bid, G, wave, lane, XB + (size_t)MP * D, D, WOUT, D, D, Y + (size_t)MP * D, Y + (size_t)MP * D, ALPHA, 1.0f, nullptr, nullptr, RSUM + 2 * (size_t)MP, P.in[I_LN1G], P.in[I_LN1B], YB2 + (size_t)MP * D, RSUM + 2 * (size_t)(MPAD + MP));
        pg8::PlainSched S{XB, WOUT, 32, 8, D, D, G, bid};
        pg8::EpiResid E{Y, Y, RSUM, P.in[I_LN1G], P.in[I_LN1B], ALPHA, 1.0f, YB2, RSUM + 2 * (size_t)MPAD, false};
        pg8::gemm_phase<pg8::PlainSched, pg8::EpiResid, true, true>(lds, D, D, D, S, E);
    }
    GRID_BAR();
    if (PHON(14)) {
        pg8::PlainSched S{YB2, WGU2, 33, 44, D, D, G, bid};
        pg8::EpiSwiglu E{H, FF, RSUM + 2 * (size_t)MPAD, CSUM + 2 * NZ};
        pg8::gemm_phase<pg8::PlainSched, pg8::EpiSwiglu, true, true>(lds, D, D, D, S, E);
    }
    GRID_BAR();
    if (PHON(15)) {
        skinny<0>(lds, bid, G, wave, lane, H + (size_t)MP * FF, FF, WD2, FF, FF, Y + (size_t)MP * D, Y + (size_t)MP * D, ALPHA, 0.5f, nullptr, nullptr, RSUM + 2 * (size_t)(MPAD + MP), P.in[I_LN2G], P.in[I_LN2B], nullptr, nullptr);
        pg8::PlainSched S{H, WD2, 32, 8, FF, FF, G, bid};
        pg8::EpiResid E{Y, Y, RSUM + 2 * (size_t)MPAD, P.in[I_LN2G], P.in[I_LN2B], ALPHA, 0.5f, nullptr, nullptr, false};
        pg8::gemm_phase<pg8::PlainSched, pg8::EpiResid, true, true>(lds, FF, FF, FF, S, E);
    }
    GRID_BAR();
    if (PHON(16)) for (int r = gw; r < MR; r += NGW) ln_row(Y + (size_t)r * D, P.in[I_LN3G], P.in[I_LN3B], out + O_Y + (size_t)r * D, nullptr, lane);
}

extern "C" void kernel_launch(void* const* d_in, const int* in_sizes, int n_in, void* d_out, int out_size, void* d_ws, size_t ws_size, hipStream_t stream) {
    static int grid = 0;
    if (grid == 0) {
        if (n_in != 35 || (size_t)out_size != O_END || ws_size < WS_END) { fprintf(stderr, "kernel_launch: unexpected shapes: n_in %d out %d (want %zu) ws %zu (need %zu)\n", n_in, out_size, (size_t)O_END, ws_size, (size_t)WS_END); grid = -1; return; }
        int dev = 0, cus = 0, per_cu = 0;
        hipGetDevice(&dev);
        hipDeviceGetAttribute(&cus, hipDeviceAttributeMultiprocessorCount, dev);
        hipFuncSetAttribute((const void*)fwd_kernel, hipFuncAttributeMaxDynamicSharedMemorySize, LDS_BYTES);
        hipOccupancyMaxActiveBlocksPerMultiprocessor(&per_cu, (const void*)fwd_kernel, NTHREADS, LDS_BYTES);
        if (per_cu < 1) { fprintf(stderr, "kernel_launch: occupancy query says %d blocks/CU\n", per_cu); per_cu = 1; }
        (void)hipGetLastError();
        grid = cus;
    }
    if (grid < 0) return;
    Params p{};
    for (int i = 0; i < 35; ++i) p.in[i] = (const float*)d_in[i];
    p.out = (float*)d_out; p.ws = (unsigned char*)d_ws;
    (void)hipMemsetAsync((char*)d_ws + WS_BAR, 0, WS_GSB - WS_BAR, stream);
    void* args[] = {&p};
    hipError_t e = hipLaunchCooperativeKernel((const void*)fwd_kernel, dim3(grid), dim3(NTHREADS), args, LDS_BYTES, stream);
    if (e != hipSuccess) fprintf(stderr, "cooperative launch failed: %s (grid %d)\n", hipGetErrorString(e), grid);
}
```
